# Optimizing an MI355X kernel written in HIP

```python
import functools
import jax, jax.numpy as jnp
from jax import lax
import numpy as np

D_MODEL = 1024
BATCH = 8
SEQ = 2048
DEPTH = 2

CHUNK = 64
Q_BLOCK = 128
MLA_HEADS = 8
MLA_NOPE = 64
MLA_ROPE = 32
MLA_V = 64
Q_LORA = 384
KV_LORA = 256
ROPE_THETA = 10000.0
SB_HEADS = 8
SB_DIM = 64
C_HEADS = 16
C_DIM = 64
LEFT_CHUNKS = 8
BAND = (LEFT_CHUNKS + 1) * CHUNK
REL_CLIP = 256
D_FF = -(-8 * D_MODEL // (3 * 256)) * 256
EVEN_IN = Q_LORA + KV_LORA + MLA_ROPE + 3 * SB_HEADS * SB_DIM
MIX_EVEN = MLA_HEADS * MLA_V + SB_HEADS * SB_DIM
MIX_ODD = C_HEADS * C_DIM
N_EVEN = (DEPTH + 1) // 2
N_ODD = DEPTH // 2
RMS_EPS = 1e-6

kernel_name = "hybrid_mla_stickbreak_chunkband_encoder"


def rms_norm(x, g):
    x32 = x.astype(jnp.float32)
    y = x32 * lax.rsqrt(jnp.mean(x32 * x32, axis=-1, keepdims=True) + RMS_EPS)
    return (y * g.astype(jnp.float32)).astype(x.dtype)


def rope_tables(seq, dim):
    pos = jnp.arange(seq, dtype=jnp.float32)
    inv_freq = ROPE_THETA ** (-jnp.arange(0, dim, 2, dtype=jnp.float32) / dim)
    ang = pos[:, None] * inv_freq[None, :]
    return jnp.cos(ang), jnp.sin(ang)


def apply_rope(x, cos, sin):
    half = x.shape[-1] // 2
    c, s = cos.astype(x.dtype), sin.astype(x.dtype)
    x1, x2 = x[..., :half], x[..., half:]
    return jnp.concatenate([x1 * c - x2 * s, x2 * c + x1 * s], axis=-1)


def swiglu(u, w_gate, w_up, w_down):
    return (jax.nn.silu(u @ w_gate) * (u @ w_up)) @ w_down


def mla_stick_breaking_mixer(u, w_in, g_cq, w_uq, g_ckv, w_ukv, w_out):
    bsz, seq, _ = u.shape
    proj = u @ w_in
    o1 = Q_LORA
    o2 = o1 + KV_LORA
    o3 = o2 + MLA_ROPE
    nb = SB_HEADS * SB_DIM
    c_q, c_kv, k_r = proj[..., :o1], proj[..., o1:o2], proj[..., o2:o3]
    q_b = proj[..., o3:o3 + nb].reshape(bsz, seq, SB_HEADS, SB_DIM)
    k_b = proj[..., o3 + nb:o3 + 2 * nb].reshape(bsz, seq, SB_HEADS, SB_DIM)
    v_b = proj[..., o3 + 2 * nb:].reshape(bsz, seq, SB_HEADS, SB_DIM)

    cos, sin = rope_tables(seq, MLA_ROPE)
    q_a = (rms_norm(c_q, g_cq) @ w_uq).reshape(bsz, seq, MLA_HEADS, MLA_NOPE + MLA_ROPE)
    q_a = jnp.concatenate([q_a[..., :MLA_NOPE],
                           apply_rope(q_a[..., MLA_NOPE:], cos[:, None, :], sin[:, None, :])], axis=-1)
    kv = (rms_norm(c_kv, g_ckv) @ w_ukv).reshape(bsz, seq, MLA_HEADS, MLA_NOPE + MLA_V)
    k_rope = apply_rope(k_r, cos, sin)
    k_a = jnp.concatenate([kv[..., :MLA_NOPE],
                           jnp.broadcast_to(k_rope[:, :, None, :], (bsz, seq, MLA_HEADS, MLA_ROPE))], axis=-1)
    v_a = kv[..., MLA_NOPE:]
    scale_a = (MLA_NOPE + MLA_ROPE) ** -0.5
    scale_b = SB_DIM ** -0.5

    outs_a, outs_b = [], []
    for blk in range(seq // Q_BLOCK):
        t0 = blk * Q_BLOCK
        kend = t0 + Q_BLOCK
        t_pos = t0 + jnp.arange(Q_BLOCK)[:, None]
        s_pos = jnp.arange(kend)[None, :]
        s_a = jnp.einsum('bqhd,bkhd->bhqk', q_a[:, t0:kend], k_a[:, :kend]).astype(jnp.float32) * scale_a
        chunk_ok = (s_pos // CHUNK) <= (t_pos // CHUNK)
        p_a = jax.nn.softmax(jnp.where(chunk_ok, s_a, -jnp.inf), axis=-1)
        outs_a.append(jnp.einsum('bhqk,bkhd->bqhd', p_a.astype(v_a.dtype), v_a[:, :kend]))
        z = jnp.einsum('bqhd,bkhd->bhqk', q_b[:, t0:kend], k_b[:, :kend]).astype(jnp.float32) * scale_b
        before = s_pos < t_pos
        log_keep = jnp.where(before, jax.nn.log_sigmoid(-z), 0.0)
        log_between = lax.cumsum(log_keep, axis=3, reverse=True) - log_keep
        w_b = jnp.where(before, jnp.exp(jax.nn.log_sigmoid(z) + log_between), 0.0)
        outs_b.append(jnp.einsum('bhqk,bkhd->bqhd', w_b.astype(v_b.dtype), v_b[:, :kend]))

    o_a = jnp.concatenate(outs_a, axis=1).reshape(bsz, seq, MLA_HEADS * MLA_V)
    o_b = jnp.concatenate(outs_b, axis=1).reshape(bsz, seq, SB_HEADS * SB_DIM)
    return jnp.concatenate([o_a, o_b], axis=-1) @ w_out


def chunk_band_mixer(u, w_qkv, rel_bias, w_out):
    bsz, seq, _ = u.shape
    n_chunks = seq // CHUNK
    qkv = (u @ w_qkv).reshape(bsz, n_chunks, CHUNK, 3, C_HEADS, C_DIM)
    q, k, v = qkv[:, :, :, 0], qkv[:, :, :, 1], qkv[:, :, :, 2]
    pad = ((0, 0), (LEFT_CHUNKS, 0), (0, 0), (0, 0), (0, 0))
    k_p = jnp.pad(k, pad)
    v_p = jnp.pad(v, pad)
    scores = jnp.concatenate(
        [jnp.einsum('bnqhd,bnkhd->bnhqk', q, k_p[:, i:i + n_chunks]) for i in range(LEFT_CHUNKS + 1)],
        axis=-1).astype(jnp.float32) * (C_DIM ** -0.5)
    q_in = jnp.arange(CHUNK)[:, None]
    j = jnp.arange(BAND)[None, :]
    rel = (LEFT_CHUNKS - j // CHUNK) * CHUNK + q_in - j % CHUNK
    bias = rel_bias[:, jnp.clip(rel, -REL_CLIP, REL_CLIP) + REL_CLIP]
    valid = (jnp.arange(n_chunks)[:, None] - LEFT_CHUNKS + j // CHUNK) >= 0
    scores = scores + bias.astype(jnp.float32)[None, None]
    p = jax.nn.softmax(jnp.where(valid[None, :, None, None, :], scores, -jnp.inf), axis=-1).astype(v.dtype)
    parts = [jnp.einsum('bnhqk,bnkhd->bnqhd', p[..., i * CHUNK:(i + 1) * CHUNK], v_p[:, i:i + n_chunks])
             for i in range(LEFT_CHUNKS + 1)]
    o = functools.reduce(jnp.add, parts)
    return o.reshape(bsz, seq, MIX_ODD) @ w_out


def setup_inputs(seed: int = 0) -> dict:
    key = jax.random.key(seed)
    ks = jax.random.split(key, 17)
    f32 = jnp.float32

    def nrm(k, shape, fan_in):
        return jax.random.normal(k, shape, f32) * (fan_in ** -0.5)

    def gain(k, shape):
        return 1.0 + 0.05 * jax.random.normal(k, shape, f32)

    return {
        "x": jax.random.normal(ks[0], (BATCH, SEQ, D_MODEL), f32),
        "ev_w_in": nrm(ks[1], (N_EVEN, D_MODEL, EVEN_IN), D_MODEL),
        "ev_g_cq": gain(ks[2], (N_EVEN, Q_LORA)),
        "ev_w_uq": nrm(ks[3], (N_EVEN, Q_LORA, MLA_HEADS * (MLA_NOPE + MLA_ROPE)), Q_LORA),
        "ev_g_ckv": gain(ks[4], (N_EVEN, KV_LORA)),
        "ev_w_ukv": nrm(ks[5], (N_EVEN, KV_LORA, MLA_HEADS * (MLA_NOPE + MLA_V)), KV_LORA),
        "ev_w_out": nrm(ks[6], (N_EVEN, MIX_EVEN, D_MODEL), MIX_EVEN),
        "od_w_qkv": nrm(ks[7], (N_ODD, D_MODEL, 3 * MIX_ODD), D_MODEL),
        "od_rel_bias": 0.1 * jax.random.normal(ks[8], (N_ODD, C_HEADS, 2 * REL_CLIP + 1), f32),
        "od_w_out": nrm(ks[9], (N_ODD, MIX_ODD, D_MODEL), MIX_ODD),
        "g_mix": gain(ks[10], (DEPTH, D_MODEL)),
        "g_ffn": gain(ks[11], (DEPTH, D_MODEL)),
        "w_gate": nrm(ks[12], (DEPTH, D_MODEL, D_FF), D_MODEL),
        "w_up": nrm(ks[13], (DEPTH, D_MODEL, D_FF), D_MODEL),
        "w_down": nrm(ks[14], (DEPTH, D_FF, D_MODEL), D_FF),
        "g_final": gain(ks[15], (D_MODEL,)),
    }


def reference(x, ev_w_in, ev_g_cq, ev_w_uq, ev_g_ckv, ev_w_ukv, ev_w_out,
              od_w_qkv, od_rel_bias, od_w_out, g_mix, g_ffn, w_gate, w_up, w_down, g_final):
    h = x
    for layer in range(DEPTH):
        u = rms_norm(h, g_mix[layer])
        if layer % 2 == 0:
            i = layer // 2
            h = h + mla_stick_breaking_mixer(u, ev_w_in[i], ev_g_cq[i], ev_w_uq[i],
                                             ev_g_ckv[i], ev_w_ukv[i], ev_w_out[i])
        else:
            i = layer // 2
            h = h + chunk_band_mixer(u, od_w_qkv[i], od_rel_bias[i], od_w_out[i])
        u = rms_norm(h, g_ffn[layer])
        h = h + swiglu(u, w_gate[layer], w_up[layer], w_down[layer])
    return rms_norm(h, g_final)
```

```cpp
#include <hip/hip_runtime.h>
#include <hip/hip_cooperative_groups.h>
#include <cstdio>
#include <cstdint>
namespace cg = cooperative_groups;

#define LAS __attribute__((address_space(3)))
typedef unsigned short bf16_t;
typedef short bf16x8 __attribute__((ext_vector_type(8)));
typedef float f32x4 __attribute__((ext_vector_type(4)));
typedef float f32x2 __attribute__((ext_vector_type(2)));
typedef unsigned u32x4 __attribute__((ext_vector_type(4)));
typedef unsigned u32x2 __attribute__((ext_vector_type(2)));

constexpr int MTOK = 16384, SEQ = 2048, DM = 1024, DFF = 2816;
constexpr int NPROJ = 2208, NPROJ_P = 2304;
constexpr int C_CKV = 384, C_KR = 640, C_QB = 672, C_KB = 1184, C_VB = 1696;
constexpr int NQA = 768, NKVA = 1024, NQKV = 3072;
constexpr float RMS_EPS = 1e-6f;
constexpr float LOG2E = 1.4426950408889634f;
constexpr float QSCALE_A = 0.10206207261596577f * LOG2E;
constexpr float QSCALE_C = 0.125f * LOG2E;

constexpr size_t KiB = 1024, MiB = 1u << 20;
constexpr size_t WS_SSQ = 0;
constexpr size_t WS_ROPE = 512 * KiB;
constexpr size_t WS_WIN = 1 * MiB;
constexpr size_t WS_WUQ = WS_WIN + (size_t)NPROJ_P * DM * 2;
constexpr size_t WS_WUKV = WS_WUQ + (size_t)NQA * 384 * 2;
constexpr size_t WS_WO0 = WS_WUKV + (size_t)NKVA * 256 * 2;
constexpr size_t WS_WGU0 = WS_WO0 + (size_t)DM * DM * 2;
constexpr size_t WS_WD0 = WS_WGU0 + (size_t)2 * DFF * DM * 2;
constexpr size_t WS_WQKV = WS_WD0 + (size_t)DM * DFF * 2;
constexpr size_t WS_WO1 = WS_WQKV + (size_t)NQKV * DM * 2;
constexpr size_t WS_WGU1 = WS_WO1 + (size_t)DM * DM * 2;
constexpr size_t WS_WD1 = WS_WGU1 + (size_t)2 * DFF * DM * 2;
constexpr size_t WS_WEND = WS_WD1 + (size_t)DM * DFF * 2;
constexpr size_t WS_HB = 50 * MiB;
constexpr size_t WS_A = 82 * MiB;
constexpr size_t WS_ATT = 178 * MiB;
constexpr size_t WS_END = 210 * MiB;
static_assert(WS_WEND <= WS_HB, "weights fit");
constexpr size_t OUT_QA = 0, OUT_KVA = 24 * MiB;

constexpr int NTHREADS = 512;
constexpr int LDS_BYTES = 147456;

__device__ __forceinline__ unsigned cvt_pk_bf16(float lo, float hi) { unsigned r; asm volatile("v_cvt_pk_bf16_f32 %0, %1, %2" : "=v"(r) : "v"(lo), "v"(hi)); return r; }
__device__ __forceinline__ float bflo(unsigned w) { return __uint_as_float(w << 16); }
__device__ __forceinline__ float bfhi(unsigned w) { return __uint_as_float(w & 0xffff0000u); }
__device__ __forceinline__ void unpack8(const u32x4 w, float* f) {
    f[0] = bflo(w.x); f[1] = bfhi(w.x); f[2] = bflo(w.y); f[3] = bfhi(w.y); f[4] = bflo(w.z); f[5] = bfhi(w.z); f[6] = bflo(w.w); f[7] = bfhi(w.w);
}
__device__ __forceinline__ float wave_sum(float v) {
#pragma unroll
    for (int o = 1; o < 64; o <<= 1) v += __shfl_xor(v, o);
    return v;
}
__device__ __forceinline__ float dot4(const f32x4 a) { return (a[0] * a[0] + a[1] * a[1]) + (a[2] * a[2] + a[3] * a[3]); }

struct Unit { int pm, pn; };


template <int MODE> struct EpiScale {
    static constexpr bool PERM = false, AFTER_DRAIN = false;
    bf16_t* O; int ldc; const float* ssq_in; float inv_n; float* ssq_a; float* ssq_b; const f32x2* rope;
    __device__ __forceinline__ void operator()(const f32x4 (&acc)[2][2][4][2], const Unit& u, int wr, int wc, int fr, int fq) const {
        const int cb0 = u.pn * 256 + wc * 32;
#pragma unroll
        for (int ai = 0; ai < 2; ++ai)
#pragma unroll
            for (int m = 0; m < 4; ++m) {
                const int row = u.pm * 256 + ai * 128 + wr * 64 + m * 16 + fr;
                const float r = rsqrtf(ssq_in[row] * inv_n + RMS_EPS);
                const int pos = row & (SEQ - 1);
#pragma unroll
                for (int bj = 0; bj < 2; ++bj) {
                    const int cb = cb0 + 128 * bj;
                    float sc = r;
                    if (MODE == 1) sc *= QSCALE_A;
                    if (MODE == 3) { if (cb < 1024) sc *= QSCALE_C; }
                    f32x4 v0 = acc[ai][bj][m][0] * sc, v1 = acc[ai][bj][m][1] * sc;
                    bool ropeg = false;
                    if (MODE == 0) ropeg = (cb == C_KR);
                    if (MODE == 1) ropeg = ((cb % 96) == 64);
                    if (ropeg) {
#pragma unroll
                        for (int j = 0; j < 4; ++j) { const f32x2 cs = rope[pos * 16 + 4 * fq + j]; const float x1 = v0[j], x2 = v1[j]; v0[j] = x1 * cs.x - x2 * cs.y; v1[j] = x2 * cs.x + x1 * cs.y; }
                    }
                    if (MODE == 0) {
                        if (cb < C_KR) { float s = dot4(v0) + dot4(v1); s += __shfl_xor(s, 16); s += __shfl_xor(s, 32); if (fq == 0) atomicAdd((cb < C_CKV ? ssq_a : ssq_b) + row, s); }
                    }
                    bf16_t* p = O + (size_t)row * ldc + cb + 4 * fq;
                    u32x2 w0, w1; w0.x = cvt_pk_bf16(v0[0], v0[1]); w0.y = cvt_pk_bf16(v0[2], v0[3]); w1.x = cvt_pk_bf16(v1[0], v1[1]); w1.y = cvt_pk_bf16(v1[2], v1[3]);
                    *(u32x2*)p = w0; *(u32x2*)(p + 16) = w1;
                }
            }
    }
};

struct EpiResid {
    static constexpr bool PERM = false, AFTER_DRAIN = false;
    const float* base; float* out; bf16_t* hb; float* ssq;
    __device__ __forceinline__ void operator()(const f32x4 (&acc)[2][2][4][2], const Unit& u, int wr, int wc, int fr, int fq) const {
#pragma unroll
        for (int ai = 0; ai < 2; ++ai)
#pragma unroll
            for (int m = 0; m < 4; ++m) {
                const int row = u.pm * 256 + ai * 128 + wr * 64 + m * 16 + fr;
                float s = 0.f;
#pragma unroll
                for (int bj = 0; bj < 2; ++bj)
#pragma unroll
                    for (int n = 0; n < 2; ++n) {
                        const size_t off = (size_t)row * DM + u.pn * 256 + bj * 128 + wc * 32 + 16 * n + 4 * fq;
                        const f32x4 h = *(const f32x4*)(base + off) + acc[ai][bj][m][n];
                        *(f32x4*)(out + off) = h;
                        if (hb) { u32x2 w; w.x = cvt_pk_bf16(h[0], h[1]); w.y = cvt_pk_bf16(h[2], h[3]); *(u32x2*)(hb + off) = w; }
                        s += dot4(h);
                    }
                s += __shfl_xor(s, 16); s += __shfl_xor(s, 32);
                if (fq == 0) atomicAdd(ssq + row, s);
            }
    }
};

struct EpiSwiglu {
    static constexpr bool PERM = true, AFTER_DRAIN = false;
    bf16_t* O; const float* ssq_in;
    __device__ __forceinline__ void operator()(const f32x4 (&acc)[2][2][4][2], const Unit& u, int wr, int wc, int fr, int fq) const {
#pragma unroll
        for (int ai = 0; ai < 2; ++ai)
#pragma unroll
            for (int m = 0; m < 4; ++m) {
                const int row = u.pm * 256 + ai * 128 + wr * 64 + m * 16 + fr;
                const float r = rsqrtf(ssq_in[row] * (1.0f / DM) + RMS_EPS);
                float a[8];
#pragma unroll
                for (int n = 0; n < 2; ++n)
#pragma unroll
                    for (int j = 0; j < 4; ++j) { const float g = acc[ai][0][m][n][j] * r, uu = acc[ai][1][m][n][j] * r; a[4 * n + j] = g * __builtin_amdgcn_rcpf(1.0f + __expf(-g)) * uu; }
                u32x4 w; w.x = cvt_pk_bf16(a[0], a[1]); w.y = cvt_pk_bf16(a[2], a[3]); w.z = cvt_pk_bf16(a[4], a[5]); w.w = cvt_pk_bf16(a[6], a[7]);
                *(u32x4*)(O + (size_t)row * DFF + u.pn * 128 + wc * 32 + 8 * fq) = w;
            }
    }
};

__host__ __device__ __forceinline__ int perm32(int rho) { const int n = rho >> 4, i = rho & 15; return 8 * (i >> 2) + 4 * n + (i & 3); }
template <class Epi>
__device__ __forceinline__ void gemm_naive(const bf16_t* A, int lda, const bf16_t* Bt, int ldb, int nM, int nN, int K, const Epi& E) {
    constexpr bool PERM = Epi::PERM;
    const int tid = threadIdx.x, wid = tid >> 6, lane = tid & 63, wr = wid >> 2, wc = wid & 3, fr = lane & 15, fq = lane >> 4;
    for (int unit = blockIdx.x; unit < nM * nN; unit += gridDim.x) {
        Unit u; u.pm = unit / nN; u.pn = unit % nN;
        f32x4 acc[2][2][4][2];
#pragma unroll
        for (int a = 0; a < 2; ++a)
#pragma unroll
            for (int b = 0; b < 2; ++b)
#pragma unroll
                for (int m = 0; m < 4; ++m)
#pragma unroll
                    for (int n = 0; n < 2; ++n) acc[a][b][m][n] = (f32x4){0.f, 0.f, 0.f, 0.f};
        const bf16_t* Ab = A + (size_t)(u.pm * 256 + wr * 64 + fr) * lda + 8 * fq;
        const bf16_t* Bb = Bt + (size_t)(u.pn * 256 + wc * 32) * ldb + 8 * fq;
        const int br0 = PERM ? perm32(fr) : fr, br1 = PERM ? perm32(16 + fr) : 16 + fr;
        for (int k0 = 0; k0 < K; k0 += 32) {
            bf16x8 af[2][4], bq[2][2];
#pragma unroll
            for (int ai = 0; ai < 2; ++ai)
#pragma unroll
                for (int m = 0; m < 4; ++m) af[ai][m] = *(const bf16x8*)(Ab + (size_t)(ai * 128 + m * 16) * lda + k0);
#pragma unroll
            for (int bj = 0; bj < 2; ++bj) { bq[bj][0] = *(const bf16x8*)(Bb + (size_t)(bj * 128 + br0) * ldb + k0); bq[bj][1] = *(const bf16x8*)(Bb + (size_t)(bj * 128 + br1) * ldb + k0); }
#pragma unroll
            for (int ai = 0; ai < 2; ++ai)
#pragma unroll
                for (int bj = 0; bj < 2; ++bj)
#pragma unroll
                    for (int m = 0; m < 4; ++m)
#pragma unroll
                        for (int n = 0; n < 2; ++n) acc[ai][bj][m][n] = __builtin_amdgcn_mfma_f32_16x16x32_bf16(bq[bj][n], af[ai][m], acc[ai][bj][m][n], 0, 0, 0);
        }
        E(acc, u, wr, wc, fr, fq);
    }
}

__device__ __forceinline__ void p0_item(const float* W, int K, int N, const float* g, bf16_t* WT, int ldt, int mode, LAS float* scr, int item, int lane) {
    const int nblk = N / 32, kb = item / nblk, nb = item % nblk, k0 = 64 * kb, n0 = 32 * nb;
#pragma unroll 8
    for (int i = 0; i < 32; ++i) { const int kk = 2 * i + (lane >> 5); const float gs = g ? g[k0 + kk] : 1.0f; scr[kk * 33 + (lane & 31)] = W[(size_t)(k0 + kk) * N + n0 + (lane & 31)] * gs; }
    asm volatile("s_waitcnt lgkmcnt(0)" ::: "memory");
    const int c = lane & 7;
#pragma unroll
    for (int j = 0; j < 4; ++j) {
        const int n = (lane >> 3) + 8 * j; const LAS float* s = scr + (8 * c) * 33 + n;
        u32x4 o; o.x = cvt_pk_bf16(s[0 * 33], s[1 * 33]); o.y = cvt_pk_bf16(s[2 * 33], s[3 * 33]); o.z = cvt_pk_bf16(s[4 * 33], s[5 * 33]); o.w = cvt_pk_bf16(s[6 * 33], s[7 * 33]);
        const int nn = n0 + n; const int row = (mode == 0) ? nn : ((nn >> 7) * 256 + (mode == 2 ? 128 : 0) + (nn & 127));
        *(u32x4*)(WT + (size_t)row * ldt + k0 + 8 * c) = o;
    }
    asm volatile("s_waitcnt lgkmcnt(0)" ::: "memory");
}

struct Args { const float* in[16]; float* out; unsigned char* ws; };

__device__ __forceinline__ void attn_mla_naive(const bf16_t* QA, const bf16_t* KVA, const bf16_t* PROJ, bf16_t* O) {
    const int nth = gridDim.x * NTHREADS;
    for (int w = blockIdx.x * NTHREADS + threadIdx.x; w < 8 * MTOK; w += nth) {
        const int h = w >> 14, row = w & (MTOK - 1), b = row >> 11, t = row & (SEQ - 1);
        float q[96];
#pragma unroll
        for (int c = 0; c < 12; ++c) unpack8(*(const u32x4*)(QA + (size_t)row * NQA + h * 96 + c * 8), q + c * 8);
        float o[64];
#pragma unroll
        for (int d = 0; d < 64; ++d) o[d] = 0.f;
        float mx = -INFINITY, l = 0.f;
        const int kend = ((t >> 6) + 1) << 6;
        for (int s = 0; s < kend; ++s) {
            const size_t kr = (size_t)(b * SEQ + s);
            const bf16_t* kp = KVA + kr * NKVA + h * 128; const bf16_t* rp = PROJ + kr * NPROJ_P + C_KR;
            float sc = 0.f;
#pragma unroll
            for (int c = 0; c < 8; ++c) { float k[8]; unpack8(*(const u32x4*)(kp + c * 8), k);
#pragma unroll
                for (int e = 0; e < 8; ++e) sc += q[c * 8 + e] * k[e]; }
#pragma unroll
            for (int c = 0; c < 4; ++c) { float k[8]; unpack8(*(const u32x4*)(rp + c * 8), k);
#pragma unroll
                for (int e = 0; e < 8; ++e) sc += q[64 + c * 8 + e] * k[e]; }
            const float mn = fmaxf(mx, sc), al = __builtin_amdgcn_exp2f(mx - mn), p = __builtin_amdgcn_exp2f(sc - mn);
            l = l * al + p; mx = mn;
#pragma unroll
            for (int c = 0; c < 8; ++c) { float v[8]; unpack8(*(const u32x4*)(kp + 64 + c * 8), v);
#pragma unroll
                for (int e = 0; e < 8; ++e) o[c * 8 + e] = o[c * 8 + e] * al + p * v[e]; }
        }
        const float inv = 1.0f / l;
#pragma unroll
        for (int c = 0; c < 8; ++c) { u32x4 wv; wv.x = cvt_pk_bf16(o[c * 8] * inv, o[c * 8 + 1] * inv); wv.y = cvt_pk_bf16(o[c * 8 + 2] * inv, o[c * 8 + 3] * inv); wv.z = cvt_pk_bf16(o[c * 8 + 4] * inv, o[c * 8 + 5] * inv); wv.w = cvt_pk_bf16(o[c * 8 + 6] * inv, o[c * 8 + 7] * inv);
            *(u32x4*)(O + (size_t)row * DM + h * 64 + c * 8) = wv; }
    }
}

__device__ __forceinline__ void attn_sb_naive(const bf16_t* PROJ, bf16_t* O) {
    const int nth = gridDim.x * NTHREADS;
    for (int w = blockIdx.x * NTHREADS + threadIdx.x; w < 8 * MTOK; w += nth) {
        const int h = w >> 14, row = w & (MTOK - 1), b = row >> 11, t = row & (SEQ - 1);
        float q[64];
#pragma unroll
        for (int c = 0; c < 8; ++c) unpack8(*(const u32x4*)(PROJ + (size_t)row * NPROJ_P + C_QB + h * 64 + c * 8), q + c * 8);
        float o[64];
#pragma unroll
        for (int d = 0; d < 64; ++d) o[d] = 0.f;
        float cum = 0.f;
        const int tmax = t | 63;
        for (int s = tmax - 1; s >= 0; --s) {
            const size_t kr = (size_t)(b * SEQ + s);
            const bf16_t* kp = PROJ + kr * NPROJ_P + C_KB + h * 64; const bf16_t* vp = PROJ + kr * NPROJ_P + C_VB + h * 64;
            float z = 0.f;
#pragma unroll
            for (int c = 0; c < 8; ++c) { float k[8]; unpack8(*(const u32x4*)(kp + c * 8), k);
#pragma unroll
                for (int e = 0; e < 8; ++e) z += q[c * 8 + e] * k[e]; }
            z *= 0.125f;
            const bool on = s < t;
            const float lg = __logf(1.0f + __expf(-fabsf(z)));
            const float wgt = on ? __expf(fminf(z, 0.f) - lg + cum) : 0.f;
            cum += on ? (fminf(-z, 0.f) - lg) : 0.f;
#pragma unroll
            for (int c = 0; c < 8; ++c) { float v[8]; unpack8(*(const u32x4*)(vp + c * 8), v);
#pragma unroll
                for (int e = 0; e < 8; ++e) o[c * 8 + e] += wgt * v[e]; }
        }
#pragma unroll
        for (int c = 0; c < 8; ++c) { u32x4 wv; wv.x = cvt_pk_bf16(o[c * 8], o[c * 8 + 1]); wv.y = cvt_pk_bf16(o[c * 8 + 2], o[c * 8 + 3]); wv.z = cvt_pk_bf16(o[c * 8 + 4], o[c * 8 + 5]); wv.w = cvt_pk_bf16(o[c * 8 + 6], o[c * 8 + 7]);
            *(u32x4*)(O + (size_t)row * DM + 512 + h * 64 + c * 8) = wv; }
    }
}

__device__ __forceinline__ void attn_band_naive(const bf16_t* QKV, const float* rel_bias, bf16_t* O) {
    const int nth = gridDim.x * NTHREADS;
    for (int w = blockIdx.x * NTHREADS + threadIdx.x; w < 16 * MTOK; w += nth) {
        const int h = w >> 14, row = w & (MTOK - 1), b = row >> 11, t = row & (SEQ - 1);
        float q[64];
#pragma unroll
        for (int c = 0; c < 8; ++c) unpack8(*(const u32x4*)(QKV + (size_t)row * NQKV + h * 64 + c * 8), q + c * 8);
        float o[64];
#pragma unroll
        for (int d = 0; d < 64; ++d) o[d] = 0.f;
        float mx = -INFINITY, l = 0.f;
        const int n = t >> 6, s0 = (n >= 8) ? (n - 8) * 64 : 0, s1 = (n + 1) * 64;
        const float* bias = rel_bias + h * 513 + 256;
        for (int s = s0; s < s1; ++s) {
            const size_t kr = (size_t)(b * SEQ + s);
            const bf16_t* kp = QKV + kr * NQKV + 1024 + h * 64; const bf16_t* vp = QKV + kr * NQKV + 2048 + h * 64;
            float sc = 0.f;
#pragma unroll
            for (int c = 0; c < 8; ++c) { float k[8]; unpack8(*(const u32x4*)(kp + c * 8), k);
#pragma unroll
                for (int e = 0; e < 8; ++e) sc += q[c * 8 + e] * k[e]; }
            int rel = t - s; rel = rel > 256 ? 256 : (rel < -256 ? -256 : rel);
            sc += bias[rel] * LOG2E;
            const float mn = fmaxf(mx, sc), al = __builtin_amdgcn_exp2f(mx - mn), p = __builtin_amdgcn_exp2f(sc - mn);
            l = l * al + p; mx = mn;
#pragma unroll
            for (int c = 0; c < 8; ++c) { float v[8]; unpack8(*(const u32x4*)(vp + c * 8), v);
#pragma unroll
                for (int e = 0; e < 8; ++e) o[c * 8 + e] = o[c * 8 + e] * al + p * v[e]; }
        }
        const float inv = 1.0f / l;
#pragma unroll
        for (int c = 0; c < 8; ++c) { u32x4 wv; wv.x = cvt_pk_bf16(o[c * 8] * inv, o[c * 8 + 1] * inv); wv.y = cvt_pk_bf16(o[c * 8 + 2] * inv, o[c * 8 + 3] * inv); wv.z = cvt_pk_bf16(o[c * 8 + 4] * inv, o[c * 8 + 5] * inv); wv.w = cvt_pk_bf16(o[c * 8 + 6] * inv, o[c * 8 + 7] * inv);
            *(u32x4*)(O + (size_t)row * DM + h * 64 + c * 8) = wv; }
    }
}

__global__ void __launch_bounds__(NTHREADS) fwd_megakernel(Args args) {
    extern __shared__ __attribute__((aligned(16))) unsigned char lds[];
    cg::grid_group grid = cg::this_grid();
    const int tid = threadIdx.x, lane = tid & 63, wave = tid >> 6;
    const int G = gridDim.x;
    unsigned char* ws = args.ws;
    const float* x = args.in[0];
    float* out = args.out;
    float* ssq = (float*)(ws + WS_SSQ);
    f32x2* rope = (f32x2*)(ws + WS_ROPE);
    bf16_t* Win = (bf16_t*)(ws + WS_WIN); bf16_t* Wuq = (bf16_t*)(ws + WS_WUQ); bf16_t* Wukv = (bf16_t*)(ws + WS_WUKV); bf16_t* Wo0 = (bf16_t*)(ws + WS_WO0);
    bf16_t* Wgu0 = (bf16_t*)(ws + WS_WGU0); bf16_t* Wd0 = (bf16_t*)(ws + WS_WD0); bf16_t* Wqkv = (bf16_t*)(ws + WS_WQKV); bf16_t* Wo1 = (bf16_t*)(ws + WS_WO1);
    bf16_t* Wgu1 = (bf16_t*)(ws + WS_WGU1); bf16_t* Wd1 = (bf16_t*)(ws + WS_WD1);
    bf16_t* HB = (bf16_t*)(ws + WS_HB); bf16_t* PROJ = (bf16_t*)(ws + WS_A); bf16_t* QKV = (bf16_t*)(ws + WS_A); bf16_t* ACT = (bf16_t*)(ws + WS_A); bf16_t* ATT = (bf16_t*)(ws + WS_ATT);
    bf16_t* QA = (bf16_t*)((unsigned char*)out + OUT_QA); bf16_t* KVA = (bf16_t*)((unsigned char*)out + OUT_KVA);

    {
        LAS float* scr = (LAS float*)((LAS unsigned char*)lds + wave * 16384);
        const int gw = blockIdx.x * 8 + wave, NGW = G * 8;
        const float* g_mix = args.in[10]; const float* g_ffn = args.in[11];
        constexpr int I_IN = 16 * (NPROJ / 32), I_UQ = 6 * 24, I_UKV = 4 * 32, I_O = 16 * 32, I_G = 16 * 88, I_D = 44 * 32, I_QKV = 16 * 96;
        constexpr int NITEMS = I_IN + I_UQ + I_UKV + I_O + 2 * I_G + I_D + I_QKV + I_O + 2 * I_G + I_D;
        for (int it = gw; it < NITEMS; it += NGW) {
            int r = it;
            if (r < I_IN) { p0_item(args.in[1], DM, NPROJ, g_mix, Win, DM, 0, scr, r, lane); continue; } r -= I_IN;
            if (r < I_UQ) { p0_item(args.in[3], 384, NQA, args.in[2], Wuq, 384, 0, scr, r, lane); continue; } r -= I_UQ;
            if (r < I_UKV) { p0_item(args.in[5], 256, NKVA, args.in[4], Wukv, 256, 0, scr, r, lane); continue; } r -= I_UKV;
            if (r < I_O) { p0_item(args.in[6], DM, DM, nullptr, Wo0, DM, 0, scr, r, lane); continue; } r -= I_O;
            if (r < I_G) { p0_item(args.in[12], DM, DFF, g_ffn, Wgu0, DM, 1, scr, r, lane); continue; } r -= I_G;
            if (r < I_G) { p0_item(args.in[13], DM, DFF, g_ffn, Wgu0, DM, 2, scr, r, lane); continue; } r -= I_G;
            if (r < I_D) { p0_item(args.in[14], DFF, DM, nullptr, Wd0, DFF, 0, scr, r, lane); continue; } r -= I_D;
            if (r < I_QKV) { p0_item(args.in[7], DM, NQKV, g_mix + DM, Wqkv, DM, 0, scr, r, lane); continue; } r -= I_QKV;
            if (r < I_O) { p0_item(args.in[9], DM, DM, nullptr, Wo1, DM, 0, scr, r, lane); continue; } r -= I_O;
            if (r < I_G) { p0_item(args.in[12] + (size_t)DM * DFF, DM, DFF, g_ffn + DM, Wgu1, DM, 1, scr, r, lane); continue; } r -= I_G;
            if (r < I_G) { p0_item(args.in[13] + (size_t)DM * DFF, DM, DFF, g_ffn + DM, Wgu1, DM, 2, scr, r, lane); continue; } r -= I_G;
            p0_item(args.in[14] + (size_t)DFF * DM, DFF, DM, nullptr, Wd1, DFF, 0, scr, r, lane);
        }
        for (int i = blockIdx.x * NTHREADS + tid; i < (NPROJ_P - NPROJ) * DM / 8; i += G * NTHREADS) ((u32x4*)(Win + (size_t)NPROJ * DM))[i] = (u32x4){0u, 0u, 0u, 0u};
        for (int i = blockIdx.x * NTHREADS + tid; i < 6 * MTOK; i += G * NTHREADS) ssq[MTOK + i] = 0.f;
        for (int i = blockIdx.x * NTHREADS + tid; i < SEQ * 16; i += G * NTHREADS) {
            const int pos = i >> 4, fi = i & 15;
            const float inv_freq = __builtin_amdgcn_exp2f(-(float)fi * (13.287712379549449f / 16.0f));
            const float ang = (float)pos * inv_freq;
            float tr = ang * 0.15915494309189535f; tr -= floorf(tr);
            rope[i] = (f32x2){__builtin_amdgcn_cosf(tr), __builtin_amdgcn_sinf(tr)};
        }
        for (int m = gw; m < MTOK; m += NGW) {
            const f32x4* xr = (const f32x4*)(x + (size_t)m * DM) + lane; f32x4 v[4]; float s = 0.f;
#pragma unroll
            for (int j = 0; j < 4; ++j) { v[j] = xr[64 * j]; s += dot4(v[j]); }
            s = wave_sum(s);
            if (lane == 0) ssq[m] = s;
#pragma unroll
            for (int j = 0; j < 4; ++j) { u32x2 w; w.x = cvt_pk_bf16(v[j][0], v[j][1]); w.y = cvt_pk_bf16(v[j][2], v[j][3]); *((u32x2*)(HB + (size_t)m * DM) + lane + 64 * j) = w; }
        }
    }
    grid.sync();
    { EpiScale<0> E{PROJ, NPROJ_P, ssq, 1.0f / DM, ssq + MTOK, ssq + 2 * MTOK, rope}; gemm_naive(HB, DM, Win, DM, MTOK / 256, NPROJ_P / 256, DM, E); }
    grid.sync();
    { EpiScale<1> E{QA, NQA, ssq + MTOK, 1.0f / 384, nullptr, nullptr, rope}; gemm_naive(PROJ, NPROJ_P, Wuq, 384, MTOK / 256, NQA / 256, 384, E); }
    { EpiScale<2> E{KVA, NKVA, ssq + 2 * MTOK, 1.0f / 256, nullptr, nullptr, rope}; gemm_naive(PROJ + C_CKV, NPROJ_P, Wukv, 256, MTOK / 256, NKVA / 256, 256, E); }
    grid.sync();
#ifndef NO_MLA
    attn_mla_naive(QA, KVA, PROJ, ATT);
#endif
#ifndef NO_SB
    attn_sb_naive(PROJ, ATT);
#endif
    grid.sync();
    { EpiResid E{x, out, HB, ssq + 3 * MTOK}; gemm_naive(ATT, DM, Wo0, DM, MTOK / 256, DM / 256, DM, E); }
    grid.sync();
    { EpiSwiglu E{ACT, ssq + 3 * MTOK}; gemm_naive(HB, DM, Wgu0, DM, MTOK / 256, 2 * DFF / 256, DM, E); }
    grid.sync();
    { EpiResid E{out, out, HB, ssq + 4 * MTOK}; gemm_naive(ACT, DFF, Wd0, DFF, MTOK / 256, DM / 256, DFF, E); }
    grid.sync();
    { EpiScale<3> E{QKV, NQKV, ssq + 4 * MTOK, 1.0f / DM, nullptr, nullptr, rope}; gemm_naive(HB, DM, Wqkv, DM, MTOK / 256, NQKV / 256, DM, E); }
    grid.sync();
#ifndef NO_BAND
    attn_band_naive(QKV, args.in[8], ATT);
#endif
    grid.sync();
    { EpiResid E{out, out, HB, ssq + 5 * MTOK}; gemm_naive(ATT, DM, Wo1, DM, MTOK / 256, DM / 256, DM, E); }
    grid.sync();
    { EpiSwiglu E{ACT, ssq + 5 * MTOK}; gemm_naive(HB, DM, Wgu1, DM, MTOK / 256, 2 * DFF / 256, DM, E); }
    grid.sync();
    { EpiResid E{out, out, nullptr, ssq + 6 * MTOK}; gemm_naive(ACT, DFF, Wd1, DFF, MTOK / 256, DM / 256, DFF, E); }
    grid.sync();
    {
        const int gw = blockIdx.x * 8 + wave, NGW = G * 8;
        const f32x4* gf = (const f32x4*)args.in[15] + lane;
        for (int m = gw; m < MTOK; m += NGW) {
            const float r = rsqrtf(ssq[6 * MTOK + m] * (1.0f / DM) + RMS_EPS);
            f32x4* p = (f32x4*)(out + (size_t)m * DM) + lane;
#pragma unroll
            for (int j = 0; j < 4; ++j) p[64 * j] = p[64 * j] * r * gf[64 * j];
        }
    }
}

extern "C" void kernel_launch(void* const* d_in, const int* in_sizes, int n_in, void* d_out, int out_size, void* d_ws, size_t ws_size, hipStream_t stream) {
    static int grid = 0;
    if (grid == 0) {
        int dev = 0, cus = 0, per_cu = 0;
        hipGetDevice(&dev);
        hipDeviceGetAttribute(&cus, hipDeviceAttributeMultiprocessorCount, dev);
        hipFuncSetAttribute((const void*)fwd_megakernel, hipFuncAttributeMaxDynamicSharedMemorySize, LDS_BYTES);
        hipOccupancyMaxActiveBlocksPerMultiprocessor(&per_cu, (const void*)fwd_megakernel, NTHREADS, LDS_BYTES);
        if (per_cu < 1) per_cu = 1;
        if (per_cu > 1) per_cu = 1;
        grid = cus * per_cu;
        if (n_in != 16 || out_size != MTOK * DM || ws_size < WS_END) { fprintf(stderr, "kernel_launch: unexpected shapes n_in %d out %d ws %zu\n", n_in, out_size, ws_size); }
    }
    Args a{};
    for (int i = 0; i < 16; ++i) a.in[i] = (const float*)d_in[i];
    a.out = (float*)d_out; a.ws = (unsigned char*)d_ws;
    void* kargs[] = {&a};
    hipError_t e = hipLaunchCooperativeKernel((const void*)fwd_megakernel, dim3(grid), dim3(NTHREADS), kargs, LDS_BYTES, stream);
    if (e != hipSuccess) fprintf(stderr, "cooperative launch failed: %s (grid %d)\n", hipGetErrorString(e), grid);
}
```

```cpp
#include <hip/hip_runtime.h>
#include <hip/hip_cooperative_groups.h>
#include <cstdio>
#include <cstdint>
namespace cg = cooperative_groups;

#define LAS __attribute__((address_space(3)))
typedef unsigned short bf16_t;
typedef short bf16x8 __attribute__((ext_vector_type(8)));
typedef float f32x4 __attribute__((ext_vector_type(4)));
typedef float f32x2 __attribute__((ext_vector_type(2)));
typedef unsigned u32x4 __attribute__((ext_vector_type(4)));
typedef unsigned u32x2 __attribute__((ext_vector_type(2)));

constexpr int MTOK = 16384, SEQ = 2048, DM = 1024, DFF = 2816;
constexpr int NPROJ = 2208, NPROJ_P = 2304;
constexpr int C_CKV = 384, C_KR = 640, C_QB = 672, C_KB = 1184, C_VB = 1696;
constexpr int NQA = 768, NKVA = 1024, NQKV = 3072;
constexpr float RMS_EPS = 1e-6f;
constexpr float LOG2E = 1.4426950408889634f;
constexpr float QSCALE_A = 0.10206207261596577f * LOG2E;
constexpr float QSCALE_C = 0.125f * LOG2E;

constexpr size_t KiB = 1024, MiB = 1u << 20;
constexpr size_t WS_SSQ = 0;
constexpr size_t WS_ROPE = 512 * KiB;
constexpr size_t WS_WIN = 1 * MiB;
constexpr size_t WS_WUQ = WS_WIN + (size_t)NPROJ_P * DM * 2;
constexpr size_t WS_WUKV = WS_WUQ + (size_t)NQA * 384 * 2;
constexpr size_t WS_WO0 = WS_WUKV + (size_t)NKVA * 256 * 2;
constexpr size_t WS_WGU0 = WS_WO0 + (size_t)DM * DM * 2;
constexpr size_t WS_WD0 = WS_WGU0 + (size_t)2 * DFF * DM * 2;
constexpr size_t WS_WQKV = WS_WD0 + (size_t)DM * DFF * 2;
constexpr size_t WS_WO1 = WS_WQKV + (size_t)NQKV * DM * 2;
constexpr size_t WS_WGU1 = WS_WO1 + (size_t)DM * DM * 2;
constexpr size_t WS_WD1 = WS_WGU1 + (size_t)2 * DFF * DM * 2;
constexpr size_t WS_WEND = WS_WD1 + (size_t)DM * DFF * 2;
constexpr size_t WS_HB = 50 * MiB;
constexpr size_t WS_A = 82 * MiB;
constexpr size_t WS_ATT = 178 * MiB;
constexpr size_t WS_END = 210 * MiB;
static_assert(WS_WEND <= WS_HB, "weights fit");
constexpr size_t OUT_QA = 0, OUT_KVA = 24 * MiB;

constexpr int NTHREADS = 512;
constexpr int LDS_BYTES = 147456;

__device__ __forceinline__ unsigned cvt_pk_bf16(float lo, float hi) { unsigned r; asm volatile("v_cvt_pk_bf16_f32 %0, %1, %2" : "=v"(r) : "v"(lo), "v"(hi)); return r; }
__device__ __forceinline__ float bflo(unsigned w) { return __uint_as_float(w << 16); }
__device__ __forceinline__ float bfhi(unsigned w) { return __uint_as_float(w & 0xffff0000u); }
__device__ __forceinline__ void unpack8(const u32x4 w, float* f) {
    f[0] = bflo(w.x); f[1] = bfhi(w.x); f[2] = bflo(w.y); f[3] = bfhi(w.y); f[4] = bflo(w.z); f[5] = bfhi(w.z); f[6] = bflo(w.w); f[7] = bfhi(w.w);
}
__device__ __forceinline__ float wave_sum(float v) {
#pragma unroll
    for (int o = 1; o < 64; o <<= 1) v += __shfl_xor(v, o);
    return v;
}
__device__ __forceinline__ float dot4(const f32x4 a) { return (a[0] * a[0] + a[1] * a[1]) + (a[2] * a[2] + a[3] * a[3]); }

struct Unit { int pm, pn; };


template <int MODE> struct EpiScale {
    static constexpr bool PERM = false, AFTER_DRAIN = false;
    bf16_t* O; int ldc; const float* ssq_in; float inv_n; float* ssq_a; float* ssq_b; const f32x2* rope;
    __device__ __forceinline__ void operator()(const f32x4 (&acc)[2][2][4][2], const Unit& u, int wr, int wc, int fr, int fq) const {
        const int cb0 = u.pn * 256 + wc * 32;
#pragma unroll
        for (int ai = 0; ai < 2; ++ai)
#pragma unroll
            for (int m = 0; m < 4; ++m) {
                const int row = u.pm * 256 + ai * 128 + wr * 64 + m * 16 + fr;
                const float r = rsqrtf(ssq_in[row] * inv_n + RMS_EPS);
                const int pos = row & (SEQ - 1);
#pragma unroll
                for (int bj = 0; bj < 2; ++bj) {
                    const int cb = cb0 + 128 * bj;
                    float sc = r;
                    if (MODE == 1) sc *= QSCALE_A;
                    if (MODE == 3) { if (cb < 1024) sc *= QSCALE_C; }
                    f32x4 v0 = acc[ai][bj][m][0] * sc, v1 = acc[ai][bj][m][1] * sc;
                    bool ropeg = false;
                    if (MODE == 0) ropeg = (cb == C_KR);
                    if (MODE == 1) ropeg = ((cb % 96) == 64);
                    if (ropeg) {
#pragma unroll
                        for (int j = 0; j < 4; ++j) { const f32x2 cs = rope[pos * 16 + 4 * fq + j]; const float x1 = v0[j], x2 = v1[j]; v0[j] = x1 * cs.x - x2 * cs.y; v1[j] = x2 * cs.x + x1 * cs.y; }
                    }
                    if (MODE == 0) {
                        if (cb < C_KR) { float s = dot4(v0) + dot4(v1); s += __shfl_xor(s, 16); s += __shfl_xor(s, 32); if (fq == 0) atomicAdd((cb < C_CKV ? ssq_a : ssq_b) + row, s); }
                    }
                    bf16_t* p = O + (size_t)row * ldc + cb + 4 * fq;
                    u32x2 w0, w1; w0.x = cvt_pk_bf16(v0[0], v0[1]); w0.y = cvt_pk_bf16(v0[2], v0[3]); w1.x = cvt_pk_bf16(v1[0], v1[1]); w1.y = cvt_pk_bf16(v1[2], v1[3]);
                    *(u32x2*)p = w0; *(u32x2*)(p + 16) = w1;
                }
                asm volatile("" ::: "memory");
            }
    }
};

struct EpiResid {
    static constexpr bool PERM = false, AFTER_DRAIN = false;
    const float* base; float* out; bf16_t* hb; float* ssq;
    __device__ __forceinline__ void operator()(const f32x4 (&acc)[2][2][4][2], const Unit& u, int wr, int wc, int fr, int fq) const {
#pragma unroll
        for (int ai = 0; ai < 2; ++ai)
#pragma unroll
            for (int m = 0; m < 4; ++m) {
                const int row = u.pm * 256 + ai * 128 + wr * 64 + m * 16 + fr;
                float s = 0.f;
#pragma unroll
                for (int bj = 0; bj < 2; ++bj)
#pragma unroll
                    for (int n = 0; n < 2; ++n) {
                        const size_t off = (size_t)row * DM + u.pn * 256 + bj * 128 + wc * 32 + 16 * n + 4 * fq;
                        const f32x4 h = *(const f32x4*)(base + off) + acc[ai][bj][m][n];
                        *(f32x4*)(out + off) = h;
                        if (hb) { u32x2 w; w.x = cvt_pk_bf16(h[0], h[1]); w.y = cvt_pk_bf16(h[2], h[3]); *(u32x2*)(hb + off) = w; }
                        s += dot4(h);
                    }
                s += __shfl_xor(s, 16); s += __shfl_xor(s, 32);
                if (fq == 0) atomicAdd(ssq + row, s);
                asm volatile("" ::: "memory");
            }
    }
};

struct EpiSwiglu {
    static constexpr bool PERM = true, AFTER_DRAIN = false;
    bf16_t* O; const float* ssq_in;
    __device__ __forceinline__ void operator()(const f32x4 (&acc)[2][2][4][2], const Unit& u, int wr, int wc, int fr, int fq) const {
#pragma unroll
        for (int ai = 0; ai < 2; ++ai)
#pragma unroll
            for (int m = 0; m < 4; ++m) {
                const int row = u.pm * 256 + ai * 128 + wr * 64 + m * 16 + fr;
                const float r = rsqrtf(ssq_in[row] * (1.0f / DM) + RMS_EPS);
                float a[8];
#pragma unroll
                for (int n = 0; n < 2; ++n)
#pragma unroll
                    for (int j = 0; j < 4; ++j) { const float g = acc[ai][0][m][n][j] * r, uu = acc[ai][1][m][n][j] * r; a[4 * n + j] = g * __builtin_amdgcn_rcpf(1.0f + __expf(-g)) * uu; }
                u32x4 w; w.x = cvt_pk_bf16(a[0], a[1]); w.y = cvt_pk_bf16(a[2], a[3]); w.z = cvt_pk_bf16(a[4], a[5]); w.w = cvt_pk_bf16(a[6], a[7]);
                *(u32x4*)(O + (size_t)row * DFF + u.pn * 128 + wc * 32 + 8 * fq) = w;
                asm volatile("" ::: "memory");
            }
    }
};

__host__ __device__ __forceinline__ int perm32(int rho) { const int n = rho >> 4, i = rho & 15; return 8 * (i >> 2) + 4 * n + (i & 3); }
template <class Epi>
__device__ __forceinline__ void gemm_naive(const bf16_t* A, int lda, const bf16_t* Bt, int ldb, int nM, int nN, int K, const Epi& E) {
    constexpr bool PERM = Epi::PERM;
    const int tid = threadIdx.x, wid = tid >> 6, lane = tid & 63, wr = wid >> 2, wc = wid & 3, fr = lane & 15, fq = lane >> 4;
    for (int unit = blockIdx.x; unit < nM * nN; unit += gridDim.x) {
        Unit u; u.pm = unit / nN; u.pn = unit % nN;
        f32x4 acc[2][2][4][2];
#pragma unroll
        for (int a = 0; a < 2; ++a)
#pragma unroll
            for (int b = 0; b < 2; ++b)
#pragma unroll
                for (int m = 0; m < 4; ++m)
#pragma unroll
                    for (int n = 0; n < 2; ++n) acc[a][b][m][n] = (f32x4){0.f, 0.f, 0.f, 0.f};
        const bf16_t* Ab = A + (size_t)(u.pm * 256 + wr * 64 + fr) * lda + 8 * fq;
        const bf16_t* Bb = Bt + (size_t)(u.pn * 256 + wc * 32) * ldb + 8 * fq;
        const int br0 = PERM ? perm32(fr) : fr, br1 = PERM ? perm32(16 + fr) : 16 + fr;
        for (int k0 = 0; k0 < K; k0 += 32) {
            bf16x8 af[2][4], bq[2][2];
#pragma unroll
            for (int ai = 0; ai < 2; ++ai)
#pragma unroll
                for (int m = 0; m < 4; ++m) af[ai][m] = *(const bf16x8*)(Ab + (size_t)(ai * 128 + m * 16) * lda + k0);
#pragma unroll
            for (int bj = 0; bj < 2; ++bj) { bq[bj][0] = *(const bf16x8*)(Bb + (size_t)(bj * 128 + br0) * ldb + k0); bq[bj][1] = *(const bf16x8*)(Bb + (size_t)(bj * 128 + br1) * ldb + k0); }
#pragma unroll
            for (int ai = 0; ai < 2; ++ai)
#pragma unroll
                for (int bj = 0; bj < 2; ++bj)
#pragma unroll
                    for (int m = 0; m < 4; ++m)
#pragma unroll
                        for (int n = 0; n < 2; ++n) acc[ai][bj][m][n] = __builtin_amdgcn_mfma_f32_16x16x32_bf16(bq[bj][n], af[ai][m], acc[ai][bj][m][n], 0, 0, 0);
        }
        E(acc, u, wr, wc, fr, fq);
    }
}

#define PG8_LAS __attribute__((address_space(3)))
constexpr int BM = 256, BK = 64, HALF = 128, HTB = HALF * BK * 2  , STAGE_BYTES = 8 * HTB, NXCD = 8, WGM = 8;
__host__ __device__ __forceinline__ int lds_byte(int r, int c) { const int st = (r >> 4) * 2 + (c >> 5), rr = r & 15, cc = c & 31, ob = rr * 64 + cc * 2; return st * 1024 + (ob ^ (((ob >> 9) & 1) << 5)); }
__host__ __device__ __forceinline__ void stage_rc(int b, int& R, int& C) { const int st = b / 1024, sb = b % 1024, swz = sb ^ (((sb >> 9) & 1) << 5); R = (st >> 1) * 16 + swz / 64; C = (st & 1) * 32 + (swz % 64) / 2; }
struct Gemm { const bf16_t* A; const bf16_t* Bt; int M, N, K, lda, ldb; };
struct StaticOrder {
    int nM, nN, nwg, G, c;
    __host__ __device__ void init(int M, int N, int G_, int c_) { nM = M / BM; nN = N / BM; nwg = nM * nN; G = G_; c = c_; }
    __host__ __device__ bool next(int i, Unit& u) const {
        const long L = (long)i * G + c; if (L >= nwg) return false;
        int wgid = (int)L; { const int q = nwg / NXCD, r = nwg % NXCD, xcd = wgid % NXCD, off = wgid / NXCD; wgid = (xcd < r ? xcd * (q + 1) : r * (q + 1) + (xcd - r) * q) + off; }
        const int nig = WGM * nN, gid = wgid / nig, fm = gid * WGM, gsz = (nM - fm) < WGM ? (nM - fm) : WGM;
        u.pm = fm + ((wgid % nig) % gsz); u.pn = (wgid % nig) / gsz; return true;
    }
    __device__ __forceinline__ void a_ready(const Unit&) const {}
    __device__ __forceinline__ void done(const Unit&) const {}
};
template <class Epi, class Sched, bool ALIGN_EPI = false, bool SP2 = false>
__device__ __forceinline__ void gemm_phase(PG8_LAS unsigned char* lds, const Gemm g, const Sched& S, const Epi& E) {
    const int tid = threadIdx.x, wid = __builtin_amdgcn_readfirstlane(tid >> 6), lane = tid & 63, wr = wid >> 2, wc = wid & 3, fr = lane & 15, fq = lane >> 4;
    const int K = g.K, nt = K / BK;
    unsigned voffA[2], voffB[2];
#pragma unroll
    for (int i = 0; i < 2; ++i) { int R, C; stage_rc(tid * 16 + i * 8192, R, C); const int Rb = Epi::PERM ? ((R & ~31) + perm32(R & 31)) : R;
        voffA[i] = (unsigned)(R * g.lda + C) * 2u; voffB[i] = (unsigned)(Rb * g.ldb + C) * 2u; }
    const size_t kstep = (size_t)(BK * 2);
    const size_t hstepA = (size_t)HALF * g.lda * 2, hstepB = (size_t)HALF * g.ldb * 2;
    const size_t tstepA = 2 * hstepA, tstepB = 2 * hstepB;
    const unsigned ldsw = (unsigned)wid * 1024u;
    const int aoff = lds_byte(wr * 64 + fr, fq * 8), boff = lds_byte(wc * 32 + fr, fq * 8);
#define PG8_SA(b, h) (((b) * 2 + (h)) * HTB)
#define PG8_SB(b, h) ((4 + (b) * 2 + (h)) * HTB)
#define PG8_STAGE(bufoff, gbase, voff) do { _Pragma("unroll") for (int _i = 0; _i < 2; ++_i) \
        __builtin_amdgcn_global_load_lds((const unsigned*)((const char*)(gbase) + (voff)[_i]), (PG8_LAS unsigned*)(lds + (bufoff) + ldsw + _i * 8192), 16, 0, 0); } while (0)
#define PG8_LDA(dst, b, h) do { _Pragma("unroll") for (int m = 0; m < 4; ++m) _Pragma("unroll") for (int k = 0; k < 2; ++k) dst[m][k] = *(const PG8_LAS bf16x8*)(lds + PG8_SA(b, h) + aoff + m * 2048 + k * 1024); } while (0)
#define PG8_LDB(dst, b, h) do { _Pragma("unroll") for (int n = 0; n < 2; ++n) _Pragma("unroll") for (int k = 0; k < 2; ++k) dst[n][k] = *(const PG8_LAS bf16x8*)(lds + PG8_SB(b, h) + boff + n * 2048 + k * 1024); } while (0)
#define PG8_MMA(ai, bj, At, Bt) do { __builtin_amdgcn_s_setprio(1); _Pragma("unroll") for (int m = 0; m < 4; ++m) _Pragma("unroll") for (int n = 0; n < 2; ++n) _Pragma("unroll") for (int k = 0; k < 2; ++k) \
        acc[ai][bj][m][n] = __builtin_amdgcn_mfma_f32_16x16x32_bf16(Bt[n][k], At[m][k], acc[ai][bj][m][n], 0, 0, 0); __builtin_amdgcn_s_setprio(0); } while (0)
#define PG8_WAIT_V(n) asm volatile("s_waitcnt vmcnt(" #n ")" ::: "memory")
#define PG8_WAIT_L(n) asm volatile("s_waitcnt lgkmcnt(" #n ")" ::: "memory")
#define PG8_BAR __builtin_amdgcn_s_barrier()
#define PG8_SCHED __builtin_amdgcn_sched_barrier(0)
    Unit cur, nxt; int ui = 0;
    if (!S.next(0, cur)) return;
    f32x4 acc[2][2][4][2];
#pragma unroll
    for (int a = 0; a < 2; ++a)
#pragma unroll
        for (int b = 0; b < 2; ++b)
#pragma unroll
            for (int m = 0; m < 4; ++m)
#pragma unroll
                for (int n = 0; n < 2; ++n) acc[a][b][m][n] = (f32x4){0.f, 0.f, 0.f, 0.f};
    bf16x8 At[4][2], B0[2][2], B1[2][2];
    const char* cA = (const char*)g.A + (size_t)cur.pm * tstepA; const char* cB = (const char*)g.Bt + (size_t)cur.pn * tstepB;
    S.a_ready(cur);
    if constexpr (SP2) {
        PG8_STAGE(PG8_SB(0, 0), cB, voffB); PG8_STAGE(PG8_SB(0, 1), cB + hstepB, voffB); PG8_STAGE(PG8_SA(0, 0), cA, voffA); PG8_STAGE(PG8_SA(0, 1), cA + hstepA, voffA);
        if (wr == 1) PG8_BAR;
        PG8_WAIT_V(2); PG8_BAR;
        PG8_STAGE(PG8_SB(1, 0), cB + kstep, voffB); PG8_STAGE(PG8_SA(1, 0), cA + kstep, voffA); PG8_STAGE(PG8_SB(1, 1), cB + hstepB + kstep, voffB);
        PG8_WAIT_V(6); PG8_BAR;
    } else {
        PG8_STAGE(PG8_SB(0, 0), cB, voffB); PG8_STAGE(PG8_SA(0, 0), cA, voffA); PG8_STAGE(PG8_SB(0, 1), cB + hstepB, voffB); PG8_STAGE(PG8_SA(0, 1), cA + hstepA, voffA);
        if (wr == 1) PG8_BAR;
        PG8_WAIT_V(4); PG8_BAR;
        PG8_STAGE(PG8_SB(1, 0), cB + kstep, voffB); PG8_STAGE(PG8_SA(1, 0), cA + kstep, voffA); PG8_STAGE(PG8_SB(1, 1), cB + hstepB + kstep, voffB);
        PG8_WAIT_V(6); PG8_BAR;
    }
    for (;;) {
        const bool has_next = S.next(ui + 1, nxt);
        const char* nA = has_next ? (const char*)g.A + (size_t)nxt.pm * tstepA : cA; const char* nB = has_next ? (const char*)g.Bt + (size_t)nxt.pn * tstepB : cB;
#pragma clang loop unroll(disable)
        for (int t = 0; t < nt; t += 2) {
            const bool last = (t == nt - 2);
            const char* a1 = cA + (size_t)(t + 1) * kstep;
            const char* a2 = last ? nA : cA + (size_t)(t + 2) * kstep; const char* b2 = last ? nB : cB + (size_t)(t + 2) * kstep;
            const char* a3 = a2 + kstep; const char* b3 = b2 + kstep;
            if (last && has_next) S.a_ready(nxt);
            if constexpr (SP2) {
            PG8_LDB(B0, 0, 0); PG8_LDB(B1, 0, 1); PG8_SCHED; PG8_LDA(At, 0, 0); PG8_STAGE(PG8_SA(1, 1), a1 + hstepA, voffA);
            PG8_WAIT_V(8); PG8_WAIT_L(0); PG8_BAR; PG8_MMA(0, 0, At, B0); PG8_MMA(0, 1, At, B1); PG8_BAR; PG8_SCHED;
            PG8_LDA(At, 0, 1); PG8_STAGE(PG8_SB(0, 0), b2, voffB); PG8_STAGE(PG8_SB(0, 1), b2 + hstepB, voffB); PG8_STAGE(PG8_SA(0, 0), a2, voffA);
            PG8_WAIT_V(8); PG8_WAIT_L(0); PG8_BAR; PG8_MMA(1, 0, At, B0); PG8_MMA(1, 1, At, B1); PG8_BAR; PG8_SCHED;
            PG8_LDB(B0, 1, 0); PG8_LDB(B1, 1, 1); PG8_SCHED; PG8_LDA(At, 1, 0); PG8_STAGE(PG8_SA(0, 1), a2 + hstepA, voffA);
            PG8_WAIT_V(8); PG8_WAIT_L(0); PG8_BAR; PG8_MMA(0, 0, At, B0); PG8_MMA(0, 1, At, B1); PG8_BAR; PG8_SCHED;
            PG8_LDA(At, 1, 1); PG8_STAGE(PG8_SB(1, 0), b3, voffB); PG8_STAGE(PG8_SB(1, 1), b3 + hstepB, voffB); PG8_STAGE(PG8_SA(1, 0), a3, voffA);
            PG8_WAIT_V(8); PG8_WAIT_L(0); PG8_BAR; PG8_MMA(1, 0, At, B0); PG8_MMA(1, 1, At, B1); PG8_BAR; PG8_SCHED;
            } else {
            PG8_LDB(B0, 0, 0); PG8_SCHED; PG8_LDA(At, 0, 0); PG8_STAGE(PG8_SA(1, 1), a1 + hstepA, voffA);
            PG8_WAIT_L(8); PG8_BAR; PG8_WAIT_L(0); PG8_MMA(0, 0, At, B0); PG8_BAR; PG8_SCHED;
            PG8_LDB(B1, 0, 1); PG8_STAGE(PG8_SB(0, 0), b2, voffB);
            PG8_BAR; PG8_WAIT_L(0); PG8_MMA(0, 1, At, B1); PG8_BAR;
            PG8_LDA(At, 0, 1); PG8_STAGE(PG8_SA(0, 0), a2, voffA);
            PG8_BAR; PG8_WAIT_L(0); PG8_MMA(1, 0, At, B0); PG8_BAR; PG8_SCHED;
            PG8_STAGE(PG8_SB(0, 1), b2 + hstepB, voffB);
            PG8_WAIT_V(6); PG8_BAR; PG8_MMA(1, 1, At, B1); PG8_BAR;
            PG8_LDB(B0, 1, 0); PG8_SCHED; PG8_LDA(At, 1, 0); PG8_STAGE(PG8_SA(0, 1), a2 + hstepA, voffA);
            PG8_WAIT_L(8); PG8_BAR; PG8_WAIT_L(0); PG8_MMA(0, 0, At, B0); PG8_BAR; PG8_SCHED;
            PG8_LDB(B1, 1, 1); PG8_STAGE(PG8_SB(1, 0), b3, voffB);
            PG8_BAR; PG8_WAIT_L(0); PG8_MMA(0, 1, At, B1); PG8_BAR;
            PG8_LDA(At, 1, 1); PG8_STAGE(PG8_SA(1, 0), a3, voffA);
            PG8_BAR; PG8_WAIT_L(0); PG8_MMA(1, 0, At, B0); PG8_BAR; PG8_SCHED;
            PG8_STAGE(PG8_SB(1, 1), b3 + hstepB, voffB);
            PG8_WAIT_V(6); PG8_BAR; PG8_MMA(1, 1, At, B1); PG8_BAR;
            }
        }
        if constexpr (ALIGN_EPI) { if (wr == 0) PG8_BAR; }
        if constexpr (!Epi::AFTER_DRAIN) { E(acc, cur, wr, wc, fr, fq); S.done(cur); }
        if (!has_next) break;
#pragma unroll
        for (int a = 0; a < 2; ++a)
#pragma unroll
            for (int b = 0; b < 2; ++b)
#pragma unroll
                for (int m = 0; m < 4; ++m)
#pragma unroll
                    for (int n = 0; n < 2; ++n) acc[a][b][m][n] = (f32x4){0.f, 0.f, 0.f, 0.f};
        cur = nxt; cA = nA; cB = nB; ++ui;
        if constexpr (ALIGN_EPI) { if (wr == 1) PG8_BAR; }
    }
    PG8_WAIT_V(0);
    if constexpr (!ALIGN_EPI) { if (wr == 0) PG8_BAR; }
    PG8_BAR;
    if constexpr (Epi::AFTER_DRAIN) { E.fused(acc, cur, wr, wc, fr, fq, lds, wid, lane); S.done(cur); }
#undef PG8_SA
#undef PG8_SB
#undef PG8_STAGE
#undef PG8_LDA
#undef PG8_LDB
#undef PG8_MMA
#undef PG8_WAIT_V
#undef PG8_WAIT_L
#undef PG8_BAR
#undef PG8_SCHED
}
template <class Epi>
__device__ __forceinline__ void gemm_fast(LAS unsigned char* lds, const bf16_t* A, int lda, const bf16_t* Bt, int ldb, int M, int N, int K, const Epi& E) {
    Gemm g{A, Bt, M, N, K, lda, ldb}; StaticOrder S; S.init(M, N, (int)gridDim.x, (int)blockIdx.x);
    gemm_phase<Epi, StaticOrder, true, true>(lds, g, S, E);
}

__device__ __forceinline__ void p0_item(const float* W, int K, int N, const float* g, bf16_t* WT, int ldt, int mode, LAS float* scr, int item, int lane) {
    const int nblk = N / 32, kb = item / nblk, nb = item % nblk, k0 = 64 * kb, n0 = 32 * nb;
#pragma unroll 8
    for (int i = 0; i < 32; ++i) { const int kk = 2 * i + (lane >> 5); const float gs = g ? g[k0 + kk] : 1.0f; scr[kk * 33 + (lane & 31)] = W[(size_t)(k0 + kk) * N + n0 + (lane & 31)] * gs; }
    asm volatile("s_waitcnt lgkmcnt(0)" ::: "memory");
    const int c = lane & 7;
#pragma unroll
    for (int j = 0; j < 4; ++j) {
        const int n = (lane >> 3) + 8 * j; const LAS float* s = scr + (8 * c) * 33 + n;
        u32x4 o; o.x = cvt_pk_bf16(s[0 * 33], s[1 * 33]); o.y = cvt_pk_bf16(s[2 * 33], s[3 * 33]); o.z = cvt_pk_bf16(s[4 * 33], s[5 * 33]); o.w = cvt_pk_bf16(s[6 * 33], s[7 * 33]);
        const int nn = n0 + n; const int row = (mode == 0) ? nn : ((nn >> 7) * 256 + (mode == 2 ? 128 : 0) + (nn & 127));
        *(u32x4*)(WT + (size_t)row * ldt + k0 + 8 * c) = o;
    }
    asm volatile("s_waitcnt lgkmcnt(0)" ::: "memory");
}


typedef float f32x16 __attribute__((ext_vector_type(16)));
constexpr int AT_VSTR = 72;
constexpr int AT_KBUF = 64 * 104 * 2, AT_VBUF = 64 * AT_VSTR * 2;
constexpr int AT_OFF_K = 0, AT_OFF_V = 2 * AT_KBUF, AT_OFF_BIAS = 2 * AT_KBUF + 2 * AT_VBUF, AT_OFF_FLAG = AT_OFF_BIAS + 2304;
__device__ __forceinline__ int crow16(int r, int hi) { return (r & 3) + 8 * (r >> 2) + 4 * hi; }
__device__ __forceinline__ int vperm(int key) { const int k16 = key & 15; return (key & ~15) + 8 * ((k16 >> 2) & 1) + 4 * (k16 >> 3) + (k16 & 3); }
__device__ __forceinline__ bf16x8 pack8(float a0, float a1, float a2, float a3, float a4, float a5, float a6, float a7) {
    u32x4 w; w.x = cvt_pk_bf16(a0, a1); w.y = cvt_pk_bf16(a2, a3); w.z = cvt_pk_bf16(a4, a5); w.w = cvt_pk_bf16(a6, a7); return __builtin_bit_cast(bf16x8, w);
}

template <int MODE>
__device__ __forceinline__ void attn_unit(LAS unsigned char* lds, int q0, const bf16_t* Qp, int ldq, const bf16_t* Kp, int ldk, const bf16_t* Krp, int ldkr, const bf16_t* Vp, int ldv, bf16_t* Op, const float* bias_g) {
    constexpr int DQK = (MODE == 0) ? 96 : 64, NDD = DQK / 16, KSTR = DQK + 8;
    const int tid = threadIdx.x, lane = tid & 63, wid = __builtin_amdgcn_readfirstlane(tid >> 6), l31 = lane & 31, hi = lane >> 5;
    const int t0w = q0 + 32 * wid, trow = t0w + l31, nq = t0w >> 6;
    LAS float* biasl = (LAS float*)(lds + AT_OFF_BIAS);
    LAS int* flags = (LAS int*)(lds + AT_OFF_FLAG);
    if (MODE == 2) { for (int i = tid; i < 513; i += NTHREADS) biasl[i] = bias_g[i] * LOG2E; }
    bf16x8 qf[NDD];
#pragma unroll
    for (int dd = 0; dd < NDD; ++dd) qf[dd] = *(const bf16x8*)(Qp + (size_t)trow * ldq + 16 * dd + 8 * hi);
    f32x16 o0, o1;
#pragma unroll
    for (int r = 0; r < 16; ++r) { o0[r] = 0.f; o1[r] = 0.f; }
    float mrow = -1e30f, lrow = 0.f, carry = 0.f;
    const int kt_hi = (q0 + 255) >> 6;
    int kt_lo = 0; if (MODE == 2) { kt_lo = (q0 >> 6) - 8; if (kt_lo < 0) kt_lo = 0; }
    const int nt = kt_hi - kt_lo + 1;
    const int skey = tid >> 3, sch = tid & 7, rkey = tid >> 2, rch = tid & 3;
    const int vcol = vperm(lane);
    u32x4 kreg, krreg, vreg;
#define AT_KT(i) ((MODE == 1) ? (kt_hi - (i)) : (kt_lo + (i)))
#define AT_LOAD(kt) do { const size_t kb_ = (size_t)(kt) * 64; \
        kreg = *(const u32x4*)(Kp + (kb_ + skey) * ldk + sch * 8); \
        if (MODE == 0) { if (tid < 256) krreg = *(const u32x4*)(Krp + (kb_ + rkey) * ldkr + rch * 8); } \
        vreg = *(const u32x4*)(Vp + (kb_ + lane) * ldv + wid * 8); } while (0)
#define AT_STORE(bufi) do { LAS bf16_t* Ks_ = (LAS bf16_t*)(lds + AT_OFF_K + (bufi) * AT_KBUF); LAS bf16_t* Vt_ = (LAS bf16_t*)(lds + AT_OFF_V + (bufi) * AT_VBUF); \
        *(LAS u32x4*)(Ks_ + skey * KSTR + sch * 8) = kreg; \
        if (MODE == 0) { if (tid < 256) *(LAS u32x4*)(Ks_ + rkey * KSTR + 64 + rch * 8) = krreg; } \
        LAS bf16_t* vd_ = Vt_ + (wid * 8) * AT_VSTR + vcol; \
        vd_[0 * AT_VSTR] = (bf16_t)(vreg.x & 0xffffu); vd_[1 * AT_VSTR] = (bf16_t)(vreg.x >> 16); vd_[2 * AT_VSTR] = (bf16_t)(vreg.y & 0xffffu); vd_[3 * AT_VSTR] = (bf16_t)(vreg.y >> 16); \
        vd_[4 * AT_VSTR] = (bf16_t)(vreg.z & 0xffffu); vd_[5 * AT_VSTR] = (bf16_t)(vreg.z >> 16); vd_[6 * AT_VSTR] = (bf16_t)(vreg.w & 0xffffu); vd_[7 * AT_VSTR] = (bf16_t)(vreg.w >> 16); } while (0)
    AT_LOAD(AT_KT(0)); AT_STORE(0);
    __syncthreads();
    for (int i = 0; i < nt; ++i) {
        const int kt = AT_KT(i);
        if (i + 1 < nt) AT_LOAD(AT_KT(i + 1));
        bool part;
        if (MODE == 0) part = (kt <= nq);
        else if (MODE == 1) part = (64 * kt <= t0w + 30);
        else part = (kt <= nq) && (kt >= nq - 8);
        if (part) {
            const LAS bf16_t* Ks = (const LAS bf16_t*)(lds + AT_OFF_K + (i & 1) * AT_KBUF); const LAS bf16_t* Vt = (const LAS bf16_t*)(lds + AT_OFF_V + (i & 1) * AT_VBUF);
            f32x16 p0, p1;
#pragma unroll
            for (int r = 0; r < 16; ++r) { p0[r] = 0.f; p1[r] = 0.f; }
#pragma unroll
            for (int dd = 0; dd < NDD; ++dd) {
                const bf16x8 a0 = *(const LAS bf16x8*)(Ks + l31 * KSTR + 16 * dd + 8 * hi), a1 = *(const LAS bf16x8*)(Ks + (32 + l31) * KSTR + 16 * dd + 8 * hi);
                p0 = __builtin_amdgcn_mfma_f32_32x32x16_bf16(a0, qf[dd], p0, 0, 0, 0); p1 = __builtin_amdgcn_mfma_f32_32x32x16_bf16(a1, qf[dd], p1, 0, 0, 0);
            }
            if (MODE != 1) {
                if (MODE == 2) {
                    const int relb = trow - 64 * kt - 4 * hi;
#pragma unroll
                    for (int r = 0; r < 16; ++r) {
                        int rel0 = relb - ((r & 3) + 8 * (r >> 2)); int rel1 = rel0 - 32;
                        rel0 = rel0 > 256 ? 256 : (rel0 < -256 ? -256 : rel0); rel1 = rel1 > 256 ? 256 : (rel1 < -256 ? -256 : rel1);
                        p0[r] += biasl[256 + rel0]; p1[r] += biasl[256 + rel1];
                    }
                }
                float mx = fmaxf(p0[0], p1[0]);
#pragma unroll
                for (int r = 1; r < 16; ++r) mx = fmaxf(mx, fmaxf(p0[r], p1[r]));
                mx = fmaxf(mx, __shfl_xor(mx, 32));
                const float mnew = fmaxf(mrow, mx), alpha = __builtin_amdgcn_exp2f(mrow - mnew);
                mrow = mnew;
                float rs = 0.f;
#pragma unroll
                for (int r = 0; r < 16; ++r) { p0[r] = __builtin_amdgcn_exp2f(p0[r] - mnew); p1[r] = __builtin_amdgcn_exp2f(p1[r] - mnew); rs += p0[r] + p1[r]; }
                lrow = lrow * alpha + rs;
#pragma unroll
                for (int r = 0; r < 16; ++r) { o0[r] *= alpha; o1[r] *= alpha; }
            } else {
                const bool need_mask = (64 * kt + 63 >= t0w);
                const int kvb = 64 * kt + 4 * hi;
                float gs[8], lkq0[16], lkq1[16];
#pragma unroll
                for (int g = 0; g < 8; ++g) {
                    float s4 = 0.f;
#pragma unroll
                    for (int c = 0; c < 4; ++c) {
                        const int r = 4 * (g & 3) + c;
                        const float z2 = ((g < 4) ? p0[r] : p1[r]) * (0.125f * LOG2E);
                        const float sp2 = fmaxf(z2, 0.f) + __builtin_amdgcn_logf(1.0f + __builtin_amdgcn_exp2f(-fabsf(z2)));
                        const bool valid = !need_mask || (kvb + 8 * g + c < trow);
                        const float lk = valid ? -sp2 : 0.f;
                        const float ls = valid ? (z2 - sp2) : -1e30f;
                        if (g < 4) { p0[r] = ls; } else { p1[r] = ls; }
                        s4 += lk;
                        if (g < 4) { lkq0[r] = lk; } else { lkq1[r] = lk; }
                    }
                    gs[g] = s4;
                }
                float run = 0.f, after[8];
#pragma unroll
                for (int g = 7; g >= 0; --g) { const float pg = __shfl_xor(gs[g], 32); after[g] = run + (hi == 0 ? pg : 0.f); run += gs[g] + pg; }
#pragma unroll
                for (int g = 0; g < 8; ++g) {
                    float suf = carry + after[g];
#pragma unroll
                    for (int c = 3; c >= 0; --c) {
                        const int r = 4 * (g & 3) + c;
                        if (g < 4) { p0[r] = __builtin_amdgcn_exp2f(p0[r] + suf); suf += lkq0[r]; } else { p1[r] = __builtin_amdgcn_exp2f(p1[r] + suf); suf += lkq1[r]; }
                    }
                }
                carry += run;
            }
            const bf16x8 pb0 = pack8(p0[0], p0[1], p0[2], p0[3], p0[4], p0[5], p0[6], p0[7]), pb1 = pack8(p0[8], p0[9], p0[10], p0[11], p0[12], p0[13], p0[14], p0[15]);
            const bf16x8 pb2 = pack8(p1[0], p1[1], p1[2], p1[3], p1[4], p1[5], p1[6], p1[7]), pb3 = pack8(p1[8], p1[9], p1[10], p1[11], p1[12], p1[13], p1[14], p1[15]);
            const LAS bf16_t* v0p = Vt + l31 * AT_VSTR + 8 * hi; const LAS bf16_t* v1p = Vt + (32 + l31) * AT_VSTR + 8 * hi;
            o0 = __builtin_amdgcn_mfma_f32_32x32x16_bf16(*(const LAS bf16x8*)(v0p + 0), pb0, o0, 0, 0, 0);  o1 = __builtin_amdgcn_mfma_f32_32x32x16_bf16(*(const LAS bf16x8*)(v1p + 0), pb0, o1, 0, 0, 0);
            o0 = __builtin_amdgcn_mfma_f32_32x32x16_bf16(*(const LAS bf16x8*)(v0p + 16), pb1, o0, 0, 0, 0); o1 = __builtin_amdgcn_mfma_f32_32x32x16_bf16(*(const LAS bf16x8*)(v1p + 16), pb1, o1, 0, 0, 0);
            o0 = __builtin_amdgcn_mfma_f32_32x32x16_bf16(*(const LAS bf16x8*)(v0p + 32), pb2, o0, 0, 0, 0); o1 = __builtin_amdgcn_mfma_f32_32x32x16_bf16(*(const LAS bf16x8*)(v1p + 32), pb2, o1, 0, 0, 0);
            o0 = __builtin_amdgcn_mfma_f32_32x32x16_bf16(*(const LAS bf16x8*)(v0p + 48), pb3, o0, 0, 0, 0); o1 = __builtin_amdgcn_mfma_f32_32x32x16_bf16(*(const LAS bf16x8*)(v1p + 48), pb3, o1, 0, 0, 0);
        }
        if (i + 1 < nt) AT_STORE((i + 1) & 1);
        if (MODE == 1) { const int done = __all(carry < -151.0f) ? 1 : 0; if (lane == 0) flags[(i & 1) * 8 + wid] = done; }
        __syncthreads();
        if (MODE == 1) {
            int alld = 1;
#pragma unroll
            for (int w8 = 0; w8 < 8; ++w8) alld &= flags[(i & 1) * 8 + w8];
            if (alld) break;
        }
    }
    if (MODE == 1) __syncthreads();
    float inv = 1.0f;
    if (MODE != 1) { const float lt = lrow + __shfl_xor(lrow, 32); inv = 1.0f / lt; }
    bf16_t* orow = Op + (size_t)trow * DM + 4 * hi;
#pragma unroll
    for (int g = 0; g < 4; ++g) {
        u32x2 w0, w1;
        w0.x = cvt_pk_bf16(o0[4 * g] * inv, o0[4 * g + 1] * inv); w0.y = cvt_pk_bf16(o0[4 * g + 2] * inv, o0[4 * g + 3] * inv);
        w1.x = cvt_pk_bf16(o1[4 * g] * inv, o1[4 * g + 1] * inv); w1.y = cvt_pk_bf16(o1[4 * g + 2] * inv, o1[4 * g + 3] * inv);
        *(u32x2*)(orow + 8 * g) = w0; *(u32x2*)(orow + 32 + 8 * g) = w1;
    }
#undef AT_KT
#undef AT_LOAD
#undef AT_STORE
}

struct Args { const float* in[16]; float* out; unsigned char* ws; };

__device__ __forceinline__ void attn_mla_naive(const bf16_t* QA, const bf16_t* KVA, const bf16_t* PROJ, bf16_t* O) {
    const int nth = gridDim.x * NTHREADS;
    for (int w = blockIdx.x * NTHREADS + threadIdx.x; w < 8 * MTOK; w += nth) {
        const int h = w >> 14, row = w & (MTOK - 1), b = row >> 11, t = row & (SEQ - 1);
        float q[96];
#pragma unroll
        for (int c = 0; c < 12; ++c) unpack8(*(const u32x4*)(QA + (size_t)row * NQA + h * 96 + c * 8), q + c * 8);
        float o[64];
#pragma unroll
        for (int d = 0; d < 64; ++d) o[d] = 0.f;
        float mx = -INFINITY, l = 0.f;
        const int kend = ((t >> 6) + 1) << 6;
        for (int s = 0; s < kend; ++s) {
            const size_t kr = (size_t)(b * SEQ + s);
            const bf16_t* kp = KVA + kr * NKVA + h * 128; const bf16_t* rp = PROJ + kr * NPROJ_P + C_KR;
            float sc = 0.f;
#pragma unroll
            for (int c = 0; c < 8; ++c) { float k[8]; unpack8(*(const u32x4*)(kp + c * 8), k);
#pragma unroll
                for (int e = 0; e < 8; ++e) sc += q[c * 8 + e] * k[e]; }
#pragma unroll
            for (int c = 0; c < 4; ++c) { float k[8]; unpack8(*(const u32x4*)(rp + c * 8), k);
#pragma unroll
                for (int e = 0; e < 8; ++e) sc += q[64 + c * 8 + e] * k[e]; }
            const float mn = fmaxf(mx, sc), al = __builtin_amdgcn_exp2f(mx - mn), p = __builtin_amdgcn_exp2f(sc - mn);
            l = l * al + p; mx = mn;
#pragma unroll
            for (int c = 0; c < 8; ++c) { float v[8]; unpack8(*(const u32x4*)(kp + 64 + c * 8), v);
#pragma unroll
                for (int e = 0; e < 8; ++e) o[c * 8 + e] = o[c * 8 + e] * al + p * v[e]; }
        }
        const float inv = 1.0f / l;
#pragma unroll
        for (int c = 0; c < 8; ++c) { u32x4 wv; wv.x = cvt_pk_bf16(o[c * 8] * inv, o[c * 8 + 1] * inv); wv.y = cvt_pk_bf16(o[c * 8 + 2] * inv, o[c * 8 + 3] * inv); wv.z = cvt_pk_bf16(o[c * 8 + 4] * inv, o[c * 8 + 5] * inv); wv.w = cvt_pk_bf16(o[c * 8 + 6] * inv, o[c * 8 + 7] * inv);
            *(u32x4*)(O + (size_t)row * DM + h * 64 + c * 8) = wv; }
    }
}

__device__ __forceinline__ void attn_sb_naive(const bf16_t* PROJ, bf16_t* O) {
    const int nth = gridDim.x * NTHREADS;
    for (int w = blockIdx.x * NTHREADS + threadIdx.x; w < 8 * MTOK; w += nth) {
        const int h = w >> 14, row = w & (MTOK - 1), b = row >> 11, t = row & (SEQ - 1);
        float q[64];
#pragma unroll
        for (int c = 0; c < 8; ++c) unpack8(*(const u32x4*)(PROJ + (size_t)row * NPROJ_P + C_QB + h * 64 + c * 8), q + c * 8);
        float o[64];
#pragma unroll
        for (int d = 0; d < 64; ++d) o[d] = 0.f;
        float cum = 0.f;
        const int tmax = t | 63;
        for (int s = tmax - 1; s >= 0; --s) {
            const size_t kr = (size_t)(b * SEQ + s);
            const bf16_t* kp = PROJ + kr * NPROJ_P + C_KB + h * 64; const bf16_t* vp = PROJ + kr * NPROJ_P + C_VB + h * 64;
            float z = 0.f;
#pragma unroll
            for (int c = 0; c < 8; ++c) { float k[8]; unpack8(*(const u32x4*)(kp + c * 8), k);
#pragma unroll
                for (int e = 0; e < 8; ++e) z += q[c * 8 + e] * k[e]; }
            z *= 0.125f;
            const bool on = s < t;
            const float lg = __logf(1.0f + __expf(-fabsf(z)));
            const float wgt = on ? __expf(fminf(z, 0.f) - lg + cum) : 0.f;
            cum += on ? (fminf(-z, 0.f) - lg) : 0.f;
#pragma unroll
            for (int c = 0; c < 8; ++c) { float v[8]; unpack8(*(const u32x4*)(vp + c * 8), v);
#pragma unroll
                for (int e = 0; e < 8; ++e) o[c * 8 + e] += wgt * v[e]; }
        }
#pragma unroll
        for (int c = 0; c < 8; ++c) { u32x4 wv; wv.x = cvt_pk_bf16(o[c * 8], o[c * 8 + 1]); wv.y = cvt_pk_bf16(o[c * 8 + 2], o[c * 8 + 3]); wv.z = cvt_pk_bf16(o[c * 8 + 4], o[c * 8 + 5]); wv.w = cvt_pk_bf16(o[c * 8 + 6], o[c * 8 + 7]);
            *(u32x4*)(O + (size_t)row * DM + 512 + h * 64 + c * 8) = wv; }
    }
}

__device__ __forceinline__ void attn_band_naive(const bf16_t* QKV, const float* rel_bias, bf16_t* O) {
    const int nth = gridDim.x * NTHREADS;
    for (int w = blockIdx.x * NTHREADS + threadIdx.x; w < 16 * MTOK; w += nth) {
        const int h = w >> 14, row = w & (MTOK - 1), b = row >> 11, t = row & (SEQ - 1);
        float q[64];
#pragma unroll
        for (int c = 0; c < 8; ++c) unpack8(*(const u32x4*)(QKV + (size_t)row * NQKV + h * 64 + c * 8), q + c * 8);
        float o[64];
#pragma unroll
        for (int d = 0; d < 64; ++d) o[d] = 0.f;
        float mx = -INFINITY, l = 0.f;
        const int n = t >> 6, s0 = (n >= 8) ? (n - 8) * 64 : 0, s1 = (n + 1) * 64;
        const float* bias = rel_bias + h * 513 + 256;
        for (int s = s0; s < s1; ++s) {
            const size_t kr = (size_t)(b * SEQ + s);
            const bf16_t* kp = QKV + kr * NQKV + 1024 + h * 64; const bf16_t* vp = QKV + kr * NQKV + 2048 + h * 64;
            float sc = 0.f;
#pragma unroll
            for (int c = 0; c < 8; ++c) { float k[8]; unpack8(*(const u32x4*)(kp + c * 8), k);
#pragma unroll
                for (int e = 0; e < 8; ++e) sc += q[c * 8 + e] * k[e]; }
            int rel = t - s; rel = rel > 256 ? 256 : (rel < -256 ? -256 : rel);
            sc += bias[rel] * LOG2E;
            const float mn = fmaxf(mx, sc), al = __builtin_amdgcn_exp2f(mx - mn), p = __builtin_amdgcn_exp2f(sc - mn);
            l = l * al + p; mx = mn;
#pragma unroll
            for (int c = 0; c < 8; ++c) { float v[8]; unpack8(*(const u32x4*)(vp + c * 8), v);
#pragma unroll
                for (int e = 0; e < 8; ++e) o[c * 8 + e] = o[c * 8 + e] * al + p * v[e]; }
        }
        const float inv = 1.0f / l;
#pragma unroll
        for (int c = 0; c < 8; ++c) { u32x4 wv; wv.x = cvt_pk_bf16(o[c * 8] * inv, o[c * 8 + 1] * inv); wv.y = cvt_pk_bf16(o[c * 8 + 2] * inv, o[c * 8 + 3] * inv); wv.z = cvt_pk_bf16(o[c * 8 + 4] * inv, o[c * 8 + 5] * inv); wv.w = cvt_pk_bf16(o[c * 8 + 6] * inv, o[c * 8 + 7] * inv);
            *(u32x4*)(O + (size_t)row * DM + h * 64 + c * 8) = wv; }
    }
}

__global__ void __launch_bounds__(NTHREADS) fwd_megakernel(Args args) {
    extern __shared__ __attribute__((aligned(16))) unsigned char lds[];
    cg::grid_group grid = cg::this_grid();
#ifdef USE_NAIVE_GEMM
#define GEMM(A, lda, Bt, ldb, M, N, K, E) gemm_naive(A, lda, Bt, ldb, (M) / 256, (N) / 256, K, E)
#else
#define GEMM(A, lda, Bt, ldb, M, N, K, E) gemm_fast((LAS unsigned char*)lds, A, lda, Bt, ldb, M, N, K, E)
#endif
    const int tid = threadIdx.x, lane = tid & 63, wave = tid >> 6;
    const int G = gridDim.x;
    const int vcu = (G % 8 == 0) ? (int)(blockIdx.x % 8) * (G / 8) + (int)(blockIdx.x / 8) : (int)blockIdx.x;
    LAS unsigned char* ldsp = (LAS unsigned char*)lds;
    unsigned char* ws = args.ws;
    const float* x = args.in[0];
    float* out = args.out;
    float* ssq = (float*)(ws + WS_SSQ);
    f32x2* rope = (f32x2*)(ws + WS_ROPE);
    bf16_t* Win = (bf16_t*)(ws + WS_WIN); bf16_t* Wuq = (bf16_t*)(ws + WS_WUQ); bf16_t* Wukv = (bf16_t*)(ws + WS_WUKV); bf16_t* Wo0 = (bf16_t*)(ws + WS_WO0);
    bf16_t* Wgu0 = (bf16_t*)(ws + WS_WGU0); bf16_t* Wd0 = (bf16_t*)(ws + WS_WD0); bf16_t* Wqkv = (bf16_t*)(ws + WS_WQKV); bf16_t* Wo1 = (bf16_t*)(ws + WS_WO1);
    bf16_t* Wgu1 = (bf16_t*)(ws + WS_WGU1); bf16_t* Wd1 = (bf16_t*)(ws + WS_WD1);
    bf16_t* HB = (bf16_t*)(ws + WS_HB); bf16_t* PROJ = (bf16_t*)(ws + WS_A); bf16_t* QKV = (bf16_t*)(ws + WS_A); bf16_t* ACT = (bf16_t*)(ws + WS_A); bf16_t* ATT = (bf16_t*)(ws + WS_ATT);
    bf16_t* QA = (bf16_t*)((unsigned char*)out + OUT_QA); bf16_t* KVA = (bf16_t*)((unsigned char*)out + OUT_KVA);

    {
        LAS float* scr = (LAS float*)((LAS unsigned char*)lds + wave * 16384);
        const int gw = blockIdx.x * 8 + wave, NGW = G * 8;
        const float* g_mix = args.in[10]; const float* g_ffn = args.in[11];
        constexpr int I_IN = 16 * (NPROJ / 32), I_UQ = 6 * 24, I_UKV = 4 * 32, I_O = 16 * 32, I_G = 16 * 88, I_D = 44 * 32, I_QKV = 16 * 96;
        constexpr int NITEMS = I_IN + I_UQ + I_UKV + I_O + 2 * I_G + I_D + I_QKV + I_O + 2 * I_G + I_D;
        for (int it = gw; it < NITEMS; it += NGW) {
            int r = it;
            if (r < I_IN) { p0_item(args.in[1], DM, NPROJ, g_mix, Win, DM, 0, scr, r, lane); continue; } r -= I_IN;
            if (r < I_UQ) { p0_item(args.in[3], 384, NQA, args.in[2], Wuq, 384, 0, scr, r, lane); continue; } r -= I_UQ;
            if (r < I_UKV) { p0_item(args.in[5], 256, NKVA, args.in[4], Wukv, 256, 0, scr, r, lane); continue; } r -= I_UKV;
            if (r < I_O) { p0_item(args.in[6], DM, DM, nullptr, Wo0, DM, 0, scr, r, lane); continue; } r -= I_O;
            if (r < I_G) { p0_item(args.in[12], DM, DFF, g_ffn, Wgu0, DM, 1, scr, r, lane); continue; } r -= I_G;
            if (r < I_G) { p0_item(args.in[13], DM, DFF, g_ffn, Wgu0, DM, 2, scr, r, lane); continue; } r -= I_G;
            if (r < I_D) { p0_item(args.in[14], DFF, DM, nullptr, Wd0, DFF, 0, scr, r, lane); continue; } r -= I_D;
            if (r < I_QKV) { p0_item(args.in[7], DM, NQKV, g_mix + DM, Wqkv, DM, 0, scr, r, lane); continue; } r -= I_QKV;
            if (r < I_O) { p0_item(args.in[9], DM, DM, nullptr, Wo1, DM, 0, scr, r, lane); continue; } r -= I_O;
            if (r < I_G) { p0_item(args.in[12] + (size_t)DM * DFF, DM, DFF, g_ffn + DM, Wgu1, DM, 1, scr, r, lane); continue; } r -= I_G;
            if (r < I_G) { p0_item(args.in[13] + (size_t)DM * DFF, DM, DFF, g_ffn + DM, Wgu1, DM, 2, scr, r, lane); continue; } r -= I_G;
            p0_item(args.in[14] + (size_t)DFF * DM, DFF, DM, nullptr, Wd1, DFF, 0, scr, r, lane);
        }
        for (int i = blockIdx.x * NTHREADS + tid; i < (NPROJ_P - NPROJ) * DM / 8; i += G * NTHREADS) ((u32x4*)(Win + (size_t)NPROJ * DM))[i] = (u32x4){0u, 0u, 0u, 0u};
        for (int i = blockIdx.x * NTHREADS + tid; i < 6 * MTOK; i += G * NTHREADS) ssq[MTOK + i] = 0.f;
        for (int i = blockIdx.x * NTHREADS + tid; i < SEQ * 16; i += G * NTHREADS) {
            const int pos = i >> 4, fi = i & 15;
            const float inv_freq = __builtin_amdgcn_exp2f(-(float)fi * (13.287712379549449f / 16.0f));
            const float ang = (float)pos * inv_freq;
            float tr = ang * 0.15915494309189535f; tr -= floorf(tr);
            rope[i] = (f32x2){__builtin_amdgcn_cosf(tr), __builtin_amdgcn_sinf(tr)};
        }
        for (int m = gw; m < MTOK; m += NGW) {
            const f32x4* xr = (const f32x4*)(x + (size_t)m * DM) + lane; f32x4 v[4]; float s = 0.f;
#pragma unroll
            for (int j = 0; j < 4; ++j) { v[j] = xr[64 * j]; s += dot4(v[j]); }
            s = wave_sum(s);
            if (lane == 0) ssq[m] = s;
#pragma unroll
            for (int j = 0; j < 4; ++j) { u32x2 w; w.x = cvt_pk_bf16(v[j][0], v[j][1]); w.y = cvt_pk_bf16(v[j][2], v[j][3]); *((u32x2*)(HB + (size_t)m * DM) + lane + 64 * j) = w; }
        }
    }
    grid.sync();
    { EpiScale<0> E{PROJ, NPROJ_P, ssq, 1.0f / DM, ssq + MTOK, ssq + 2 * MTOK, rope}; GEMM(HB, DM, Win, DM, MTOK, NPROJ_P, DM, E); }
    grid.sync();
    { EpiScale<1> E{QA, NQA, ssq + MTOK, 1.0f / 384, nullptr, nullptr, rope}; GEMM(PROJ, NPROJ_P, Wuq, 384, MTOK, NQA, 384, E); }
    { EpiScale<2> E{KVA, NKVA, ssq + 2 * MTOK, 1.0f / 256, nullptr, nullptr, rope}; GEMM(PROJ + C_CKV, NPROJ_P, Wukv, 256, MTOK, NKVA, 256, E); }
    grid.sync();
#ifdef NAIVE_ATTN
    attn_mla_naive(QA, KVA, PROJ, ATT);
    attn_sb_naive(PROJ, ATT);
#else
    for (int u = vcu; u < 256; u += G) {
        const int bh = u >> 2, j = u & 3, b = bh >> 3, h = bh & 7;
        const size_t rb = (size_t)b * SEQ;
        for (int k = 0; k < 2; ++k) { const int qt = k ? 7 - j : j;
            attn_unit<0>(ldsp, 256 * qt, QA + rb * NQA + h * 96, NQA, KVA + rb * NKVA + h * 128, NKVA, PROJ + rb * NPROJ_P + C_KR, NPROJ_P, KVA + rb * NKVA + h * 128 + 64, NKVA, ATT + rb * DM + h * 64, nullptr); }
        for (int k = 0; k < 2; ++k) { const int qt = k ? 7 - j : j;
            attn_unit<1>(ldsp, 256 * qt, PROJ + rb * NPROJ_P + C_QB + h * 64, NPROJ_P, PROJ + rb * NPROJ_P + C_KB + h * 64, NPROJ_P, nullptr, 0, PROJ + rb * NPROJ_P + C_VB + h * 64, NPROJ_P, ATT + rb * DM + 512 + h * 64, nullptr); }
    }
#endif
    grid.sync();
    { EpiResid E{x, out, HB, ssq + 3 * MTOK}; GEMM(ATT, DM, Wo0, DM, MTOK, DM, DM, E); }
    grid.sync();
    { EpiSwiglu E{ACT, ssq + 3 * MTOK}; GEMM(HB, DM, Wgu0, DM, MTOK, 2 * DFF, DM, E); }
    grid.sync();
    { EpiResid E{out, out, HB, ssq + 4 * MTOK}; GEMM(ACT, DFF, Wd0, DFF, MTOK, DM, DFF, E); }
    grid.sync();
    { EpiScale<3> E{QKV, NQKV, ssq + 4 * MTOK, 1.0f / DM, nullptr, nullptr, rope}; GEMM(HB, DM, Wqkv, DM, MTOK, NQKV, DM, E); }
    grid.sync();
#ifdef NAIVE_ATTN
    attn_band_naive(QKV, args.in[8], ATT);
#else
    for (int u = vcu; u < 256; u += G) {
        const int bh = u >> 1, half = u & 1, b = bh >> 4, h = bh & 15;
        const size_t rb = (size_t)b * SEQ;
        for (int k = 0; k < 4; ++k)
            attn_unit<2>(ldsp, 256 * (4 * half + k), QKV + rb * NQKV + h * 64, NQKV, QKV + rb * NQKV + 1024 + h * 64, NQKV, nullptr, 0, QKV + rb * NQKV + 2048 + h * 64, NQKV, ATT + rb * DM + h * 64, args.in[8] + h * 513);
    }
#endif
    grid.sync();
    { EpiResid E{out, out, HB, ssq + 5 * MTOK}; GEMM(ATT, DM, Wo1, DM, MTOK, DM, DM, E); }
    grid.sync();
    { EpiSwiglu E{ACT, ssq + 5 * MTOK}; GEMM(HB, DM, Wgu1, DM, MTOK, 2 * DFF, DM, E); }
    grid.sync();
    { EpiResid E{out, out, nullptr, ssq + 6 * MTOK}; GEMM(ACT, DFF, Wd1, DFF, MTOK, DM, DFF, E); }
    grid.sync();
    {
        const int gw = blockIdx.x * 8 + wave, NGW = G * 8;
        const f32x4* gf = (const f32x4*)args.in[15] + lane;
        for (int m = gw; m < MTOK; m += NGW) {
            const float r = rsqrtf(ssq[6 * MTOK + m] * (1.0f / DM) + RMS_EPS);
            f32x4* p = (f32x4*)(out + (size_t)m * DM) + lane;
#pragma unroll
            for (int j = 0; j < 4; ++j) p[64 * j] = p[64 * j] * r * gf[64 * j];
        }
    }
}

extern "C" void kernel_launch(void* const* d_in, const int* in_sizes, int n_in, void* d_out, int out_size, void* d_ws, size_t ws_size, hipStream_t stream) {
    static int grid = 0;
    if (grid == 0) {
        int dev = 0, cus = 0, per_cu = 0;
        hipGetDevice(&dev);
        hipDeviceGetAttribute(&cus, hipDeviceAttributeMultiprocessorCount, dev);
        hipFuncSetAttribute((const void*)fwd_megakernel, hipFuncAttributeMaxDynamicSharedMemorySize, LDS_BYTES);
        hipOccupancyMaxActiveBlocksPerMultiprocessor(&per_cu, (const void*)fwd_megakernel, NTHREADS, LDS_BYTES);
        if (per_cu < 1) per_cu = 1;
        if (per_cu > 1) per_cu = 1;
        grid = cus * per_cu;
        if (n_in != 16 || out_size != MTOK * DM || ws_size < WS_END) { fprintf(stderr, "kernel_launch: unexpected shapes n_in %d out %d ws %zu\n", n_in, out_size, ws_size); }
    }
    Args a{};
    for (int i = 0; i < 16; ++i) a.in[i] = (const float*)d_in[i];
    a.out = (float*)d_out; a.ws = (unsigned char*)d_ws;
    void* kargs[] = {&a};
    hipError_t e = hipLaunchCooperativeKernel((const void*)fwd_megakernel, dim3(grid), dim3(NTHREADS), kargs, LDS_BYTES, stream);
    if (e != hipSuccess) fprintf(stderr, "cooperative launch failed: %s (grid %d)\n", hipGetErrorString(e), grid);
}
```

```cpp
#include <hip/hip_runtime.h>
#include <hip/hip_cooperative_groups.h>
#include <cstdio>
#include <cstdint>
namespace cg = cooperative_groups;

#define LAS __attribute__((address_space(3)))
typedef unsigned short bf16_t;
typedef short bf16x8 __attribute__((ext_vector_type(8)));
typedef float f32x4 __attribute__((ext_vector_type(4)));
typedef float f32x2 __attribute__((ext_vector_type(2)));
typedef unsigned u32x4 __attribute__((ext_vector_type(4)));
typedef unsigned u32x2 __attribute__((ext_vector_type(2)));

constexpr int MTOK = 16384, SEQ = 2048, DM = 1024, DFF = 2816;
constexpr int NPROJ = 2208, NPROJ_P = 2304;
constexpr int C_CKV = 384, C_KR = 640, C_QB = 672, C_KB = 1184, C_VB = 1696;
constexpr int NQA = 768, NKVA = 1024, NQKV = 3072;
constexpr float RMS_EPS = 1e-6f;
constexpr float LOG2E = 1.4426950408889634f;
constexpr float QSCALE_A = 0.10206207261596577f * LOG2E;
constexpr float QSCALE_C = 0.125f * LOG2E;

constexpr size_t KiB = 1024, MiB = 1u << 20;
constexpr size_t WS_SSQ = 0;
constexpr size_t WS_ROPE = 512 * KiB;
constexpr size_t WS_CTL = 768 * KiB, CTL_BYTES = 16 * KiB;
constexpr size_t WS_WIN = 1 * MiB;
constexpr size_t WS_WUQ = WS_WIN + (size_t)NPROJ_P * DM * 2;
constexpr size_t WS_WUKV = WS_WUQ + (size_t)NQA * 384 * 2;
constexpr size_t WS_WO0 = WS_WUKV + (size_t)NKVA * 256 * 2;
constexpr size_t WS_WGU0 = WS_WO0 + (size_t)DM * DM * 2;
constexpr size_t WS_WD0 = WS_WGU0 + (size_t)2 * DFF * DM * 2;
constexpr size_t WS_WQKV = WS_WD0 + (size_t)DM * DFF * 2;
constexpr size_t WS_WO1 = WS_WQKV + (size_t)NQKV * DM * 2;
constexpr size_t WS_WGU1 = WS_WO1 + (size_t)DM * DM * 2;
constexpr size_t WS_WD1 = WS_WGU1 + (size_t)2 * DFF * DM * 2;
constexpr size_t WS_WEND = WS_WD1 + (size_t)DM * DFF * 2;
constexpr size_t WS_HB = 50 * MiB;
constexpr size_t WS_A = 82 * MiB;
constexpr size_t WS_ATT = 178 * MiB;
constexpr size_t WS_END = 210 * MiB;
static_assert(WS_WEND <= WS_HB, "weights fit");
constexpr size_t OUT_QA = 0, OUT_KVA = 24 * MiB;

constexpr int NTHREADS = 512;
constexpr int LDS_BYTES = 147456;

__device__ __forceinline__ unsigned cvt_pk_bf16(float lo, float hi) { unsigned r; asm volatile("v_cvt_pk_bf16_f32 %0, %1, %2" : "=v"(r) : "v"(lo), "v"(hi)); return r; }
__device__ __forceinline__ float bflo(unsigned w) { return __uint_as_float(w << 16); }
__device__ __forceinline__ float bfhi(unsigned w) { return __uint_as_float(w & 0xffff0000u); }
__device__ __forceinline__ void unpack8(const u32x4 w, float* f) {
    f[0] = bflo(w.x); f[1] = bfhi(w.x); f[2] = bflo(w.y); f[3] = bfhi(w.y); f[4] = bflo(w.z); f[5] = bfhi(w.z); f[6] = bflo(w.w); f[7] = bfhi(w.w);
}
__device__ __forceinline__ float wave_sum(float v) {
#pragma unroll
    for (int o = 1; o < 64; o <<= 1) v += __shfl_xor(v, o);
    return v;
}
__device__ __forceinline__ float dot4(const f32x4 a) { return (a[0] * a[0] + a[1] * a[1]) + (a[2] * a[2] + a[3] * a[3]); }

struct Unit { int pm, pn; };


template <int MODE> struct EpiScale {
    static constexpr bool PERM = false, AFTER_DRAIN = false;
    bf16_t* O; int ldc; const float* ssq_in; float inv_n; float* ssq_a; float* ssq_b; const f32x2* rope;
    __device__ __forceinline__ void operator()(const f32x4 (&acc)[2][2][4][2], const Unit& u, int wr, int wc, int fr, int fq) const {
        const int cb0 = u.pn * 256 + wc * 32;
#pragma unroll
        for (int ai = 0; ai < 2; ++ai)
#pragma unroll
            for (int m = 0; m < 4; ++m) {
                const int row = u.pm * 256 + ai * 128 + wr * 64 + m * 16 + fr;
                const float r = rsqrtf(ssq_in[row] * inv_n + RMS_EPS);
                const int pos = row & (SEQ - 1);
#pragma unroll
                for (int bj = 0; bj < 2; ++bj) {
                    const int cb = cb0 + 128 * bj;
                    float sc = r;
                    if (MODE == 1) sc *= QSCALE_A;
                    if (MODE == 3) { if (cb < 1024) sc *= QSCALE_C; }
                    f32x4 v0 = acc[ai][bj][m][0] * sc, v1 = acc[ai][bj][m][1] * sc;
                    bool ropeg = false;
                    if (MODE == 0) ropeg = (cb == C_KR);
                    if (MODE == 1) ropeg = ((cb % 96) == 64);
                    if (ropeg) {
#pragma unroll
                        for (int j = 0; j < 4; ++j) { const f32x2 cs = rope[pos * 16 + 4 * fq + j]; const float x1 = v0[j], x2 = v1[j]; v0[j] = x1 * cs.x - x2 * cs.y; v1[j] = x2 * cs.x + x1 * cs.y; }
                    }
                    if (MODE == 0) {
                        if (cb < C_KR) { float s = dot4(v0) + dot4(v1); s += __shfl_xor(s, 16); s += __shfl_xor(s, 32); if (fq == 0) atomicAdd((cb < C_CKV ? ssq_a : ssq_b) + row, s); }
                    }
                    bf16_t* p = O + (size_t)row * ldc + cb + 4 * fq;
                    u32x2 w0, w1; w0.x = cvt_pk_bf16(v0[0], v0[1]); w0.y = cvt_pk_bf16(v0[2], v0[3]); w1.x = cvt_pk_bf16(v1[0], v1[1]); w1.y = cvt_pk_bf16(v1[2], v1[3]);
                    *(u32x2*)p = w0; *(u32x2*)(p + 16) = w1;
                }
                asm volatile("" ::: "memory");
            }
    }
};

struct EpiResid {
    static constexpr bool PERM = false, AFTER_DRAIN = false;
    const float* base; float* out; bf16_t* hb; float* ssq;
    __device__ __forceinline__ void operator()(const f32x4 (&acc)[2][2][4][2], const Unit& u, int wr, int wc, int fr, int fq) const {
#pragma unroll
        for (int ai = 0; ai < 2; ++ai)
#pragma unroll
            for (int m = 0; m < 4; ++m) {
                const int row = u.pm * 256 + ai * 128 + wr * 64 + m * 16 + fr;
                float s = 0.f;
#pragma unroll
                for (int bj = 0; bj < 2; ++bj)
#pragma unroll
                    for (int n = 0; n < 2; ++n) {
                        const size_t off = (size_t)row * DM + u.pn * 256 + bj * 128 + wc * 32 + 16 * n + 4 * fq;
                        const f32x4 h = *(const f32x4*)(base + off) + acc[ai][bj][m][n];
                        *(f32x4*)(out + off) = h;
                        if (hb) { u32x2 w; w.x = cvt_pk_bf16(h[0], h[1]); w.y = cvt_pk_bf16(h[2], h[3]); *(u32x2*)(hb + off) = w; }
                        s += dot4(h);
                    }
                s += __shfl_xor(s, 16); s += __shfl_xor(s, 32);
                if (fq == 0) atomicAdd(ssq + row, s);
                asm volatile("" ::: "memory");
            }
    }
};

struct EpiSwiglu {
    static constexpr bool PERM = true, AFTER_DRAIN = false;
    bf16_t* O; const float* ssq_in;
    __device__ __forceinline__ void operator()(const f32x4 (&acc)[2][2][4][2], const Unit& u, int wr, int wc, int fr, int fq) const {
#pragma unroll
        for (int ai = 0; ai < 2; ++ai)
#pragma unroll
            for (int m = 0; m < 4; ++m) {
                const int row = u.pm * 256 + ai * 128 + wr * 64 + m * 16 + fr;
                const float r = rsqrtf(ssq_in[row] * (1.0f / DM) + RMS_EPS);
                float a[8];
#pragma unroll
                for (int n = 0; n < 2; ++n)
#pragma unroll
                    for (int j = 0; j < 4; ++j) { const float g = acc[ai][0][m][n][j] * r, uu = acc[ai][1][m][n][j] * r; a[4 * n + j] = g * __builtin_amdgcn_rcpf(1.0f + __expf(-g)) * uu; }
                u32x4 w; w.x = cvt_pk_bf16(a[0], a[1]); w.y = cvt_pk_bf16(a[2], a[3]); w.z = cvt_pk_bf16(a[4], a[5]); w.w = cvt_pk_bf16(a[6], a[7]);
                *(u32x4*)(O + (size_t)row * DFF + u.pn * 128 + wc * 32 + 8 * fq) = w;
                asm volatile("" ::: "memory");
            }
    }
};

__host__ __device__ __forceinline__ int perm32(int rho) { const int n = rho >> 4, i = rho & 15; return 8 * (i >> 2) + 4 * n + (i & 3); }
template <class Epi>
__device__ __forceinline__ void gemm_naive(const bf16_t* A, int lda, const bf16_t* Bt, int ldb, int nM, int nN, int K, const Epi& E) {
    constexpr bool PERM = Epi::PERM;
    const int tid = threadIdx.x, wid = tid >> 6, lane = tid & 63, wr = wid >> 2, wc = wid & 3, fr = lane & 15, fq = lane >> 4;
    for (int unit = blockIdx.x; unit < nM * nN; unit += gridDim.x) {
        Unit u; u.pm = unit / nN; u.pn = unit % nN;
        f32x4 acc[2][2][4][2];
#pragma unroll
        for (int a = 0; a < 2; ++a)
#pragma unroll
            for (int b = 0; b < 2; ++b)
#pragma unroll
                for (int m = 0; m < 4; ++m)
#pragma unroll
                    for (int n = 0; n < 2; ++n) acc[a][b][m][n] = (f32x4){0.f, 0.f, 0.f, 0.f};
        const bf16_t* Ab = A + (size_t)(u.pm * 256 + wr * 64 + fr) * lda + 8 * fq;
        const bf16_t* Bb = Bt + (size_t)(u.pn * 256 + wc * 32) * ldb + 8 * fq;
        const int br0 = PERM ? perm32(fr) : fr, br1 = PERM ? perm32(16 + fr) : 16 + fr;
        for (int k0 = 0; k0 < K; k0 += 32) {
            bf16x8 af[2][4], bq[2][2];
#pragma unroll
            for (int ai = 0; ai < 2; ++ai)
#pragma unroll
                for (int m = 0; m < 4; ++m) af[ai][m] = *(const bf16x8*)(Ab + (size_t)(ai * 128 + m * 16) * lda + k0);
#pragma unroll
            for (int bj = 0; bj < 2; ++bj) { bq[bj][0] = *(const bf16x8*)(Bb + (size_t)(bj * 128 + br0) * ldb + k0); bq[bj][1] = *(const bf16x8*)(Bb + (size_t)(bj * 128 + br1) * ldb + k0); }
#pragma unroll
            for (int ai = 0; ai < 2; ++ai)
#pragma unroll
                for (int bj = 0; bj < 2; ++bj)
#pragma unroll
                    for (int m = 0; m < 4; ++m)
#pragma unroll
                        for (int n = 0; n < 2; ++n) acc[ai][bj][m][n] = __builtin_amdgcn_mfma_f32_16x16x32_bf16(bq[bj][n], af[ai][m], acc[ai][bj][m][n], 0, 0, 0);
        }
        E(acc, u, wr, wc, fr, fq);
    }
}

#define PG8_LAS __attribute__((address_space(3)))
constexpr int BM = 256, BK = 64, HALF = 128, HTB = HALF * BK * 2  , STAGE_BYTES = 8 * HTB, NXCD = 8, WGM = 8;
__host__ __device__ __forceinline__ int lds_byte(int r, int c) { const int st = (r >> 4) * 2 + (c >> 5), rr = r & 15, cc = c & 31, ob = rr * 64 + cc * 2; return st * 1024 + (ob ^ (((ob >> 9) & 1) << 5)); }
__host__ __device__ __forceinline__ void stage_rc(int b, int& R, int& C) { const int st = b / 1024, sb = b % 1024, swz = sb ^ (((sb >> 9) & 1) << 5); R = (st >> 1) * 16 + swz / 64; C = (st & 1) * 32 + (swz % 64) / 2; }
struct Gemm { const bf16_t* A; const bf16_t* Bt; int M, N, K, lda, ldb; };
struct StaticOrder {
    int nM, nN, nwg, G, c;
    __host__ __device__ void init(int M, int N, int G_, int c_) { nM = M / BM; nN = N / BM; nwg = nM * nN; G = G_; c = c_; }
    __host__ __device__ bool next(int i, Unit& u) const {
        const long L = (long)i * G + c; if (L >= nwg) return false;
        int wgid = (int)L; { const int q = nwg / NXCD, r = nwg % NXCD, xcd = wgid % NXCD, off = wgid / NXCD; wgid = (xcd < r ? xcd * (q + 1) : r * (q + 1) + (xcd - r) * q) + off; }
        const int nig = WGM * nN, gid = wgid / nig, fm = gid * WGM, gsz = (nM - fm) < WGM ? (nM - fm) : WGM;
        u.pm = fm + ((wgid % nig) % gsz); u.pn = (wgid % nig) / gsz; return true;
    }
    __device__ __forceinline__ void a_ready(const Unit&) const {}
    __device__ __forceinline__ void done(const Unit&) const {}
};
template <class Epi, class Sched, bool ALIGN_EPI = false, bool SP2 = false>
__device__ __forceinline__ void gemm_phase(PG8_LAS unsigned char* lds, const Gemm g, const Sched& S, const Epi& E) {
    const int tid = threadIdx.x, wid = __builtin_amdgcn_readfirstlane(tid >> 6), lane = tid & 63, wr = wid >> 2, wc = wid & 3, fr = lane & 15, fq = lane >> 4;
    const int K = g.K, nt = K / BK;
    unsigned voffA[2], voffB[2];
#pragma unroll
    for (int i = 0; i < 2; ++i) { int R, C; stage_rc(tid * 16 + i * 8192, R, C); const int Rb = Epi::PERM ? ((R & ~31) + perm32(R & 31)) : R;
        voffA[i] = (unsigned)(R * g.lda + C) * 2u; voffB[i] = (unsigned)(Rb * g.ldb + C) * 2u; }
    const size_t kstep = (size_t)(BK * 2);
    const size_t hstepA = (size_t)HALF * g.lda * 2, hstepB = (size_t)HALF * g.ldb * 2;
    const size_t tstepA = 2 * hstepA, tstepB = 2 * hstepB;
    const unsigned ldsw = (unsigned)wid * 1024u;
    const int aoff = lds_byte(wr * 64 + fr, fq * 8), boff = lds_byte(wc * 32 + fr, fq * 8);
#define PG8_SA(b, h) (((b) * 2 + (h)) * HTB)
#define PG8_SB(b, h) ((4 + (b) * 2 + (h)) * HTB)
#define PG8_STAGE(bufoff, gbase, voff) do { _Pragma("unroll") for (int _i = 0; _i < 2; ++_i) \
        __builtin_amdgcn_global_load_lds((const unsigned*)((const char*)(gbase) + (voff)[_i]), (PG8_LAS unsigned*)(lds + (bufoff) + ldsw + _i * 8192), 16, 0, 0); } while (0)
#define PG8_LDA(dst, b, h) do { _Pragma("unroll") for (int m = 0; m < 4; ++m) _Pragma("unroll") for (int k = 0; k < 2; ++k) dst[m][k] = *(const PG8_LAS bf16x8*)(lds + PG8_SA(b, h) + aoff + m * 2048 + k * 1024); } while (0)
#define PG8_LDB(dst, b, h) do { _Pragma("unroll") for (int n = 0; n < 2; ++n) _Pragma("unroll") for (int k = 0; k < 2; ++k) dst[n][k] = *(const PG8_LAS bf16x8*)(lds + PG8_SB(b, h) + boff + n * 2048 + k * 1024); } while (0)
#define PG8_MMA(ai, bj, At, Bt) do { __builtin_amdgcn_s_setprio(1); _Pragma("unroll") for (int m = 0; m < 4; ++m) _Pragma("unroll") for (int n = 0; n < 2; ++n) _Pragma("unroll") for (int k = 0; k < 2; ++k) \
        acc[ai][bj][m][n] = __builtin_amdgcn_mfma_f32_16x16x32_bf16(Bt[n][k], At[m][k], acc[ai][bj][m][n], 0, 0, 0); __builtin_amdgcn_s_setprio(0); } while (0)
#define PG8_WAIT_V(n) asm volatile("s_waitcnt vmcnt(" #n ")" ::: "memory")
#define PG8_WAIT_L(n) asm volatile("s_waitcnt lgkmcnt(" #n ")" ::: "memory")
#define PG8_BAR __builtin_amdgcn_s_barrier()
#define PG8_SCHED __builtin_amdgcn_sched_barrier(0)
    Unit cur, nxt; int ui = 0;
    if (!S.next(0, cur)) return;
    f32x4 acc[2][2][4][2];
#pragma unroll
    for (int a = 0; a < 2; ++a)
#pragma unroll
        for (int b = 0; b < 2; ++b)
#pragma unroll
            for (int m = 0; m < 4; ++m)
#pragma unroll
                for (int n = 0; n < 2; ++n) acc[a][b][m][n] = (f32x4){0.f, 0.f, 0.f, 0.f};
    bf16x8 At[4][2], B0[2][2], B1[2][2];
    const char* cA = (const char*)g.A + (size_t)cur.pm * tstepA; const char* cB = (const char*)g.Bt + (size_t)cur.pn * tstepB;
    S.a_ready(cur);
    if constexpr (SP2) {
        PG8_STAGE(PG8_SB(0, 0), cB, voffB); PG8_STAGE(PG8_SB(0, 1), cB + hstepB, voffB); PG8_STAGE(PG8_SA(0, 0), cA, voffA); PG8_STAGE(PG8_SA(0, 1), cA + hstepA, voffA);
        if (wr == 1) PG8_BAR;
        PG8_WAIT_V(2); PG8_BAR;
        PG8_STAGE(PG8_SB(1, 0), cB + kstep, voffB); PG8_STAGE(PG8_SA(1, 0), cA + kstep, voffA); PG8_STAGE(PG8_SB(1, 1), cB + hstepB + kstep, voffB);
        PG8_WAIT_V(6); PG8_BAR;
    } else {
        PG8_STAGE(PG8_SB(0, 0), cB, voffB); PG8_STAGE(PG8_SA(0, 0), cA, voffA); PG8_STAGE(PG8_SB(0, 1), cB + hstepB, voffB); PG8_STAGE(PG8_SA(0, 1), cA + hstepA, voffA);
        if (wr == 1) PG8_BAR;
        PG8_WAIT_V(4); PG8_BAR;
        PG8_STAGE(PG8_SB(1, 0), cB + kstep, voffB); PG8_STAGE(PG8_SA(1, 0), cA + kstep, voffA); PG8_STAGE(PG8_SB(1, 1), cB + hstepB + kstep, voffB);
        PG8_WAIT_V(6); PG8_BAR;
    }
    for (;;) {
        const bool has_next = S.next(ui + 1, nxt);
        const char* nA = has_next ? (const char*)g.A + (size_t)nxt.pm * tstepA : cA; const char* nB = has_next ? (const char*)g.Bt + (size_t)nxt.pn * tstepB : cB;
#pragma clang loop unroll(disable)
        for (int t = 0; t < nt; t += 2) {
            const bool last = (t == nt - 2);
            const char* a1 = cA + (size_t)(t + 1) * kstep;
            const char* a2 = last ? nA : cA + (size_t)(t + 2) * kstep; const char* b2 = last ? nB : cB + (size_t)(t + 2) * kstep;
            const char* a3 = a2 + kstep; const char* b3 = b2 + kstep;
            if (last && has_next) S.a_ready(nxt);
            if constexpr (SP2) {
            PG8_LDB(B0, 0, 0); PG8_LDB(B1, 0, 1); PG8_SCHED; PG8_LDA(At, 0, 0); PG8_STAGE(PG8_SA(1, 1), a1 + hstepA, voffA);
            PG8_WAIT_V(8); PG8_WAIT_L(0); PG8_BAR; PG8_MMA(0, 0, At, B0); PG8_MMA(0, 1, At, B1); PG8_BAR; PG8_SCHED;
            PG8_LDA(At, 0, 1); PG8_STAGE(PG8_SB(0, 0), b2, voffB); PG8_STAGE(PG8_SB(0, 1), b2 + hstepB, voffB); PG8_STAGE(PG8_SA(0, 0), a2, voffA);
            PG8_WAIT_V(8); PG8_WAIT_L(0); PG8_BAR; PG8_MMA(1, 0, At, B0); PG8_MMA(1, 1, At, B1); PG8_BAR; PG8_SCHED;
            PG8_LDB(B0, 1, 0); PG8_LDB(B1, 1, 1); PG8_SCHED; PG8_LDA(At, 1, 0); PG8_STAGE(PG8_SA(0, 1), a2 + hstepA, voffA);
            PG8_WAIT_V(8); PG8_WAIT_L(0); PG8_BAR; PG8_MMA(0, 0, At, B0); PG8_MMA(0, 1, At, B1); PG8_BAR; PG8_SCHED;
            PG8_LDA(At, 1, 1); PG8_STAGE(PG8_SB(1, 0), b3, voffB); PG8_STAGE(PG8_SB(1, 1), b3 + hstepB, voffB); PG8_STAGE(PG8_SA(1, 0), a3, voffA);
            PG8_WAIT_V(8); PG8_WAIT_L(0); PG8_BAR; PG8_MMA(1, 0, At, B0); PG8_MMA(1, 1, At, B1); PG8_BAR; PG8_SCHED;
            } else {
            PG8_LDB(B0, 0, 0); PG8_SCHED; PG8_LDA(At, 0, 0); PG8_STAGE(PG8_SA(1, 1), a1 + hstepA, voffA);
            PG8_WAIT_L(8); PG8_BAR; PG8_WAIT_L(0); PG8_MMA(0, 0, At, B0); PG8_BAR; PG8_SCHED;
            PG8_LDB(B1, 0, 1); PG8_STAGE(PG8_SB(0, 0), b2, voffB);
            PG8_BAR; PG8_WAIT_L(0); PG8_MMA(0, 1, At, B1); PG8_BAR;
            PG8_LDA(At, 0, 1); PG8_STAGE(PG8_SA(0, 0), a2, voffA);
            PG8_BAR; PG8_WAIT_L(0); PG8_MMA(1, 0, At, B0); PG8_BAR; PG8_SCHED;
            PG8_STAGE(PG8_SB(0, 1), b2 + hstepB, voffB);
            PG8_WAIT_V(6); PG8_BAR; PG8_MMA(1, 1, At, B1); PG8_BAR;
            PG8_LDB(B0, 1, 0); PG8_SCHED; PG8_LDA(At, 1, 0); PG8_STAGE(PG8_SA(0, 1), a2 + hstepA, voffA);
            PG8_WAIT_L(8); PG8_BAR; PG8_WAIT_L(0); PG8_MMA(0, 0, At, B0); PG8_BAR; PG8_SCHED;
            PG8_LDB(B1, 1, 1); PG8_STAGE(PG8_SB(1, 0), b3, voffB);
            PG8_BAR; PG8_WAIT_L(0); PG8_MMA(0, 1, At, B1); PG8_BAR;
            PG8_LDA(At, 1, 1); PG8_STAGE(PG8_SA(1, 0), a3, voffA);
            PG8_BAR; PG8_WAIT_L(0); PG8_MMA(1, 0, At, B0); PG8_BAR; PG8_SCHED;
            PG8_STAGE(PG8_SB(1, 1), b3 + hstepB, voffB);
            PG8_WAIT_V(6); PG8_BAR; PG8_MMA(1, 1, At, B1); PG8_BAR;
            }
        }
        if constexpr (ALIGN_EPI) { if (wr == 0) PG8_BAR; }
        if constexpr (!Epi::AFTER_DRAIN) { E(acc, cur, wr, wc, fr, fq); S.done(cur); }
        if (!has_next) break;
#pragma unroll
        for (int a = 0; a < 2; ++a)
#pragma unroll
            for (int b = 0; b < 2; ++b)
#pragma unroll
                for (int m = 0; m < 4; ++m)
#pragma unroll
                    for (int n = 0; n < 2; ++n) acc[a][b][m][n] = (f32x4){0.f, 0.f, 0.f, 0.f};
        cur = nxt; cA = nA; cB = nB; ++ui;
        if constexpr (ALIGN_EPI) { if (wr == 1) PG8_BAR; }
    }
    PG8_WAIT_V(0);
    if constexpr (!ALIGN_EPI) { if (wr == 0) PG8_BAR; }
    PG8_BAR;
    if constexpr (Epi::AFTER_DRAIN) { E.fused(acc, cur, wr, wc, fr, fq, lds, wid, lane); S.done(cur); }
#undef PG8_SA
#undef PG8_SB
#undef PG8_STAGE
#undef PG8_LDA
#undef PG8_LDB
#undef PG8_MMA
#undef PG8_WAIT_V
#undef PG8_WAIT_L
#undef PG8_BAR
#undef PG8_SCHED
}
template <class Epi>
__device__ __forceinline__ void gemm_fast(LAS unsigned char* lds, const bf16_t* A, int lda, const bf16_t* Bt, int ldb, int M, int N, int K, const Epi& E) {
    Gemm g{A, Bt, M, N, K, lda, ldb}; StaticOrder S; S.init(M, N, (int)gridDim.x, (int)blockIdx.x);
    gemm_phase<Epi, StaticOrder, true, true>(lds, g, S, E);
}

__device__ __forceinline__ void p0_item(const float* W, int K, int N, const float* g, bf16_t* WT, int ldt, int mode, LAS float* scr, int item, int lane) {
    const int nblk = N / 32, kb = item / nblk, nb = item % nblk, k0 = 64 * kb, n0 = 32 * nb;
#pragma unroll 8
    for (int i = 0; i < 32; ++i) { const int kk = 2 * i + (lane >> 5); const float gs = g ? g[k0 + kk] : 1.0f; scr[kk * 33 + (lane & 31)] = W[(size_t)(k0 + kk) * N + n0 + (lane & 31)] * gs; }
    asm volatile("s_waitcnt lgkmcnt(0)" ::: "memory");
    const int c = lane & 7;
#pragma unroll
    for (int j = 0; j < 4; ++j) {
        const int n = (lane >> 3) + 8 * j; const LAS float* s = scr + (8 * c) * 33 + n;
        u32x4 o; o.x = cvt_pk_bf16(s[0 * 33], s[1 * 33]); o.y = cvt_pk_bf16(s[2 * 33], s[3 * 33]); o.z = cvt_pk_bf16(s[4 * 33], s[5 * 33]); o.w = cvt_pk_bf16(s[6 * 33], s[7 * 33]);
        const int nn = n0 + n; const int row = (mode == 0) ? nn : ((nn >> 7) * 256 + (mode == 2 ? 128 : 0) + (nn & 127));
        *(u32x4*)(WT + (size_t)row * ldt + k0 + 8 * c) = o;
    }
    asm volatile("s_waitcnt lgkmcnt(0)" ::: "memory");
}


typedef float f32x16 __attribute__((ext_vector_type(16)));
constexpr int AT_VSTR = 72;
constexpr int AT_KBUF = 64 * 104 * 2, AT_VBUF = 64 * AT_VSTR * 2;
constexpr int AT_OFF_K = 0, AT_OFF_V = 2 * AT_KBUF, AT_OFF_BIAS = 2 * AT_KBUF + 2 * AT_VBUF, AT_OFF_FLAG = AT_OFF_BIAS + 2304;
__device__ __forceinline__ int crow16(int r, int hi) { return (r & 3) + 8 * (r >> 2) + 4 * hi; }
__device__ __forceinline__ int vperm(int key) { const int k16 = key & 15; return (key & ~15) + 8 * ((k16 >> 2) & 1) + 4 * (k16 >> 3) + (k16 & 3); }
__device__ __forceinline__ bf16x8 pack8(float a0, float a1, float a2, float a3, float a4, float a5, float a6, float a7) {
    u32x4 w; w.x = cvt_pk_bf16(a0, a1); w.y = cvt_pk_bf16(a2, a3); w.z = cvt_pk_bf16(a4, a5); w.w = cvt_pk_bf16(a6, a7); return __builtin_bit_cast(bf16x8, w);
}

template <int MODE>
__device__ __forceinline__ void attn_unit(LAS unsigned char* lds, int q0, const bf16_t* Qp, int ldq, const bf16_t* Kp, int ldk, const bf16_t* Krp, int ldkr, const bf16_t* Vp, int ldv, bf16_t* Op, const float* bias_g) {
    constexpr int DQK = (MODE == 0) ? 96 : 64, NDD = DQK / 16, KSTR = DQK + 8;
    const int tid = threadIdx.x, lane = tid & 63, wid = __builtin_amdgcn_readfirstlane(tid >> 6), l31 = lane & 31, hi = lane >> 5;
    const int t0w = q0 + 32 * wid, trow = t0w + l31, nq = t0w >> 6;
    LAS float* biasl = (LAS float*)(lds + AT_OFF_BIAS);
    LAS int* flags = (LAS int*)(lds + AT_OFF_FLAG);
    if (MODE == 2) { for (int i = tid; i < 513; i += NTHREADS) biasl[i] = bias_g[i] * LOG2E; }
    bf16x8 qf[NDD];
#pragma unroll
    for (int dd = 0; dd < NDD; ++dd) qf[dd] = *(const bf16x8*)(Qp + (size_t)trow * ldq + 16 * dd + 8 * hi);
    f32x16 o0, o1;
#pragma unroll
    for (int r = 0; r < 16; ++r) { o0[r] = 0.f; o1[r] = 0.f; }
    float mrow = -1e30f, lrow = 0.f, carry = 0.f;
    const int kt_hi = (q0 + 255) >> 6;
    int kt_lo = 0; if (MODE == 2) { kt_lo = (q0 >> 6) - 8; if (kt_lo < 0) kt_lo = 0; }
    const int nt = kt_hi - kt_lo + 1;
    const int skey = tid >> 3, sch = tid & 7, rkey = tid >> 2, rch = tid & 3;
    const int vcol = vperm(lane);
    u32x4 kreg, krreg, vreg;
#define AT_KT(i) ((MODE == 1) ? (kt_hi - (i)) : (kt_lo + (i)))
#define AT_LOAD(kt) do { const size_t kb_ = (size_t)(kt) * 64; \
        kreg = *(const u32x4*)(Kp + (kb_ + skey) * ldk + sch * 8); \
        if (MODE == 0) { if (tid < 256) krreg = *(const u32x4*)(Krp + (kb_ + rkey) * ldkr + rch * 8); } \
        vreg = *(const u32x4*)(Vp + (kb_ + lane) * ldv + wid * 8); } while (0)
#define AT_STORE(bufi) do { LAS bf16_t* Ks_ = (LAS bf16_t*)(lds + AT_OFF_K + (bufi) * AT_KBUF); LAS bf16_t* Vt_ = (LAS bf16_t*)(lds + AT_OFF_V + (bufi) * AT_VBUF); \
        *(LAS u32x4*)(Ks_ + skey * KSTR + sch * 8) = kreg; \
        if (MODE == 0) { if (tid < 256) *(LAS u32x4*)(Ks_ + rkey * KSTR + 64 + rch * 8) = krreg; } \
        LAS bf16_t* vd_ = Vt_ + (wid * 8) * AT_VSTR + vcol; \
        vd_[0 * AT_VSTR] = (bf16_t)(vreg.x & 0xffffu); vd_[1 * AT_VSTR] = (bf16_t)(vreg.x >> 16); vd_[2 * AT_VSTR] = (bf16_t)(vreg.y & 0xffffu); vd_[3 * AT_VSTR] = (bf16_t)(vreg.y >> 16); \
        vd_[4 * AT_VSTR] = (bf16_t)(vreg.z & 0xffffu); vd_[5 * AT_VSTR] = (bf16_t)(vreg.z >> 16); vd_[6 * AT_VSTR] = (bf16_t)(vreg.w & 0xffffu); vd_[7 * AT_VSTR] = (bf16_t)(vreg.w >> 16); } while (0)
    AT_LOAD(AT_KT(0)); AT_STORE(0);
    __syncthreads();
    for (int i = 0; i < nt; ++i) {
        const int kt = AT_KT(i);
        if (i + 1 < nt) AT_LOAD(AT_KT(i + 1));
        bool part;
        if (MODE == 0) part = (kt <= nq);
        else if (MODE == 1) part = (64 * kt <= t0w + 30);
        else part = (kt <= nq) && (kt >= nq - 8);
        if (part) {
            const LAS bf16_t* Ks = (const LAS bf16_t*)(lds + AT_OFF_K + (i & 1) * AT_KBUF); const LAS bf16_t* Vt = (const LAS bf16_t*)(lds + AT_OFF_V + (i & 1) * AT_VBUF);
            f32x16 p0, p1;
#pragma unroll
            for (int r = 0; r < 16; ++r) { p0[r] = 0.f; p1[r] = 0.f; }
#pragma unroll
            for (int dd = 0; dd < NDD; ++dd) {
                const bf16x8 a0 = *(const LAS bf16x8*)(Ks + l31 * KSTR + 16 * dd + 8 * hi), a1 = *(const LAS bf16x8*)(Ks + (32 + l31) * KSTR + 16 * dd + 8 * hi);
                p0 = __builtin_amdgcn_mfma_f32_32x32x16_bf16(a0, qf[dd], p0, 0, 0, 0); p1 = __builtin_amdgcn_mfma_f32_32x32x16_bf16(a1, qf[dd], p1, 0, 0, 0);
            }
            if (MODE != 1) {
                if (MODE == 2) {
                    const int relb = trow - 64 * kt - 4 * hi;
#pragma unroll
                    for (int r = 0; r < 16; ++r) {
                        int rel0 = relb - ((r & 3) + 8 * (r >> 2)); int rel1 = rel0 - 32;
                        rel0 = rel0 > 256 ? 256 : (rel0 < -256 ? -256 : rel0); rel1 = rel1 > 256 ? 256 : (rel1 < -256 ? -256 : rel1);
                        p0[r] += biasl[256 + rel0]; p1[r] += biasl[256 + rel1];
                    }
                }
                float mx = fmaxf(p0[0], p1[0]);
#pragma unroll
                for (int r = 1; r < 16; ++r) mx = fmaxf(mx, fmaxf(p0[r], p1[r]));
                mx = fmaxf(mx, __shfl_xor(mx, 32));
                const float mnew = fmaxf(mrow, mx), alpha = __builtin_amdgcn_exp2f(mrow - mnew);
                mrow = mnew;
                float rs = 0.f;
#pragma unroll
                for (int r = 0; r < 16; ++r) { p0[r] = __builtin_amdgcn_exp2f(p0[r] - mnew); p1[r] = __builtin_amdgcn_exp2f(p1[r] - mnew); rs += p0[r] + p1[r]; }
                lrow = lrow * alpha + rs;
#pragma unroll
                for (int r = 0; r < 16; ++r) { o0[r] *= alpha; o1[r] *= alpha; }
            } else {
                const bool need_mask = (64 * kt + 63 >= t0w);
                const int kvb = 64 * kt + 4 * hi;
                float gs[8], lkq0[16], lkq1[16];
#pragma unroll
                for (int g = 0; g < 8; ++g) {
                    float s4 = 0.f;
#pragma unroll
                    for (int c = 0; c < 4; ++c) {
                        const int r = 4 * (g & 3) + c;
                        const float z2 = ((g < 4) ? p0[r] : p1[r]) * (0.125f * LOG2E);
                        const float sp2 = fmaxf(z2, 0.f) + __builtin_amdgcn_logf(1.0f + __builtin_amdgcn_exp2f(-fabsf(z2)));
                        const bool valid = !need_mask || (kvb + 8 * g + c < trow);
                        const float lk = valid ? -sp2 : 0.f;
                        const float ls = valid ? (z2 - sp2) : -1e30f;
                        if (g < 4) { p0[r] = ls; } else { p1[r] = ls; }
                        s4 += lk;
                        if (g < 4) { lkq0[r] = lk; } else { lkq1[r] = lk; }
                    }
                    gs[g] = s4;
                }
                float run = 0.f, after[8];
#pragma unroll
                for (int g = 7; g >= 0; --g) { const float pg = __shfl_xor(gs[g], 32); after[g] = run + (hi == 0 ? pg : 0.f); run += gs[g] + pg; }
#pragma unroll
                for (int g = 0; g < 8; ++g) {
                    float suf = carry + after[g];
#pragma unroll
                    for (int c = 3; c >= 0; --c) {
                        const int r = 4 * (g & 3) + c;
                        if (g < 4) { p0[r] = __builtin_amdgcn_exp2f(p0[r] + suf); suf += lkq0[r]; } else { p1[r] = __builtin_amdgcn_exp2f(p1[r] + suf); suf += lkq1[r]; }
                    }
                }
                carry += run;
            }
            const bf16x8 pb0 = pack8(p0[0], p0[1], p0[2], p0[3], p0[4], p0[5], p0[6], p0[7]), pb1 = pack8(p0[8], p0[9], p0[10], p0[11], p0[12], p0[13], p0[14], p0[15]);
            const bf16x8 pb2 = pack8(p1[0], p1[1], p1[2], p1[3], p1[4], p1[5], p1[6], p1[7]), pb3 = pack8(p1[8], p1[9], p1[10], p1[11], p1[12], p1[13], p1[14], p1[15]);
            const LAS bf16_t* v0p = Vt + l31 * AT_VSTR + 8 * hi; const LAS bf16_t* v1p = Vt + (32 + l31) * AT_VSTR + 8 * hi;
            o0 = __builtin_amdgcn_mfma_f32_32x32x16_bf16(*(const LAS bf16x8*)(v0p + 0), pb0, o0, 0, 0, 0);  o1 = __builtin_amdgcn_mfma_f32_32x32x16_bf16(*(const LAS bf16x8*)(v1p + 0), pb0, o1, 0, 0, 0);
            o0 = __builtin_amdgcn_mfma_f32_32x32x16_bf16(*(const LAS bf16x8*)(v0p + 16), pb1, o0, 0, 0, 0); o1 = __builtin_amdgcn_mfma_f32_32x32x16_bf16(*(const LAS bf16x8*)(v1p + 16), pb1, o1, 0, 0, 0);
            o0 = __builtin_amdgcn_mfma_f32_32x32x16_bf16(*(const LAS bf16x8*)(v0p + 32), pb2, o0, 0, 0, 0); o1 = __builtin_amdgcn_mfma_f32_32x32x16_bf16(*(const LAS bf16x8*)(v1p + 32), pb2, o1, 0, 0, 0);
            o0 = __builtin_amdgcn_mfma_f32_32x32x16_bf16(*(const LAS bf16x8*)(v0p + 48), pb3, o0, 0, 0, 0); o1 = __builtin_amdgcn_mfma_f32_32x32x16_bf16(*(const LAS bf16x8*)(v1p + 48), pb3, o1, 0, 0, 0);
        }
        if (i + 1 < nt) AT_STORE((i + 1) & 1);
        if (MODE == 1) { const int done = __all(carry < -151.0f) ? 1 : 0; if (lane == 0) flags[(i & 1) * 8 + wid] = done; }
        __syncthreads();
        if (MODE == 1) {
            int alld = 1;
#pragma unroll
            for (int w8 = 0; w8 < 8; ++w8) alld &= flags[(i & 1) * 8 + w8];
            if (alld) break;
        }
    }
    if (MODE == 1) __syncthreads();
    float inv = 1.0f;
    if (MODE != 1) { const float lt = lrow + __shfl_xor(lrow, 32); inv = 1.0f / lt; }
    bf16_t* orow = Op + (size_t)trow * DM + 4 * hi;
#pragma unroll
    for (int g = 0; g < 4; ++g) {
        u32x2 w0, w1;
        w0.x = cvt_pk_bf16(o0[4 * g] * inv, o0[4 * g + 1] * inv); w0.y = cvt_pk_bf16(o0[4 * g + 2] * inv, o0[4 * g + 3] * inv);
        w1.x = cvt_pk_bf16(o1[4 * g] * inv, o1[4 * g + 1] * inv); w1.y = cvt_pk_bf16(o1[4 * g + 2] * inv, o1[4 * g + 3] * inv);
        *(u32x2*)(orow + 8 * g) = w0; *(u32x2*)(orow + 32 + 8 * g) = w1;
    }
#undef AT_KT
#undef AT_LOAD
#undef AT_STORE
}


#define XB_TMO      128
#define XB_XCNT(j)  (256  + 64 * (j))
#define XB_XSUB(j)  (1280 + 64 * (j))
#define XB_XGEN(j)  (2304 + 64 * (j))
#define XB_TOP      3328
#define XB_TOPGEN   3392
#define XCD_BAR_WORDS 3456
#define XB_SPIN_CAP (1u << 18)
__device__ __forceinline__ unsigned xb_ld(unsigned* p)              { return __hip_atomic_load(p, __ATOMIC_RELAXED, __HIP_MEMORY_SCOPE_AGENT); }
__device__ __forceinline__ unsigned xb_add(unsigned* p, unsigned v) { return __hip_atomic_fetch_add(p, v, __ATOMIC_RELAXED, __HIP_MEMORY_SCOPE_AGENT); }
__device__ __forceinline__ unsigned xb_xcc_id() { return (unsigned)__builtin_amdgcn_s_getreg((3 << 11) | 20) & 0xFu; }
#define XB_SPIN(cond, bar) do { unsigned _sp = 0; while (cond) { __builtin_amdgcn_s_sleep(1); \
    if ((++_sp & 255u) == 0u) { if (xb_ld(&(bar)[XB_TMO])) break; if (_sp > XB_SPIN_CAP) { atomicAdd(&(bar)[XB_TMO], 1u); break; } } } } while (0)
struct XcdBarrier { unsigned* bar; unsigned x; volatile LAS unsigned* st; };
__device__ __forceinline__ XcdBarrier xcd_barrier_post(unsigned* bar, volatile LAS unsigned* st) {
    XcdBarrier b; b.bar = bar; b.x = xb_xcc_id(); b.st = st;
    if (threadIdx.x == 0) (void)xb_add(&bar[XB_XCNT(b.x)], 1u);
    return b;
}
__device__ __forceinline__ void xcd_barrier_complete(unsigned* bar, unsigned x, unsigned& nloc, unsigned& nx) {
    const unsigned G = gridDim.x * gridDim.y * gridDim.z;
    unsigned sum, cnt, mine, sp = 0u;
    for (;;) {
        sum = 0u; cnt = 0u; mine = 0u;
#pragma unroll
        for (unsigned j = 0; j < 16; ++j) { const unsigned c = xb_ld(&bar[XB_XCNT(j)]); sum += c; cnt += (c > 0u) ? 1u : 0u; mine = (j == x) ? c : mine; }
        if (sum == G) break;
        __builtin_amdgcn_s_sleep(1);
        if ((++sp & 255u) == 0u) { if (xb_ld(&bar[XB_TMO])) break; if (sp > XB_SPIN_CAP) { atomicAdd(&bar[XB_TMO], 1u); break; } }
    }
    nloc = mine > 0u ? mine : 1u; nx = cnt > 0u ? cnt : 1u;
}
__device__ __forceinline__ void xcd_barrier(const XcdBarrier& b) {
    asm volatile("s_waitcnt vmcnt(0)" ::: "memory");
    __syncthreads();
    if (threadIdx.x == 0) {
        unsigned* bar = b.bar;
        __builtin_amdgcn_s_waitcnt(0);
        unsigned nloc = b.st[0], nx = b.st[1];
        if (nloc == 0u) { xcd_barrier_complete(bar, b.x, nloc, nx); b.st[0] = nloc; b.st[1] = nx; }
        const unsigned old = xb_add(&bar[XB_XSUB(b.x)], 1u);
        const unsigned gen = old / nloc;
        if (old + 1u == (gen + 1u) * nloc) {
            __builtin_amdgcn_fence(__ATOMIC_RELEASE, "agent");
            asm volatile("s_waitcnt vmcnt(0)" ::: "memory");
            const unsigned og = xb_add(&bar[XB_TOP], 1u);
            const unsigned tg = og / nx;
            if (og + 1u == (tg + 1u) * nx) xb_add(&bar[XB_TOPGEN], 1u);
            else XB_SPIN(xb_ld(&bar[XB_TOPGEN]) == tg, bar);
            __builtin_amdgcn_fence(__ATOMIC_ACQUIRE, "agent");
            xb_add(&bar[XB_XGEN(b.x)], 1u);
            asm volatile("s_waitcnt vmcnt(0)" ::: "memory");
        } else {
            XB_SPIN(xb_ld(&bar[XB_XGEN(b.x)]) == gen, bar);
            __builtin_amdgcn_fence(__ATOMIC_ACQUIRE, "agent");
            asm volatile("s_waitcnt vmcnt(0)" ::: "memory");
        }
    }
    __syncthreads();
}

struct Args { const float* in[16]; float* out; unsigned char* ws; };

__device__ __forceinline__ void attn_mla_naive(const bf16_t* QA, const bf16_t* KVA, const bf16_t* PROJ, bf16_t* O) {
    const int nth = gridDim.x * NTHREADS;
    for (int w = blockIdx.x * NTHREADS + threadIdx.x; w < 8 * MTOK; w += nth) {
        const int h = w >> 14, row = w & (MTOK - 1), b = row >> 11, t = row & (SEQ - 1);
        float q[96];
#pragma unroll
        for (int c = 0; c < 12; ++c) unpack8(*(const u32x4*)(QA + (size_t)row * NQA + h * 96 + c * 8), q + c * 8);
        float o[64];
#pragma unroll
        for (int d = 0; d < 64; ++d) o[d] = 0.f;
        float mx = -INFINITY, l = 0.f;
        const int kend = ((t >> 6) + 1) << 6;
        for (int s = 0; s < kend; ++s) {
            const size_t kr = (size_t)(b * SEQ + s);
            const bf16_t* kp = KVA + kr * NKVA + h * 128; const bf16_t* rp = PROJ + kr * NPROJ_P + C_KR;
            float sc = 0.f;
#pragma unroll
            for (int c = 0; c < 8; ++c) { float k[8]; unpack8(*(const u32x4*)(kp + c * 8), k);
#pragma unroll
                for (int e = 0; e < 8; ++e) sc += q[c * 8 + e] * k[e]; }
#pragma unroll
            for (int c = 0; c < 4; ++c) { float k[8]; unpack8(*(const u32x4*)(rp + c * 8), k);
#pragma unroll
                for (int e = 0; e < 8; ++e) sc += q[64 + c * 8 + e] * k[e]; }
            const float mn = fmaxf(mx, sc), al = __builtin_amdgcn_exp2f(mx - mn), p = __builtin_amdgcn_exp2f(sc - mn);
            l = l * al + p; mx = mn;
#pragma unroll
            for (int c = 0; c < 8; ++c) { float v[8]; unpack8(*(const u32x4*)(kp + 64 + c * 8), v);
#pragma unroll
                for (int e = 0; e < 8; ++e) o[c * 8 + e] = o[c * 8 + e] * al + p * v[e]; }
        }
        const float inv = 1.0f / l;
#pragma unroll
        for (int c = 0; c < 8; ++c) { u32x4 wv; wv.x = cvt_pk_bf16(o[c * 8] * inv, o[c * 8 + 1] * inv); wv.y = cvt_pk_bf16(o[c * 8 + 2] * inv, o[c * 8 + 3] * inv); wv.z = cvt_pk_bf16(o[c * 8 + 4] * inv, o[c * 8 + 5] * inv); wv.w = cvt_pk_bf16(o[c * 8 + 6] * inv, o[c * 8 + 7] * inv);
            *(u32x4*)(O + (size_t)row * DM + h * 64 + c * 8) = wv; }
    }
}

__device__ __forceinline__ void attn_sb_naive(const bf16_t* PROJ, bf16_t* O) {
    const int nth = gridDim.x * NTHREADS;
    for (int w = blockIdx.x * NTHREADS + threadIdx.x; w < 8 * MTOK; w += nth) {
        const int h = w >> 14, row = w & (MTOK - 1), b = row >> 11, t = row & (SEQ - 1);
        float q[64];
#pragma unroll
        for (int c = 0; c < 8; ++c) unpack8(*(const u32x4*)(PROJ + (size_t)row * NPROJ_P + C_QB + h * 64 + c * 8), q + c * 8);
        float o[64];
#pragma unroll
        for (int d = 0; d < 64; ++d) o[d] = 0.f;
        float cum = 0.f;
        const int tmax = t | 63;
        for (int s = tmax - 1; s >= 0; --s) {
            const size_t kr = (size_t)(b * SEQ + s);
            const bf16_t* kp = PROJ + kr * NPROJ_P + C_KB + h * 64; const bf16_t* vp = PROJ + kr * NPROJ_P + C_VB + h * 64;
            float z = 0.f;
#pragma unroll
            for (int c = 0; c < 8; ++c) { float k[8]; unpack8(*(const u32x4*)(kp + c * 8), k);
#pragma unroll
                for (int e = 0; e < 8; ++e) z += q[c * 8 + e] * k[e]; }
            z *= 0.125f;
            const bool on = s < t;
            const float lg = __logf(1.0f + __expf(-fabsf(z)));
            const float wgt = on ? __expf(fminf(z, 0.f) - lg + cum) : 0.f;
            cum += on ? (fminf(-z, 0.f) - lg) : 0.f;
#pragma unroll
            for (int c = 0; c < 8; ++c) { float v[8]; unpack8(*(const u32x4*)(vp + c * 8), v);
#pragma unroll
                for (int e = 0; e < 8; ++e) o[c * 8 + e] += wgt * v[e]; }
        }
#pragma unroll
        for (int c = 0; c < 8; ++c) { u32x4 wv; wv.x = cvt_pk_bf16(o[c * 8], o[c * 8 + 1]); wv.y = cvt_pk_bf16(o[c * 8 + 2], o[c * 8 + 3]); wv.z = cvt_pk_bf16(o[c * 8 + 4], o[c * 8 + 5]); wv.w = cvt_pk_bf16(o[c * 8 + 6], o[c * 8 + 7]);
            *(u32x4*)(O + (size_t)row * DM + 512 + h * 64 + c * 8) = wv; }
    }
}

__device__ __forceinline__ void attn_band_naive(const bf16_t* QKV, const float* rel_bias, bf16_t* O) {
    const int nth = gridDim.x * NTHREADS;
    for (int w = blockIdx.x * NTHREADS + threadIdx.x; w < 16 * MTOK; w += nth) {
        const int h = w >> 14, row = w & (MTOK - 1), b = row >> 11, t = row & (SEQ - 1);
        float q[64];
#pragma unroll
        for (int c = 0; c < 8; ++c) unpack8(*(const u32x4*)(QKV + (size_t)row * NQKV + h * 64 + c * 8), q + c * 8);
        float o[64];
#pragma unroll
        for (int d = 0; d < 64; ++d) o[d] = 0.f;
        float mx = -INFINITY, l = 0.f;
        const int n = t >> 6, s0 = (n >= 8) ? (n - 8) * 64 : 0, s1 = (n + 1) * 64;
        const float* bias = rel_bias + h * 513 + 256;
        for (int s = s0; s < s1; ++s) {
            const size_t kr = (size_t)(b * SEQ + s);
            const bf16_t* kp = QKV + kr * NQKV + 1024 + h * 64; const bf16_t* vp = QKV + kr * NQKV + 2048 + h * 64;
            float sc = 0.f;
#pragma unroll
            for (int c = 0; c < 8; ++c) { float k[8]; unpack8(*(const u32x4*)(kp + c * 8), k);
#pragma unroll
                for (int e = 0; e < 8; ++e) sc += q[c * 8 + e] * k[e]; }
            int rel = t - s; rel = rel > 256 ? 256 : (rel < -256 ? -256 : rel);
            sc += bias[rel] * LOG2E;
            const float mn = fmaxf(mx, sc), al = __builtin_amdgcn_exp2f(mx - mn), p = __builtin_amdgcn_exp2f(sc - mn);
            l = l * al + p; mx = mn;
#pragma unroll
            for (int c = 0; c < 8; ++c) { float v[8]; unpack8(*(const u32x4*)(vp + c * 8), v);
#pragma unroll
                for (int e = 0; e < 8; ++e) o[c * 8 + e] = o[c * 8 + e] * al + p * v[e]; }
        }
        const float inv = 1.0f / l;
#pragma unroll
        for (int c = 0; c < 8; ++c) { u32x4 wv; wv.x = cvt_pk_bf16(o[c * 8] * inv, o[c * 8 + 1] * inv); wv.y = cvt_pk_bf16(o[c * 8 + 2] * inv, o[c * 8 + 3] * inv); wv.z = cvt_pk_bf16(o[c * 8 + 4] * inv, o[c * 8 + 5] * inv); wv.w = cvt_pk_bf16(o[c * 8 + 6] * inv, o[c * 8 + 7] * inv);
            *(u32x4*)(O + (size_t)row * DM + h * 64 + c * 8) = wv; }
    }
}

__global__ void __launch_bounds__(NTHREADS) fwd_megakernel(Args args) {
    extern __shared__ __attribute__((aligned(16))) unsigned char lds[];
#ifdef USE_CG_SYNC
    cg::grid_group grid = cg::this_grid();
#define GRID_SYNC() grid.sync()
#else
    { volatile LAS unsigned* st0 = (volatile LAS unsigned*)((LAS unsigned char*)lds + LDS_BYTES - 64); if (threadIdx.x == 0) { st0[0] = 0u; st0[1] = 0u; } }
    __syncthreads();
    const XcdBarrier xbar = xcd_barrier_post((unsigned*)(args.ws + WS_CTL), (volatile LAS unsigned*)((LAS unsigned char*)lds + LDS_BYTES - 64));
#define GRID_SYNC() xcd_barrier(xbar)
#endif
#ifdef USE_NAIVE_GEMM
#define GEMM(A, lda, Bt, ldb, M, N, K, E) gemm_naive(A, lda, Bt, ldb, (M) / 256, (N) / 256, K, E)
#else
#define GEMM(A, lda, Bt, ldb, M, N, K, E) gemm_fast((LAS unsigned char*)lds, A, lda, Bt, ldb, M, N, K, E)
#endif
    const int tid = threadIdx.x, lane = tid & 63, wave = tid >> 6;
    const int G = gridDim.x;
    const int vcu = (G % 8 == 0) ? (int)(blockIdx.x % 8) * (G / 8) + (int)(blockIdx.x / 8) : (int)blockIdx.x;
    LAS unsigned char* ldsp = (LAS unsigned char*)lds;
    unsigned char* ws = args.ws;
    const float* x = args.in[0];
    float* out = args.out;
    float* ssq = (float*)(ws + WS_SSQ);
    f32x2* rope = (f32x2*)(ws + WS_ROPE);
    bf16_t* Win = (bf16_t*)(ws + WS_WIN); bf16_t* Wuq = (bf16_t*)(ws + WS_WUQ); bf16_t* Wukv = (bf16_t*)(ws + WS_WUKV); bf16_t* Wo0 = (bf16_t*)(ws + WS_WO0);
    bf16_t* Wgu0 = (bf16_t*)(ws + WS_WGU0); bf16_t* Wd0 = (bf16_t*)(ws + WS_WD0); bf16_t* Wqkv = (bf16_t*)(ws + WS_WQKV); bf16_t* Wo1 = (bf16_t*)(ws + WS_WO1);
    bf16_t* Wgu1 = (bf16_t*)(ws + WS_WGU1); bf16_t* Wd1 = (bf16_t*)(ws + WS_WD1);
    bf16_t* HB = (bf16_t*)(ws + WS_HB); bf16_t* PROJ = (bf16_t*)(ws + WS_A); bf16_t* QKV = (bf16_t*)(ws + WS_A); bf16_t* ACT = (bf16_t*)(ws + WS_A); bf16_t* ATT = (bf16_t*)(ws + WS_ATT);
    bf16_t* QA = (bf16_t*)((unsigned char*)out + OUT_QA); bf16_t* KVA = (bf16_t*)((unsigned char*)out + OUT_KVA);

    {
        LAS float* scr = (LAS float*)((LAS unsigned char*)lds + wave * 16384);
        const int gw = blockIdx.x * 8 + wave, NGW = G * 8;
        const float* g_mix = args.in[10]; const float* g_ffn = args.in[11];
        constexpr int I_IN = 16 * (NPROJ / 32), I_UQ = 6 * 24, I_UKV = 4 * 32, I_O = 16 * 32, I_G = 16 * 88, I_D = 44 * 32, I_QKV = 16 * 96;
        constexpr int NITEMS = I_IN + I_UQ + I_UKV + I_O + 2 * I_G + I_D + I_QKV + I_O + 2 * I_G + I_D;
        for (int it = gw; it < NITEMS; it += NGW) {
            int r = it;
            if (r < I_IN) { p0_item(args.in[1], DM, NPROJ, g_mix, Win, DM, 0, scr, r, lane); continue; } r -= I_IN;
            if (r < I_UQ) { p0_item(args.in[3], 384, NQA, args.in[2], Wuq, 384, 0, scr, r, lane); continue; } r -= I_UQ;
            if (r < I_UKV) { p0_item(args.in[5], 256, NKVA, args.in[4], Wukv, 256, 0, scr, r, lane); continue; } r -= I_UKV;
            if (r < I_O) { p0_item(args.in[6], DM, DM, nullptr, Wo0, DM, 0, scr, r, lane); continue; } r -= I_O;
            if (r < I_G) { p0_item(args.in[12], DM, DFF, g_ffn, Wgu0, DM, 1, scr, r, lane); continue; } r -= I_G;
            if (r < I_G) { p0_item(args.in[13], DM, DFF, g_ffn, Wgu0, DM, 2, scr, r, lane); continue; } r -= I_G;
            if (r < I_D) { p0_item(args.in[14], DFF, DM, nullptr, Wd0, DFF, 0, scr, r, lane); continue; } r -= I_D;
            if (r < I_QKV) { p0_item(args.in[7], DM, NQKV, g_mix + DM, Wqkv, DM, 0, scr, r, lane); continue; } r -= I_QKV;
            if (r < I_O) { p0_item(args.in[9], DM, DM, nullptr, Wo1, DM, 0, scr, r, lane); continue; } r -= I_O;
            if (r < I_G) { p0_item(args.in[12] + (size_t)DM * DFF, DM, DFF, g_ffn + DM, Wgu1, DM, 1, scr, r, lane); continue; } r -= I_G;
            if (r < I_G) { p0_item(args.in[13] + (size_t)DM * DFF, DM, DFF, g_ffn + DM, Wgu1, DM, 2, scr, r, lane); continue; } r -= I_G;
            p0_item(args.in[14] + (size_t)DFF * DM, DFF, DM, nullptr, Wd1, DFF, 0, scr, r, lane);
        }
        for (int i = blockIdx.x * NTHREADS + tid; i < (NPROJ_P - NPROJ) * DM / 8; i += G * NTHREADS) ((u32x4*)(Win + (size_t)NPROJ * DM))[i] = (u32x4){0u, 0u, 0u, 0u};
        for (int i = blockIdx.x * NTHREADS + tid; i < 6 * MTOK; i += G * NTHREADS) ssq[MTOK + i] = 0.f;
        for (int i = blockIdx.x * NTHREADS + tid; i < SEQ * 16; i += G * NTHREADS) {
            const int pos = i >> 4, fi = i & 15;
            const float inv_freq = __builtin_amdgcn_exp2f(-(float)fi * (13.287712379549449f / 16.0f));
            const float ang = (float)pos * inv_freq;
            float tr = ang * 0.15915494309189535f; tr -= floorf(tr);
            rope[i] = (f32x2){__builtin_amdgcn_cosf(tr), __builtin_amdgcn_sinf(tr)};
        }
        for (int m = gw; m < MTOK; m += NGW) {
            const f32x4* xr = (const f32x4*)(x + (size_t)m * DM) + lane; f32x4 v[4]; float s = 0.f;
#pragma unroll
            for (int j = 0; j < 4; ++j) { v[j] = xr[64 * j]; s += dot4(v[j]); }
            s = wave_sum(s);
            if (lane == 0) ssq[m] = s;
#pragma unroll
            for (int j = 0; j < 4; ++j) { u32x2 w; w.x = cvt_pk_bf16(v[j][0], v[j][1]); w.y = cvt_pk_bf16(v[j][2], v[j][3]); *((u32x2*)(HB + (size_t)m * DM) + lane + 64 * j) = w; }
        }
    }
    GRID_SYNC();
    { EpiScale<0> E{PROJ, NPROJ_P, ssq, 1.0f / DM, ssq + MTOK, ssq + 2 * MTOK, rope}; GEMM(HB, DM, Win, DM, MTOK, NPROJ_P, DM, E); }
    GRID_SYNC();
    { EpiScale<1> E{QA, NQA, ssq + MTOK, 1.0f / 384, nullptr, nullptr, rope}; GEMM(PROJ, NPROJ_P, Wuq, 384, MTOK, NQA, 384, E); }
    { EpiScale<2> E{KVA, NKVA, ssq + 2 * MTOK, 1.0f / 256, nullptr, nullptr, rope}; GEMM(PROJ + C_CKV, NPROJ_P, Wukv, 256, MTOK, NKVA, 256, E); }
    GRID_SYNC();
#ifdef NAIVE_ATTN
    attn_mla_naive(QA, KVA, PROJ, ATT);
    attn_sb_naive(PROJ, ATT);
#else
    for (int u = vcu; u < 256; u += G) {
        const int bh = u >> 2, j = u & 3, b = bh >> 3, h = bh & 7;
        const size_t rb = (size_t)b * SEQ;
        for (int k = 0; k < 2; ++k) { const int qt = k ? 7 - j : j;
            attn_unit<0>(ldsp, 256 * qt, QA + rb * NQA + h * 96, NQA, KVA + rb * NKVA + h * 128, NKVA, PROJ + rb * NPROJ_P + C_KR, NPROJ_P, KVA + rb * NKVA + h * 128 + 64, NKVA, ATT + rb * DM + h * 64, nullptr); }
        for (int k = 0; k < 2; ++k) { const int qt = k ? 7 - j : j;
            attn_unit<1>(ldsp, 256 * qt, PROJ + rb * NPROJ_P + C_QB + h * 64, NPROJ_P, PROJ + rb * NPROJ_P + C_KB + h * 64, NPROJ_P, nullptr, 0, PROJ + rb * NPROJ_P + C_VB + h * 64, NPROJ_P, ATT + rb * DM + 512 + h * 64, nullptr); }
    }
#endif
    GRID_SYNC();
    { EpiResid E{x, out, HB, ssq + 3 * MTOK}; GEMM(ATT, DM, Wo0, DM, MTOK, DM, DM, E); }
    GRID_SYNC();
    { EpiSwiglu E{ACT, ssq + 3 * MTOK}; GEMM(HB, DM, Wgu0, DM, MTOK, 2 * DFF, DM, E); }
    GRID_SYNC();
    { EpiResid E{out, out, HB, ssq + 4 * MTOK}; GEMM(ACT, DFF, Wd0, DFF, MTOK, DM, DFF, E); }
    GRID_SYNC();
    { EpiScale<3> E{QKV, NQKV, ssq + 4 * MTOK, 1.0f / DM, nullptr, nullptr, rope}; GEMM(HB, DM, Wqkv, DM, MTOK, NQKV, DM, E); }
    GRID_SYNC();
#ifdef NAIVE_ATTN
    attn_band_naive(QKV, args.in[8], ATT);
#else
    for (int u = vcu; u < 256; u += G) {
        const int bh = u >> 1, half = u & 1, b = bh >> 4, h = bh & 15;
        const size_t rb = (size_t)b * SEQ;
        for (int k = 0; k < 4; ++k)
            attn_unit<2>(ldsp, 256 * (4 * half + k), QKV + rb * NQKV + h * 64, NQKV, QKV + rb * NQKV + 1024 + h * 64, NQKV, nullptr, 0, QKV + rb * NQKV + 2048 + h * 64, NQKV, ATT + rb * DM + h * 64, args.in[8] + h * 513);
    }
#endif
    GRID_SYNC();
    { EpiResid E{out, out, HB, ssq + 5 * MTOK}; GEMM(ATT, DM, Wo1, DM, MTOK, DM, DM, E); }
    GRID_SYNC();
    { EpiSwiglu E{ACT, ssq + 5 * MTOK}; GEMM(HB, DM, Wgu1, DM, MTOK, 2 * DFF, DM, E); }
    GRID_SYNC();
    { EpiResid E{out, out, nullptr, ssq + 6 * MTOK}; GEMM(ACT, DFF, Wd1, DFF, MTOK, DM, DFF, E); }
    GRID_SYNC();
    {
        const int gw = blockIdx.x * 8 + wave, NGW = G * 8;
        const f32x4* gf = (const f32x4*)args.in[15] + lane;
        for (int m = gw; m < MTOK; m += NGW) {
            const float r = rsqrtf(ssq[6 * MTOK + m] * (1.0f / DM) + RMS_EPS);
            f32x4* p = (f32x4*)(out + (size_t)m * DM) + lane;
#pragma unroll
            for (int j = 0; j < 4; ++j) p[64 * j] = p[64 * j] * r * gf[64 * j];
        }
    }
}

extern "C" void kernel_launch(void* const* d_in, const int* in_sizes, int n_in, void* d_out, int out_size, void* d_ws, size_t ws_size, hipStream_t stream) {
    static int grid = 0;
    if (grid == 0) {
        int dev = 0, cus = 0, per_cu = 0;
        hipGetDevice(&dev);
        hipDeviceGetAttribute(&cus, hipDeviceAttributeMultiprocessorCount, dev);
        hipFuncSetAttribute((const void*)fwd_megakernel, hipFuncAttributeMaxDynamicSharedMemorySize, LDS_BYTES);
        hipOccupancyMaxActiveBlocksPerMultiprocessor(&per_cu, (const void*)fwd_megakernel, NTHREADS, LDS_BYTES);
        if (per_cu < 1) per_cu = 1;
        if (per_cu > 1) per_cu = 1;
        grid = cus * per_cu;
        if (n_in != 16 || out_size != MTOK * DM || ws_size < WS_END) { fprintf(stderr, "kernel_launch: unexpected shapes n_in %d out %d ws %zu\n", n_in, out_size, ws_size); }
    }
    Args a{};
    for (int i = 0; i < 16; ++i) a.in[i] = (const float*)d_in[i];
    a.out = (float*)d_out; a.ws = (unsigned char*)d_ws;
    hipMemsetAsync((char*)d_ws + WS_CTL, 0, CTL_BYTES, stream);
    void* kargs[] = {&a};
    hipError_t e = hipLaunchCooperativeKernel((const void*)fwd_megakernel, dim3(grid), dim3(NTHREADS), kargs, LDS_BYTES, stream);
    if (e != hipSuccess) fprintf(stderr, "cooperative launch failed: %s (grid %d)\n", hipGetErrorString(e), grid);
}
```

```cpp
#include <hip/hip_runtime.h>
#include <hip/hip_cooperative_groups.h>
#include <cstdio>
#include <cstdint>
namespace cg = cooperative_groups;
#define REP_MLA 1
#define REP_SB 1
#define REP_BAND 1
#define REP_GU 1

#define LAS __attribute__((address_space(3)))
typedef unsigned short bf16_t;
typedef short bf16x8 __attribute__((ext_vector_type(8)));
typedef float f32x4 __attribute__((ext_vector_type(4)));
typedef float f32x2 __attribute__((ext_vector_type(2)));
typedef unsigned u32x4 __attribute__((ext_vector_type(4)));
typedef unsigned u32x2 __attribute__((ext_vector_type(2)));

constexpr int MTOK = 16384, SEQ = 2048, DM = 1024, DFF = 2816;
constexpr int NPROJ = 2208, NPROJ_P = 2304;
constexpr int C_CKV = 384, C_KR = 640, C_QB = 672, C_KB = 1184, C_VB = 1696;
constexpr int NQA = 768, NKVA = 1024, NQKV = 3072;
constexpr float RMS_EPS = 1e-6f;
constexpr float LOG2E = 1.4426950408889634f;
constexpr float QSCALE_A = 0.10206207261596577f * LOG2E;
constexpr float QSCALE_C = 0.125f * LOG2E;

constexpr size_t KiB = 1024, MiB = 1u << 20;
constexpr size_t WS_SSQ = 0;
constexpr size_t WS_ROPE = 512 * KiB;
constexpr size_t WS_CTL = 768 * KiB, CTL_BYTES = 16 * KiB;
constexpr size_t WS_WIN = 1 * MiB;
constexpr size_t WS_WUQ = WS_WIN + (size_t)NPROJ_P * DM * 2;
constexpr size_t WS_WUKV = WS_WUQ + (size_t)NQA * 384 * 2;
constexpr size_t WS_WO0 = WS_WUKV + (size_t)NKVA * 256 * 2;
constexpr size_t WS_WGU0 = WS_WO0 + (size_t)DM * DM * 2;
constexpr size_t WS_WD0 = WS_WGU0 + (size_t)2 * DFF * DM * 2;
constexpr size_t WS_WQKV = WS_WD0 + (size_t)DM * DFF * 2;
constexpr size_t WS_WO1 = WS_WQKV + (size_t)NQKV * DM * 2;
constexpr size_t WS_WGU1 = WS_WO1 + (size_t)DM * DM * 2;
constexpr size_t WS_WD1 = WS_WGU1 + (size_t)2 * DFF * DM * 2;
constexpr size_t WS_WEND = WS_WD1 + (size_t)DM * DFF * 2;
constexpr size_t WS_HB = 50 * MiB;
constexpr size_t WS_A = 82 * MiB;
constexpr size_t WS_ATT = 178 * MiB;
constexpr size_t WS_END = 210 * MiB;
static_assert(WS_WEND <= WS_HB, "weights fit");
constexpr size_t OUT_QA = 0, OUT_KVA = 24 * MiB;

constexpr int NTHREADS = 512;
constexpr int LDS_BYTES = 147456;

__device__ __forceinline__ unsigned cvt_pk_bf16(float lo, float hi) { unsigned r; asm volatile("v_cvt_pk_bf16_f32 %0, %1, %2" : "=v"(r) : "v"(lo), "v"(hi)); return r; }
__device__ __forceinline__ float bflo(unsigned w) { return __uint_as_float(w << 16); }
__device__ __forceinline__ float bfhi(unsigned w) { return __uint_as_float(w & 0xffff0000u); }
__device__ __forceinline__ void unpack8(const u32x4 w, float* f) {
    f[0] = bflo(w.x); f[1] = bfhi(w.x); f[2] = bflo(w.y); f[3] = bfhi(w.y); f[4] = bflo(w.z); f[5] = bfhi(w.z); f[6] = bflo(w.w); f[7] = bfhi(w.w);
}
__device__ __forceinline__ float wave_sum(float v) {
#pragma unroll
    for (int o = 1; o < 64; o <<= 1) v += __shfl_xor(v, o);
    return v;
}
__device__ __forceinline__ float dot4(const f32x4 a) { return (a[0] * a[0] + a[1] * a[1]) + (a[2] * a[2] + a[3] * a[3]); }

struct Unit { int pm, pn; };


template <int MODE> struct EpiScale {
    static constexpr bool PERM = false, AFTER_DRAIN = false;
    bf16_t* O; int ldc; const float* ssq_in; float inv_n; float* ssq_a; float* ssq_b; const f32x2* rope;
    __device__ __forceinline__ void operator()(const f32x4 (&acc)[2][2][4][2], const Unit& u, int wr, int wc, int fr, int fq) const {
        const int cb0 = u.pn * 256 + wc * 32;
#pragma unroll
        for (int ai = 0; ai < 2; ++ai)
#pragma unroll
            for (int m = 0; m < 4; ++m) {
                const int row = u.pm * 256 + ai * 128 + wr * 64 + m * 16 + fr;
                const float r = rsqrtf(ssq_in[row] * inv_n + RMS_EPS);
                const int pos = row & (SEQ - 1);
#pragma unroll
                for (int bj = 0; bj < 2; ++bj) {
                    const int cb = cb0 + 128 * bj;
                    float sc = r;
                    if (MODE == 1) sc *= QSCALE_A;
                    if (MODE == 3) { if (cb < 1024) sc *= QSCALE_C; }
                    f32x4 v0 = acc[ai][bj][m][0] * sc, v1 = acc[ai][bj][m][1] * sc;
                    bool ropeg = false;
                    if (MODE == 0) ropeg = (cb == C_KR);
                    if (MODE == 1) ropeg = ((cb % 96) == 64);
                    if (ropeg) {
#pragma unroll
                        for (int j = 0; j < 4; ++j) { const f32x2 cs = rope[pos * 16 + 4 * fq + j]; const float x1 = v0[j], x2 = v1[j]; v0[j] = x1 * cs.x - x2 * cs.y; v1[j] = x2 * cs.x + x1 * cs.y; }
                    }
                    if (MODE == 0) {
                        if (cb < C_KR) { float s = dot4(v0) + dot4(v1); s += __shfl_xor(s, 16); s += __shfl_xor(s, 32); if (fq == 0) atomicAdd((cb < C_CKV ? ssq_a : ssq_b) + row, s); }
                    }
                    bf16_t* p = O + (size_t)row * ldc + cb + 4 * fq;
                    u32x2 w0, w1; w0.x = cvt_pk_bf16(v0[0], v0[1]); w0.y = cvt_pk_bf16(v0[2], v0[3]); w1.x = cvt_pk_bf16(v1[0], v1[1]); w1.y = cvt_pk_bf16(v1[2], v1[3]);
                    *(u32x2*)p = w0; *(u32x2*)(p + 16) = w1;
                }
                asm volatile("" ::: "memory");
            }
    }
};

struct EpiResid {
    static constexpr bool PERM = false, AFTER_DRAIN = false;
    bf16_t* hb; float* ssq;
    __device__ __forceinline__ void operator()(const f32x4 (&acc)[2][2][4][2], const Unit& u, int wr, int wc, int fr, int fq) const {
#pragma unroll
        for (int ai = 0; ai < 2; ++ai)
#pragma unroll
            for (int m = 0; m < 4; ++m) {
                const int row = u.pm * 256 + ai * 128 + wr * 64 + m * 16 + fr;
                float s = 0.f;
                u32x2 b[2][2];
#pragma unroll
                for (int bj = 0; bj < 2; ++bj)
#pragma unroll
                    for (int n = 0; n < 2; ++n) b[bj][n] = *(const u32x2*)(hb + (size_t)row * DM + u.pn * 256 + bj * 128 + wc * 32 + 16 * n + 4 * fq);
#pragma unroll
                for (int bj = 0; bj < 2; ++bj)
#pragma unroll
                    for (int n = 0; n < 2; ++n) {
                        const size_t off = (size_t)row * DM + u.pn * 256 + bj * 128 + wc * 32 + 16 * n + 4 * fq;
                        const f32x4 a = acc[ai][bj][m][n];
                        f32x4 h; h[0] = bflo(b[bj][n].x) + a[0]; h[1] = bfhi(b[bj][n].x) + a[1]; h[2] = bflo(b[bj][n].y) + a[2]; h[3] = bfhi(b[bj][n].y) + a[3];
                        u32x2 w; w.x = cvt_pk_bf16(h[0], h[1]); w.y = cvt_pk_bf16(h[2], h[3]); *(u32x2*)(hb + off) = w;
                        s += dot4(h);
                    }
                s += __shfl_xor(s, 16); s += __shfl_xor(s, 32);
                if (fq == 0) atomicAdd(ssq + row, s);
                asm volatile("" ::: "memory");
            }
    }
};

struct EpiSwiglu {
    static constexpr bool PERM = true, AFTER_DRAIN = false;
    bf16_t* O; const float* ssq_in;
    __device__ __forceinline__ void operator()(const f32x4 (&acc)[2][2][4][2], const Unit& u, int wr, int wc, int fr, int fq) const {
#pragma unroll
        for (int ai = 0; ai < 2; ++ai)
#pragma unroll
            for (int m = 0; m < 4; ++m) {
                const int row = u.pm * 256 + ai * 128 + wr * 64 + m * 16 + fr;
                const float r = rsqrtf(ssq_in[row] * (1.0f / DM) + RMS_EPS);
                float a[8];
#pragma unroll
                for (int n = 0; n < 2; ++n)
#pragma unroll
                    for (int j = 0; j < 4; ++j) { const float g = acc[ai][0][m][n][j] * r, uu = acc[ai][1][m][n][j] * r; a[4 * n + j] = g * __builtin_amdgcn_rcpf(1.0f + __expf(-g)) * uu; }
                u32x4 w; w.x = cvt_pk_bf16(a[0], a[1]); w.y = cvt_pk_bf16(a[2], a[3]); w.z = cvt_pk_bf16(a[4], a[5]); w.w = cvt_pk_bf16(a[6], a[7]);
                *(u32x4*)(O + (size_t)row * DFF + u.pn * 128 + wc * 32 + 8 * fq) = w;
                asm volatile("" ::: "memory");
            }
    }
};

__host__ __device__ __forceinline__ int perm32(int rho) { const int n = rho >> 4, i = rho & 15; return 8 * (i >> 2) + 4 * n + (i & 3); }
template <class Epi>
__device__ __forceinline__ void gemm_naive(const bf16_t* A, int lda, const bf16_t* Bt, int ldb, int nM, int nN, int K, const Epi& E) {
    constexpr bool PERM = Epi::PERM;
    const int tid = threadIdx.x, wid = tid >> 6, lane = tid & 63, wr = wid >> 2, wc = wid & 3, fr = lane & 15, fq = lane >> 4;
    for (int unit = blockIdx.x; unit < nM * nN; unit += gridDim.x) {
        Unit u; u.pm = unit / nN; u.pn = unit % nN;
        f32x4 acc[2][2][4][2];
#pragma unroll
        for (int a = 0; a < 2; ++a)
#pragma unroll
            for (int b = 0; b < 2; ++b)
#pragma unroll
                for (int m = 0; m < 4; ++m)
#pragma unroll
                    for (int n = 0; n < 2; ++n) acc[a][b][m][n] = (f32x4){0.f, 0.f, 0.f, 0.f};
        const bf16_t* Ab = A + (size_t)(u.pm * 256 + wr * 64 + fr) * lda + 8 * fq;
        const bf16_t* Bb = Bt + (size_t)(u.pn * 256 + wc * 32) * ldb + 8 * fq;
        const int br0 = PERM ? perm32(fr) : fr, br1 = PERM ? perm32(16 + fr) : 16 + fr;
        for (int k0 = 0; k0 < K; k0 += 32) {
            bf16x8 af[2][4], bq[2][2];
#pragma unroll
            for (int ai = 0; ai < 2; ++ai)
#pragma unroll
                for (int m = 0; m < 4; ++m) af[ai][m] = *(const bf16x8*)(Ab + (size_t)(ai * 128 + m * 16) * lda + k0);
#pragma unroll
            for (int bj = 0; bj < 2; ++bj) { bq[bj][0] = *(const bf16x8*)(Bb + (size_t)(bj * 128 + br0) * ldb + k0); bq[bj][1] = *(const bf16x8*)(Bb + (size_t)(bj * 128 + br1) * ldb + k0); }
#pragma unroll
            for (int ai = 0; ai < 2; ++ai)
#pragma unroll
                for (int bj = 0; bj < 2; ++bj)
#pragma unroll
                    for (int m = 0; m < 4; ++m)
#pragma unroll
                        for (int n = 0; n < 2; ++n) acc[ai][bj][m][n] = __builtin_amdgcn_mfma_f32_16x16x32_bf16(bq[bj][n], af[ai][m], acc[ai][bj][m][n], 0, 0, 0);
        }
        E(acc, u, wr, wc, fr, fq);
    }
}

#define PG8_LAS __attribute__((address_space(3)))
constexpr int BM = 256, BK = 64, HALF = 128, HTB = HALF * BK * 2  , STAGE_BYTES = 8 * HTB, NXCD = 8, WGM = 8;
__host__ __device__ __forceinline__ int lds_byte(int r, int c) { const int st = (r >> 4) * 2 + (c >> 5), rr = r & 15, cc = c & 31, ob = rr * 64 + cc * 2; return st * 1024 + (ob ^ (((ob >> 9) & 1) << 5)); }
__host__ __device__ __forceinline__ void stage_rc(int b, int& R, int& C) { const int st = b / 1024, sb = b % 1024, swz = sb ^ (((sb >> 9) & 1) << 5); R = (st >> 1) * 16 + swz / 64; C = (st & 1) * 32 + (swz % 64) / 2; }
struct Gemm { const bf16_t* A; const bf16_t* Bt; int M, N, K, lda, ldb; };
struct StaticOrder {
    int nM, nN, nwg, G, c;
    __host__ __device__ void init(int M, int N, int G_, int c_) { nM = M / BM; nN = N / BM; nwg = nM * nN; G = G_; c = c_; }
    __host__ __device__ bool next(int i, Unit& u) const {
        const long L = (long)i * G + c; if (L >= nwg) return false;
        int wgid = (int)L; { const int q = nwg / NXCD, r = nwg % NXCD, xcd = wgid % NXCD, off = wgid / NXCD; wgid = (xcd < r ? xcd * (q + 1) : r * (q + 1) + (xcd - r) * q) + off; }
        const int nig = WGM * nN, gid = wgid / nig, fm = gid * WGM, gsz = (nM - fm) < WGM ? (nM - fm) : WGM;
        u.pm = fm + ((wgid % nig) % gsz); u.pn = (wgid % nig) / gsz; return true;
    }
    __device__ __forceinline__ void a_ready(const Unit&) const {}
    __device__ __forceinline__ void done(const Unit&) const {}
};
template <class Epi, class Sched, bool ALIGN_EPI = false, bool SP2 = false>
__device__ __forceinline__ void gemm_phase(PG8_LAS unsigned char* lds, const Gemm g, const Sched& S, const Epi& E) {
    const int tid = threadIdx.x, wid = __builtin_amdgcn_readfirstlane(tid >> 6), lane = tid & 63, wr = wid >> 2, wc = wid & 3, fr = lane & 15, fq = lane >> 4;
    const int K = g.K, nt = K / BK;
    unsigned voffA[2], voffB[2];
#pragma unroll
    for (int i = 0; i < 2; ++i) { int R, C; stage_rc(tid * 16 + i * 8192, R, C); const int Rb = Epi::PERM ? ((R & ~31) + perm32(R & 31)) : R;
        voffA[i] = (unsigned)(R * g.lda + C) * 2u; voffB[i] = (unsigned)(Rb * g.ldb + C) * 2u; }
    const size_t kstep = (size_t)(BK * 2);
    const size_t hstepA = (size_t)HALF * g.lda * 2, hstepB = (size_t)HALF * g.ldb * 2;
    const size_t tstepA = 2 * hstepA, tstepB = 2 * hstepB;
    const unsigned ldsw = (unsigned)wid * 1024u;
    const int aoff = lds_byte(wr * 64 + fr, fq * 8), boff = lds_byte(wc * 32 + fr, fq * 8);
#define PG8_SA(b, h) (((b) * 2 + (h)) * HTB)
#define PG8_SB(b, h) ((4 + (b) * 2 + (h)) * HTB)
#define PG8_STAGE(bufoff, gbase, voff) do { _Pragma("unroll") for (int _i = 0; _i < 2; ++_i) \
        __builtin_amdgcn_global_load_lds((const unsigned*)((const char*)(gbase) + (voff)[_i]), (PG8_LAS unsigned*)(lds + (bufoff) + ldsw + _i * 8192), 16, 0, 0); } while (0)
#define PG8_LDA(dst, b, h) do { _Pragma("unroll") for (int m = 0; m < 4; ++m) _Pragma("unroll") for (int k = 0; k < 2; ++k) dst[m][k] = *(const PG8_LAS bf16x8*)(lds + PG8_SA(b, h) + aoff + m * 2048 + k * 1024); } while (0)
#define PG8_LDB(dst, b, h) do { _Pragma("unroll") for (int n = 0; n < 2; ++n) _Pragma("unroll") for (int k = 0; k < 2; ++k) dst[n][k] = *(const PG8_LAS bf16x8*)(lds + PG8_SB(b, h) + boff + n * 2048 + k * 1024); } while (0)
#define PG8_MMA(ai, bj, At, Bt) do { __builtin_amdgcn_s_setprio(1); _Pragma("unroll") for (int m = 0; m < 4; ++m) _Pragma("unroll") for (int n = 0; n < 2; ++n) _Pragma("unroll") for (int k = 0; k < 2; ++k) \
        acc[ai][bj][m][n] = __builtin_amdgcn_mfma_f32_16x16x32_bf16(Bt[n][k], At[m][k], acc[ai][bj][m][n], 0, 0, 0); __builtin_amdgcn_s_setprio(0); } while (0)
#define PG8_WAIT_V(n) asm volatile("s_waitcnt vmcnt(" #n ")" ::: "memory")
#define PG8_WAIT_L(n) asm volatile("s_waitcnt lgkmcnt(" #n ")" ::: "memory")
#define PG8_BAR __builtin_amdgcn_s_barrier()
#define PG8_SCHED __builtin_amdgcn_sched_barrier(0)
    Unit cur, nxt; int ui = 0;
    if (!S.next(0, cur)) return;
    f32x4 acc[2][2][4][2];
#pragma unroll
    for (int a = 0; a < 2; ++a)
#pragma unroll
        for (int b = 0; b < 2; ++b)
#pragma unroll
            for (int m = 0; m < 4; ++m)
#pragma unroll
                for (int n = 0; n < 2; ++n) acc[a][b][m][n] = (f32x4){0.f, 0.f, 0.f, 0.f};
    bf16x8 At[4][2], B0[2][2], B1[2][2];
    const char* cA = (const char*)g.A + (size_t)cur.pm * tstepA; const char* cB = (const char*)g.Bt + (size_t)cur.pn * tstepB;
    S.a_ready(cur);
    if constexpr (SP2) {
        PG8_STAGE(PG8_SB(0, 0), cB, voffB); PG8_STAGE(PG8_SB(0, 1), cB + hstepB, voffB); PG8_STAGE(PG8_SA(0, 0), cA, voffA); PG8_STAGE(PG8_SA(0, 1), cA + hstepA, voffA);
        if (wr == 1) PG8_BAR;
        PG8_WAIT_V(2); PG8_BAR;
        PG8_STAGE(PG8_SB(1, 0), cB + kstep, voffB); PG8_STAGE(PG8_SA(1, 0), cA + kstep, voffA); PG8_STAGE(PG8_SB(1, 1), cB + hstepB + kstep, voffB);
        PG8_WAIT_V(6); PG8_BAR;
    } else {
        PG8_STAGE(PG8_SB(0, 0), cB, voffB); PG8_STAGE(PG8_SA(0, 0), cA, voffA); PG8_STAGE(PG8_SB(0, 1), cB + hstepB, voffB); PG8_STAGE(PG8_SA(0, 1), cA + hstepA, voffA);
        if (wr == 1) PG8_BAR;
        PG8_WAIT_V(4); PG8_BAR;
        PG8_STAGE(PG8_SB(1, 0), cB + kstep, voffB); PG8_STAGE(PG8_SA(1, 0), cA + kstep, voffA); PG8_STAGE(PG8_SB(1, 1), cB + hstepB + kstep, voffB);
        PG8_WAIT_V(6); PG8_BAR;
    }
    for (;;) {
        const bool has_next = S.next(ui + 1, nxt);
        const char* nA = has_next ? (const char*)g.A + (size_t)nxt.pm * tstepA : cA; const char* nB = has_next ? (const char*)g.Bt + (size_t)nxt.pn * tstepB : cB;
#pragma clang loop unroll(disable)
        for (int t = 0; t < nt; t += 2) {
            const bool last = (t == nt - 2);
            const char* a1 = cA + (size_t)(t + 1) * kstep;
            const char* a2 = last ? nA : cA + (size_t)(t + 2) * kstep; const char* b2 = last ? nB : cB + (size_t)(t + 2) * kstep;
            const char* a3 = a2 + kstep; const char* b3 = b2 + kstep;
            if (last && has_next) S.a_ready(nxt);
            if constexpr (SP2) {
            PG8_LDB(B0, 0, 0); PG8_LDB(B1, 0, 1); PG8_SCHED; PG8_LDA(At, 0, 0); PG8_STAGE(PG8_SA(1, 1), a1 + hstepA, voffA);
            PG8_WAIT_V(8); PG8_WAIT_L(0); PG8_BAR; PG8_MMA(0, 0, At, B0); PG8_MMA(0, 1, At, B1); PG8_BAR; PG8_SCHED;
            PG8_LDA(At, 0, 1); PG8_STAGE(PG8_SB(0, 0), b2, voffB); PG8_STAGE(PG8_SB(0, 1), b2 + hstepB, voffB); PG8_STAGE(PG8_SA(0, 0), a2, voffA);
            PG8_WAIT_V(8); PG8_WAIT_L(0); PG8_BAR; PG8_MMA(1, 0, At, B0); PG8_MMA(1, 1, At, B1); PG8_BAR; PG8_SCHED;
            PG8_LDB(B0, 1, 0); PG8_LDB(B1, 1, 1); PG8_SCHED; PG8_LDA(At, 1, 0); PG8_STAGE(PG8_SA(0, 1), a2 + hstepA, voffA);
            PG8_WAIT_V(8); PG8_WAIT_L(0); PG8_BAR; PG8_MMA(0, 0, At, B0); PG8_MMA(0, 1, At, B1); PG8_BAR; PG8_SCHED;
            PG8_LDA(At, 1, 1); PG8_STAGE(PG8_SB(1, 0), b3, voffB); PG8_STAGE(PG8_SB(1, 1), b3 + hstepB, voffB); PG8_STAGE(PG8_SA(1, 0), a3, voffA);
            PG8_WAIT_V(8); PG8_WAIT_L(0); PG8_BAR; PG8_MMA(1, 0, At, B0); PG8_MMA(1, 1, At, B1); PG8_BAR; PG8_SCHED;
            } else {
            PG8_LDB(B0, 0, 0); PG8_SCHED; PG8_LDA(At, 0, 0); PG8_STAGE(PG8_SA(1, 1), a1 + hstepA, voffA);
            PG8_WAIT_L(8); PG8_BAR; PG8_WAIT_L(0); PG8_MMA(0, 0, At, B0); PG8_BAR; PG8_SCHED;
            PG8_LDB(B1, 0, 1); PG8_STAGE(PG8_SB(0, 0), b2, voffB);
            PG8_BAR; PG8_WAIT_L(0); PG8_MMA(0, 1, At, B1); PG8_BAR;
            PG8_LDA(At, 0, 1); PG8_STAGE(PG8_SA(0, 0), a2, voffA);
            PG8_BAR; PG8_WAIT_L(0); PG8_MMA(1, 0, At, B0); PG8_BAR; PG8_SCHED;
            PG8_STAGE(PG8_SB(0, 1), b2 + hstepB, voffB);
            PG8_WAIT_V(6); PG8_BAR; PG8_MMA(1, 1, At, B1); PG8_BAR;
            PG8_LDB(B0, 1, 0); PG8_SCHED; PG8_LDA(At, 1, 0); PG8_STAGE(PG8_SA(0, 1), a2 + hstepA, voffA);
            PG8_WAIT_L(8); PG8_BAR; PG8_WAIT_L(0); PG8_MMA(0, 0, At, B0); PG8_BAR; PG8_SCHED;
            PG8_LDB(B1, 1, 1); PG8_STAGE(PG8_SB(1, 0), b3, voffB);
            PG8_BAR; PG8_WAIT_L(0); PG8_MMA(0, 1, At, B1); PG8_BAR;
            PG8_LDA(At, 1, 1); PG8_STAGE(PG8_SA(1, 0), a3, voffA);
            PG8_BAR; PG8_WAIT_L(0); PG8_MMA(1, 0, At, B0); PG8_BAR; PG8_SCHED;
            PG8_STAGE(PG8_SB(1, 1), b3 + hstepB, voffB);
            PG8_WAIT_V(6); PG8_BAR; PG8_MMA(1, 1, At, B1); PG8_BAR;
            }
        }
        if constexpr (ALIGN_EPI) { if (wr == 0) PG8_BAR; }
        if constexpr (!Epi::AFTER_DRAIN) { E(acc, cur, wr, wc, fr, fq); S.done(cur); }
        if (!has_next) break;
#pragma unroll
        for (int a = 0; a < 2; ++a)
#pragma unroll
            for (int b = 0; b < 2; ++b)
#pragma unroll
                for (int m = 0; m < 4; ++m)
#pragma unroll
                    for (int n = 0; n < 2; ++n) acc[a][b][m][n] = (f32x4){0.f, 0.f, 0.f, 0.f};
        cur = nxt; cA = nA; cB = nB; ++ui;
        if constexpr (ALIGN_EPI) { if (wr == 1) PG8_BAR; }
    }
    PG8_WAIT_V(0);
    if constexpr (!ALIGN_EPI) { if (wr == 0) PG8_BAR; }
    PG8_BAR;
    if constexpr (Epi::AFTER_DRAIN) { E.fused(acc, cur, wr, wc, fr, fq, lds, wid, lane); S.done(cur); }
#undef PG8_SA
#undef PG8_SB
#undef PG8_STAGE
#undef PG8_LDA
#undef PG8_LDB
#undef PG8_MMA
#undef PG8_WAIT_V
#undef PG8_WAIT_L
#undef PG8_BAR
#undef PG8_SCHED
}
template <class Epi>
__device__ __forceinline__ void gemm_fast(LAS unsigned char* lds, const bf16_t* A, int lda, const bf16_t* Bt, int ldb, int M, int N, int K, const Epi& E) {
    Gemm g{A, Bt, M, N, K, lda, ldb}; StaticOrder S; S.init(M, N, (int)gridDim.x, (int)blockIdx.x);
    gemm_phase<Epi, StaticOrder, true, true>(lds, g, S, E);
}

__device__ __forceinline__ void p0_item(const float* W, int K, int N, const float* g, bf16_t* WT, int ldt, int mode, LAS float* scr, int item, int lane) {
    const int nblk = N / 32, kb = item / nblk, nb = item % nblk, k0 = 64 * kb, n0 = 32 * nb;
#pragma unroll 8
    for (int i = 0; i < 32; ++i) { const int kk = 2 * i + (lane >> 5); const float gs = g ? g[k0 + kk] : 1.0f; scr[kk * 33 + (lane & 31)] = W[(size_t)(k0 + kk) * N + n0 + (lane & 31)] * gs; }
    asm volatile("s_waitcnt lgkmcnt(0)" ::: "memory");
    const int c = lane & 7;
#pragma unroll
    for (int j = 0; j < 4; ++j) {
        const int n = (lane >> 3) + 8 * j; const LAS float* s = scr + (8 * c) * 33 + n;
        u32x4 o; o.x = cvt_pk_bf16(s[0 * 33], s[1 * 33]); o.y = cvt_pk_bf16(s[2 * 33], s[3 * 33]); o.z = cvt_pk_bf16(s[4 * 33], s[5 * 33]); o.w = cvt_pk_bf16(s[6 * 33], s[7 * 33]);
        const int nn = n0 + n; const int row = (mode == 0) ? nn : ((nn >> 7) * 256 + (mode == 2 ? 128 : 0) + (nn & 127));
        *(u32x4*)(WT + (size_t)row * ldt + k0 + 8 * c) = o;
    }
    asm volatile("s_waitcnt lgkmcnt(0)" ::: "memory");
}


typedef float f32x16 __attribute__((ext_vector_type(16)));
constexpr int AT_VSTR = 72;
constexpr int AT_KBUF = 64 * 104 * 2, AT_VBUF = 64 * AT_VSTR * 2;
constexpr int AT_OFF_K = 0, AT_OFF_V = 2 * AT_KBUF, AT_OFF_BIAS = 2 * AT_KBUF + 2 * AT_VBUF, AT_OFF_FLAG = AT_OFF_BIAS + 2304;
__device__ __forceinline__ int crow16(int r, int hi) { return (r & 3) + 8 * (r >> 2) + 4 * hi; }
__device__ __forceinline__ int vperm(int key) { const int k16 = key & 15; return (key & ~15) + 8 * ((k16 >> 2) & 1) + 4 * (k16 >> 3) + (k16 & 3); }
__device__ __forceinline__ bf16x8 pack8(float a0, float a1, float a2, float a3, float a4, float a5, float a6, float a7) {
    u32x4 w; w.x = cvt_pk_bf16(a0, a1); w.y = cvt_pk_bf16(a2, a3); w.z = cvt_pk_bf16(a4, a5); w.w = cvt_pk_bf16(a6, a7); return __builtin_bit_cast(bf16x8, w);
}

template <int MODE>
__device__ __forceinline__ void attn_unit(LAS unsigned char* lds, int q0, const bf16_t* Qp, int ldq, const bf16_t* Kp, int ldk, const bf16_t* Krp, int ldkr, const bf16_t* Vp, int ldv, bf16_t* Op, const float* bias_g) {
    constexpr int DQK = (MODE == 0) ? 96 : 64, NDD = DQK / 16, KSTR = DQK + 8;
    const int tid = threadIdx.x, lane = tid & 63, wid = __builtin_amdgcn_readfirstlane(tid >> 6), l31 = lane & 31, hi = lane >> 5;
    const int t0w = q0 + 32 * wid, trow = t0w + l31, nq = t0w >> 6;
    LAS float* biasl = (LAS float*)(lds + AT_OFF_BIAS);
    LAS int* flags = (LAS int*)(lds + AT_OFF_FLAG);
    if (MODE == 2) { for (int i = tid; i < 513; i += NTHREADS) biasl[i] = bias_g[i] * LOG2E; }
    bf16x8 qf[NDD];
#pragma unroll
    for (int dd = 0; dd < NDD; ++dd) qf[dd] = *(const bf16x8*)(Qp + (size_t)trow * ldq + 16 * dd + 8 * hi);
    f32x16 o0, o1;
#pragma unroll
    for (int r = 0; r < 16; ++r) { o0[r] = 0.f; o1[r] = 0.f; }
    float mrow = -1e30f, lrow = 0.f, carry = 0.f;
    const int kt_hi = (q0 + 255) >> 6;
    int kt_lo = 0; if (MODE == 2) { kt_lo = (q0 >> 6) - 8; if (kt_lo < 0) kt_lo = 0; }
    const int nt = kt_hi - kt_lo + 1;
    const int skey = tid >> 3, sch = tid & 7, rkey = tid >> 2, rch = tid & 3;
    const int vcol = vperm(lane);
    u32x4 kreg, krreg, vreg;
#define AT_KT(i) ((MODE == 1) ? (kt_hi - (i)) : (kt_lo + (i)))
#define AT_LOAD(kt) do { const size_t kb_ = (size_t)(kt) * 64; \
        kreg = *(const u32x4*)(Kp + (kb_ + skey) * ldk + sch * 8); \
        if (MODE == 0) { if (tid < 256) krreg = *(const u32x4*)(Krp + (kb_ + rkey) * ldkr + rch * 8); } \
        vreg = *(const u32x4*)(Vp + (kb_ + lane) * ldv + wid * 8); } while (0)
#define AT_STORE(bufi) do { LAS bf16_t* Ks_ = (LAS bf16_t*)(lds + AT_OFF_K + (bufi) * AT_KBUF); LAS bf16_t* Vt_ = (LAS bf16_t*)(lds + AT_OFF_V + (bufi) * AT_VBUF); \
        *(LAS u32x4*)(Ks_ + skey * KSTR + sch * 8) = kreg; \
        if (MODE == 0) { if (tid < 256) *(LAS u32x4*)(Ks_ + rkey * KSTR + 64 + rch * 8) = krreg; } \
        LAS bf16_t* vd_ = Vt_ + (wid * 8) * AT_VSTR + vcol; \
        vd_[0 * AT_VSTR] = (bf16_t)(vreg.x & 0xffffu); vd_[1 * AT_VSTR] = (bf16_t)(vreg.x >> 16); vd_[2 * AT_VSTR] = (bf16_t)(vreg.y & 0xffffu); vd_[3 * AT_VSTR] = (bf16_t)(vreg.y >> 16); \
        vd_[4 * AT_VSTR] = (bf16_t)(vreg.z & 0xffffu); vd_[5 * AT_VSTR] = (bf16_t)(vreg.z >> 16); vd_[6 * AT_VSTR] = (bf16_t)(vreg.w & 0xffffu); vd_[7 * AT_VSTR] = (bf16_t)(vreg.w >> 16); } while (0)
    AT_LOAD(AT_KT(0)); AT_STORE(0);
    __syncthreads();
    for (int i = 0; i < nt; ++i) {
        const int kt = AT_KT(i);
        if (i + 1 < nt) AT_LOAD(AT_KT(i + 1));
        bool part;
        if (MODE == 0) part = (kt <= nq);
        else if (MODE == 1) part = (64 * kt <= t0w + 30);
        else part = (kt <= nq) && (kt >= nq - 8);
        if (part) {
            const LAS bf16_t* Ks = (const LAS bf16_t*)(lds + AT_OFF_K + (i & 1) * AT_KBUF); const LAS bf16_t* Vt = (const LAS bf16_t*)(lds + AT_OFF_V + (i & 1) * AT_VBUF);
            f32x16 p0, p1;
#pragma unroll
            for (int r = 0; r < 16; ++r) { p0[r] = 0.f; p1[r] = 0.f; }
#pragma unroll
            for (int dd = 0; dd < NDD; ++dd) {
                const bf16x8 a0 = *(const LAS bf16x8*)(Ks + l31 * KSTR + 16 * dd + 8 * hi), a1 = *(const LAS bf16x8*)(Ks + (32 + l31) * KSTR + 16 * dd + 8 * hi);
                p0 = __builtin_amdgcn_mfma_f32_32x32x16_bf16(a0, qf[dd], p0, 0, 0, 0); p1 = __builtin_amdgcn_mfma_f32_32x32x16_bf16(a1, qf[dd], p1, 0, 0, 0);
            }
            if (MODE != 1) {
                if (MODE == 2) {
                    const int relb = trow - 64 * kt - 4 * hi;
#pragma unroll
                    for (int r = 0; r < 16; ++r) {
                        int rel0 = relb - ((r & 3) + 8 * (r >> 2)); int rel1 = rel0 - 32;
                        rel0 = rel0 > 256 ? 256 : (rel0 < -256 ? -256 : rel0); rel1 = rel1 > 256 ? 256 : (rel1 < -256 ? -256 : rel1);
                        p0[r] += biasl[256 + rel0]; p1[r] += biasl[256 + rel1];
                    }
                }
                float mx = fmaxf(p0[0], p1[0]);
#pragma unroll
                for (int r = 1; r < 16; ++r) mx = fmaxf(mx, fmaxf(p0[r], p1[r]));
                mx = fmaxf(mx, __shfl_xor(mx, 32));
                const float mnew = fmaxf(mrow, mx), alpha = __builtin_amdgcn_exp2f(mrow - mnew);
                mrow = mnew;
                float rs = 0.f;
#pragma unroll
                for (int r = 0; r < 16; ++r) { p0[r] = __builtin_amdgcn_exp2f(p0[r] - mnew); p1[r] = __builtin_amdgcn_exp2f(p1[r] - mnew); rs += p0[r] + p1[r]; }
                lrow = lrow * alpha + rs;
#pragma unroll
                for (int r = 0; r < 16; ++r) { o0[r] *= alpha; o1[r] *= alpha; }
            } else {
                const bool need_mask = (64 * kt + 63 >= t0w);
                const int kvb = 64 * kt + 4 * hi;
                float gs[8], lkq0[16], lkq1[16];
#pragma unroll
                for (int g = 0; g < 8; ++g) {
                    float s4 = 0.f;
#pragma unroll
                    for (int c = 0; c < 4; ++c) {
                        const int r = 4 * (g & 3) + c;
                        const float z2 = ((g < 4) ? p0[r] : p1[r]) * (0.125f * LOG2E);
                        const float sp2 = fmaxf(z2, 0.f) + __builtin_amdgcn_logf(1.0f + __builtin_amdgcn_exp2f(-fabsf(z2)));
                        const bool valid = !need_mask || (kvb + 8 * g + c < trow);
                        const float lk = valid ? -sp2 : 0.f;
                        const float ls = valid ? (z2 - sp2) : -1e30f;
                        if (g < 4) { p0[r] = ls; } else { p1[r] = ls; }
                        s4 += lk;
                        if (g < 4) { lkq0[r] = lk; } else { lkq1[r] = lk; }
                    }
                    gs[g] = s4;
                }
                float run = 0.f, after[8];
#pragma unroll
                for (int g = 7; g >= 0; --g) { const float pg = __shfl_xor(gs[g], 32); after[g] = run + (hi == 0 ? pg : 0.f); run += gs[g] + pg; }
#pragma unroll
                for (int g = 0; g < 8; ++g) {
                    float suf = carry + after[g];
#pragma unroll
                    for (int c = 3; c >= 0; --c) {
                        const int r = 4 * (g & 3) + c;
                        if (g < 4) { p0[r] = __builtin_amdgcn_exp2f(p0[r] + suf); suf += lkq0[r]; } else { p1[r] = __builtin_amdgcn_exp2f(p1[r] + suf); suf += lkq1[r]; }
                    }
                }
                carry += run;
            }
            const bf16x8 pb0 = pack8(p0[0], p0[1], p0[2], p0[3], p0[4], p0[5], p0[6], p0[7]), pb1 = pack8(p0[8], p0[9], p0[10], p0[11], p0[12], p0[13], p0[14], p0[15]);
            const bf16x8 pb2 = pack8(p1[0], p1[1], p1[2], p1[3], p1[4], p1[5], p1[6], p1[7]), pb3 = pack8(p1[8], p1[9], p1[10], p1[11], p1[12], p1[13], p1[14], p1[15]);
            const LAS bf16_t* v0p = Vt + l31 * AT_VSTR + 8 * hi; const LAS bf16_t* v1p = Vt + (32 + l31) * AT_VSTR + 8 * hi;
            o0 = __builtin_amdgcn_mfma_f32_32x32x16_bf16(*(const LAS bf16x8*)(v0p + 0), pb0, o0, 0, 0, 0);  o1 = __builtin_amdgcn_mfma_f32_32x32x16_bf16(*(const LAS bf16x8*)(v1p + 0), pb0, o1, 0, 0, 0);
            o0 = __builtin_amdgcn_mfma_f32_32x32x16_bf16(*(const LAS bf16x8*)(v0p + 16), pb1, o0, 0, 0, 0); o1 = __builtin_amdgcn_mfma_f32_32x32x16_bf16(*(const LAS bf16x8*)(v1p + 16), pb1, o1, 0, 0, 0);
            o0 = __builtin_amdgcn_mfma_f32_32x32x16_bf16(*(const LAS bf16x8*)(v0p + 32), pb2, o0, 0, 0, 0); o1 = __builtin_amdgcn_mfma_f32_32x32x16_bf16(*(const LAS bf16x8*)(v1p + 32), pb2, o1, 0, 0, 0);
            o0 = __builtin_amdgcn_mfma_f32_32x32x16_bf16(*(const LAS bf16x8*)(v0p + 48), pb3, o0, 0, 0, 0); o1 = __builtin_amdgcn_mfma_f32_32x32x16_bf16(*(const LAS bf16x8*)(v1p + 48), pb3, o1, 0, 0, 0);
        }
        if (i + 1 < nt) AT_STORE((i + 1) & 1);
        if (MODE == 1) { const int done = __all(carry < -151.0f) ? 1 : 0; if (lane == 0) flags[(i & 1) * 8 + wid] = done; }
        __syncthreads();
        if (MODE == 1) {
            int alld = 1;
#pragma unroll
            for (int w8 = 0; w8 < 8; ++w8) alld &= flags[(i & 1) * 8 + w8];
            if (alld) break;
        }
    }
    if (MODE == 1) __syncthreads();
    float inv = 1.0f;
    if (MODE != 1) { const float lt = lrow + __shfl_xor(lrow, 32); inv = 1.0f / lt; }
    bf16_t* orow = Op + (size_t)trow * DM + 4 * hi;
#pragma unroll
    for (int g = 0; g < 4; ++g) {
        u32x2 w0, w1;
        w0.x = cvt_pk_bf16(o0[4 * g] * inv, o0[4 * g + 1] * inv); w0.y = cvt_pk_bf16(o0[4 * g + 2] * inv, o0[4 * g + 3] * inv);
        w1.x = cvt_pk_bf16(o1[4 * g] * inv, o1[4 * g + 1] * inv); w1.y = cvt_pk_bf16(o1[4 * g + 2] * inv, o1[4 * g + 3] * inv);
        *(u32x2*)(orow + 8 * g) = w0; *(u32x2*)(orow + 32 + 8 * g) = w1;
    }
#undef AT_KT
#undef AT_LOAD
#undef AT_STORE
}


#define XB_TMO      128
#define XB_XCNT(j)  (256  + 64 * (j))
#define XB_XSUB(j)  (1280 + 64 * (j))
#define XB_XGEN(j)  (2304 + 64 * (j))
#define XB_TOP      3328
#define XB_TOPGEN   3392
#define XCD_BAR_WORDS 3456
#define XB_SPIN_CAP (1u << 18)
__device__ __forceinline__ unsigned xb_ld(unsigned* p)              { return __hip_atomic_load(p, __ATOMIC_RELAXED, __HIP_MEMORY_SCOPE_AGENT); }
__device__ __forceinline__ unsigned xb_add(unsigned* p, unsigned v) { return __hip_atomic_fetch_add(p, v, __ATOMIC_RELAXED, __HIP_MEMORY_SCOPE_AGENT); }
__device__ __forceinline__ unsigned xb_xcc_id() { return (unsigned)__builtin_amdgcn_s_getreg((3 << 11) | 20) & 0xFu; }
#define XB_SPIN(cond, bar) do { unsigned _sp = 0; while (cond) { __builtin_amdgcn_s_sleep(1); \
    if ((++_sp & 255u) == 0u) { if (xb_ld(&(bar)[XB_TMO])) break; if (_sp > XB_SPIN_CAP) { atomicAdd(&(bar)[XB_TMO], 1u); break; } } } } while (0)
struct XcdBarrier { unsigned* bar; unsigned x; volatile LAS unsigned* st; };
__device__ __forceinline__ XcdBarrier xcd_barrier_post(unsigned* bar, volatile LAS unsigned* st) {
    XcdBarrier b; b.bar = bar; b.x = xb_xcc_id(); b.st = st;
    if (threadIdx.x == 0) (void)xb_add(&bar[XB_XCNT(b.x)], 1u);
    return b;
}
__device__ __forceinline__ void xcd_barrier_complete(unsigned* bar, unsigned x, unsigned& nloc, unsigned& nx) {
    const unsigned G = gridDim.x * gridDim.y * gridDim.z;
    unsigned sum, cnt, mine, sp = 0u;
    for (;;) {
        sum = 0u; cnt = 0u; mine = 0u;
#pragma unroll
        for (unsigned j = 0; j < 16; ++j) { const unsigned c = xb_ld(&bar[XB_XCNT(j)]); sum += c; cnt += (c > 0u) ? 1u : 0u; mine = (j == x) ? c : mine; }
        if (sum == G) break;
        __builtin_amdgcn_s_sleep(1);
        if ((++sp & 255u) == 0u) { if (xb_ld(&bar[XB_TMO])) break; if (sp > XB_SPIN_CAP) { atomicAdd(&bar[XB_TMO], 1u); break; } }
    }
    nloc = mine > 0u ? mine : 1u; nx = cnt > 0u ? cnt : 1u;
}
__device__ __forceinline__ void xcd_barrier(const XcdBarrier& b) {
    asm volatile("s_waitcnt vmcnt(0)" ::: "memory");
    __syncthreads();
    if (threadIdx.x == 0) {
        unsigned* bar = b.bar;
        __builtin_amdgcn_s_waitcnt(0);
        unsigned nloc = b.st[0], nx = b.st[1];
        if (nloc == 0u) { xcd_barrier_complete(bar, b.x, nloc, nx); b.st[0] = nloc; b.st[1] = nx; }
        const unsigned old = xb_add(&bar[XB_XSUB(b.x)], 1u);
        const unsigned gen = old / nloc;
        if (old + 1u == (gen + 1u) * nloc) {
            __builtin_amdgcn_fence(__ATOMIC_RELEASE, "agent");
            asm volatile("s_waitcnt vmcnt(0)" ::: "memory");
            const unsigned og = xb_add(&bar[XB_TOP], 1u);
            const unsigned tg = og / nx;
            if (og + 1u == (tg + 1u) * nx) xb_add(&bar[XB_TOPGEN], 1u);
            else XB_SPIN(xb_ld(&bar[XB_TOPGEN]) == tg, bar);
            __builtin_amdgcn_fence(__ATOMIC_ACQUIRE, "agent");
            xb_add(&bar[XB_XGEN(b.x)], 1u);
            asm volatile("s_waitcnt vmcnt(0)" ::: "memory");
        } else {
            XB_SPIN(xb_ld(&bar[XB_XGEN(b.x)]) == gen, bar);
            __builtin_amdgcn_fence(__ATOMIC_ACQUIRE, "agent");
            asm volatile("s_waitcnt vmcnt(0)" ::: "memory");
        }
    }
    __syncthreads();
}

struct Args { const float* in[16]; float* out; unsigned char* ws; };

__device__ __forceinline__ void attn_mla_naive(const bf16_t* QA, const bf16_t* KVA, const bf16_t* PROJ, bf16_t* O) {
    const int nth = gridDim.x * NTHREADS;
    for (int w = blockIdx.x * NTHREADS + threadIdx.x; w < 8 * MTOK; w += nth) {
        const int h = w >> 14, row = w & (MTOK - 1), b = row >> 11, t = row & (SEQ - 1);
        float q[96];
#pragma unroll
        for (int c = 0; c < 12; ++c) unpack8(*(const u32x4*)(QA + (size_t)row * NQA + h * 96 + c * 8), q + c * 8);
        float o[64];
#pragma unroll
        for (int d = 0; d < 64; ++d) o[d] = 0.f;
        float mx = -INFINITY, l = 0.f;
        const int kend = ((t >> 6) + 1) << 6;
        for (int s = 0; s < kend; ++s) {
            const size_t kr = (size_t)(b * SEQ + s);
            const bf16_t* kp = KVA + kr * NKVA + h * 128; const bf16_t* rp = PROJ + kr * NPROJ_P + C_KR;
            float sc = 0.f;
#pragma unroll
            for (int c = 0; c < 8; ++c) { float k[8]; unpack8(*(const u32x4*)(kp + c * 8), k);
#pragma unroll
                for (int e = 0; e < 8; ++e) sc += q[c * 8 + e] * k[e]; }
#pragma unroll
            for (int c = 0; c < 4; ++c) { float k[8]; unpack8(*(const u32x4*)(rp + c * 8), k);
#pragma unroll
                for (int e = 0; e < 8; ++e) sc += q[64 + c * 8 + e] * k[e]; }
            const float mn = fmaxf(mx, sc), al = __builtin_amdgcn_exp2f(mx - mn), p = __builtin_amdgcn_exp2f(sc - mn);
            l = l * al + p; mx = mn;
#pragma unroll
            for (int c = 0; c < 8; ++c) { float v[8]; unpack8(*(const u32x4*)(kp + 64 + c * 8), v);
#pragma unroll
                for (int e = 0; e < 8; ++e) o[c * 8 + e] = o[c * 8 + e] * al + p * v[e]; }
        }
        const float inv = 1.0f / l;
#pragma unroll
        for (int c = 0; c < 8; ++c) { u32x4 wv; wv.x = cvt_pk_bf16(o[c * 8] * inv, o[c * 8 + 1] * inv); wv.y = cvt_pk_bf16(o[c * 8 + 2] * inv, o[c * 8 + 3] * inv); wv.z = cvt_pk_bf16(o[c * 8 + 4] * inv, o[c * 8 + 5] * inv); wv.w = cvt_pk_bf16(o[c * 8 + 6] * inv, o[c * 8 + 7] * inv);
            *(u32x4*)(O + (size_t)row * DM + h * 64 + c * 8) = wv; }
    }
}

__device__ __forceinline__ void attn_sb_naive(const bf16_t* PROJ, bf16_t* O) {
    const int nth = gridDim.x * NTHREADS;
    for (int w = blockIdx.x * NTHREADS + threadIdx.x; w < 8 * MTOK; w += nth) {
        const int h = w >> 14, row = w & (MTOK - 1), b = row >> 11, t = row & (SEQ - 1);
        float q[64];
#pragma unroll
        for (int c = 0; c < 8; ++c) unpack8(*(const u32x4*)(PROJ + (size_t)row * NPROJ_P + C_QB + h * 64 + c * 8), q + c * 8);
        float o[64];
#pragma unroll
        for (int d = 0; d < 64; ++d) o[d] = 0.f;
        float cum = 0.f;
        const int tmax = t | 63;
        for (int s = tmax - 1; s >= 0; --s) {
            const size_t kr = (size_t)(b * SEQ + s);
            const bf16_t* kp = PROJ + kr * NPROJ_P + C_KB + h * 64; const bf16_t* vp = PROJ + kr * NPROJ_P + C_VB + h * 64;
            float z = 0.f;
#pragma unroll
            for (int c = 0; c < 8; ++c) { float k[8]; unpack8(*(const u32x4*)(kp + c * 8), k);
#pragma unroll
                for (int e = 0; e < 8; ++e) z += q[c * 8 + e] * k[e]; }
            z *= 0.125f;
            const bool on = s < t;
            const float lg = __logf(1.0f + __expf(-fabsf(z)));
            const float wgt = on ? __expf(fminf(z, 0.f) - lg + cum) : 0.f;
            cum += on ? (fminf(-z, 0.f) - lg) : 0.f;
#pragma unroll
            for (int c = 0; c < 8; ++c) { float v[8]; unpack8(*(const u32x4*)(vp + c * 8), v);
#pragma unroll
                for (int e = 0; e < 8; ++e) o[c * 8 + e] += wgt * v[e]; }
        }
#pragma unroll
        for (int c = 0; c < 8; ++c) { u32x4 wv; wv.x = cvt_pk_bf16(o[c * 8], o[c * 8 + 1]); wv.y = cvt_pk_bf16(o[c * 8 + 2], o[c * 8 + 3]); wv.z = cvt_pk_bf16(o[c * 8 + 4], o[c * 8 + 5]); wv.w = cvt_pk_bf16(o[c * 8 + 6], o[c * 8 + 7]);
            *(u32x4*)(O + (size_t)row * DM + 512 + h * 64 + c * 8) = wv; }
    }
}

__device__ __forceinline__ void attn_band_naive(const bf16_t* QKV, const float* rel_bias, bf16_t* O) {
    const int nth = gridDim.x * NTHREADS;
    for (int w = blockIdx.x * NTHREADS + threadIdx.x; w < 16 * MTOK; w += nth) {
        const int h = w >> 14, row = w & (MTOK - 1), b = row >> 11, t = row & (SEQ - 1);
        float q[64];
#pragma unroll
        for (int c = 0; c < 8; ++c) unpack8(*(const u32x4*)(QKV + (size_t)row * NQKV + h * 64 + c * 8), q + c * 8);
        float o[64];
#pragma unroll
        for (int d = 0; d < 64; ++d) o[d] = 0.f;
        float mx = -INFINITY, l = 0.f;
        const int n = t >> 6, s0 = (n >= 8) ? (n - 8) * 64 : 0, s1 = (n + 1) * 64;
        const float* bias = rel_bias + h * 513 + 256;
        for (int s = s0; s < s1; ++s) {
            const size_t kr = (size_t)(b * SEQ + s);
            const bf16_t* kp = QKV + kr * NQKV + 1024 + h * 64; const bf16_t* vp = QKV + kr * NQKV + 2048 + h * 64;
            float sc = 0.f;
#pragma unroll
            for (int c = 0; c < 8; ++c) { float k[8]; unpack8(*(const u32x4*)(kp + c * 8), k);
#pragma unroll
                for (int e = 0; e < 8; ++e) sc += q[c * 8 + e] * k[e]; }
            int rel = t - s; rel = rel > 256 ? 256 : (rel < -256 ? -256 : rel);
            sc += bias[rel] * LOG2E;
            const float mn = fmaxf(mx, sc), al = __builtin_amdgcn_exp2f(mx - mn), p = __builtin_amdgcn_exp2f(sc - mn);
            l = l * al + p; mx = mn;
#pragma unroll
            for (int c = 0; c < 8; ++c) { float v[8]; unpack8(*(const u32x4*)(vp + c * 8), v);
#pragma unroll
                for (int e = 0; e < 8; ++e) o[c * 8 + e] = o[c * 8 + e] * al + p * v[e]; }
        }
        const float inv = 1.0f / l;
#pragma unroll
        for (int c = 0; c < 8; ++c) { u32x4 wv; wv.x = cvt_pk_bf16(o[c * 8] * inv, o[c * 8 + 1] * inv); wv.y = cvt_pk_bf16(o[c * 8 + 2] * inv, o[c * 8 + 3] * inv); wv.z = cvt_pk_bf16(o[c * 8 + 4] * inv, o[c * 8 + 5] * inv); wv.w = cvt_pk_bf16(o[c * 8 + 6] * inv, o[c * 8 + 7] * inv);
            *(u32x4*)(O + (size_t)row * DM + h * 64 + c * 8) = wv; }
    }
}

__global__ void __launch_bounds__(NTHREADS) fwd_megakernel(Args args) {
    extern __shared__ __attribute__((aligned(16))) unsigned char lds[];
#ifdef USE_CG_SYNC
    cg::grid_group grid = cg::this_grid();
#define GRID_SYNC() grid.sync()
#else
    { volatile LAS unsigned* st0 = (volatile LAS unsigned*)((LAS unsigned char*)lds + LDS_BYTES - 64); if (threadIdx.x == 0) { st0[0] = 0u; st0[1] = 0u; } }
    __syncthreads();
    const XcdBarrier xbar = xcd_barrier_post((unsigned*)(args.ws + WS_CTL), (volatile LAS unsigned*)((LAS unsigned char*)lds + LDS_BYTES - 64));
#define GRID_SYNC() xcd_barrier(xbar)
#endif
#ifdef USE_NAIVE_GEMM
#define GEMM(A, lda, Bt, ldb, M, N, K, E) gemm_naive(A, lda, Bt, ldb, (M) / 256, (N) / 256, K, E)
#else
#define GEMM(A, lda, Bt, ldb, M, N, K, E) gemm_fast((LAS unsigned char*)lds, A, lda, Bt, ldb, M, N, K, E)
#endif
    const int G = gridDim.x;
    const int vcu = (G % 8 == 0) ? (int)(blockIdx.x % 8) * (G / 8) + (int)(blockIdx.x / 8) : (int)blockIdx.x;
    LAS unsigned char* ldsp = (LAS unsigned char*)lds;
    unsigned char* ws = args.ws;
    const float* x = args.in[0];
    float* out = args.out;
    float* ssq = (float*)(ws + WS_SSQ);
    f32x2* rope = (f32x2*)(ws + WS_ROPE);
    bf16_t* Win = (bf16_t*)(ws + WS_WIN); bf16_t* Wuq = (bf16_t*)(ws + WS_WUQ); bf16_t* Wukv = (bf16_t*)(ws + WS_WUKV); bf16_t* Wo0 = (bf16_t*)(ws + WS_WO0);
    bf16_t* Wgu0 = (bf16_t*)(ws + WS_WGU0); bf16_t* Wd0 = (bf16_t*)(ws + WS_WD0); bf16_t* Wqkv = (bf16_t*)(ws + WS_WQKV); bf16_t* Wo1 = (bf16_t*)(ws + WS_WO1);
    bf16_t* Wgu1 = (bf16_t*)(ws + WS_WGU1); bf16_t* Wd1 = (bf16_t*)(ws + WS_WD1);
    bf16_t* HB = (bf16_t*)(ws + WS_HB); bf16_t* PROJ = (bf16_t*)(ws + WS_A); bf16_t* QKV = (bf16_t*)(ws + WS_A); bf16_t* ACT = (bf16_t*)(ws + WS_A); bf16_t* ATT = (bf16_t*)(ws + WS_ATT);
    bf16_t* QA = (bf16_t*)((unsigned char*)out + OUT_QA); bf16_t* KVA = (bf16_t*)((unsigned char*)out + OUT_KVA);

    {
        const int tid = threadIdx.x, lane = tid & 63, wave = __builtin_amdgcn_readfirstlane(tid >> 6);
        LAS float* scr = (LAS float*)((LAS unsigned char*)lds + wave * 16384);
        const int gw = blockIdx.x * 8 + wave, NGW = G * 8;
        const float* g_mix = args.in[10]; const float* g_ffn = args.in[11];
        constexpr int I_IN = 16 * (NPROJ / 32), I_UQ = 6 * 24, I_UKV = 4 * 32, I_O = 16 * 32, I_G = 16 * 88, I_D = 44 * 32, I_QKV = 16 * 96;
        constexpr int NITEMS = I_IN + I_UQ + I_UKV + I_O + 2 * I_G + I_D + I_QKV + I_O + 2 * I_G + I_D;
        for (int it = gw; it < NITEMS; it += NGW) {
            int r = it;
            if (r < I_IN) { p0_item(args.in[1], DM, NPROJ, g_mix, Win, DM, 0, scr, r, lane); continue; } r -= I_IN;
            if (r < I_UQ) { p0_item(args.in[3], 384, NQA, args.in[2], Wuq, 384, 0, scr, r, lane); continue; } r -= I_UQ;
            if (r < I_UKV) { p0_item(args.in[5], 256, NKVA, args.in[4], Wukv, 256, 0, scr, r, lane); continue; } r -= I_UKV;
            if (r < I_O) { p0_item(args.in[6], DM, DM, nullptr, Wo0, DM, 0, scr, r, lane); continue; } r -= I_O;
            if (r < I_G) { p0_item(args.in[12], DM, DFF, g_ffn, Wgu0, DM, 1, scr, r, lane); continue; } r -= I_G;
            if (r < I_G) { p0_item(args.in[13], DM, DFF, g_ffn, Wgu0, DM, 2, scr, r, lane); continue; } r -= I_G;
            if (r < I_D) { p0_item(args.in[14], DFF, DM, nullptr, Wd0, DFF, 0, scr, r, lane); continue; } r -= I_D;
            if (r < I_QKV) { p0_item(args.in[7], DM, NQKV, g_mix + DM, Wqkv, DM, 0, scr, r, lane); continue; } r -= I_QKV;
            if (r < I_O) { p0_item(args.in[9], DM, DM, nullptr, Wo1, DM, 0, scr, r, lane); continue; } r -= I_O;
            if (r < I_G) { p0_item(args.in[12] + (size_t)DM * DFF, DM, DFF, g_ffn + DM, Wgu1, DM, 1, scr, r, lane); continue; } r -= I_G;
            if (r < I_G) { p0_item(args.in[13] + (size_t)DM * DFF, DM, DFF, g_ffn + DM, Wgu1, DM, 2, scr, r, lane); continue; } r -= I_G;
            p0_item(args.in[14] + (size_t)DFF * DM, DFF, DM, nullptr, Wd1, DFF, 0, scr, r, lane);
        }
        for (int i = blockIdx.x * NTHREADS + tid; i < (NPROJ_P - NPROJ) * DM / 8; i += G * NTHREADS) ((u32x4*)(Win + (size_t)NPROJ * DM))[i] = (u32x4){0u, 0u, 0u, 0u};
        for (int i = blockIdx.x * NTHREADS + tid; i < 6 * MTOK; i += G * NTHREADS) ssq[MTOK + i] = 0.f;
        for (int i = blockIdx.x * NTHREADS + tid; i < SEQ * 16; i += G * NTHREADS) {
            const int pos = i >> 4, fi = i & 15;
            const float inv_freq = __builtin_amdgcn_exp2f(-(float)fi * (13.287712379549449f / 16.0f));
            const float ang = (float)pos * inv_freq;
            float tr = ang * 0.15915494309189535f; tr -= floorf(tr);
            rope[i] = (f32x2){__builtin_amdgcn_cosf(tr), __builtin_amdgcn_sinf(tr)};
        }
        for (int m = gw; m < MTOK; m += NGW) {
            const f32x4* xr = (const f32x4*)(x + (size_t)m * DM) + lane; f32x4 v[4]; float s = 0.f;
#pragma unroll
            for (int j = 0; j < 4; ++j) { v[j] = xr[64 * j]; s += dot4(v[j]); }
            s = wave_sum(s);
            if (lane == 0) ssq[m] = s;
#pragma unroll
            for (int j = 0; j < 4; ++j) { u32x2 w; w.x = cvt_pk_bf16(v[j][0], v[j][1]); w.y = cvt_pk_bf16(v[j][2], v[j][3]); *((u32x2*)(HB + (size_t)m * DM) + lane + 64 * j) = w; }
        }
    }
    GRID_SYNC();
    { EpiScale<0> E{PROJ, NPROJ_P, ssq, 1.0f / DM, ssq + MTOK, ssq + 2 * MTOK, rope}; GEMM(HB, DM, Win, DM, MTOK, NPROJ_P, DM, E); }
    GRID_SYNC();
    { EpiScale<1> E{QA, NQA, ssq + MTOK, 1.0f / 384, nullptr, nullptr, rope}; GEMM(PROJ, NPROJ_P, Wuq, 384, MTOK, NQA, 384, E); }
    { EpiScale<2> E{KVA, NKVA, ssq + 2 * MTOK, 1.0f / 256, nullptr, nullptr, rope}; GEMM(PROJ + C_CKV, NPROJ_P, Wukv, 256, MTOK, NKVA, 256, E); }
    GRID_SYNC();
#ifdef NAIVE_ATTN
    attn_mla_naive(QA, KVA, PROJ, ATT);
    attn_sb_naive(PROJ, ATT);
#else
    for (int u = vcu; u < 256; u += G) {
        const int bh = u >> 2, j = u & 3, b = bh >> 3, h = bh & 7;
        const size_t rb = (size_t)b * SEQ;
        for (int k = 0; k < 2 * REP_MLA; ++k) { const int qt = (k & 1) ? 7 - j : j;
            attn_unit<0>(ldsp, 256 * qt, QA + rb * NQA + h * 96, NQA, KVA + rb * NKVA + h * 128, NKVA, PROJ + rb * NPROJ_P + C_KR, NPROJ_P, KVA + rb * NKVA + h * 128 + 64, NKVA, ATT + rb * DM + h * 64, nullptr); }
        for (int k = 0; k < 2 * REP_SB; ++k) { const int qt = (k & 1) ? 7 - j : j;
            attn_unit<1>(ldsp, 256 * qt, PROJ + rb * NPROJ_P + C_QB + h * 64, NPROJ_P, PROJ + rb * NPROJ_P + C_KB + h * 64, NPROJ_P, nullptr, 0, PROJ + rb * NPROJ_P + C_VB + h * 64, NPROJ_P, ATT + rb * DM + 512 + h * 64, nullptr); }
    }
#endif
    GRID_SYNC();
    { EpiResid E{HB, ssq + 3 * MTOK}; GEMM(ATT, DM, Wo0, DM, MTOK, DM, DM, E); }
    GRID_SYNC();
    for (int rep = 0; rep < REP_GU; ++rep) { EpiSwiglu E{ACT, ssq + 3 * MTOK}; GEMM(HB, DM, Wgu0, DM, MTOK, 2 * DFF, DM, E); }
    GRID_SYNC();
    { EpiResid E{HB, ssq + 4 * MTOK}; GEMM(ACT, DFF, Wd0, DFF, MTOK, DM, DFF, E); }
    GRID_SYNC();
    { EpiScale<3> E{QKV, NQKV, ssq + 4 * MTOK, 1.0f / DM, nullptr, nullptr, rope}; GEMM(HB, DM, Wqkv, DM, MTOK, NQKV, DM, E); }
    GRID_SYNC();
#ifdef NAIVE_ATTN
    attn_band_naive(QKV, args.in[8], ATT);
#else
    for (int u = vcu; u < 256; u += G) {
        const int bh = u >> 1, half = u & 1, b = bh >> 4, h = bh & 15;
        const size_t rb = (size_t)b * SEQ;
        for (int k = 0; k < 4 * REP_BAND; ++k)
            attn_unit<2>(ldsp, 256 * (4 * half + (k & 3)), QKV + rb * NQKV + h * 64, NQKV, QKV + rb * NQKV + 1024 + h * 64, NQKV, nullptr, 0, QKV + rb * NQKV + 2048 + h * 64, NQKV, ATT + rb * DM + h * 64, args.in[8] + h * 513);
    }
#endif
    GRID_SYNC();
    { EpiResid E{HB, ssq + 5 * MTOK}; GEMM(ATT, DM, Wo1, DM, MTOK, DM, DM, E); }
    GRID_SYNC();
    { EpiSwiglu E{ACT, ssq + 5 * MTOK}; GEMM(HB, DM, Wgu1, DM, MTOK, 2 * DFF, DM, E); }
    GRID_SYNC();
    { EpiResid E{HB, ssq + 6 * MTOK}; GEMM(ACT, DFF, Wd1, DFF, MTOK, DM, DFF, E); }
    GRID_SYNC();
    {
        const int tid = threadIdx.x, lane = tid & 63, wave = __builtin_amdgcn_readfirstlane(tid >> 6); (void)tid;
        const int gw = blockIdx.x * 8 + wave, NGW = G * 8;
        const f32x4* gf = (const f32x4*)args.in[15] + lane;
        for (int m = gw; m < MTOK; m += NGW) {
            const float r = rsqrtf(ssq[6 * MTOK + m] * (1.0f / DM) + RMS_EPS);
            f32x4* p = (f32x4*)(out + (size_t)m * DM) + lane; const u32x2* hp = (const u32x2*)(HB + (size_t)m * DM) + lane;
#pragma unroll
            for (int j = 0; j < 4; ++j) { const u32x2 hv = hp[64 * j]; const f32x4 g4 = gf[64 * j]; f32x4 o; o[0] = bflo(hv.x) * r * g4[0]; o[1] = bfhi(hv.x) * r * g4[1]; o[2] = bflo(hv.y) * r * g4[2]; o[3] = bfhi(hv.y) * r * g4[3]; p[64 * j] = o; }
        }
    }
}

extern "C" void kernel_launch(void* const* d_in, const int* in_sizes, int n_in, void* d_out, int out_size, void* d_ws, size_t ws_size, hipStream_t stream) {
    static int grid = 0;
    if (grid == 0) {
        int dev = 0, cus = 0, per_cu = 0;
        hipGetDevice(&dev);
        hipDeviceGetAttribute(&cus, hipDeviceAttributeMultiprocessorCount, dev);
        hipFuncSetAttribute((const void*)fwd_megakernel, hipFuncAttributeMaxDynamicSharedMemorySize, LDS_BYTES);
        hipOccupancyMaxActiveBlocksPerMultiprocessor(&per_cu, (const void*)fwd_megakernel, NTHREADS, LDS_BYTES);
        if (per_cu < 1) per_cu = 1;
        if (per_cu > 1) per_cu = 1;
        grid = cus * per_cu;
        if (n_in != 16 || out_size != MTOK * DM || ws_size < WS_END) { fprintf(stderr, "kernel_launch: unexpected shapes n_in %d out %d ws %zu\n", n_in, out_size, ws_size); }
    }
    Args a{};
    for (int i = 0; i < 16; ++i) a.in[i] = (const float*)d_in[i];
    a.out = (float*)d_out; a.ws = (unsigned char*)d_ws;
    hipMemsetAsync((char*)d_ws + WS_CTL, 0, CTL_BYTES, stream);
    void* kargs[] = {&a};
    hipError_t e = hipLaunchCooperativeKernel((const void*)fwd_megakernel, dim3(grid), dim3(NTHREADS), kargs, LDS_BYTES, stream);
    if (e != hipSuccess) fprintf(stderr, "cooperative launch failed: %s (grid %d)\n", hipGetErrorString(e), grid);
}
```

```cpp
#include <hip/hip_runtime.h>
#include <hip/hip_cooperative_groups.h>
#include <cstdio>
#include <cstdint>
namespace cg = cooperative_groups;
#define REP_MLA 1
#define REP_SB 1
#define REP_BAND 1
#define REP_GU 1

#define LAS __attribute__((address_space(3)))
typedef unsigned short bf16_t;
typedef short bf16x8 __attribute__((ext_vector_type(8)));
typedef float f32x4 __attribute__((ext_vector_type(4)));
typedef float f32x2 __attribute__((ext_vector_type(2)));
typedef unsigned u32x4 __attribute__((ext_vector_type(4)));
typedef unsigned u32x2 __attribute__((ext_vector_type(2)));

constexpr int MTOK = 16384, SEQ = 2048, DM = 1024, DFF = 2816;
constexpr int NPROJ = 2208, NPROJ_P = 2304;
constexpr int C_CKV = 384, C_KR = 640, C_QB = 672, C_KB = 1184, C_VB = 1696;
constexpr int NQA = 768, NKVA = 1024, NQKV = 3072;
constexpr float RMS_EPS = 1e-6f;
constexpr float LOG2E = 1.4426950408889634f;
constexpr float QSCALE_A = 0.10206207261596577f * LOG2E;
constexpr float QSCALE_C = 0.125f * LOG2E;

constexpr size_t KiB = 1024, MiB = 1u << 20;
constexpr size_t WS_SSQ = 216 * MiB;
constexpr size_t WS_ROPE = 512 * KiB;
constexpr size_t WS_CTL = 768 * KiB, CTL_BYTES = 16 * KiB;
constexpr size_t WS_WIN = 1 * MiB;
constexpr size_t WS_WUQ = WS_WIN + (size_t)NPROJ_P * DM * 2;
constexpr size_t WS_WUKV = WS_WUQ + (size_t)NQA * 384 * 2;
constexpr size_t WS_WO0 = WS_WUKV + (size_t)NKVA * 256 * 2;
constexpr size_t WS_WGU0 = WS_WO0 + (size_t)DM * DM * 2;
constexpr size_t WS_WD0 = WS_WGU0 + (size_t)2 * DFF * DM * 2;
constexpr size_t WS_WQKV = WS_WD0 + (size_t)DM * DFF * 2;
constexpr size_t WS_WO1 = WS_WQKV + (size_t)NQKV * DM * 2;
constexpr size_t WS_WGU1 = WS_WO1 + (size_t)DM * DM * 2;
constexpr size_t WS_WD1 = WS_WGU1 + (size_t)2 * DFF * DM * 2;
constexpr size_t WS_WEND = WS_WD1 + (size_t)DM * DFF * 2;
constexpr size_t WS_HB = 50 * MiB;
constexpr size_t WS_A = 82 * MiB;
constexpr size_t WS_ATT = 178 * MiB;
constexpr size_t WS_SSQP = 210 * MiB;
constexpr size_t WS_END = 218 * MiB;
static_assert(WS_WEND <= WS_HB, "weights fit");
constexpr size_t OUT_QA = 0, OUT_KVA = 24 * MiB;

constexpr int NTHREADS = 512;
constexpr int LDS_BYTES = 147456;

__device__ __forceinline__ unsigned cvt_pk_bf16(float lo, float hi) { unsigned r; asm volatile("v_cvt_pk_bf16_f32 %0, %1, %2" : "=v"(r) : "v"(lo), "v"(hi)); return r; }
__device__ __forceinline__ float bflo(unsigned w) { return __uint_as_float(w << 16); }
__device__ __forceinline__ float bfhi(unsigned w) { return __uint_as_float(w & 0xffff0000u); }
__device__ __forceinline__ void unpack8(const u32x4 w, float* f) {
    f[0] = bflo(w.x); f[1] = bfhi(w.x); f[2] = bflo(w.y); f[3] = bfhi(w.y); f[4] = bflo(w.z); f[5] = bfhi(w.z); f[6] = bflo(w.w); f[7] = bfhi(w.w);
}
__device__ __forceinline__ float wave_sum(float v) {
#pragma unroll
    for (int o = 1; o < 64; o <<= 1) v += __shfl_xor(v, o);
    return v;
}
__device__ __forceinline__ float dot4(const f32x4 a) { return (a[0] * a[0] + a[1] * a[1]) + (a[2] * a[2] + a[3] * a[3]); }

struct Unit { int pm, pn; };
typedef unsigned long long u64;
__device__ __forceinline__ u64 ssq_fix(float s) { const unsigned hi = (unsigned)s; const unsigned lo = (unsigned)((s - (float)hi) * 4294967296.0f); return ((u64)hi << 32) | (u64)lo; }
__device__ __forceinline__ float ssq_get(const u64* p, int row) { const u64 v = p[row]; return (float)(unsigned)(v >> 32) + (float)(unsigned)v * 2.3283064365386963e-10f; }
__device__ __forceinline__ void ssq_add(u64* p, int row, float s) { atomicAdd(p + row, ssq_fix(s)); }


template <int MODE> struct EpiScale {
    static constexpr bool PERM = false, AFTER_DRAIN = false;
    bf16_t* O; int ldc; const u64* ssq_in; float inv_n; u64* ssq_a; u64* ssq_b; const f32x2* rope;
    __device__ __forceinline__ void operator()(const f32x4 (&acc)[2][2][4][2], const Unit& u, int wr, int wc, int fr, int fq) const {
        const int cb0 = u.pn * 256 + wc * 32;
#pragma unroll
        for (int ai = 0; ai < 2; ++ai)
#pragma unroll
            for (int m = 0; m < 4; ++m) {
                const int row = u.pm * 256 + ai * 128 + wr * 64 + m * 16 + fr;
                const float r = rsqrtf(ssq_get(ssq_in, row) * inv_n + RMS_EPS);
                const int pos = row & (SEQ - 1);
#pragma unroll
                for (int bj = 0; bj < 2; ++bj) {
                    const int cb = cb0 + 128 * bj;
                    float sc = r;
                    if (MODE == 1) sc *= QSCALE_A;
                    if (MODE == 3) { if (cb < 1024) sc *= QSCALE_C; }
                    f32x4 v0 = acc[ai][bj][m][0] * sc, v1 = acc[ai][bj][m][1] * sc;
                    bool ropeg = false;
                    if (MODE == 0) ropeg = (cb == C_KR);
                    if (MODE == 1) ropeg = ((cb % 96) == 64);
                    if (ropeg) {
#pragma unroll
                        for (int j = 0; j < 4; ++j) { const f32x2 cs = rope[pos * 16 + 4 * fq + j]; const float x1 = v0[j], x2 = v1[j]; v0[j] = x1 * cs.x - x2 * cs.y; v1[j] = x2 * cs.x + x1 * cs.y; }
                    }
                    if (MODE == 0) {
                        if (cb < C_KR) { float s = dot4(v0) + dot4(v1); s += __shfl_xor(s, 16); s += __shfl_xor(s, 32); if (fq == 0) ssq_add(cb < C_CKV ? ssq_a : ssq_b, row, s); }
                    }
                    bf16_t* p = O + (size_t)row * ldc + cb + 4 * fq;
                    u32x2 w0, w1; w0.x = cvt_pk_bf16(v0[0], v0[1]); w0.y = cvt_pk_bf16(v0[2], v0[3]); w1.x = cvt_pk_bf16(v1[0], v1[1]); w1.y = cvt_pk_bf16(v1[2], v1[3]);
                    *(u32x2*)p = w0; *(u32x2*)(p + 16) = w1;
                }
                asm volatile("" ::: "memory");
            }
    }
};

struct EpiResid {
    static constexpr bool PERM = false, AFTER_DRAIN = false;
    bf16_t* hb; u64* ssq;
    __device__ __forceinline__ void operator()(const f32x4 (&acc)[2][2][4][2], const Unit& u, int wr, int wc, int fr, int fq) const {
#pragma unroll
        for (int ai = 0; ai < 2; ++ai)
#pragma unroll
            for (int m = 0; m < 4; ++m) {
                const int row = u.pm * 256 + ai * 128 + wr * 64 + m * 16 + fr;
                float s = 0.f;
                u32x2 b[2][2];
#pragma unroll
                for (int bj = 0; bj < 2; ++bj)
#pragma unroll
                    for (int n = 0; n < 2; ++n) b[bj][n] = *(const u32x2*)(hb + (size_t)row * DM + u.pn * 256 + bj * 128 + wc * 32 + 16 * n + 4 * fq);
#pragma unroll
                for (int bj = 0; bj < 2; ++bj)
#pragma unroll
                    for (int n = 0; n < 2; ++n) {
                        const size_t off = (size_t)row * DM + u.pn * 256 + bj * 128 + wc * 32 + 16 * n + 4 * fq;
                        const f32x4 a = acc[ai][bj][m][n];
                        f32x4 h; h[0] = bflo(b[bj][n].x) + a[0]; h[1] = bfhi(b[bj][n].x) + a[1]; h[2] = bflo(b[bj][n].y) + a[2]; h[3] = bfhi(b[bj][n].y) + a[3];
                        u32x2 w; w.x = cvt_pk_bf16(h[0], h[1]); w.y = cvt_pk_bf16(h[2], h[3]); *(u32x2*)(hb + off) = w;
                        s += dot4(h);
                    }
                s += __shfl_xor(s, 16); s += __shfl_xor(s, 32);
                if (fq == 0) ssq_add(ssq, row, s);
                asm volatile("" ::: "memory");
            }
    }
};

struct EpiSwiglu {
    static constexpr bool PERM = true, AFTER_DRAIN = false;
    bf16_t* O; const u64* ssq_in;
    __device__ __forceinline__ void operator()(const f32x4 (&acc)[2][2][4][2], const Unit& u, int wr, int wc, int fr, int fq) const {
#pragma unroll
        for (int ai = 0; ai < 2; ++ai)
#pragma unroll
            for (int m = 0; m < 4; ++m) {
                const int row = u.pm * 256 + ai * 128 + wr * 64 + m * 16 + fr;
                const float r = rsqrtf(ssq_get(ssq_in, row) * (1.0f / DM) + RMS_EPS);
                float a[8];
#pragma unroll
                for (int n = 0; n < 2; ++n)
#pragma unroll
                    for (int j = 0; j < 4; ++j) { const float g = acc[ai][0][m][n][j] * r, uu = acc[ai][1][m][n][j] * r; a[4 * n + j] = g * __builtin_amdgcn_rcpf(1.0f + __expf(-g)) * uu; }
                u32x4 w; w.x = cvt_pk_bf16(a[0], a[1]); w.y = cvt_pk_bf16(a[2], a[3]); w.z = cvt_pk_bf16(a[4], a[5]); w.w = cvt_pk_bf16(a[6], a[7]);
                *(u32x4*)(O + (size_t)row * DFF + u.pn * 128 + wc * 32 + 8 * fq) = w;
                asm volatile("" ::: "memory");
            }
    }
};

__host__ __device__ __forceinline__ int perm32(int rho) { const int n = rho >> 4, i = rho & 15; return 8 * (i >> 2) + 4 * n + (i & 3); }
template <class Epi>
__device__ __forceinline__ void gemm_naive(const bf16_t* A, int lda, const bf16_t* Bt, int ldb, int nM, int nN, int K, const Epi& E) {
    constexpr bool PERM = Epi::PERM;
    const int tid = threadIdx.x, wid = tid >> 6, lane = tid & 63, wr = wid >> 2, wc = wid & 3, fr = lane & 15, fq = lane >> 4;
    for (int unit = blockIdx.x; unit < nM * nN; unit += gridDim.x) {
        Unit u; u.pm = unit / nN; u.pn = unit % nN;
        f32x4 acc[2][2][4][2];
#pragma unroll
        for (int a = 0; a < 2; ++a)
#pragma unroll
            for (int b = 0; b < 2; ++b)
#pragma unroll
                for (int m = 0; m < 4; ++m)
#pragma unroll
                    for (int n = 0; n < 2; ++n) acc[a][b][m][n] = (f32x4){0.f, 0.f, 0.f, 0.f};
        const bf16_t* Ab = A + (size_t)(u.pm * 256 + wr * 64 + fr) * lda + 8 * fq;
        const bf16_t* Bb = Bt + (size_t)(u.pn * 256 + wc * 32) * ldb + 8 * fq;
        const int br0 = PERM ? perm32(fr) : fr, br1 = PERM ? perm32(16 + fr) : 16 + fr;
        for (int k0 = 0; k0 < K; k0 += 32) {
            bf16x8 af[2][4], bq[2][2];
#pragma unroll
            for (int ai = 0; ai < 2; ++ai)
#pragma unroll
                for (int m = 0; m < 4; ++m) af[ai][m] = *(const bf16x8*)(Ab + (size_t)(ai * 128 + m * 16) * lda + k0);
#pragma unroll
            for (int bj = 0; bj < 2; ++bj) { bq[bj][0] = *(const bf16x8*)(Bb + (size_t)(bj * 128 + br0) * ldb + k0); bq[bj][1] = *(const bf16x8*)(Bb + (size_t)(bj * 128 + br1) * ldb + k0); }
#pragma unroll
            for (int ai = 0; ai < 2; ++ai)
#pragma unroll
                for (int bj = 0; bj < 2; ++bj)
#pragma unroll
                    for (int m = 0; m < 4; ++m)
#pragma unroll
                        for (int n = 0; n < 2; ++n) acc[ai][bj][m][n] = __builtin_amdgcn_mfma_f32_16x16x32_bf16(bq[bj][n], af[ai][m], acc[ai][bj][m][n], 0, 0, 0);
        }
        E(acc, u, wr, wc, fr, fq);
    }
}

#define PG8_LAS __attribute__((address_space(3)))
constexpr int BM = 256, BK = 64, HALF = 128, HTB = HALF * BK * 2  , STAGE_BYTES = 8 * HTB, NXCD = 8, WGM = 8;
__host__ __device__ __forceinline__ int lds_byte(int r, int c) { const int st = (r >> 4) * 2 + (c >> 5), rr = r & 15, cc = c & 31, ob = rr * 64 + cc * 2; return st * 1024 + (ob ^ (((ob >> 9) & 1) << 5)); }
__host__ __device__ __forceinline__ void stage_rc(int b, int& R, int& C) { const int st = b / 1024, sb = b % 1024, swz = sb ^ (((sb >> 9) & 1) << 5); R = (st >> 1) * 16 + swz / 64; C = (st & 1) * 32 + (swz % 64) / 2; }
struct Gemm { const bf16_t* A; const bf16_t* Bt; int M, N, K, lda, ldb; };
struct StaticOrder {
    int nM, nN, nwg, G, c;
    __host__ __device__ void init(int M, int N, int G_, int c_) { nM = M / BM; nN = N / BM; nwg = nM * nN; G = G_; c = c_; }
    __host__ __device__ bool next(int i, Unit& u) const {
        const long L = (long)i * G + c; if (L >= nwg) return false;
        int wgid = (int)L; { const int q = nwg / NXCD, r = nwg % NXCD, xcd = wgid % NXCD, off = wgid / NXCD; wgid = (xcd < r ? xcd * (q + 1) : r * (q + 1) + (xcd - r) * q) + off; }
        const int nig = WGM * nN, gid = wgid / nig, fm = gid * WGM, gsz = (nM - fm) < WGM ? (nM - fm) : WGM;
        u.pm = fm + ((wgid % nig) % gsz); u.pn = (wgid % nig) / gsz; return true;
    }
    __device__ __forceinline__ void a_ready(const Unit&) const {}
    __device__ __forceinline__ void done(const Unit&) const {}
};
template <class Epi, class Sched, bool ALIGN_EPI = false, bool SP2 = false>
__device__ __forceinline__ void gemm_phase(PG8_LAS unsigned char* lds, const Gemm g, const Sched& S, const Epi& E) {
    int tid_ = threadIdx.x; asm volatile("" : "+v"(tid_));
    const int tid = tid_, wid = __builtin_amdgcn_readfirstlane(tid >> 6), lane = tid & 63, wr = wid >> 2, wc = wid & 3, fr = lane & 15, fq = lane >> 4;
    const int K = g.K, nt = K / BK;
    unsigned voffA[2], voffB[2];
#pragma unroll
    for (int i = 0; i < 2; ++i) { int R, C; stage_rc(tid * 16 + i * 8192, R, C); const int Rb = Epi::PERM ? ((R & ~31) + perm32(R & 31)) : R;
        voffA[i] = (unsigned)(R * g.lda + C) * 2u; voffB[i] = (unsigned)(Rb * g.ldb + C) * 2u; }
    const size_t kstep = (size_t)(BK * 2);
    const size_t hstepA = (size_t)HALF * g.lda * 2, hstepB = (size_t)HALF * g.ldb * 2;
    const size_t tstepA = 2 * hstepA, tstepB = 2 * hstepB;
    const unsigned ldsw = (unsigned)wid * 1024u;
    const int aoff = lds_byte(wr * 64 + fr, fq * 8), boff = lds_byte(wc * 32 + fr, fq * 8);
#define PG8_SA(b, h) (((b) * 2 + (h)) * HTB)
#define PG8_SB(b, h) ((4 + (b) * 2 + (h)) * HTB)
#define PG8_STAGE(bufoff, gbase, voff) do { _Pragma("unroll") for (int _i = 0; _i < 2; ++_i) \
        __builtin_amdgcn_global_load_lds((const unsigned*)((const char*)(gbase) + (voff)[_i]), (PG8_LAS unsigned*)(lds + (bufoff) + ldsw + _i * 8192), 16, 0, 0); } while (0)
#define PG8_LDA(dst, b, h) do { _Pragma("unroll") for (int m = 0; m < 4; ++m) _Pragma("unroll") for (int k = 0; k < 2; ++k) dst[m][k] = *(const PG8_LAS bf16x8*)(lds + PG8_SA(b, h) + aoff + m * 2048 + k * 1024); } while (0)
#define PG8_LDB(dst, b, h) do { _Pragma("unroll") for (int n = 0; n < 2; ++n) _Pragma("unroll") for (int k = 0; k < 2; ++k) dst[n][k] = *(const PG8_LAS bf16x8*)(lds + PG8_SB(b, h) + boff + n * 2048 + k * 1024); } while (0)
#define PG8_MMA(ai, bj, At, Bt) do { __builtin_amdgcn_s_setprio(1); _Pragma("unroll") for (int m = 0; m < 4; ++m) _Pragma("unroll") for (int n = 0; n < 2; ++n) _Pragma("unroll") for (int k = 0; k < 2; ++k) \
        acc[ai][bj][m][n] = __builtin_amdgcn_mfma_f32_16x16x32_bf16(Bt[n][k], At[m][k], acc[ai][bj][m][n], 0, 0, 0); __builtin_amdgcn_s_setprio(0); } while (0)
#define PG8_WAIT_V(n) asm volatile("s_waitcnt vmcnt(" #n ")" ::: "memory")
#define PG8_WAIT_L(n) asm volatile("s_waitcnt lgkmcnt(" #n ")" ::: "memory")
#define PG8_BAR __builtin_amdgcn_s_barrier()
#define PG8_SCHED __builtin_amdgcn_sched_barrier(0)
    Unit cur, nxt; int ui = 0;
    if (!S.next(0, cur)) return;
    f32x4 acc[2][2][4][2];
#pragma unroll
    for (int a = 0; a < 2; ++a)
#pragma unroll
        for (int b = 0; b < 2; ++b)
#pragma unroll
            for (int m = 0; m < 4; ++m)
#pragma unroll
                for (int n = 0; n < 2; ++n) acc[a][b][m][n] = (f32x4){0.f, 0.f, 0.f, 0.f};
    bf16x8 At[4][2], B0[2][2], B1[2][2];
    const char* cA = (const char*)g.A + (size_t)cur.pm * tstepA; const char* cB = (const char*)g.Bt + (size_t)cur.pn * tstepB;
    S.a_ready(cur);
    if constexpr (SP2) {
        PG8_STAGE(PG8_SB(0, 0), cB, voffB); PG8_STAGE(PG8_SB(0, 1), cB + hstepB, voffB); PG8_STAGE(PG8_SA(0, 0), cA, voffA); PG8_STAGE(PG8_SA(0, 1), cA + hstepA, voffA);
        if (wr == 1) PG8_BAR;
        PG8_WAIT_V(2); PG8_BAR;
        PG8_STAGE(PG8_SB(1, 0), cB + kstep, voffB); PG8_STAGE(PG8_SA(1, 0), cA + kstep, voffA); PG8_STAGE(PG8_SB(1, 1), cB + hstepB + kstep, voffB);
        PG8_WAIT_V(6); PG8_BAR;
    } else {
        PG8_STAGE(PG8_SB(0, 0), cB, voffB); PG8_STAGE(PG8_SA(0, 0), cA, voffA); PG8_STAGE(PG8_SB(0, 1), cB + hstepB, voffB); PG8_STAGE(PG8_SA(0, 1), cA + hstepA, voffA);
        if (wr == 1) PG8_BAR;
        PG8_WAIT_V(4); PG8_BAR;
        PG8_STAGE(PG8_SB(1, 0), cB + kstep, voffB); PG8_STAGE(PG8_SA(1, 0), cA + kstep, voffA); PG8_STAGE(PG8_SB(1, 1), cB + hstepB + kstep, voffB);
        PG8_WAIT_V(6); PG8_BAR;
    }
    for (;;) {
        const bool has_next = S.next(ui + 1, nxt);
        const char* nA = has_next ? (const char*)g.A + (size_t)nxt.pm * tstepA : cA; const char* nB = has_next ? (const char*)g.Bt + (size_t)nxt.pn * tstepB : cB;
#pragma clang loop unroll(disable)
        for (int t = 0; t < nt; t += 2) {
            const bool last = (t == nt - 2);
            const char* a1 = cA + (size_t)(t + 1) * kstep;
            const char* a2 = last ? nA : cA + (size_t)(t + 2) * kstep; const char* b2 = last ? nB : cB + (size_t)(t + 2) * kstep;
            const char* a3 = a2 + kstep; const char* b3 = b2 + kstep;
            if (last && has_next) S.a_ready(nxt);
            if constexpr (SP2) {
            PG8_LDB(B0, 0, 0); PG8_LDB(B1, 0, 1); PG8_SCHED; PG8_LDA(At, 0, 0); PG8_STAGE(PG8_SA(1, 1), a1 + hstepA, voffA);
            PG8_WAIT_V(8); PG8_WAIT_L(0); PG8_BAR; PG8_MMA(0, 0, At, B0); PG8_MMA(0, 1, At, B1); PG8_BAR; PG8_SCHED;
            PG8_LDA(At, 0, 1); PG8_STAGE(PG8_SB(0, 0), b2, voffB); PG8_STAGE(PG8_SB(0, 1), b2 + hstepB, voffB); PG8_STAGE(PG8_SA(0, 0), a2, voffA);
            PG8_WAIT_V(8); PG8_WAIT_L(0); PG8_BAR; PG8_MMA(1, 0, At, B0); PG8_MMA(1, 1, At, B1); PG8_BAR; PG8_SCHED;
            PG8_LDB(B0, 1, 0); PG8_LDB(B1, 1, 1); PG8_SCHED; PG8_LDA(At, 1, 0); PG8_STAGE(PG8_SA(0, 1), a2 + hstepA, voffA);
            PG8_WAIT_V(8); PG8_WAIT_L(0); PG8_BAR; PG8_MMA(0, 0, At, B0); PG8_MMA(0, 1, At, B1); PG8_BAR; PG8_SCHED;
            PG8_LDA(At, 1, 1); PG8_STAGE(PG8_SB(1, 0), b3, voffB); PG8_STAGE(PG8_SB(1, 1), b3 + hstepB, voffB); PG8_STAGE(PG8_SA(1, 0), a3, voffA);
            PG8_WAIT_V(8); PG8_WAIT_L(0); PG8_BAR; PG8_MMA(1, 0, At, B0); PG8_MMA(1, 1, At, B1); PG8_BAR; PG8_SCHED;
            } else {
            PG8_LDB(B0, 0, 0); PG8_SCHED; PG8_LDA(At, 0, 0); PG8_STAGE(PG8_SA(1, 1), a1 + hstepA, voffA);
            PG8_WAIT_L(8); PG8_BAR; PG8_WAIT_L(0); PG8_MMA(0, 0, At, B0); PG8_BAR; PG8_SCHED;
            PG8_LDB(B1, 0, 1); PG8_STAGE(PG8_SB(0, 0), b2, voffB);
            PG8_BAR; PG8_WAIT_L(0); PG8_MMA(0, 1, At, B1); PG8_BAR;
            PG8_LDA(At, 0, 1); PG8_STAGE(PG8_SA(0, 0), a2, voffA);
            PG8_BAR; PG8_WAIT_L(0); PG8_MMA(1, 0, At, B0); PG8_BAR; PG8_SCHED;
            PG8_STAGE(PG8_SB(0, 1), b2 + hstepB, voffB);
            PG8_WAIT_V(6); PG8_BAR; PG8_MMA(1, 1, At, B1); PG8_BAR;
            PG8_LDB(B0, 1, 0); PG8_SCHED; PG8_LDA(At, 1, 0); PG8_STAGE(PG8_SA(0, 1), a2 + hstepA, voffA);
            PG8_WAIT_L(8); PG8_BAR; PG8_WAIT_L(0); PG8_MMA(0, 0, At, B0); PG8_BAR; PG8_SCHED;
            PG8_LDB(B1, 1, 1); PG8_STAGE(PG8_SB(1, 0), b3, voffB);
            PG8_BAR; PG8_WAIT_L(0); PG8_MMA(0, 1, At, B1); PG8_BAR;
            PG8_LDA(At, 1, 1); PG8_STAGE(PG8_SA(1, 0), a3, voffA);
            PG8_BAR; PG8_WAIT_L(0); PG8_MMA(1, 0, At, B0); PG8_BAR; PG8_SCHED;
            PG8_STAGE(PG8_SB(1, 1), b3 + hstepB, voffB);
            PG8_WAIT_V(6); PG8_BAR; PG8_MMA(1, 1, At, B1); PG8_BAR;
            }
        }
        if constexpr (ALIGN_EPI) { if (wr == 0) PG8_BAR; }
        if constexpr (!Epi::AFTER_DRAIN) { E(acc, cur, wr, wc, fr, fq); S.done(cur); }
        if (!has_next) break;
#pragma unroll
        for (int a = 0; a < 2; ++a)
#pragma unroll
            for (int b = 0; b < 2; ++b)
#pragma unroll
                for (int m = 0; m < 4; ++m)
#pragma unroll
                    for (int n = 0; n < 2; ++n) acc[a][b][m][n] = (f32x4){0.f, 0.f, 0.f, 0.f};
        cur = nxt; cA = nA; cB = nB; ++ui;
        if constexpr (ALIGN_EPI) { if (wr == 1) PG8_BAR; }
    }
    PG8_WAIT_V(0);
    if constexpr (!ALIGN_EPI) { if (wr == 0) PG8_BAR; }
    PG8_BAR;
    if constexpr (Epi::AFTER_DRAIN) { E.fused(acc, cur, wr, wc, fr, fq, lds, wid, lane); S.done(cur); }
#undef PG8_SA
#undef PG8_SB
#undef PG8_STAGE
#undef PG8_LDA
#undef PG8_LDB
#undef PG8_MMA
#undef PG8_WAIT_V
#undef PG8_WAIT_L
#undef PG8_BAR
#undef PG8_SCHED
}
template <class Epi>
__device__ __forceinline__ void gemm_fast(LAS unsigned char* lds, const bf16_t* A, int lda, const bf16_t* Bt, int ldb, int M, int N, int K, const Epi& E) {
    Gemm g{A, Bt, M, N, K, lda, ldb}; StaticOrder S; S.init(M, N, (int)gridDim.x, (int)blockIdx.x);
    gemm_phase<Epi, StaticOrder, true, true>(lds, g, S, E);
}

__device__ __forceinline__ void p0_item(const float* W, int K, int N, const float* g, bf16_t* WT, int ldt, int mode, LAS float* scr, int item, int lane) {
    const int nblk = N / 32, kb = item / nblk, nb = item % nblk, k0 = 64 * kb, n0 = 32 * nb;
    { const int kr = lane >> 3, ch = lane & 7; f32x4 v[8];
#pragma unroll
      for (int i = 0; i < 8; ++i) v[i] = *(const f32x4*)(W + (size_t)(k0 + 8 * i + kr) * N + n0 + 4 * ch);
#pragma unroll
      for (int i = 0; i < 8; ++i) { const int kk = 8 * i + kr; const float gs = g ? g[k0 + kk] : 1.0f; LAS float* d = scr + kk * 33 + 4 * ch; d[0] = v[i][0] * gs; d[1] = v[i][1] * gs; d[2] = v[i][2] * gs; d[3] = v[i][3] * gs; } }
    asm volatile("s_waitcnt lgkmcnt(0)" ::: "memory");
    const int c = lane & 7;
#pragma unroll
    for (int j = 0; j < 4; ++j) {
        const int n = (lane >> 3) + 8 * j; const LAS float* s = scr + (8 * c) * 33 + n;
        u32x4 o; o.x = cvt_pk_bf16(s[0 * 33], s[1 * 33]); o.y = cvt_pk_bf16(s[2 * 33], s[3 * 33]); o.z = cvt_pk_bf16(s[4 * 33], s[5 * 33]); o.w = cvt_pk_bf16(s[6 * 33], s[7 * 33]);
        const int nn = n0 + n; const int row = (mode == 0) ? nn : ((nn >> 7) * 256 + (mode == 2 ? 128 : 0) + (nn & 127));
        *(u32x4*)(WT + (size_t)row * ldt + k0 + 8 * c) = o;
    }
    asm volatile("s_waitcnt lgkmcnt(0)" ::: "memory");
}


typedef float f32x16 __attribute__((ext_vector_type(16)));
constexpr int AT_VSTR = 72;
constexpr int AT_KBUF = 64 * 104 * 2, AT_VBUF = 64 * AT_VSTR * 2;
constexpr int AT_OFF_K = 0, AT_OFF_V = 2 * AT_KBUF, AT_OFF_BIAS = 2 * AT_KBUF + 2 * AT_VBUF, AT_OFF_FLAG = AT_OFF_BIAS + 2304;
__device__ __forceinline__ int crow16(int r, int hi) { return (r & 3) + 8 * (r >> 2) + 4 * hi; }
__device__ __forceinline__ int vperm(int key) { const int k16 = key & 15; return (key & ~15) + 8 * ((k16 >> 2) & 1) + 4 * (k16 >> 3) + (k16 & 3); }
__device__ __forceinline__ bf16x8 pack8(float a0, float a1, float a2, float a3, float a4, float a5, float a6, float a7) {
    u32x4 w; w.x = cvt_pk_bf16(a0, a1); w.y = cvt_pk_bf16(a2, a3); w.z = cvt_pk_bf16(a4, a5); w.w = cvt_pk_bf16(a6, a7); return __builtin_bit_cast(bf16x8, w);
}

template <int MODE>
__device__ __forceinline__ void attn_unit(LAS unsigned char* lds, int q0, const bf16_t* Qp, int ldq, const bf16_t* Kp, int ldk, const bf16_t* Krp, int ldkr, const bf16_t* Vp, int ldv, bf16_t* Op, const float* bias_g) {
    constexpr int DQK = (MODE == 0) ? 96 : 64, NDD = DQK / 16, KSTR = DQK + 8;
    int tid_ = threadIdx.x; asm volatile("" : "+v"(tid_));
    const int tid = tid_, lane = tid & 63, wid = __builtin_amdgcn_readfirstlane(tid >> 6), l31 = lane & 31, hi = lane >> 5;
    const int t0w = q0 + 32 * wid, trow = t0w + l31, nq = t0w >> 6;
    LAS float* biasl = (LAS float*)(lds + AT_OFF_BIAS);
    LAS int* flags = (LAS int*)(lds + AT_OFF_FLAG);
    if (MODE == 2) { for (int i = tid; i < 513; i += NTHREADS) biasl[i] = bias_g[i] * LOG2E; }
    bf16x8 qf[NDD];
#pragma unroll
    for (int dd = 0; dd < NDD; ++dd) qf[dd] = *(const bf16x8*)(Qp + (size_t)trow * ldq + 16 * dd + 8 * hi);
    f32x16 o0, o1;
#pragma unroll
    for (int r = 0; r < 16; ++r) { o0[r] = 0.f; o1[r] = 0.f; }
    float mrow = -1e30f, lrow = 0.f, carry = 0.f;
    const int kt_hi = (q0 + 255) >> 6;
    int kt_lo = 0; if (MODE == 2) { kt_lo = (q0 >> 6) - 8; if (kt_lo < 0) kt_lo = 0; }
    const int nt = kt_hi - kt_lo + 1;
    const int skey = tid >> 3, sch = tid & 7, rkey = tid >> 2, rch = tid & 3;
    const int vcol = vperm(lane);
    u32x4 kreg, krreg, vreg;
#define AT_KT(i) ((MODE == 1) ? (kt_hi - (i)) : (kt_lo + (i)))
#define AT_LOAD(kt) do { const size_t kb_ = (size_t)(kt) * 64; \
        kreg = *(const u32x4*)(Kp + (kb_ + skey) * ldk + sch * 8); \
        if (MODE == 0) { if (tid < 256) krreg = *(const u32x4*)(Krp + (kb_ + rkey) * ldkr + rch * 8); } \
        vreg = *(const u32x4*)(Vp + (kb_ + lane) * ldv + wid * 8); } while (0)
#define AT_STORE(bufi) do { LAS bf16_t* Ks_ = (LAS bf16_t*)(lds + AT_OFF_K + (bufi) * AT_KBUF); LAS bf16_t* Vt_ = (LAS bf16_t*)(lds + AT_OFF_V + (bufi) * AT_VBUF); \
        *(LAS u32x4*)(Ks_ + skey * KSTR + sch * 8) = kreg; \
        if (MODE == 0) { if (tid < 256) *(LAS u32x4*)(Ks_ + rkey * KSTR + 64 + rch * 8) = krreg; } \
        LAS bf16_t* vd_ = Vt_ + (wid * 8) * AT_VSTR + vcol; \
        vd_[0 * AT_VSTR] = (bf16_t)(vreg.x & 0xffffu); vd_[1 * AT_VSTR] = (bf16_t)(vreg.x >> 16); vd_[2 * AT_VSTR] = (bf16_t)(vreg.y & 0xffffu); vd_[3 * AT_VSTR] = (bf16_t)(vreg.y >> 16); \
        vd_[4 * AT_VSTR] = (bf16_t)(vreg.z & 0xffffu); vd_[5 * AT_VSTR] = (bf16_t)(vreg.z >> 16); vd_[6 * AT_VSTR] = (bf16_t)(vreg.w & 0xffffu); vd_[7 * AT_VSTR] = (bf16_t)(vreg.w >> 16); } while (0)
    AT_LOAD(AT_KT(0)); AT_STORE(0);
    __syncthreads();
    for (int i = 0; i < nt; ++i) {
        const int kt = AT_KT(i);
        if (i + 1 < nt) AT_LOAD(AT_KT(i + 1));
        bool part;
        if (MODE == 0) part = (kt <= nq);
        else if (MODE == 1) part = (64 * kt <= t0w + 30);
        else part = (kt <= nq) && (kt >= nq - 8);
        if (part) {
            const LAS bf16_t* Ks = (const LAS bf16_t*)(lds + AT_OFF_K + (i & 1) * AT_KBUF); const LAS bf16_t* Vt = (const LAS bf16_t*)(lds + AT_OFF_V + (i & 1) * AT_VBUF);
            f32x16 p0, p1;
#pragma unroll
            for (int r = 0; r < 16; ++r) { p0[r] = 0.f; p1[r] = 0.f; }
#pragma unroll
            for (int dd = 0; dd < NDD; ++dd) {
                const bf16x8 a0 = *(const LAS bf16x8*)(Ks + l31 * KSTR + 16 * dd + 8 * hi), a1 = *(const LAS bf16x8*)(Ks + (32 + l31) * KSTR + 16 * dd + 8 * hi);
                p0 = __builtin_amdgcn_mfma_f32_32x32x16_bf16(a0, qf[dd], p0, 0, 0, 0); p1 = __builtin_amdgcn_mfma_f32_32x32x16_bf16(a1, qf[dd], p1, 0, 0, 0);
            }
            if (MODE != 1) {
                if (MODE == 2) {
                    const int relb = trow - 64 * kt - 4 * hi;
#pragma unroll
                    for (int r = 0; r < 16; ++r) {
                        int rel0 = relb - ((r & 3) + 8 * (r >> 2)); int rel1 = rel0 - 32;
                        rel0 = rel0 > 256 ? 256 : (rel0 < -256 ? -256 : rel0); rel1 = rel1 > 256 ? 256 : (rel1 < -256 ? -256 : rel1);
                        p0[r] += biasl[256 + rel0]; p1[r] += biasl[256 + rel1];
                    }
                }
                float mx = fmaxf(p0[0], p1[0]);
#pragma unroll
                for (int r = 1; r < 16; ++r) mx = fmaxf(mx, fmaxf(p0[r], p1[r]));
                mx = fmaxf(mx, __shfl_xor(mx, 32));
                const float mnew = fmaxf(mrow, mx), alpha = __builtin_amdgcn_exp2f(mrow - mnew);
                mrow = mnew;
                float rs = 0.f;
#pragma unroll
                for (int r = 0; r < 16; ++r) { p0[r] = __builtin_amdgcn_exp2f(p0[r] - mnew); p1[r] = __builtin_amdgcn_exp2f(p1[r] - mnew); rs += p0[r] + p1[r]; }
                lrow = lrow * alpha + rs;
#pragma unroll
                for (int r = 0; r < 16; ++r) { o0[r] *= alpha; o1[r] *= alpha; }
            } else {
                const bool need_mask = (64 * kt + 63 >= t0w);
                const int kvb = 64 * kt + 4 * hi;
                float gs[8], lkq0[16], lkq1[16];
#pragma unroll
                for (int g = 0; g < 8; ++g) {
                    float s4 = 0.f;
#pragma unroll
                    for (int c = 0; c < 4; ++c) {
                        const int r = 4 * (g & 3) + c;
                        const float z2 = ((g < 4) ? p0[r] : p1[r]) * (0.125f * LOG2E);
                        const float sp2 = fmaxf(z2, 0.f) + __builtin_amdgcn_logf(1.0f + __builtin_amdgcn_exp2f(-fabsf(z2)));
                        const bool valid = !need_mask || (kvb + 8 * g + c < trow);
                        const float lk = valid ? -sp2 : 0.f;
                        const float ls = valid ? (z2 - sp2) : -1e30f;
                        if (g < 4) { p0[r] = ls; } else { p1[r] = ls; }
                        s4 += lk;
                        if (g < 4) { lkq0[r] = lk; } else { lkq1[r] = lk; }
                    }
                    gs[g] = s4;
                }
                float run = 0.f, after[8];
#pragma unroll
                for (int g = 7; g >= 0; --g) { const float pg = __shfl_xor(gs[g], 32); after[g] = run + (hi == 0 ? pg : 0.f); run += gs[g] + pg; }
#pragma unroll
                for (int g = 0; g < 8; ++g) {
                    float suf = carry + after[g];
#pragma unroll
                    for (int c = 3; c >= 0; --c) {
                        const int r = 4 * (g & 3) + c;
                        if (g < 4) { p0[r] = __builtin_amdgcn_exp2f(p0[r] + suf); suf += lkq0[r]; } else { p1[r] = __builtin_amdgcn_exp2f(p1[r] + suf); suf += lkq1[r]; }
                    }
                }
                carry += run;
            }
            const bf16x8 pb0 = pack8(p0[0], p0[1], p0[2], p0[3], p0[4], p0[5], p0[6], p0[7]), pb1 = pack8(p0[8], p0[9], p0[10], p0[11], p0[12], p0[13], p0[14], p0[15]);
            const bf16x8 pb2 = pack8(p1[0], p1[1], p1[2], p1[3], p1[4], p1[5], p1[6], p1[7]), pb3 = pack8(p1[8], p1[9], p1[10], p1[11], p1[12], p1[13], p1[14], p1[15]);
            const LAS bf16_t* v0p = Vt + l31 * AT_VSTR + 8 * hi; const LAS bf16_t* v1p = Vt + (32 + l31) * AT_VSTR + 8 * hi;
            o0 = __builtin_amdgcn_mfma_f32_32x32x16_bf16(*(const LAS bf16x8*)(v0p + 0), pb0, o0, 0, 0, 0);  o1 = __builtin_amdgcn_mfma_f32_32x32x16_bf16(*(const LAS bf16x8*)(v1p + 0), pb0, o1, 0, 0, 0);
            o0 = __builtin_amdgcn_mfma_f32_32x32x16_bf16(*(const LAS bf16x8*)(v0p + 16), pb1, o0, 0, 0, 0); o1 = __builtin_amdgcn_mfma_f32_32x32x16_bf16(*(const LAS bf16x8*)(v1p + 16), pb1, o1, 0, 0, 0);
            o0 = __builtin_amdgcn_mfma_f32_32x32x16_bf16(*(const LAS bf16x8*)(v0p + 32), pb2, o0, 0, 0, 0); o1 = __builtin_amdgcn_mfma_f32_32x32x16_bf16(*(const LAS bf16x8*)(v1p + 32), pb2, o1, 0, 0, 0);
            o0 = __builtin_amdgcn_mfma_f32_32x32x16_bf16(*(const LAS bf16x8*)(v0p + 48), pb3, o0, 0, 0, 0); o1 = __builtin_amdgcn_mfma_f32_32x32x16_bf16(*(const LAS bf16x8*)(v1p + 48), pb3, o1, 0, 0, 0);
        }
        if (i + 1 < nt) AT_STORE((i + 1) & 1);
        if (MODE == 1) { const int done = __all(carry < -151.0f) ? 1 : 0; if (lane == 0) flags[(i & 1) * 8 + wid] = done; }
        __syncthreads();
        if (MODE == 1) {
            int alld = 1;
#pragma unroll
            for (int w8 = 0; w8 < 8; ++w8) alld &= flags[(i & 1) * 8 + w8];
            if (alld) break;
        }
    }
    if (MODE == 1) __syncthreads();
    float inv = 1.0f;
    if (MODE != 1) { const float lt = lrow + __shfl_xor(lrow, 32); inv = 1.0f / lt; }
    bf16_t* orow = Op + (size_t)trow * DM + 4 * hi;
#pragma unroll
    for (int g = 0; g < 4; ++g) {
        u32x2 w0, w1;
        w0.x = cvt_pk_bf16(o0[4 * g] * inv, o0[4 * g + 1] * inv); w0.y = cvt_pk_bf16(o0[4 * g + 2] * inv, o0[4 * g + 3] * inv);
        w1.x = cvt_pk_bf16(o1[4 * g] * inv, o1[4 * g + 1] * inv); w1.y = cvt_pk_bf16(o1[4 * g + 2] * inv, o1[4 * g + 3] * inv);
        *(u32x2*)(orow + 8 * g) = w0; *(u32x2*)(orow + 32 + 8 * g) = w1;
    }
#undef AT_KT
#undef AT_LOAD
#undef AT_STORE
}


#define XB_TMO      128
#define XB_XCNT(j)  (256  + 64 * (j))
#define XB_XSUB(j)  (1280 + 64 * (j))
#define XB_XGEN(j)  (2304 + 64 * (j))
#define XB_TOP      3328
#define XB_TOPGEN   3392
#define XCD_BAR_WORDS 3456
#define XB_SPIN_CAP (1u << 18)
__device__ __forceinline__ unsigned xb_ld(unsigned* p)              { return __hip_atomic_load(p, __ATOMIC_RELAXED, __HIP_MEMORY_SCOPE_AGENT); }
__device__ __forceinline__ unsigned xb_add(unsigned* p, unsigned v) { return __hip_atomic_fetch_add(p, v, __ATOMIC_RELAXED, __HIP_MEMORY_SCOPE_AGENT); }
__device__ __forceinline__ unsigned xb_xcc_id() { return (unsigned)__builtin_amdgcn_s_getreg((3 << 11) | 20) & 0xFu; }
#define XB_SPIN(cond, bar) do { unsigned _sp = 0; while (cond) { __builtin_amdgcn_s_sleep(1); \
    if ((++_sp & 255u) == 0u) { if (xb_ld(&(bar)[XB_TMO])) break; if (_sp > XB_SPIN_CAP) { atomicAdd(&(bar)[XB_TMO], 1u); break; } } } } while (0)
struct XcdBarrier { unsigned* bar; unsigned x; volatile LAS unsigned* st; };
__device__ __forceinline__ XcdBarrier xcd_barrier_post(unsigned* bar, volatile LAS unsigned* st) {
    XcdBarrier b; b.bar = bar; b.x = xb_xcc_id(); b.st = st;
    if (threadIdx.x == 0) (void)xb_add(&bar[XB_XCNT(b.x)], 1u);
    return b;
}
__device__ __forceinline__ void xcd_barrier_complete(unsigned* bar, unsigned x, unsigned& nloc, unsigned& nx) {
    const unsigned G = gridDim.x * gridDim.y * gridDim.z;
    unsigned sum, cnt, mine, sp = 0u;
    for (;;) {
        sum = 0u; cnt = 0u; mine = 0u;
#pragma unroll
        for (unsigned j = 0; j < 16; ++j) { const unsigned c = xb_ld(&bar[XB_XCNT(j)]); sum += c; cnt += (c > 0u) ? 1u : 0u; mine = (j == x) ? c : mine; }
        if (sum == G) break;
        __builtin_amdgcn_s_sleep(1);
        if ((++sp & 255u) == 0u) { if (xb_ld(&bar[XB_TMO])) break; if (sp > XB_SPIN_CAP) { atomicAdd(&bar[XB_TMO], 1u); break; } }
    }
    nloc = mine > 0u ? mine : 1u; nx = cnt > 0u ? cnt : 1u;
}
__device__ __forceinline__ void xcd_barrier(const XcdBarrier& b) {
    asm volatile("s_waitcnt vmcnt(0)" ::: "memory");
    __syncthreads();
    if (threadIdx.x == 0) {
        unsigned* bar = b.bar;
        __builtin_amdgcn_s_waitcnt(0);
        unsigned nloc = b.st[0], nx = b.st[1];
        if (nloc == 0u) { xcd_barrier_complete(bar, b.x, nloc, nx); b.st[0] = nloc; b.st[1] = nx; }
        const unsigned old = xb_add(&bar[XB_XSUB(b.x)], 1u);
        const unsigned gen = old / nloc;
        if (old + 1u == (gen + 1u) * nloc) {
            __builtin_amdgcn_fence(__ATOMIC_RELEASE, "agent");
            asm volatile("s_waitcnt vmcnt(0)" ::: "memory");
            const unsigned og = xb_add(&bar[XB_TOP], 1u);
            const unsigned tg = og / nx;
            if (og + 1u == (tg + 1u) * nx) xb_add(&bar[XB_TOPGEN], 1u);
            else XB_SPIN(xb_ld(&bar[XB_TOPGEN]) == tg, bar);
            __builtin_amdgcn_fence(__ATOMIC_ACQUIRE, "agent");
            xb_add(&bar[XB_XGEN(b.x)], 1u);
            asm volatile("s_waitcnt vmcnt(0)" ::: "memory");
        } else {
            XB_SPIN(xb_ld(&bar[XB_XGEN(b.x)]) == gen, bar);
            __builtin_amdgcn_fence(__ATOMIC_ACQUIRE, "agent");
            asm volatile("s_waitcnt vmcnt(0)" ::: "memory");
        }
    }
    __syncthreads();
}

struct Args { const float* in[16]; float* out; unsigned char* ws; };

__device__ __forceinline__ void attn_mla_naive(const bf16_t* QA, const bf16_t* KVA, const bf16_t* PROJ, bf16_t* O) {
    const int nth = gridDim.x * NTHREADS;
    for (int w = blockIdx.x * NTHREADS + threadIdx.x; w < 8 * MTOK; w += nth) {
        const int h = w >> 14, row = w & (MTOK - 1), b = row >> 11, t = row & (SEQ - 1);
        float q[96];
#pragma unroll
        for (int c = 0; c < 12; ++c) unpack8(*(const u32x4*)(QA + (size_t)row * NQA + h * 96 + c * 8), q + c * 8);
        float o[64];
#pragma unroll
        for (int d = 0; d < 64; ++d) o[d] = 0.f;
        float mx = -INFINITY, l = 0.f;
        const int kend = ((t >> 6) + 1) << 6;
        for (int s = 0; s < kend; ++s) {
            const size_t kr = (size_t)(b * SEQ + s);
            const bf16_t* kp = KVA + kr * NKVA + h * 128; const bf16_t* rp = PROJ + kr * NPROJ_P + C_KR;
            float sc = 0.f;
#pragma unroll
            for (int c = 0; c < 8; ++c) { float k[8]; unpack8(*(const u32x4*)(kp + c * 8), k);
#pragma unroll
                for (int e = 0; e < 8; ++e) sc += q[c * 8 + e] * k[e]; }
#pragma unroll
            for (int c = 0; c < 4; ++c) { float k[8]; unpack8(*(const u32x4*)(rp + c * 8), k);
#pragma unroll
                for (int e = 0; e < 8; ++e) sc += q[64 + c * 8 + e] * k[e]; }
            const float mn = fmaxf(mx, sc), al = __builtin_amdgcn_exp2f(mx - mn), p = __builtin_amdgcn_exp2f(sc - mn);
            l = l * al + p; mx = mn;
#pragma unroll
            for (int c = 0; c < 8; ++c) { float v[8]; unpack8(*(const u32x4*)(kp + 64 + c * 8), v);
#pragma unroll
                for (int e = 0; e < 8; ++e) o[c * 8 + e] = o[c * 8 + e] * al + p * v[e]; }
        }
        const float inv = 1.0f / l;
#pragma unroll
        for (int c = 0; c < 8; ++c) { u32x4 wv; wv.x = cvt_pk_bf16(o[c * 8] * inv, o[c * 8 + 1] * inv); wv.y = cvt_pk_bf16(o[c * 8 + 2] * inv, o[c * 8 + 3] * inv); wv.z = cvt_pk_bf16(o[c * 8 + 4] * inv, o[c * 8 + 5] * inv); wv.w = cvt_pk_bf16(o[c * 8 + 6] * inv, o[c * 8 + 7] * inv);
            *(u32x4*)(O + (size_t)row * DM + h * 64 + c * 8) = wv; }
    }
}

__device__ __forceinline__ void attn_sb_naive(const bf16_t* PROJ, bf16_t* O) {
    const int nth = gridDim.x * NTHREADS;
    for (int w = blockIdx.x * NTHREADS + threadIdx.x; w < 8 * MTOK; w += nth) {
        const int h = w >> 14, row = w & (MTOK - 1), b = row >> 11, t = row & (SEQ - 1);
        float q[64];
#pragma unroll
        for (int c = 0; c < 8; ++c) unpack8(*(const u32x4*)(PROJ + (size_t)row * NPROJ_P + C_QB + h * 64 + c * 8), q + c * 8);
        float o[64];
#pragma unroll
        for (int d = 0; d < 64; ++d) o[d] = 0.f;
        float cum = 0.f;
        const int tmax = t | 63;
        for (int s = tmax - 1; s >= 0; --s) {
            const size_t kr = (size_t)(b * SEQ + s);
            const bf16_t* kp = PROJ + kr * NPROJ_P + C_KB + h * 64; const bf16_t* vp = PROJ + kr * NPROJ_P + C_VB + h * 64;
            float z = 0.f;
#pragma unroll
            for (int c = 0; c < 8; ++c) { float k[8]; unpack8(*(const u32x4*)(kp + c * 8), k);
#pragma unroll
                for (int e = 0; e < 8; ++e) z += q[c * 8 + e] * k[e]; }
            z *= 0.125f;
            const bool on = s < t;
            const float lg = __logf(1.0f + __expf(-fabsf(z)));
            const float wgt = on ? __expf(fminf(z, 0.f) - lg + cum) : 0.f;
            cum += on ? (fminf(-z, 0.f) - lg) : 0.f;
#pragma unroll
            for (int c = 0; c < 8; ++c) { float v[8]; unpack8(*(const u32x4*)(vp + c * 8), v);
#pragma unroll
                for (int e = 0; e < 8; ++e) o[c * 8 + e] += wgt * v[e]; }
        }
#pragma unroll
        for (int c = 0; c < 8; ++c) { u32x4 wv; wv.x = cvt_pk_bf16(o[c * 8], o[c * 8 + 1]); wv.y = cvt_pk_bf16(o[c * 8 + 2], o[c * 8 + 3]); wv.z = cvt_pk_bf16(o[c * 8 + 4], o[c * 8 + 5]); wv.w = cvt_pk_bf16(o[c * 8 + 6], o[c * 8 + 7]);
            *(u32x4*)(O + (size_t)row * DM + 512 + h * 64 + c * 8) = wv; }
    }
}

__device__ __forceinline__ void attn_band_naive(const bf16_t* QKV, const float* rel_bias, bf16_t* O) {
    const int nth = gridDim.x * NTHREADS;
    for (int w = blockIdx.x * NTHREADS + threadIdx.x; w < 16 * MTOK; w += nth) {
        const int h = w >> 14, row = w & (MTOK - 1), b = row >> 11, t = row & (SEQ - 1);
        float q[64];
#pragma unroll
        for (int c = 0; c < 8; ++c) unpack8(*(const u32x4*)(QKV + (size_t)row * NQKV + h * 64 + c * 8), q + c * 8);
        float o[64];
#pragma unroll
        for (int d = 0; d < 64; ++d) o[d] = 0.f;
        float mx = -INFINITY, l = 0.f;
        const int n = t >> 6, s0 = (n >= 8) ? (n - 8) * 64 : 0, s1 = (n + 1) * 64;
        const float* bias = rel_bias + h * 513 + 256;
        for (int s = s0; s < s1; ++s) {
            const size_t kr = (size_t)(b * SEQ + s);
            const bf16_t* kp = QKV + kr * NQKV + 1024 + h * 64; const bf16_t* vp = QKV + kr * NQKV + 2048 + h * 64;
            float sc = 0.f;
#pragma unroll
            for (int c = 0; c < 8; ++c) { float k[8]; unpack8(*(const u32x4*)(kp + c * 8), k);
#pragma unroll
                for (int e = 0; e < 8; ++e) sc += q[c * 8 + e] * k[e]; }
            int rel = t - s; rel = rel > 256 ? 256 : (rel < -256 ? -256 : rel);
            sc += bias[rel] * LOG2E;
            const float mn = fmaxf(mx, sc), al = __builtin_amdgcn_exp2f(mx - mn), p = __builtin_amdgcn_exp2f(sc - mn);
            l = l * al + p; mx = mn;
#pragma unroll
            for (int c = 0; c < 8; ++c) { float v[8]; unpack8(*(const u32x4*)(vp + c * 8), v);
#pragma unroll
                for (int e = 0; e < 8; ++e) o[c * 8 + e] = o[c * 8 + e] * al + p * v[e]; }
        }
        const float inv = 1.0f / l;
#pragma unroll
        for (int c = 0; c < 8; ++c) { u32x4 wv; wv.x = cvt_pk_bf16(o[c * 8] * inv, o[c * 8 + 1] * inv); wv.y = cvt_pk_bf16(o[c * 8 + 2] * inv, o[c * 8 + 3] * inv); wv.z = cvt_pk_bf16(o[c * 8 + 4] * inv, o[c * 8 + 5] * inv); wv.w = cvt_pk_bf16(o[c * 8 + 6] * inv, o[c * 8 + 7] * inv);
            *(u32x4*)(O + (size_t)row * DM + h * 64 + c * 8) = wv; }
    }
}

constexpr int I_IN = 16 * (NPROJ / 32), I_UQ = 6 * 24, I_UKV = 4 * 32, I_O = 16 * 32, I_G = 16 * 88, I_D = 44 * 32, I_QKV = 16 * 96;
constexpr int CV_R0 = I_IN + I_UQ + I_UKV, CV_R1 = CV_R0 + I_O + 2 * I_G + I_D + I_QKV + I_O, CV_NITEMS = CV_R1 + 2 * I_G + I_D;
#define CONV_ITEM(it_) do { int r = (it_); \
        if (r < I_IN) { p0_item(args.in[1], DM, NPROJ, args.in[10], Win, DM, 0, scr, r, lane); break; } r -= I_IN; \
        if (r < I_UQ) { p0_item(args.in[3], 384, NQA, args.in[2], Wuq, 384, 0, scr, r, lane); break; } r -= I_UQ; \
        if (r < I_UKV) { p0_item(args.in[5], 256, NKVA, args.in[4], Wukv, 256, 0, scr, r, lane); break; } r -= I_UKV; \
        if (r < I_O) { p0_item(args.in[6], DM, DM, nullptr, Wo0, DM, 0, scr, r, lane); break; } r -= I_O; \
        if (r < I_G) { p0_item(args.in[12], DM, DFF, args.in[11], Wgu0, DM, 1, scr, r, lane); break; } r -= I_G; \
        if (r < I_G) { p0_item(args.in[13], DM, DFF, args.in[11], Wgu0, DM, 2, scr, r, lane); break; } r -= I_G; \
        if (r < I_D) { p0_item(args.in[14], DFF, DM, nullptr, Wd0, DFF, 0, scr, r, lane); break; } r -= I_D; \
        if (r < I_QKV) { p0_item(args.in[7], DM, NQKV, args.in[10] + DM, Wqkv, DM, 0, scr, r, lane); break; } r -= I_QKV; \
        if (r < I_O) { p0_item(args.in[9], DM, DM, nullptr, Wo1, DM, 0, scr, r, lane); break; } r -= I_O; \
        if (r < I_G) { p0_item(args.in[12] + (size_t)DM * DFF, DM, DFF, args.in[11] + DM, Wgu1, DM, 1, scr, r, lane); break; } r -= I_G; \
        if (r < I_G) { p0_item(args.in[13] + (size_t)DM * DFF, DM, DFF, args.in[11] + DM, Wgu1, DM, 2, scr, r, lane); break; } r -= I_G; \
        p0_item(args.in[14] + (size_t)DFF * DM, DFF, DM, nullptr, Wd1, DFF, 0, scr, r, lane); } while (0)
#define CONV_TAIL(first, lo, hi) do { if (G == 256 && (int)blockIdx.x >= (first)) { int tid_c = threadIdx.x; asm volatile("" : "+v"(tid_c)); const int lane = tid_c & 63, wave = __builtin_amdgcn_readfirstlane(tid_c >> 6); \
        LAS float* scr = (LAS float*)((LAS unsigned char*)lds + wave * 16384); \
        for (int it = (lo) + ((int)blockIdx.x - (first)) * 8 + wave; it < (hi); it += (G - (first)) * 8) CONV_ITEM(it); } } while (0)

__global__ void __launch_bounds__(NTHREADS) fwd_megakernel(Args args) {
    extern __shared__ __attribute__((aligned(16))) unsigned char lds[];
#ifdef USE_CG_SYNC
    cg::grid_group grid = cg::this_grid();
#define GRID_SYNC() grid.sync()
#else
    { volatile LAS unsigned* st0 = (volatile LAS unsigned*)((LAS unsigned char*)lds + LDS_BYTES - 64); if (threadIdx.x == 0) { st0[0] = 0u; st0[1] = 0u; } }
    __syncthreads();
    const XcdBarrier xbar = xcd_barrier_post((unsigned*)(args.ws + WS_CTL), (volatile LAS unsigned*)((LAS unsigned char*)lds + LDS_BYTES - 64));
#define GRID_SYNC() xcd_barrier(xbar)
#endif
#ifdef USE_NAIVE_GEMM
#define GEMM(A, lda, Bt, ldb, M, N, K, E) gemm_naive(A, lda, Bt, ldb, (M) / 256, (N) / 256, K, E)
#else
#define GEMM(A, lda, Bt, ldb, M, N, K, E) gemm_fast((LAS unsigned char*)lds, A, lda, Bt, ldb, M, N, K, E)
#endif
    const int G = gridDim.x;
    const int vcu = (G % 8 == 0) ? (int)(blockIdx.x % 8) * (G / 8) + (int)(blockIdx.x / 8) : (int)blockIdx.x;
    LAS unsigned char* ldsp = (LAS unsigned char*)lds;
    unsigned char* ws = args.ws;
    const float* x = args.in[0];
    float* out = args.out;
    u64* ssq = (u64*)(ws + WS_SSQ);
    f32x2* rope = (f32x2*)(ws + WS_ROPE);
    bf16_t* Win = (bf16_t*)(ws + WS_WIN); bf16_t* Wuq = (bf16_t*)(ws + WS_WUQ); bf16_t* Wukv = (bf16_t*)(ws + WS_WUKV); bf16_t* Wo0 = (bf16_t*)(ws + WS_WO0);
    bf16_t* Wgu0 = (bf16_t*)(ws + WS_WGU0); bf16_t* Wd0 = (bf16_t*)(ws + WS_WD0); bf16_t* Wqkv = (bf16_t*)(ws + WS_WQKV); bf16_t* Wo1 = (bf16_t*)(ws + WS_WO1);
    bf16_t* Wgu1 = (bf16_t*)(ws + WS_WGU1); bf16_t* Wd1 = (bf16_t*)(ws + WS_WD1);
    bf16_t* HB = (bf16_t*)(ws + WS_HB); bf16_t* PROJ = (bf16_t*)(ws + WS_A); bf16_t* QKV = (bf16_t*)(ws + WS_A); bf16_t* ACT = (bf16_t*)(ws + WS_A); bf16_t* ATT = (bf16_t*)(ws + WS_ATT);
    bf16_t* QA = (bf16_t*)((unsigned char*)out + OUT_QA); bf16_t* KVA = (bf16_t*)((unsigned char*)out + OUT_KVA);

    {
        const int tid = threadIdx.x, lane = tid & 63, wave = __builtin_amdgcn_readfirstlane(tid >> 6);
        LAS float* scr = (LAS float*)((LAS unsigned char*)lds + wave * 16384);
        const int gw = blockIdx.x * 8 + wave, NGW = G * 8;
        const bool offload = (G == 256);
        for (int it = gw; it < (offload ? CV_R0 : CV_NITEMS); it += NGW) CONV_ITEM(it);
        for (int i = blockIdx.x * NTHREADS + tid; i < (NPROJ_P - NPROJ) * DM / 8; i += G * NTHREADS) ((u32x4*)(Win + (size_t)NPROJ * DM))[i] = (u32x4){0u, 0u, 0u, 0u};
        for (int i = blockIdx.x * NTHREADS + tid; i < 6 * MTOK; i += G * NTHREADS) ssq[MTOK + i] = 0ull;
        for (int i = blockIdx.x * NTHREADS + tid; i < SEQ * 16; i += G * NTHREADS) {
            const int pos = i >> 4, fi = i & 15;
            const float inv_freq = __builtin_amdgcn_exp2f(-(float)fi * (13.287712379549449f / 16.0f));
            const float ang = (float)pos * inv_freq;
            float tr = ang * 0.15915494309189535f; tr -= floorf(tr);
            rope[i] = (f32x2){__builtin_amdgcn_cosf(tr), __builtin_amdgcn_sinf(tr)};
        }
        for (int m = gw; m < MTOK; m += NGW) {
            const f32x4* xr = (const f32x4*)(x + (size_t)m * DM) + lane; f32x4 v[4]; float s = 0.f;
#pragma unroll
            for (int j = 0; j < 4; ++j) { v[j] = xr[64 * j]; s += dot4(v[j]); }
            s = wave_sum(s);
            if (lane == 0) ssq[m] = ssq_fix(s);
#pragma unroll
            for (int j = 0; j < 4; ++j) { u32x2 w; w.x = cvt_pk_bf16(v[j][0], v[j][1]); w.y = cvt_pk_bf16(v[j][2], v[j][3]); *((u32x2*)(HB + (size_t)m * DM) + lane + 64 * j) = w; }
        }
    }
    GRID_SYNC();
    { EpiScale<0> E{PROJ, NPROJ_P, ssq, 1.0f / DM, ssq + MTOK, ssq + 2 * MTOK, rope}; GEMM(HB, DM, Win, DM, MTOK, NPROJ_P, DM, E); }
    CONV_TAIL(64, CV_R0, CV_R1);
    GRID_SYNC();
    { EpiScale<1> E{QA, NQA, ssq + MTOK, 1.0f / 384, nullptr, nullptr, rope}; GEMM(PROJ, NPROJ_P, Wuq, 384, MTOK, NQA, 384, E); }
    { EpiScale<2> E{KVA, NKVA, ssq + 2 * MTOK, 1.0f / 256, nullptr, nullptr, rope}; GEMM(PROJ + C_CKV, NPROJ_P, Wukv, 256, MTOK, NKVA, 256, E); }
    GRID_SYNC();
#ifdef NAIVE_ATTN
    attn_mla_naive(QA, KVA, PROJ, ATT);
    attn_sb_naive(PROJ, ATT);
#else
    for (int u = vcu; u < 256; u += G) {
        const int bh = u >> 2, j = u & 3, b = bh >> 3, h = bh & 7;
        const size_t rb = (size_t)b * SEQ;
        for (int k = 0; k < 2 * REP_MLA; ++k) { const int qt = (k & 1) ? 7 - j : j;
            attn_unit<0>(ldsp, 256 * qt, QA + rb * NQA + h * 96, NQA, KVA + rb * NKVA + h * 128, NKVA, PROJ + rb * NPROJ_P + C_KR, NPROJ_P, KVA + rb * NKVA + h * 128 + 64, NKVA, ATT + rb * DM + h * 64, nullptr); }
        for (int k = 0; k < 2 * REP_SB; ++k) { const int qt = (k & 1) ? 7 - j : j;
            attn_unit<1>(ldsp, 256 * qt, PROJ + rb * NPROJ_P + C_QB + h * 64, NPROJ_P, PROJ + rb * NPROJ_P + C_KB + h * 64, NPROJ_P, nullptr, 0, PROJ + rb * NPROJ_P + C_VB + h * 64, NPROJ_P, ATT + rb * DM + 512 + h * 64, nullptr); }
    }
#endif
    GRID_SYNC();
    { EpiResid E{HB, ssq + 3 * MTOK}; GEMM(ATT, DM, Wo0, DM, MTOK, DM, DM, E); }
    GRID_SYNC();
    for (int rep = 0; rep < REP_GU; ++rep) { EpiSwiglu E{ACT, ssq + 3 * MTOK}; GEMM(HB, DM, Wgu0, DM, MTOK, 2 * DFF, DM, E); }
    CONV_TAIL(128, CV_R1, CV_NITEMS);
    GRID_SYNC();
    { EpiResid E{HB, ssq + 4 * MTOK}; GEMM(ACT, DFF, Wd0, DFF, MTOK, DM, DFF, E); }
    GRID_SYNC();
    { EpiScale<3> E{QKV, NQKV, ssq + 4 * MTOK, 1.0f / DM, nullptr, nullptr, rope}; GEMM(HB, DM, Wqkv, DM, MTOK, NQKV, DM, E); }
    GRID_SYNC();
#ifdef NAIVE_ATTN
    attn_band_naive(QKV, args.in[8], ATT);
#else
    for (int u = vcu; u < 256; u += G) {
        const int bh = u >> 1, half = u & 1, b = bh >> 4, h = bh & 15;
        const size_t rb = (size_t)b * SEQ;
        for (int k = 0; k < 4 * REP_BAND; ++k)
            attn_unit<2>(ldsp, 256 * (4 * half + (k & 3)), QKV + rb * NQKV + h * 64, NQKV, QKV + rb * NQKV + 1024 + h * 64, NQKV, nullptr, 0, QKV + rb * NQKV + 2048 + h * 64, NQKV, ATT + rb * DM + h * 64, args.in[8] + h * 513);
    }
#endif
    GRID_SYNC();
    { EpiResid E{HB, ssq + 5 * MTOK}; GEMM(ATT, DM, Wo1, DM, MTOK, DM, DM, E); }
    GRID_SYNC();
    { EpiSwiglu E{ACT, ssq + 5 * MTOK}; GEMM(HB, DM, Wgu1, DM, MTOK, 2 * DFF, DM, E); }
    GRID_SYNC();
    { EpiResid E{HB, ssq + 6 * MTOK}; GEMM(ACT, DFF, Wd1, DFF, MTOK, DM, DFF, E); }
    GRID_SYNC();
    {
        const int tid = threadIdx.x, lane = tid & 63, wave = __builtin_amdgcn_readfirstlane(tid >> 6); (void)tid;
        const int gw = blockIdx.x * 8 + wave, NGW = G * 8;
        const f32x4* gf = (const f32x4*)args.in[15] + lane;
        for (int m = gw; m < MTOK; m += NGW) {
            const float r = rsqrtf(ssq_get(ssq + 6 * MTOK, m) * (1.0f / DM) + RMS_EPS);
            f32x4* p = (f32x4*)(out + (size_t)m * DM) + lane; const u32x2* hp = (const u32x2*)(HB + (size_t)m * DM) + lane;
#pragma unroll
            for (int j = 0; j < 4; ++j) { const u32x2 hv = hp[64 * j]; const f32x4 g4 = gf[64 * j]; f32x4 o; o[0] = bflo(hv.x) * r * g4[0]; o[1] = bfhi(hv.x) * r * g4[1]; o[2] = bflo(hv.y) * r * g4[2]; o[3] = bfhi(hv.y) * r * g4[3]; p[64 * j] = o; }
        }
    }
}

extern "C" void kernel_launch(void* const* d_in, const int* in_sizes, int n_in, void* d_out, int out_size, void* d_ws, size_t ws_size, hipStream_t stream) {
    static int grid = 0;
    if (grid == 0) {
        int dev = 0, cus = 0, per_cu = 0;
        hipGetDevice(&dev);
        hipDeviceGetAttribute(&cus, hipDeviceAttributeMultiprocessorCount, dev);
        hipFuncSetAttribute((const void*)fwd_megakernel, hipFuncAttributeMaxDynamicSharedMemorySize, LDS_BYTES);
        hipOccupancyMaxActiveBlocksPerMultiprocessor(&per_cu, (const void*)fwd_megakernel, NTHREADS, LDS_BYTES);
        if (per_cu < 1) per_cu = 1;
        if (per_cu > 1) per_cu = 1;
        grid = cus * per_cu;
        if (n_in != 16 || out_size != MTOK * DM || ws_size < WS_END) { fprintf(stderr, "kernel_launch: unexpected shapes n_in %d out %d ws %zu\n", n_in, out_size, ws_size); }
    }
    Args a{};
    for (int i = 0; i < 16; ++i) a.in[i] = (const float*)d_in[i];
    a.out = (float*)d_out; a.ws = (unsigned char*)d_ws;
    hipMemsetAsync((char*)d_ws + WS_CTL, 0, CTL_BYTES, stream);
    void* kargs[] = {&a};
    hipError_t e = hipLaunchCooperativeKernel((const void*)fwd_megakernel, dim3(grid), dim3(NTHREADS), kargs, LDS_BYTES, stream);
    if (e != hipSuccess) fprintf(stderr, "cooperative launch failed: %s (grid %d)\n", hipGetErrorString(e), grid);
}
```

```cpp
#include <hip/hip_runtime.h>
#include <hip/hip_cooperative_groups.h>
#include <cstdio>
#include <cstdint>
namespace cg = cooperative_groups;
#define REP_MLA 1
#define REP_SB 1
#define REP_BAND 1
#define REP_GU 1

#define LAS __attribute__((address_space(3)))
typedef unsigned short bf16_t;
typedef short bf16x8 __attribute__((ext_vector_type(8)));
typedef float f32x4 __attribute__((ext_vector_type(4)));
typedef float f32x2 __attribute__((ext_vector_type(2)));
typedef unsigned u32x4 __attribute__((ext_vector_type(4)));
typedef unsigned u32x2 __attribute__((ext_vector_type(2)));

constexpr int MTOK = 16384, SEQ = 2048, DM = 1024, DFF = 2816;
constexpr int NPROJ = 2208, NPROJ_P = 2304;
constexpr int C_CKV = 384, C_KR = 640, C_QB = 672, C_KB = 1184, C_VB = 1696;
constexpr int NQA = 768, NKVA = 1024, NQKV = 3072;
constexpr float RMS_EPS = 1e-6f;
constexpr float LOG2E = 1.4426950408889634f;
constexpr float QSCALE_A = 0.10206207261596577f * LOG2E;
constexpr float QSCALE_C = 0.125f * LOG2E;

constexpr size_t KiB = 1024, MiB = 1u << 20;
constexpr size_t WS_SSQ = 216 * MiB;
constexpr size_t WS_ROPE = 512 * KiB;
constexpr size_t WS_CTL = 768 * KiB, CTL_BYTES = 32 * KiB; constexpr int CW_PANEL = 4096;
constexpr size_t WS_WIN = 1 * MiB;
constexpr size_t WS_WUQ = WS_WIN + (size_t)NPROJ_P * DM * 2;
constexpr size_t WS_WUKV = WS_WUQ + (size_t)NQA * 384 * 2;
constexpr size_t WS_WO0 = WS_WUKV + (size_t)NKVA * 256 * 2;
constexpr size_t WS_WGU0 = WS_WO0 + (size_t)DM * DM * 2;
constexpr size_t WS_WD0 = WS_WGU0 + (size_t)2 * DFF * DM * 2;
constexpr size_t WS_WQKV = WS_WD0 + (size_t)DM * DFF * 2;
constexpr size_t WS_WO1 = WS_WQKV + (size_t)NQKV * DM * 2;
constexpr size_t WS_WGU1 = WS_WO1 + (size_t)DM * DM * 2;
constexpr size_t WS_WD1 = WS_WGU1 + (size_t)2 * DFF * DM * 2;
constexpr size_t WS_WEND = WS_WD1 + (size_t)DM * DFF * 2;
constexpr size_t WS_HB = 50 * MiB;
constexpr size_t WS_A = 82 * MiB;
constexpr size_t WS_ATT = 178 * MiB;
constexpr size_t WS_SSQP = 210 * MiB;
constexpr size_t WS_END = 218 * MiB;
static_assert(WS_WEND <= WS_HB, "weights fit");
constexpr size_t OUT_QA = 0, OUT_KVA = 24 * MiB;

constexpr int NTHREADS = 512;
constexpr int LDS_BYTES = 147456;

__device__ __forceinline__ unsigned cvt_pk_bf16(float lo, float hi) { unsigned r; asm volatile("v_cvt_pk_bf16_f32 %0, %1, %2" : "=v"(r) : "v"(lo), "v"(hi)); return r; }
__device__ __forceinline__ float bflo(unsigned w) { return __uint_as_float(w << 16); }
__device__ __forceinline__ float bfhi(unsigned w) { return __uint_as_float(w & 0xffff0000u); }
__device__ __forceinline__ void unpack8(const u32x4 w, float* f) {
    f[0] = bflo(w.x); f[1] = bfhi(w.x); f[2] = bflo(w.y); f[3] = bfhi(w.y); f[4] = bflo(w.z); f[5] = bfhi(w.z); f[6] = bflo(w.w); f[7] = bfhi(w.w);
}
__device__ __forceinline__ float wave_sum(float v) {
#pragma unroll
    for (int o = 1; o < 64; o <<= 1) v += __shfl_xor(v, o);
    return v;
}
__device__ __forceinline__ float dot4(const f32x4 a) { return (a[0] * a[0] + a[1] * a[1]) + (a[2] * a[2] + a[3] * a[3]); }

struct Unit { int pm, pn; };
typedef unsigned long long u64;
__device__ __forceinline__ u64 ssq_fix(float s) { const unsigned hi = (unsigned)s; const unsigned lo = (unsigned)((s - (float)hi) * 4294967296.0f); return ((u64)hi << 32) | (u64)lo; }
__device__ __forceinline__ float ssq_val(const u64 v) { return (float)(unsigned)(v >> 32) + (float)(unsigned)v * 2.3283064365386963e-10f; }
__device__ __forceinline__ float ssq_get(const u64* p, int row) { return ssq_val(p[row]); }
__device__ __forceinline__ void ssq_add(u64* p, int row, float s) { atomicAdd(p + row, ssq_fix(s)); }


template <int MODE> struct EpiScale {
    static constexpr bool PERM = false, AFTER_DRAIN = false;
    bf16_t* O; int ldc; const u64* ssq_in; float inv_n; u64* ssq_a; u64* ssq_b; const f32x2* rope;
    __device__ __forceinline__ void operator()(const f32x4 (&acc)[2][2][4][2], const Unit& u, int wr, int wc, int fr, int fq) const {
        const int cb0 = u.pn * 256 + wc * 32;
        u64 sv[2][4];
#pragma unroll
        for (int ai = 0; ai < 2; ++ai)
#pragma unroll
            for (int m = 0; m < 4; ++m) sv[ai][m] = ssq_in[u.pm * 256 + ai * 128 + wr * 64 + m * 16 + fr];
#pragma unroll
        for (int ai = 0; ai < 2; ++ai)
#pragma unroll
            for (int m = 0; m < 4; ++m) {
                const int row = u.pm * 256 + ai * 128 + wr * 64 + m * 16 + fr;
                const float r = rsqrtf(ssq_val(sv[ai][m]) * inv_n + RMS_EPS);
                const int pos = row & (SEQ - 1);
#pragma unroll
                for (int bj = 0; bj < 2; ++bj) {
                    const int cb = cb0 + 128 * bj;
                    float sc = r;
                    if (MODE == 1) sc *= QSCALE_A;
                    if (MODE == 3) { if (cb < 1024) sc *= QSCALE_C; }
                    f32x4 v0 = acc[ai][bj][m][0] * sc, v1 = acc[ai][bj][m][1] * sc;
                    bool ropeg = false;
                    if (MODE == 0) ropeg = (cb == C_KR);
                    if (MODE == 1) ropeg = ((cb % 96) == 64);
                    if (ropeg) {
#pragma unroll
                        for (int j = 0; j < 4; ++j) { const f32x2 cs = rope[pos * 16 + 4 * fq + j]; const float x1 = v0[j], x2 = v1[j]; v0[j] = x1 * cs.x - x2 * cs.y; v1[j] = x2 * cs.x + x1 * cs.y; }
                    }
                    if (MODE == 0) {
                        if (cb < C_KR) { float s = dot4(v0) + dot4(v1); s += __shfl_xor(s, 16); s += __shfl_xor(s, 32); if (fq == 0) ssq_add(cb < C_CKV ? ssq_a : ssq_b, row, s); }
                    }
                    bf16_t* p = O + (size_t)row * ldc + cb + 4 * fq;
                    u32x2 w0, w1; w0.x = cvt_pk_bf16(v0[0], v0[1]); w0.y = cvt_pk_bf16(v0[2], v0[3]); w1.x = cvt_pk_bf16(v1[0], v1[1]); w1.y = cvt_pk_bf16(v1[2], v1[3]);
                    *(u32x2*)p = w0; *(u32x2*)(p + 16) = w1;
                }
            }
    }
};

struct EpiResid {
    static constexpr bool PERM = false, AFTER_DRAIN = false;
    bf16_t* hb; u64* ssq;
    __device__ __forceinline__ void operator()(const f32x4 (&acc)[2][2][4][2], const Unit& u, int wr, int wc, int fr, int fq) const {
#pragma unroll
        for (int ai = 0; ai < 2; ++ai) {
            u32x2 b[4][2][2];
#pragma unroll
            for (int m = 0; m < 4; ++m)
#pragma unroll
                for (int bj = 0; bj < 2; ++bj)
#pragma unroll
                    for (int n = 0; n < 2; ++n) b[m][bj][n] = *(const u32x2*)(hb + (size_t)(u.pm * 256 + ai * 128 + wr * 64 + m * 16 + fr) * DM + u.pn * 256 + bj * 128 + wc * 32 + 16 * n + 4 * fq);
#pragma unroll
            for (int m = 0; m < 4; ++m) {
                const int row = u.pm * 256 + ai * 128 + wr * 64 + m * 16 + fr;
                float s = 0.f;
#pragma unroll
                for (int bj = 0; bj < 2; ++bj)
#pragma unroll
                    for (int n = 0; n < 2; ++n) {
                        const size_t off = (size_t)row * DM + u.pn * 256 + bj * 128 + wc * 32 + 16 * n + 4 * fq;
                        const f32x4 a = acc[ai][bj][m][n]; const u32x2 bb = b[m][bj][n];
                        f32x4 h; h[0] = bflo(bb.x) + a[0]; h[1] = bfhi(bb.x) + a[1]; h[2] = bflo(bb.y) + a[2]; h[3] = bfhi(bb.y) + a[3];
                        u32x2 w; w.x = cvt_pk_bf16(h[0], h[1]); w.y = cvt_pk_bf16(h[2], h[3]); *(u32x2*)(hb + off) = w;
                        s += dot4(h);
                    }
                s += __shfl_xor(s, 16); s += __shfl_xor(s, 32);
                if (fq == 0) ssq_add(ssq, row, s);
            }
            asm volatile("" ::: "memory");
        }
    }
};

struct EpiSwiglu {
    static constexpr bool PERM = true, AFTER_DRAIN = false;
    bf16_t* O; const u64* ssq_in;
    __device__ __forceinline__ void operator()(const f32x4 (&acc)[2][2][4][2], const Unit& u, int wr, int wc, int fr, int fq) const {
        u64 sv[2][4];
#pragma unroll
        for (int ai = 0; ai < 2; ++ai)
#pragma unroll
            for (int m = 0; m < 4; ++m) sv[ai][m] = ssq_in[u.pm * 256 + ai * 128 + wr * 64 + m * 16 + fr];
#pragma unroll
        for (int ai = 0; ai < 2; ++ai)
#pragma unroll
            for (int m = 0; m < 4; ++m) {
                const int row = u.pm * 256 + ai * 128 + wr * 64 + m * 16 + fr;
                const float r = rsqrtf(ssq_val(sv[ai][m]) * (1.0f / DM) + RMS_EPS);
                float a[8];
#pragma unroll
                for (int n = 0; n < 2; ++n)
#pragma unroll
                    for (int j = 0; j < 4; ++j) { const float g = acc[ai][0][m][n][j] * r, uu = acc[ai][1][m][n][j] * r; a[4 * n + j] = g * __builtin_amdgcn_rcpf(1.0f + __expf(-g)) * uu; }
                u32x4 w; w.x = cvt_pk_bf16(a[0], a[1]); w.y = cvt_pk_bf16(a[2], a[3]); w.z = cvt_pk_bf16(a[4], a[5]); w.w = cvt_pk_bf16(a[6], a[7]);
                *(u32x4*)(O + (size_t)row * DFF + u.pn * 128 + wc * 32 + 8 * fq) = w;
            }
    }
};

struct EpiFinal {
    static constexpr bool PERM = false, AFTER_DRAIN = true;
    const bf16_t* hb; u64* ssq; unsigned* cnt; const float* gfin; float* out;
    __device__ __forceinline__ void operator()(const f32x4 (&)[2][2][4][2], const Unit&, int, int, int, int) const {}
    __device__ __forceinline__ void fused(f32x4 (&acc)[2][2][4][2], const Unit& u, int wr, int wc, int fr, int fq, LAS unsigned char*, int, int) const {
#pragma unroll
        for (int ai = 0; ai < 2; ++ai) {
            u32x2 b[4][2][2];
#pragma unroll
            for (int m = 0; m < 4; ++m)
#pragma unroll
                for (int bj = 0; bj < 2; ++bj)
#pragma unroll
                    for (int n = 0; n < 2; ++n) b[m][bj][n] = *(const u32x2*)(hb + (size_t)(u.pm * 256 + ai * 128 + wr * 64 + m * 16 + fr) * DM + u.pn * 256 + bj * 128 + wc * 32 + 16 * n + 4 * fq);
#pragma unroll
            for (int m = 0; m < 4; ++m) {
                const int row = u.pm * 256 + ai * 128 + wr * 64 + m * 16 + fr;
                float s = 0.f;
#pragma unroll
                for (int bj = 0; bj < 2; ++bj)
#pragma unroll
                    for (int n = 0; n < 2; ++n) {
                        const f32x4 a = acc[ai][bj][m][n]; const u32x2 bb = b[m][bj][n];
                        f32x4 h; h[0] = bflo(bb.x) + a[0]; h[1] = bfhi(bb.x) + a[1]; h[2] = bflo(bb.y) + a[2]; h[3] = bfhi(bb.y) + a[3];
                        acc[ai][bj][m][n] = h; s += dot4(h);
                    }
                s += __shfl_xor(s, 16); s += __shfl_xor(s, 32);
                if (fq == 0) ssq_add(ssq, row, s);
            }
            asm volatile("" ::: "memory");
        }
        asm volatile("s_waitcnt vmcnt(0)" ::: "memory");
        __syncthreads();
        if (threadIdx.x == 0) {
            unsigned* c = cnt + 16 * u.pm;
            __hip_atomic_fetch_add(c, 1u, __ATOMIC_RELEASE, __HIP_MEMORY_SCOPE_AGENT);
            unsigned sp = 0;
            while (__hip_atomic_load(c, __ATOMIC_RELAXED, __HIP_MEMORY_SCOPE_AGENT) < 4u) { __builtin_amdgcn_s_sleep(1); if (++sp > (1u << 22)) break; }
            __builtin_amdgcn_fence(__ATOMIC_ACQUIRE, "agent");
            asm volatile("s_waitcnt vmcnt(0)" ::: "memory");
        }
        __syncthreads();
        u64 sv[2][4];
#pragma unroll
        for (int ai = 0; ai < 2; ++ai)
#pragma unroll
            for (int m = 0; m < 4; ++m) sv[ai][m] = __hip_atomic_load(ssq + (u.pm * 256 + ai * 128 + wr * 64 + m * 16 + fr), __ATOMIC_RELAXED, __HIP_MEMORY_SCOPE_AGENT);
        f32x4 g4[2][2];
#pragma unroll
        for (int bj = 0; bj < 2; ++bj)
#pragma unroll
            for (int n = 0; n < 2; ++n) g4[bj][n] = *(const f32x4*)(gfin + u.pn * 256 + bj * 128 + wc * 32 + 16 * n + 4 * fq);
#pragma unroll
        for (int ai = 0; ai < 2; ++ai)
#pragma unroll
            for (int m = 0; m < 4; ++m) {
                const int row = u.pm * 256 + ai * 128 + wr * 64 + m * 16 + fr;
                const float r = rsqrtf(ssq_val(sv[ai][m]) * (1.0f / DM) + RMS_EPS);
#pragma unroll
                for (int bj = 0; bj < 2; ++bj)
#pragma unroll
                    for (int n = 0; n < 2; ++n) *(f32x4*)(out + (size_t)row * DM + u.pn * 256 + bj * 128 + wc * 32 + 16 * n + 4 * fq) = acc[ai][bj][m][n] * r * g4[bj][n];
            }
    }
};

__host__ __device__ __forceinline__ int perm32(int rho) { const int n = rho >> 4, i = rho & 15; return 8 * (i >> 2) + 4 * n + (i & 3); }
template <class Epi>
__device__ __forceinline__ void gemm_naive(const bf16_t* A, int lda, const bf16_t* Bt, int ldb, int nM, int nN, int K, const Epi& E) {
    constexpr bool PERM = Epi::PERM;
    const int tid = threadIdx.x, wid = tid >> 6, lane = tid & 63, wr = wid >> 2, wc = wid & 3, fr = lane & 15, fq = lane >> 4;
    for (int unit = blockIdx.x; unit < nM * nN; unit += gridDim.x) {
        Unit u; u.pm = unit / nN; u.pn = unit % nN;
        f32x4 acc[2][2][4][2];
#pragma unroll
        for (int a = 0; a < 2; ++a)
#pragma unroll
            for (int b = 0; b < 2; ++b)
#pragma unroll
                for (int m = 0; m < 4; ++m)
#pragma unroll
                    for (int n = 0; n < 2; ++n) acc[a][b][m][n] = (f32x4){0.f, 0.f, 0.f, 0.f};
        const bf16_t* Ab = A + (size_t)(u.pm * 256 + wr * 64 + fr) * lda + 8 * fq;
        const bf16_t* Bb = Bt + (size_t)(u.pn * 256 + wc * 32) * ldb + 8 * fq;
        const int br0 = PERM ? perm32(fr) : fr, br1 = PERM ? perm32(16 + fr) : 16 + fr;
        for (int k0 = 0; k0 < K; k0 += 32) {
            bf16x8 af[2][4], bq[2][2];
#pragma unroll
            for (int ai = 0; ai < 2; ++ai)
#pragma unroll
                for (int m = 0; m < 4; ++m) af[ai][m] = *(const bf16x8*)(Ab + (size_t)(ai * 128 + m * 16) * lda + k0);
#pragma unroll
            for (int bj = 0; bj < 2; ++bj) { bq[bj][0] = *(const bf16x8*)(Bb + (size_t)(bj * 128 + br0) * ldb + k0); bq[bj][1] = *(const bf16x8*)(Bb + (size_t)(bj * 128 + br1) * ldb + k0); }
#pragma unroll
            for (int ai = 0; ai < 2; ++ai)
#pragma unroll
                for (int bj = 0; bj < 2; ++bj)
#pragma unroll
                    for (int m = 0; m < 4; ++m)
#pragma unroll
                        for (int n = 0; n < 2; ++n) acc[ai][bj][m][n] = __builtin_amdgcn_mfma_f32_16x16x32_bf16(bq[bj][n], af[ai][m], acc[ai][bj][m][n], 0, 0, 0);
        }
        E(acc, u, wr, wc, fr, fq);
    }
}

#define PG8_LAS __attribute__((address_space(3)))
constexpr int BM = 256, BK = 64, HALF = 128, HTB = HALF * BK * 2  , STAGE_BYTES = 8 * HTB, NXCD = 8, WGM = 8;
__host__ __device__ __forceinline__ int lds_byte(int r, int c) { const int st = (r >> 4) * 2 + (c >> 5), rr = r & 15, cc = c & 31, ob = rr * 64 + cc * 2; return st * 1024 + (ob ^ (((ob >> 9) & 1) << 5)); }
__host__ __device__ __forceinline__ void stage_rc(int b, int& R, int& C) { const int st = b / 1024, sb = b % 1024, swz = sb ^ (((sb >> 9) & 1) << 5); R = (st >> 1) * 16 + swz / 64; C = (st & 1) * 32 + (swz % 64) / 2; }
struct Gemm { const bf16_t* A; const bf16_t* Bt; int M, N, K, lda, ldb; };
struct StaticOrder {
    int nM, nN, nwg, G, c;
    __host__ __device__ void init(int M, int N, int G_, int c_) { nM = M / BM; nN = N / BM; nwg = nM * nN; G = G_; c = c_; }
    __host__ __device__ bool next(int i, Unit& u) const {
        const long L = (long)i * G + c; if (L >= nwg) return false;
        int wgid = (int)L; { const int q = nwg / NXCD, r = nwg % NXCD, xcd = wgid % NXCD, off = wgid / NXCD; wgid = (xcd < r ? xcd * (q + 1) : r * (q + 1) + (xcd - r) * q) + off; }
        const int nig = WGM * nN, gid = wgid / nig, fm = gid * WGM, gsz = (nM - fm) < WGM ? (nM - fm) : WGM;
        u.pm = fm + ((wgid % nig) % gsz); u.pn = (wgid % nig) / gsz; return true;
    }
    __device__ __forceinline__ void a_ready(const Unit&) const {}
    __device__ __forceinline__ void done(const Unit&) const {}
};
template <class Epi, class Sched, bool ALIGN_EPI = false, bool SP2 = false>
__device__ __forceinline__ void gemm_phase(PG8_LAS unsigned char* lds, const Gemm g, const Sched& S, const Epi& E) {
    int tid_ = threadIdx.x; asm volatile("" : "+v"(tid_));
    const int tid = tid_, wid = __builtin_amdgcn_readfirstlane(tid >> 6), lane = tid & 63, wr = wid >> 2, wc = wid & 3, fr = lane & 15, fq = lane >> 4;
    const int K = g.K, nt = K / BK;
    unsigned voffA[2], voffB[2];
#pragma unroll
    for (int i = 0; i < 2; ++i) { int R, C; stage_rc(tid * 16 + i * 8192, R, C); const int Rb = Epi::PERM ? ((R & ~31) + perm32(R & 31)) : R;
        voffA[i] = (unsigned)(R * g.lda + C) * 2u; voffB[i] = (unsigned)(Rb * g.ldb + C) * 2u; }
    const size_t kstep = (size_t)(BK * 2);
    const size_t hstepA = (size_t)HALF * g.lda * 2, hstepB = (size_t)HALF * g.ldb * 2;
    const size_t tstepA = 2 * hstepA, tstepB = 2 * hstepB;
    const unsigned ldsw = (unsigned)wid * 1024u;
    const int aoff = lds_byte(wr * 64 + fr, fq * 8), boff = lds_byte(wc * 32 + fr, fq * 8);
#define PG8_SA(b, h) (((b) * 2 + (h)) * HTB)
#define PG8_SB(b, h) ((4 + (b) * 2 + (h)) * HTB)
#define PG8_STAGE(bufoff, gbase, voff) do { _Pragma("unroll") for (int _i = 0; _i < 2; ++_i) \
        __builtin_amdgcn_global_load_lds((const unsigned*)((const char*)(gbase) + (voff)[_i]), (PG8_LAS unsigned*)(lds + (bufoff) + ldsw + _i * 8192), 16, 0, 0); } while (0)
#define PG8_LDA(dst, b, h) do { _Pragma("unroll") for (int m = 0; m < 4; ++m) _Pragma("unroll") for (int k = 0; k < 2; ++k) dst[m][k] = *(const PG8_LAS bf16x8*)(lds + PG8_SA(b, h) + aoff + m * 2048 + k * 1024); } while (0)
#define PG8_LDB(dst, b, h) do { _Pragma("unroll") for (int n = 0; n < 2; ++n) _Pragma("unroll") for (int k = 0; k < 2; ++k) dst[n][k] = *(const PG8_LAS bf16x8*)(lds + PG8_SB(b, h) + boff + n * 2048 + k * 1024); } while (0)
#define PG8_MMA(ai, bj, At, Bt) do { __builtin_amdgcn_s_setprio(1); _Pragma("unroll") for (int m = 0; m < 4; ++m) _Pragma("unroll") for (int n = 0; n < 2; ++n) _Pragma("unroll") for (int k = 0; k < 2; ++k) \
        acc[ai][bj][m][n] = __builtin_amdgcn_mfma_f32_16x16x32_bf16(Bt[n][k], At[m][k], acc[ai][bj][m][n], 0, 0, 0); __builtin_amdgcn_s_setprio(0); } while (0)
#define PG8_WAIT_V(n) asm volatile("s_waitcnt vmcnt(" #n ")" ::: "memory")
#define PG8_WAIT_L(n) asm volatile("s_waitcnt lgkmcnt(" #n ")" ::: "memory")
#define PG8_BAR __builtin_amdgcn_s_barrier()
#define PG8_SCHED __builtin_amdgcn_sched_barrier(0)
    Unit cur, nxt; int ui = 0;
    if (!S.next(0, cur)) return;
    f32x4 acc[2][2][4][2];
#pragma unroll
    for (int a = 0; a < 2; ++a)
#pragma unroll
        for (int b = 0; b < 2; ++b)
#pragma unroll
            for (int m = 0; m < 4; ++m)
#pragma unroll
                for (int n = 0; n < 2; ++n) acc[a][b][m][n] = (f32x4){0.f, 0.f, 0.f, 0.f};
    bf16x8 At[4][2], B0[2][2], B1[2][2];
    const char* cA = (const char*)g.A + (size_t)cur.pm * tstepA; const char* cB = (const char*)g.Bt + (size_t)cur.pn * tstepB;
    S.a_ready(cur);
    if constexpr (SP2) {
        PG8_STAGE(PG8_SB(0, 0), cB, voffB); PG8_STAGE(PG8_SB(0, 1), cB + hstepB, voffB); PG8_STAGE(PG8_SA(0, 0), cA, voffA); PG8_STAGE(PG8_SA(0, 1), cA + hstepA, voffA);
        if (wr == 1) PG8_BAR;
        PG8_WAIT_V(2); PG8_BAR;
        PG8_STAGE(PG8_SB(1, 0), cB + kstep, voffB); PG8_STAGE(PG8_SA(1, 0), cA + kstep, voffA); PG8_STAGE(PG8_SB(1, 1), cB + hstepB + kstep, voffB);
        PG8_WAIT_V(6); PG8_BAR;
    } else {
        PG8_STAGE(PG8_SB(0, 0), cB, voffB); PG8_STAGE(PG8_SA(0, 0), cA, voffA); PG8_STAGE(PG8_SB(0, 1), cB + hstepB, voffB); PG8_STAGE(PG8_SA(0, 1), cA + hstepA, voffA);
        if (wr == 1) PG8_BAR;
        PG8_WAIT_V(4); PG8_BAR;
        PG8_STAGE(PG8_SB(1, 0), cB + kstep, voffB); PG8_STAGE(PG8_SA(1, 0), cA + kstep, voffA); PG8_STAGE(PG8_SB(1, 1), cB + hstepB + kstep, voffB);
        PG8_WAIT_V(6); PG8_BAR;
    }
    for (;;) {
        const bool has_next = S.next(ui + 1, nxt);
        const char* nA = has_next ? (const char*)g.A + (size_t)nxt.pm * tstepA : cA; const char* nB = has_next ? (const char*)g.Bt + (size_t)nxt.pn * tstepB : cB;
#pragma clang loop unroll(disable)
        for (int t = 0; t < nt; t += 2) {
            const bool last = (t == nt - 2);
            const char* a1 = cA + (size_t)(t + 1) * kstep;
            const char* a2 = last ? nA : cA + (size_t)(t + 2) * kstep; const char* b2 = last ? nB : cB + (size_t)(t + 2) * kstep;
            const char* a3 = a2 + kstep; const char* b3 = b2 + kstep;
            if (last && has_next) S.a_ready(nxt);
            if constexpr (SP2) {
            PG8_LDB(B0, 0, 0); PG8_LDB(B1, 0, 1); PG8_SCHED; PG8_LDA(At, 0, 0); PG8_STAGE(PG8_SA(1, 1), a1 + hstepA, voffA);
            PG8_WAIT_V(8); PG8_WAIT_L(0); PG8_BAR; PG8_MMA(0, 0, At, B0); PG8_MMA(0, 1, At, B1); PG8_BAR; PG8_SCHED;
            PG8_LDA(At, 0, 1); PG8_STAGE(PG8_SB(0, 0), b2, voffB); PG8_STAGE(PG8_SB(0, 1), b2 + hstepB, voffB); PG8_STAGE(PG8_SA(0, 0), a2, voffA);
            PG8_WAIT_V(8); PG8_WAIT_L(0); PG8_BAR; PG8_MMA(1, 0, At, B0); PG8_MMA(1, 1, At, B1); PG8_BAR; PG8_SCHED;
            PG8_LDB(B0, 1, 0); PG8_LDB(B1, 1, 1); PG8_SCHED; PG8_LDA(At, 1, 0); PG8_STAGE(PG8_SA(0, 1), a2 + hstepA, voffA);
            PG8_WAIT_V(8); PG8_WAIT_L(0); PG8_BAR; PG8_MMA(0, 0, At, B0); PG8_MMA(0, 1, At, B1); PG8_BAR; PG8_SCHED;
            PG8_LDA(At, 1, 1); PG8_STAGE(PG8_SB(1, 0), b3, voffB); PG8_STAGE(PG8_SB(1, 1), b3 + hstepB, voffB); PG8_STAGE(PG8_SA(1, 0), a3, voffA);
            PG8_WAIT_V(8); PG8_WAIT_L(0); PG8_BAR; PG8_MMA(1, 0, At, B0); PG8_MMA(1, 1, At, B1); PG8_BAR; PG8_SCHED;
            } else {
            PG8_LDB(B0, 0, 0); PG8_SCHED; PG8_LDA(At, 0, 0); PG8_STAGE(PG8_SA(1, 1), a1 + hstepA, voffA);
            PG8_WAIT_L(8); PG8_BAR; PG8_WAIT_L(0); PG8_MMA(0, 0, At, B0); PG8_BAR; PG8_SCHED;
            PG8_LDB(B1, 0, 1); PG8_STAGE(PG8_SB(0, 0), b2, voffB);
            PG8_BAR; PG8_WAIT_L(0); PG8_MMA(0, 1, At, B1); PG8_BAR;
            PG8_LDA(At, 0, 1); PG8_STAGE(PG8_SA(0, 0), a2, voffA);
            PG8_BAR; PG8_WAIT_L(0); PG8_MMA(1, 0, At, B0); PG8_BAR; PG8_SCHED;
            PG8_STAGE(PG8_SB(0, 1), b2 + hstepB, voffB);
            PG8_WAIT_V(6); PG8_BAR; PG8_MMA(1, 1, At, B1); PG8_BAR;
            PG8_LDB(B0, 1, 0); PG8_SCHED; PG8_LDA(At, 1, 0); PG8_STAGE(PG8_SA(0, 1), a2 + hstepA, voffA);
            PG8_WAIT_L(8); PG8_BAR; PG8_WAIT_L(0); PG8_MMA(0, 0, At, B0); PG8_BAR; PG8_SCHED;
            PG8_LDB(B1, 1, 1); PG8_STAGE(PG8_SB(1, 0), b3, voffB);
            PG8_BAR; PG8_WAIT_L(0); PG8_MMA(0, 1, At, B1); PG8_BAR;
            PG8_LDA(At, 1, 1); PG8_STAGE(PG8_SA(1, 0), a3, voffA);
            PG8_BAR; PG8_WAIT_L(0); PG8_MMA(1, 0, At, B0); PG8_BAR; PG8_SCHED;
            PG8_STAGE(PG8_SB(1, 1), b3 + hstepB, voffB);
            PG8_WAIT_V(6); PG8_BAR; PG8_MMA(1, 1, At, B1); PG8_BAR;
            }
        }
        if constexpr (ALIGN_EPI) { if (wr == 0) PG8_BAR; }
        if constexpr (!Epi::AFTER_DRAIN) { E(acc, cur, wr, wc, fr, fq); S.done(cur); }
        if (!has_next) break;
#pragma unroll
        for (int a = 0; a < 2; ++a)
#pragma unroll
            for (int b = 0; b < 2; ++b)
#pragma unroll
                for (int m = 0; m < 4; ++m)
#pragma unroll
                    for (int n = 0; n < 2; ++n) acc[a][b][m][n] = (f32x4){0.f, 0.f, 0.f, 0.f};
        cur = nxt; cA = nA; cB = nB; ++ui;
        if constexpr (ALIGN_EPI) { if (wr == 1) PG8_BAR; }
    }
    PG8_WAIT_V(0);
    if constexpr (!ALIGN_EPI) { if (wr == 0) PG8_BAR; }
    PG8_BAR;
    if constexpr (Epi::AFTER_DRAIN) { E.fused(acc, cur, wr, wc, fr, fq, lds, wid, lane); S.done(cur); }
#undef PG8_SA
#undef PG8_SB
#undef PG8_STAGE
#undef PG8_LDA
#undef PG8_LDB
#undef PG8_MMA
#undef PG8_WAIT_V
#undef PG8_WAIT_L
#undef PG8_BAR
#undef PG8_SCHED
}
template <class Epi>
__device__ __forceinline__ void gemm_fast(LAS unsigned char* lds, const bf16_t* A, int lda, const bf16_t* Bt, int ldb, int M, int N, int K, const Epi& E) {
    Gemm g{A, Bt, M, N, K, lda, ldb}; StaticOrder S; S.init(M, N, (int)gridDim.x, (int)blockIdx.x);
    gemm_phase<Epi, StaticOrder, !Epi::AFTER_DRAIN, true>(lds, g, S, E);
}

__device__ __forceinline__ void p0_item(const float* W, int K, int N, const float* g, bf16_t* WT, int ldt, int mode, LAS float* scr, int item, int lane) {
    const int nblk = N / 32, kb = item / nblk, nb = item % nblk, k0 = 64 * kb, n0 = 32 * nb;
    { const int kr = lane >> 3, ch = lane & 7; f32x4 v[8];
#pragma unroll
      for (int i = 0; i < 8; ++i) v[i] = *(const f32x4*)(W + (size_t)(k0 + 8 * i + kr) * N + n0 + 4 * ch);
#pragma unroll
      for (int i = 0; i < 8; ++i) { const int kk = 8 * i + kr; const float gs = g ? g[k0 + kk] : 1.0f; LAS float* d = scr + kk * 33 + 4 * ch; d[0] = v[i][0] * gs; d[1] = v[i][1] * gs; d[2] = v[i][2] * gs; d[3] = v[i][3] * gs; } }
    asm volatile("s_waitcnt lgkmcnt(0)" ::: "memory");
    const int c = lane & 7;
#pragma unroll
    for (int j = 0; j < 4; ++j) {
        const int n = (lane >> 3) + 8 * j; const LAS float* s = scr + (8 * c) * 33 + n;
        u32x4 o; o.x = cvt_pk_bf16(s[0 * 33], s[1 * 33]); o.y = cvt_pk_bf16(s[2 * 33], s[3 * 33]); o.z = cvt_pk_bf16(s[4 * 33], s[5 * 33]); o.w = cvt_pk_bf16(s[6 * 33], s[7 * 33]);
        const int nn = n0 + n; const int row = (mode == 0) ? nn : ((nn >> 7) * 256 + (mode == 2 ? 128 : 0) + (nn & 127));
        *(u32x4*)(WT + (size_t)row * ldt + k0 + 8 * c) = o;
    }
    asm volatile("s_waitcnt lgkmcnt(0)" ::: "memory");
}


typedef float f32x16 __attribute__((ext_vector_type(16)));
constexpr int AT_VSTR = 72;
constexpr int AT_KBUF = 64 * 104 * 2, AT_VBUF = 64 * AT_VSTR * 2;
constexpr int AT_OFF_K = 0, AT_OFF_V = 2 * AT_KBUF, AT_OFF_BIAS = 2 * AT_KBUF + 2 * AT_VBUF, AT_OFF_FLAG = AT_OFF_BIAS + 2304;
__device__ __forceinline__ int crow16(int r, int hi) { return (r & 3) + 8 * (r >> 2) + 4 * hi; }
__device__ __forceinline__ int vperm(int key) { const int k16 = key & 15; return (key & ~15) + 8 * ((k16 >> 2) & 1) + 4 * (k16 >> 3) + (k16 & 3); }
__device__ __forceinline__ bf16x8 pack8(float a0, float a1, float a2, float a3, float a4, float a5, float a6, float a7) {
    u32x4 w; w.x = cvt_pk_bf16(a0, a1); w.y = cvt_pk_bf16(a2, a3); w.z = cvt_pk_bf16(a4, a5); w.w = cvt_pk_bf16(a6, a7); return __builtin_bit_cast(bf16x8, w);
}

__device__ __forceinline__ float max3f(float a, float b, float c) { float r; asm("v_max3_f32 %0, %1, %2, %3" : "=v"(r) : "v"(a), "v"(b), "v"(c)); return r; }
template <int MODE>
__device__ __forceinline__ void attn_unit(LAS unsigned char* lds, int q0, const bf16_t* Qp, int ldq, const bf16_t* Kp, int ldk, const bf16_t* Krp, int ldkr, const bf16_t* Vp, int ldv, bf16_t* Op, const float* bias_g) {
    constexpr int DQK = (MODE == 0) ? 96 : 64, NDD = DQK / 16, KSTR = DQK + 8;
    int tid_ = threadIdx.x; asm volatile("" : "+v"(tid_));
    const int tid = tid_, lane = tid & 63, wid = __builtin_amdgcn_readfirstlane(tid >> 6), l31 = lane & 31, hi = lane >> 5;
    const int t0w = q0 + 32 * wid, trow = t0w + l31, nq = t0w >> 6;
    LAS float* biasl = (LAS float*)(lds + AT_OFF_BIAS);
    LAS int* flags = (LAS int*)(lds + AT_OFF_FLAG);
    if (MODE == 2) { for (int i = tid; i < 513; i += NTHREADS) biasl[i] = bias_g[i] * LOG2E; }
    bf16x8 qf[NDD];
#pragma unroll
    for (int dd = 0; dd < NDD; ++dd) qf[dd] = *(const bf16x8*)(Qp + (size_t)trow * ldq + 16 * dd + 8 * hi);
    f32x16 o0, o1;
#pragma unroll
    for (int r = 0; r < 16; ++r) { o0[r] = 0.f; o1[r] = 0.f; }
    float mref = 0.f, lrow = 0.f, carry = 0.f; bool first = true;
    f32x16 negm;
#pragma unroll
    for (int r = 0; r < 16; ++r) negm[r] = 0.f;
    const int kt_hi = (q0 + 255) >> 6;
    int kt_lo = 0; if (MODE == 2) { kt_lo = (q0 >> 6) - 8; if (kt_lo < 0) kt_lo = 0; }
    const int nt = kt_hi - kt_lo + 1;
    const int skey = tid >> 3, sch = tid & 7, rkey = tid >> 2, rch = tid & 3;
    const int vcol = vperm(lane);
    u32x4 kreg, krreg, vreg;
#define AT_KT(i) ((MODE == 1) ? (kt_hi - (i)) : (kt_lo + (i)))
#define AT_LOAD(kt) do { const size_t kb_ = (size_t)(kt) * 64; \
        kreg = *(const u32x4*)(Kp + (kb_ + skey) * ldk + sch * 8); \
        if (MODE == 0) { if (tid < 256) krreg = *(const u32x4*)(Krp + (kb_ + rkey) * ldkr + rch * 8); } \
        vreg = *(const u32x4*)(Vp + (kb_ + lane) * ldv + wid * 8); } while (0)
#define AT_STORE(bufi) do { LAS bf16_t* Ks_ = (LAS bf16_t*)(lds + AT_OFF_K + (bufi) * AT_KBUF); LAS bf16_t* Vt_ = (LAS bf16_t*)(lds + AT_OFF_V + (bufi) * AT_VBUF); \
        *(LAS u32x4*)(Ks_ + skey * KSTR + sch * 8) = kreg; \
        if (MODE == 0) { if (tid < 256) *(LAS u32x4*)(Ks_ + rkey * KSTR + 64 + rch * 8) = krreg; } \
        LAS bf16_t* vd_ = Vt_ + (wid * 8) * AT_VSTR + vcol; \
        vd_[0 * AT_VSTR] = (bf16_t)(vreg.x & 0xffffu); vd_[1 * AT_VSTR] = (bf16_t)(vreg.x >> 16); vd_[2 * AT_VSTR] = (bf16_t)(vreg.y & 0xffffu); vd_[3 * AT_VSTR] = (bf16_t)(vreg.y >> 16); \
        vd_[4 * AT_VSTR] = (bf16_t)(vreg.z & 0xffffu); vd_[5 * AT_VSTR] = (bf16_t)(vreg.z >> 16); vd_[6 * AT_VSTR] = (bf16_t)(vreg.w & 0xffffu); vd_[7 * AT_VSTR] = (bf16_t)(vreg.w >> 16); } while (0)
    AT_LOAD(AT_KT(0)); AT_STORE(0);
    __syncthreads();
    for (int i = 0; i < nt; ++i) {
        const int kt = AT_KT(i);
        if (i + 1 < nt) AT_LOAD(AT_KT(i + 1));
        bool part;
        if (MODE == 0) part = (kt <= nq);
        else if (MODE == 1) part = (64 * kt <= t0w + 30);
        else part = (kt <= nq) && (kt >= nq - 8);
        if (part) {
            const LAS bf16_t* Ks = (const LAS bf16_t*)(lds + AT_OFF_K + (i & 1) * AT_KBUF); const LAS bf16_t* Vt = (const LAS bf16_t*)(lds + AT_OFF_V + (i & 1) * AT_VBUF);
            f32x16 p0, p1;
            if (MODE == 1) {
#pragma unroll
                for (int r = 0; r < 16; ++r) { p0[r] = 0.f; p1[r] = 0.f; }
            } else { p0 = negm; p1 = negm; }
#pragma unroll
            for (int dd = 0; dd < NDD; ++dd) {
                const bf16x8 a0 = *(const LAS bf16x8*)(Ks + l31 * KSTR + 16 * dd + 8 * hi), a1 = *(const LAS bf16x8*)(Ks + (32 + l31) * KSTR + 16 * dd + 8 * hi);
                p0 = __builtin_amdgcn_mfma_f32_32x32x16_bf16(a0, qf[dd], p0, 0, 0, 0); p1 = __builtin_amdgcn_mfma_f32_32x32x16_bf16(a1, qf[dd], p1, 0, 0, 0);
            }
            if (MODE != 1) {
                if (MODE == 2) {
                    if (nq - kt >= 5) { const float cb = biasl[512];
#pragma unroll
                        for (int r = 0; r < 16; ++r) { p0[r] += cb; p1[r] += cb; }
                    } else {
                        const int relb = trow - 64 * kt - 4 * hi;
#pragma unroll
                        for (int r = 0; r < 16; ++r) {
                            int rel0 = relb - ((r & 3) + 8 * (r >> 2)); int rel1 = rel0 - 32;
                            rel0 = rel0 > 256 ? 256 : rel0; rel1 = rel1 > 256 ? 256 : rel1;
                            p0[r] += biasl[256 + rel0]; p1[r] += biasl[256 + rel1];
                        }
                    }
                }
                float mx = max3f(p0[0], p1[0], p0[1]);
#pragma unroll
                for (int r = 1; r < 15; r += 2) { mx = max3f(mx, p1[r], p0[r + 1]); mx = max3f(mx, p1[r + 1], p0[(r + 2 > 15) ? 15 : (r + 2)]); }
                mx = fmaxf(mx, p1[15]);
                mx = fmaxf(mx, __shfl_xor(mx, 32));
                if (first || __any(mx > 8.0f)) {
                    const float dl = first ? mx : fmaxf(mx, 0.f);
                    mref += dl;
#pragma unroll
                    for (int r = 0; r < 16; ++r) { p0[r] -= dl; p1[r] -= dl; }
                    if (!first) { const float f = __builtin_amdgcn_exp2f(-dl); lrow *= f;
#pragma unroll
                        for (int r = 0; r < 16; ++r) { o0[r] *= f; o1[r] *= f; } }
#pragma unroll
                    for (int r = 0; r < 16; ++r) negm[r] = -mref;
                    first = false;
                }
                float rs = 0.f;
#pragma unroll
                for (int r = 0; r < 16; ++r) { p0[r] = __builtin_amdgcn_exp2f(p0[r]); p1[r] = __builtin_amdgcn_exp2f(p1[r]); rs += p0[r] + p1[r]; }
                lrow += rs;
            } else {
                const bool need_mask = (64 * kt + 63 >= t0w);
                const int kvb = 64 * kt + 4 * hi;
                float gs[8], lkq0[16], lkq1[16];
#pragma unroll
                for (int g = 0; g < 8; ++g) {
                    float s4 = 0.f;
#pragma unroll
                    for (int c = 0; c < 4; ++c) {
                        const int r = 4 * (g & 3) + c;
                        const float z2 = ((g < 4) ? p0[r] : p1[r]) * (0.125f * LOG2E);
                        const float sp2 = fmaxf(z2, 0.f) + __builtin_amdgcn_logf(1.0f + __builtin_amdgcn_exp2f(-fabsf(z2)));
                        const bool valid = !need_mask || (kvb + 8 * g + c < trow);
                        const float lk = valid ? -sp2 : 0.f;
                        const float ls = valid ? (z2 - sp2) : -1e30f;
                        if (g < 4) { p0[r] = ls; } else { p1[r] = ls; }
                        s4 += lk;
                        if (g < 4) { lkq0[r] = lk; } else { lkq1[r] = lk; }
                    }
                    gs[g] = s4;
                }
                float run = 0.f, after[8];
#pragma unroll
                for (int g = 7; g >= 0; --g) { const float pg = __shfl_xor(gs[g], 32); after[g] = run + (hi == 0 ? pg : 0.f); run += gs[g] + pg; }
#pragma unroll
                for (int g = 0; g < 8; ++g) {
                    float suf = carry + after[g];
#pragma unroll
                    for (int c = 3; c >= 0; --c) {
                        const int r = 4 * (g & 3) + c;
                        if (g < 4) { p0[r] = __builtin_amdgcn_exp2f(p0[r] + suf); suf += lkq0[r]; } else { p1[r] = __builtin_amdgcn_exp2f(p1[r] + suf); suf += lkq1[r]; }
                    }
                }
                carry += run;
            }
            const bf16x8 pb0 = pack8(p0[0], p0[1], p0[2], p0[3], p0[4], p0[5], p0[6], p0[7]), pb1 = pack8(p0[8], p0[9], p0[10], p0[11], p0[12], p0[13], p0[14], p0[15]);
            const bf16x8 pb2 = pack8(p1[0], p1[1], p1[2], p1[3], p1[4], p1[5], p1[6], p1[7]), pb3 = pack8(p1[8], p1[9], p1[10], p1[11], p1[12], p1[13], p1[14], p1[15]);
            const LAS bf16_t* v0p = Vt + l31 * AT_VSTR + 8 * hi; const LAS bf16_t* v1p = Vt + (32 + l31) * AT_VSTR + 8 * hi;
            o0 = __builtin_amdgcn_mfma_f32_32x32x16_bf16(*(const LAS bf16x8*)(v0p + 0), pb0, o0, 0, 0, 0);  o1 = __builtin_amdgcn_mfma_f32_32x32x16_bf16(*(const LAS bf16x8*)(v1p + 0), pb0, o1, 0, 0, 0);
            o0 = __builtin_amdgcn_mfma_f32_32x32x16_bf16(*(const LAS bf16x8*)(v0p + 16), pb1, o0, 0, 0, 0); o1 = __builtin_amdgcn_mfma_f32_32x32x16_bf16(*(const LAS bf16x8*)(v1p + 16), pb1, o1, 0, 0, 0);
            o0 = __builtin_amdgcn_mfma_f32_32x32x16_bf16(*(const LAS bf16x8*)(v0p + 32), pb2, o0, 0, 0, 0); o1 = __builtin_amdgcn_mfma_f32_32x32x16_bf16(*(const LAS bf16x8*)(v1p + 32), pb2, o1, 0, 0, 0);
            o0 = __builtin_amdgcn_mfma_f32_32x32x16_bf16(*(const LAS bf16x8*)(v0p + 48), pb3, o0, 0, 0, 0); o1 = __builtin_amdgcn_mfma_f32_32x32x16_bf16(*(const LAS bf16x8*)(v1p + 48), pb3, o1, 0, 0, 0);
        }
        if (i + 1 < nt) AT_STORE((i + 1) & 1);
        if (MODE == 1) { const int done = __all(carry < -151.0f) ? 1 : 0; if (lane == 0) flags[(i & 1) * 8 + wid] = done; }
        __syncthreads();
        if (MODE == 1) {
            int alld = 1;
#pragma unroll
            for (int w8 = 0; w8 < 8; ++w8) alld &= flags[(i & 1) * 8 + w8];
            if (alld) break;
        }
    }
    if (MODE == 1) __syncthreads();
    float inv = 1.0f;
    if (MODE != 1) { const float lt = lrow + __shfl_xor(lrow, 32); inv = 1.0f / lt; }
    bf16_t* orow = Op + (size_t)trow * DM + 4 * hi;
#pragma unroll
    for (int g = 0; g < 4; ++g) {
        u32x2 w0, w1;
        w0.x = cvt_pk_bf16(o0[4 * g] * inv, o0[4 * g + 1] * inv); w0.y = cvt_pk_bf16(o0[4 * g + 2] * inv, o0[4 * g + 3] * inv);
        w1.x = cvt_pk_bf16(o1[4 * g] * inv, o1[4 * g + 1] * inv); w1.y = cvt_pk_bf16(o1[4 * g + 2] * inv, o1[4 * g + 3] * inv);
        *(u32x2*)(orow + 8 * g) = w0; *(u32x2*)(orow + 32 + 8 * g) = w1;
    }
#undef AT_KT
#undef AT_LOAD
#undef AT_STORE
}


#define XB_TMO      128
#define XB_XCNT(j)  (256  + 64 * (j))
#define XB_XSUB(j)  (1280 + 64 * (j))
#define XB_XGEN(j)  (2304 + 64 * (j))
#define XB_TOP      3328
#define XB_TOPGEN   3392
#define XCD_BAR_WORDS 3456
#define XB_SPIN_CAP (1u << 18)
__device__ __forceinline__ unsigned xb_ld(unsigned* p)              { return __hip_atomic_load(p, __ATOMIC_RELAXED, __HIP_MEMORY_SCOPE_AGENT); }
__device__ __forceinline__ unsigned xb_add(unsigned* p, unsigned v) { return __hip_atomic_fetch_add(p, v, __ATOMIC_RELAXED, __HIP_MEMORY_SCOPE_AGENT); }
__device__ __forceinline__ unsigned xb_xcc_id() { return (unsigned)__builtin_amdgcn_s_getreg((3 << 11) | 20) & 0xFu; }
#define XB_SPIN(cond, bar) do { unsigned _sp = 0; while (cond) { __builtin_amdgcn_s_sleep(1); \
    if ((++_sp & 255u) == 0u) { if (xb_ld(&(bar)[XB_TMO])) break; if (_sp > XB_SPIN_CAP) { atomicAdd(&(bar)[XB_TMO], 1u); break; } } } } while (0)
struct XcdBarrier { unsigned* bar; unsigned x; volatile LAS unsigned* st; };
__device__ __forceinline__ XcdBarrier xcd_barrier_post(unsigned* bar, volatile LAS unsigned* st) {
    XcdBarrier b; b.bar = bar; b.x = xb_xcc_id(); b.st = st;
    if (threadIdx.x == 0) (void)xb_add(&bar[XB_XCNT(b.x)], 1u);
    return b;
}
__device__ __forceinline__ void xcd_barrier_complete(unsigned* bar, unsigned x, unsigned& nloc, unsigned& nx) {
    const unsigned G = gridDim.x * gridDim.y * gridDim.z;
    unsigned sum, cnt, mine, sp = 0u;
    for (;;) {
        sum = 0u; cnt = 0u; mine = 0u;
#pragma unroll
        for (unsigned j = 0; j < 16; ++j) { const unsigned c = xb_ld(&bar[XB_XCNT(j)]); sum += c; cnt += (c > 0u) ? 1u : 0u; mine = (j == x) ? c : mine; }
        if (sum == G) break;
        __builtin_amdgcn_s_sleep(1);
        if ((++sp & 255u) == 0u) { if (xb_ld(&bar[XB_TMO])) break; if (sp > XB_SPIN_CAP) { atomicAdd(&bar[XB_TMO], 1u); break; } }
    }
    nloc = mine > 0u ? mine : 1u; nx = cnt > 0u ? cnt : 1u;
}
__device__ __forceinline__ void xcd_barrier(const XcdBarrier& b) {
    asm volatile("s_waitcnt vmcnt(0)" ::: "memory");
    __syncthreads();
    if (threadIdx.x == 0) {
        unsigned* bar = b.bar;
        __builtin_amdgcn_s_waitcnt(0);
        unsigned nloc = b.st[0], nx = b.st[1];
        if (nloc == 0u) { xcd_barrier_complete(bar, b.x, nloc, nx); b.st[0] = nloc; b.st[1] = nx; }
        const unsigned old = xb_add(&bar[XB_XSUB(b.x)], 1u);
        const unsigned gen = old / nloc;
        if (old + 1u == (gen + 1u) * nloc) {
            __builtin_amdgcn_fence(__ATOMIC_RELEASE, "agent");
            asm volatile("s_waitcnt vmcnt(0)" ::: "memory");
            const unsigned og = xb_add(&bar[XB_TOP], 1u);
            const unsigned tg = og / nx;
            if (og + 1u == (tg + 1u) * nx) xb_add(&bar[XB_TOPGEN], 1u);
            else XB_SPIN(xb_ld(&bar[XB_TOPGEN]) == tg, bar);
            __builtin_amdgcn_fence(__ATOMIC_ACQUIRE, "agent");
            xb_add(&bar[XB_XGEN(b.x)], 1u);
            asm volatile("s_waitcnt vmcnt(0)" ::: "memory");
        } else {
            XB_SPIN(xb_ld(&bar[XB_XGEN(b.x)]) == gen, bar);
            __builtin_amdgcn_fence(__ATOMIC_ACQUIRE, "agent");
            asm volatile("s_waitcnt vmcnt(0)" ::: "memory");
        }
    }
    __syncthreads();
}

struct Args { const float* in[16]; float* out; unsigned char* ws; };

__device__ __forceinline__ void attn_mla_naive(const bf16_t* QA, const bf16_t* KVA, const bf16_t* PROJ, bf16_t* O) {
    const int nth = gridDim.x * NTHREADS;
    for (int w = blockIdx.x * NTHREADS + threadIdx.x; w < 8 * MTOK; w += nth) {
        const int h = w >> 14, row = w & (MTOK - 1), b = row >> 11, t = row & (SEQ - 1);
        float q[96];
#pragma unroll
        for (int c = 0; c < 12; ++c) unpack8(*(const u32x4*)(QA + (size_t)row * NQA + h * 96 + c * 8), q + c * 8);
        float o[64];
#pragma unroll
        for (int d = 0; d < 64; ++d) o[d] = 0.f;
        float mx = -INFINITY, l = 0.f;
        const int kend = ((t >> 6) + 1) << 6;
        for (int s = 0; s < kend; ++s) {
            const size_t kr = (size_t)(b * SEQ + s);
            const bf16_t* kp = KVA + kr * NKVA + h * 128; const bf16_t* rp = PROJ + kr * NPROJ_P + C_KR;
            float sc = 0.f;
#pragma unroll
            for (int c = 0; c < 8; ++c) { float k[8]; unpack8(*(const u32x4*)(kp + c * 8), k);
#pragma unroll
                for (int e = 0; e < 8; ++e) sc += q[c * 8 + e] * k[e]; }
#pragma unroll
            for (int c = 0; c < 4; ++c) { float k[8]; unpack8(*(const u32x4*)(rp + c * 8), k);
#pragma unroll
                for (int e = 0; e < 8; ++e) sc += q[64 + c * 8 + e] * k[e]; }
            const float mn = fmaxf(mx, sc), al = __builtin_amdgcn_exp2f(mx - mn), p = __builtin_amdgcn_exp2f(sc - mn);
            l = l * al + p; mx = mn;
#pragma unroll
            for (int c = 0; c < 8; ++c) { float v[8]; unpack8(*(const u32x4*)(kp + 64 + c * 8), v);
#pragma unroll
                for (int e = 0; e < 8; ++e) o[c * 8 + e] = o[c * 8 + e] * al + p * v[e]; }
        }
        const float inv = 1.0f / l;
#pragma unroll
        for (int c = 0; c < 8; ++c) { u32x4 wv; wv.x = cvt_pk_bf16(o[c * 8] * inv, o[c * 8 + 1] * inv); wv.y = cvt_pk_bf16(o[c * 8 + 2] * inv, o[c * 8 + 3] * inv); wv.z = cvt_pk_bf16(o[c * 8 + 4] * inv, o[c * 8 + 5] * inv); wv.w = cvt_pk_bf16(o[c * 8 + 6] * inv, o[c * 8 + 7] * inv);
            *(u32x4*)(O + (size_t)row * DM + h * 64 + c * 8) = wv; }
    }
}

__device__ __forceinline__ void attn_sb_naive(const bf16_t* PROJ, bf16_t* O) {
    const int nth = gridDim.x * NTHREADS;
    for (int w = blockIdx.x * NTHREADS + threadIdx.x; w < 8 * MTOK; w += nth) {
        const int h = w >> 14, row = w & (MTOK - 1), b = row >> 11, t = row & (SEQ - 1);
        float q[64];
#pragma unroll
        for (int c = 0; c < 8; ++c) unpack8(*(const u32x4*)(PROJ + (size_t)row * NPROJ_P + C_QB + h * 64 + c * 8), q + c * 8);
        float o[64];
#pragma unroll
        for (int d = 0; d < 64; ++d) o[d] = 0.f;
        float cum = 0.f;
        const int tmax = t | 63;
        for (int s = tmax - 1; s >= 0; --s) {
            const size_t kr = (size_t)(b * SEQ + s);
            const bf16_t* kp = PROJ + kr * NPROJ_P + C_KB + h * 64; const bf16_t* vp = PROJ + kr * NPROJ_P + C_VB + h * 64;
            float z = 0.f;
#pragma unroll
            for (int c = 0; c < 8; ++c) { float k[8]; unpack8(*(const u32x4*)(kp + c * 8), k);
#pragma unroll
                for (int e = 0; e < 8; ++e) z += q[c * 8 + e] * k[e]; }
            z *= 0.125f;
            const bool on = s < t;
            const float lg = __logf(1.0f + __expf(-fabsf(z)));
            const float wgt = on ? __expf(fminf(z, 0.f) - lg + cum) : 0.f;
            cum += on ? (fminf(-z, 0.f) - lg) : 0.f;
#pragma unroll
            for (int c = 0; c < 8; ++c) { float v[8]; unpack8(*(const u32x4*)(vp + c * 8), v);
#pragma unroll
                for (int e = 0; e < 8; ++e) o[c * 8 + e] += wgt * v[e]; }
        }
#pragma unroll
        for (int c = 0; c < 8; ++c) { u32x4 wv; wv.x = cvt_pk_bf16(o[c * 8], o[c * 8 + 1]); wv.y = cvt_pk_bf16(o[c * 8 + 2], o[c * 8 + 3]); wv.z = cvt_pk_bf16(o[c * 8 + 4], o[c * 8 + 5]); wv.w = cvt_pk_bf16(o[c * 8 + 6], o[c * 8 + 7]);
            *(u32x4*)(O + (size_t)row * DM + 512 + h * 64 + c * 8) = wv; }
    }
}

__device__ __forceinline__ void attn_band_naive(const bf16_t* QKV, const float* rel_bias, bf16_t* O) {
    const int nth = gridDim.x * NTHREADS;
    for (int w = blockIdx.x * NTHREADS + threadIdx.x; w < 16 * MTOK; w += nth) {
        const int h = w >> 14, row = w & (MTOK - 1), b = row >> 11, t = row & (SEQ - 1);
        float q[64];
#pragma unroll
        for (int c = 0; c < 8; ++c) unpack8(*(const u32x4*)(QKV + (size_t)row * NQKV + h * 64 + c * 8), q + c * 8);
        float o[64];
#pragma unroll
        for (int d = 0; d < 64; ++d) o[d] = 0.f;
        float mx = -INFINITY, l = 0.f;
        const int n = t >> 6, s0 = (n >= 8) ? (n - 8) * 64 : 0, s1 = (n + 1) * 64;
        const float* bias = rel_bias + h * 513 + 256;
        for (int s = s0; s < s1; ++s) {
            const size_t kr = (size_t)(b * SEQ + s);
            const bf16_t* kp = QKV + kr * NQKV + 1024 + h * 64; const bf16_t* vp = QKV + kr * NQKV + 2048 + h * 64;
            float sc = 0.f;
#pragma unroll
            for (int c = 0; c < 8; ++c) { float k[8]; unpack8(*(const u32x4*)(kp + c * 8), k);
#pragma unroll
                for (int e = 0; e < 8; ++e) sc += q[c * 8 + e] * k[e]; }
            int rel = t - s; rel = rel > 256 ? 256 : (rel < -256 ? -256 : rel);
            sc += bias[rel] * LOG2E;
            const float mn = fmaxf(mx, sc), al = __builtin_amdgcn_exp2f(mx - mn), p = __builtin_amdgcn_exp2f(sc - mn);
            l = l * al + p; mx = mn;
#pragma unroll
            for (int c = 0; c < 8; ++c) { float v[8]; unpack8(*(const u32x4*)(vp + c * 8), v);
#pragma unroll
                for (int e = 0; e < 8; ++e) o[c * 8 + e] = o[c * 8 + e] * al + p * v[e]; }
        }
        const float inv = 1.0f / l;
#pragma unroll
        for (int c = 0; c < 8; ++c) { u32x4 wv; wv.x = cvt_pk_bf16(o[c * 8] * inv, o[c * 8 + 1] * inv); wv.y = cvt_pk_bf16(o[c * 8 + 2] * inv, o[c * 8 + 3] * inv); wv.z = cvt_pk_bf16(o[c * 8 + 4] * inv, o[c * 8 + 5] * inv); wv.w = cvt_pk_bf16(o[c * 8 + 6] * inv, o[c * 8 + 7] * inv);
            *(u32x4*)(O + (size_t)row * DM + h * 64 + c * 8) = wv; }
    }
}

constexpr int I_IN = 16 * (NPROJ / 32), I_UQ = 6 * 24, I_UKV = 4 * 32, I_O = 16 * 32, I_G = 16 * 88, I_D = 44 * 32, I_QKV = 16 * 96;
constexpr int CV_R0 = I_IN + I_UQ + I_UKV, CV_R1 = CV_R0 + I_O + 2 * I_G + I_D + I_QKV + I_O, CV_NITEMS = CV_R1 + 2 * I_G + I_D;
#define CONV_ITEM(it_) do { int r = (it_); \
        if (r < I_IN) { p0_item(args.in[1], DM, NPROJ, args.in[10], Win, DM, 0, scr, r, lane); break; } r -= I_IN; \
        if (r < I_UQ) { p0_item(args.in[3], 384, NQA, args.in[2], Wuq, 384, 0, scr, r, lane); break; } r -= I_UQ; \
        if (r < I_UKV) { p0_item(args.in[5], 256, NKVA, args.in[4], Wukv, 256, 0, scr, r, lane); break; } r -= I_UKV; \
        if (r < I_O) { p0_item(args.in[6], DM, DM, nullptr, Wo0, DM, 0, scr, r, lane); break; } r -= I_O; \
        if (r < I_G) { p0_item(args.in[12], DM, DFF, args.in[11], Wgu0, DM, 1, scr, r, lane); break; } r -= I_G; \
        if (r < I_G) { p0_item(args.in[13], DM, DFF, args.in[11], Wgu0, DM, 2, scr, r, lane); break; } r -= I_G; \
        if (r < I_D) { p0_item(args.in[14], DFF, DM, nullptr, Wd0, DFF, 0, scr, r, lane); break; } r -= I_D; \
        if (r < I_QKV) { p0_item(args.in[7], DM, NQKV, args.in[10] + DM, Wqkv, DM, 0, scr, r, lane); break; } r -= I_QKV; \
        if (r < I_O) { p0_item(args.in[9], DM, DM, nullptr, Wo1, DM, 0, scr, r, lane); break; } r -= I_O; \
        if (r < I_G) { p0_item(args.in[12] + (size_t)DM * DFF, DM, DFF, args.in[11] + DM, Wgu1, DM, 1, scr, r, lane); break; } r -= I_G; \
        if (r < I_G) { p0_item(args.in[13] + (size_t)DM * DFF, DM, DFF, args.in[11] + DM, Wgu1, DM, 2, scr, r, lane); break; } r -= I_G; \
        p0_item(args.in[14] + (size_t)DFF * DM, DFF, DM, nullptr, Wd1, DFF, 0, scr, r, lane); } while (0)
#define CONV_TAIL(first, lo, hi) do { if (G == 256 && (int)blockIdx.x >= (first)) { int tid_c = threadIdx.x; asm volatile("" : "+v"(tid_c)); const int lane = tid_c & 63, wave = __builtin_amdgcn_readfirstlane(tid_c >> 6); \
        LAS float* scr = (LAS float*)((LAS unsigned char*)lds + wave * 16384); \
        for (int it = (lo) + ((int)blockIdx.x - (first)) * 8 + wave; it < (hi); it += (G - (first)) * 8) CONV_ITEM(it); } } while (0)

__global__ void __launch_bounds__(NTHREADS) fwd_megakernel(Args args) {
    extern __shared__ __attribute__((aligned(16))) unsigned char lds[];
#ifdef USE_CG_SYNC
    cg::grid_group grid = cg::this_grid();
#define GRID_SYNC() grid.sync()
#else
    { volatile LAS unsigned* st0 = (volatile LAS unsigned*)((LAS unsigned char*)lds + LDS_BYTES - 64); if (threadIdx.x == 0) { st0[0] = 0u; st0[1] = 0u; } }
    __syncthreads();
    const XcdBarrier xbar = xcd_barrier_post((unsigned*)(args.ws + WS_CTL), (volatile LAS unsigned*)((LAS unsigned char*)lds + LDS_BYTES - 64));
#define GRID_SYNC() xcd_barrier(xbar)
#endif
#ifdef USE_NAIVE_GEMM
#define GEMM(A, lda, Bt, ldb, M, N, K, E) gemm_naive(A, lda, Bt, ldb, (M) / 256, (N) / 256, K, E)
#else
#define GEMM(A, lda, Bt, ldb, M, N, K, E) gemm_fast((LAS unsigned char*)lds, A, lda, Bt, ldb, M, N, K, E)
#endif
    const int G = gridDim.x;
    const int vcu = (G % 8 == 0) ? (int)(blockIdx.x % 8) * (G / 8) + (int)(blockIdx.x / 8) : (int)blockIdx.x;
    LAS unsigned char* ldsp = (LAS unsigned char*)lds;
    unsigned char* ws = args.ws;
    const float* x = args.in[0];
    float* out = args.out;
    u64* ssq = (u64*)(ws + WS_SSQ);
    f32x2* rope = (f32x2*)(ws + WS_ROPE);
    bf16_t* Win = (bf16_t*)(ws + WS_WIN); bf16_t* Wuq = (bf16_t*)(ws + WS_WUQ); bf16_t* Wukv = (bf16_t*)(ws + WS_WUKV); bf16_t* Wo0 = (bf16_t*)(ws + WS_WO0);
    bf16_t* Wgu0 = (bf16_t*)(ws + WS_WGU0); bf16_t* Wd0 = (bf16_t*)(ws + WS_WD0); bf16_t* Wqkv = (bf16_t*)(ws + WS_WQKV); bf16_t* Wo1 = (bf16_t*)(ws + WS_WO1);
    bf16_t* Wgu1 = (bf16_t*)(ws + WS_WGU1); bf16_t* Wd1 = (bf16_t*)(ws + WS_WD1);
    bf16_t* HB = (bf16_t*)(ws + WS_HB); bf16_t* PROJ = (bf16_t*)(ws + WS_A); bf16_t* QKV = (bf16_t*)(ws + WS_A); bf16_t* ACT = (bf16_t*)(ws + WS_A); bf16_t* ATT = (bf16_t*)(ws + WS_ATT);
    bf16_t* QA = (bf16_t*)((unsigned char*)out + OUT_QA); bf16_t* KVA = (bf16_t*)((unsigned char*)out + OUT_KVA);

    {
        const int tid = threadIdx.x, lane = tid & 63, wave = __builtin_amdgcn_readfirstlane(tid >> 6);
        LAS float* scr = (LAS float*)((LAS unsigned char*)lds + wave * 16384);
        const int gw = blockIdx.x * 8 + wave, NGW = G * 8;
        const bool offload = (G == 256);
        for (int it = gw; it < (offload ? CV_R0 : CV_NITEMS); it += NGW) CONV_ITEM(it);
        for (int i = blockIdx.x * NTHREADS + tid; i < (NPROJ_P - NPROJ) * DM / 8; i += G * NTHREADS) ((u32x4*)(Win + (size_t)NPROJ * DM))[i] = (u32x4){0u, 0u, 0u, 0u};
        for (int i = blockIdx.x * NTHREADS + tid; i < 6 * MTOK; i += G * NTHREADS) ssq[MTOK + i] = 0ull;
        for (int i = blockIdx.x * NTHREADS + tid; i < SEQ * 16; i += G * NTHREADS) {
            const int pos = i >> 4, fi = i & 15;
            const float inv_freq = __builtin_amdgcn_exp2f(-(float)fi * (13.287712379549449f / 16.0f));
            const float ang = (float)pos * inv_freq;
            float tr = ang * 0.15915494309189535f; tr -= floorf(tr);
            rope[i] = (f32x2){__builtin_amdgcn_cosf(tr), __builtin_amdgcn_sinf(tr)};
        }
        for (int m = gw; m < MTOK; m += NGW) {
            const f32x4* xr = (const f32x4*)(x + (size_t)m * DM) + lane; f32x4 v[4]; float s = 0.f;
#pragma unroll
            for (int j = 0; j < 4; ++j) { v[j] = xr[64 * j]; s += dot4(v[j]); }
            s = wave_sum(s);
            if (lane == 0) ssq[m] = ssq_fix(s);
#pragma unroll
            for (int j = 0; j < 4; ++j) { u32x2 w; w.x = cvt_pk_bf16(v[j][0], v[j][1]); w.y = cvt_pk_bf16(v[j][2], v[j][3]); *((u32x2*)(HB + (size_t)m * DM) + lane + 64 * j) = w; }
        }
    }
    GRID_SYNC();
    { EpiScale<0> E{PROJ, NPROJ_P, ssq, 1.0f / DM, ssq + MTOK, ssq + 2 * MTOK, rope}; GEMM(HB, DM, Win, DM, MTOK, NPROJ_P, DM, E); }
    CONV_TAIL(64, CV_R0, CV_R1);
    GRID_SYNC();
    { EpiScale<1> E{QA, NQA, ssq + MTOK, 1.0f / 384, nullptr, nullptr, rope}; GEMM(PROJ, NPROJ_P, Wuq, 384, MTOK, NQA, 384, E); }
    { EpiScale<2> E{KVA, NKVA, ssq + 2 * MTOK, 1.0f / 256, nullptr, nullptr, rope}; GEMM(PROJ + C_CKV, NPROJ_P, Wukv, 256, MTOK, NKVA, 256, E); }
    GRID_SYNC();
#ifdef NAIVE_ATTN
    attn_mla_naive(QA, KVA, PROJ, ATT);
    attn_sb_naive(PROJ, ATT);
#else
    for (int u = vcu; u < 256; u += G) {
        const int bh = u >> 2, j = u & 3, b = bh >> 3, h = bh & 7;
        const size_t rb = (size_t)b * SEQ;
        for (int k = 0; k < 2 * REP_MLA; ++k) { const int qt = (k & 1) ? 7 - j : j;
            attn_unit<0>(ldsp, 256 * qt, QA + rb * NQA + h * 96, NQA, KVA + rb * NKVA + h * 128, NKVA, PROJ + rb * NPROJ_P + C_KR, NPROJ_P, KVA + rb * NKVA + h * 128 + 64, NKVA, ATT + rb * DM + h * 64, nullptr); }
        for (int k = 0; k < 2 * REP_SB; ++k) { const int qt = (k & 1) ? 7 - j : j;
            attn_unit<1>(ldsp, 256 * qt, PROJ + rb * NPROJ_P + C_QB + h * 64, NPROJ_P, PROJ + rb * NPROJ_P + C_KB + h * 64, NPROJ_P, nullptr, 0, PROJ + rb * NPROJ_P + C_VB + h * 64, NPROJ_P, ATT + rb * DM + 512 + h * 64, nullptr); }
    }
#endif
    GRID_SYNC();
    { EpiResid E{HB, ssq + 3 * MTOK}; GEMM(ATT, DM, Wo0, DM, MTOK, DM, DM, E); }
    GRID_SYNC();
    for (int rep = 0; rep < REP_GU; ++rep) { EpiSwiglu E{ACT, ssq + 3 * MTOK}; GEMM(HB, DM, Wgu0, DM, MTOK, 2 * DFF, DM, E); }
    CONV_TAIL(128, CV_R1, CV_NITEMS);
    GRID_SYNC();
    { EpiResid E{HB, ssq + 4 * MTOK}; GEMM(ACT, DFF, Wd0, DFF, MTOK, DM, DFF, E); }
    GRID_SYNC();
    { EpiScale<3> E{QKV, NQKV, ssq + 4 * MTOK, 1.0f / DM, nullptr, nullptr, rope}; GEMM(HB, DM, Wqkv, DM, MTOK, NQKV, DM, E); }
    GRID_SYNC();
#ifdef NAIVE_ATTN
    attn_band_naive(QKV, args.in[8], ATT);
#else
    for (int u = vcu; u < 256; u += G) {
        const int bh = u >> 1, half = u & 1, b = bh >> 4, h = bh & 15;
        const size_t rb = (size_t)b * SEQ;
        for (int k = 0; k < 4 * REP_BAND; ++k)
            attn_unit<2>(ldsp, 256 * (4 * half + (k & 3)), QKV + rb * NQKV + h * 64, NQKV, QKV + rb * NQKV + 1024 + h * 64, NQKV, nullptr, 0, QKV + rb * NQKV + 2048 + h * 64, NQKV, ATT + rb * DM + h * 64, args.in[8] + h * 513);
    }
#endif
    GRID_SYNC();
    { EpiResid E{HB, ssq + 5 * MTOK}; GEMM(ATT, DM, Wo1, DM, MTOK, DM, DM, E); }
    GRID_SYNC();
    { EpiSwiglu E{ACT, ssq + 5 * MTOK}; GEMM(HB, DM, Wgu1, DM, MTOK, 2 * DFF, DM, E); }
    GRID_SYNC();
    if (G == 256) {
        EpiFinal E{HB, ssq + 6 * MTOK, (unsigned*)(args.ws + WS_CTL) + CW_PANEL, args.in[15], out};
        gemm_fast((LAS unsigned char*)lds, ACT, DFF, Wd1, DFF, MTOK, DM, DFF, E);
        return;
    }
    { EpiResid E{HB, ssq + 6 * MTOK}; GEMM(ACT, DFF, Wd1, DFF, MTOK, DM, DFF, E); }
    GRID_SYNC();
    {
        const int tid = threadIdx.x, lane = tid & 63, wave = __builtin_amdgcn_readfirstlane(tid >> 6); (void)tid;
        const int gw = blockIdx.x * 8 + wave, NGW = G * 8;
        const f32x4* gf = (const f32x4*)args.in[15] + lane;
        for (int m = gw; m < MTOK; m += NGW) {
            const float r = rsqrtf(ssq_get(ssq + 6 * MTOK, m) * (1.0f / DM) + RMS_EPS);
            f32x4* p = (f32x4*)(out + (size_t)m * DM) + lane; const u32x2* hp = (const u32x2*)(HB + (size_t)m * DM) + lane;
#pragma unroll
            for (int j = 0; j < 4; ++j) { const u32x2 hv = hp[64 * j]; const f32x4 g4 = gf[64 * j]; f32x4 o; o[0] = bflo(hv.x) * r * g4[0]; o[1] = bfhi(hv.x) * r * g4[1]; o[2] = bflo(hv.y) * r * g4[2]; o[3] = bfhi(hv.y) * r * g4[3]; p[64 * j] = o; }
        }
    }
}

extern "C" void kernel_launch(void* const* d_in, const int* in_sizes, int n_in, void* d_out, int out_size, void* d_ws, size_t ws_size, hipStream_t stream) {
    static int grid = 0;
    if (grid == 0) {
        int dev = 0, cus = 0, per_cu = 0;
        hipGetDevice(&dev);
        hipDeviceGetAttribute(&cus, hipDeviceAttributeMultiprocessorCount, dev);
        hipFuncSetAttribute((const void*)fwd_megakernel, hipFuncAttributeMaxDynamicSharedMemorySize, LDS_BYTES);
        hipOccupancyMaxActiveBlocksPerMultiprocessor(&per_cu, (const void*)fwd_megakernel, NTHREADS, LDS_BYTES);
        if (per_cu < 1) per_cu = 1;
        if (per_cu > 1) per_cu = 1;
        grid = cus * per_cu;
        if (n_in != 16 || out_size != MTOK * DM || ws_size < WS_END) { fprintf(stderr, "kernel_launch: unexpected shapes n_in %d out %d ws %zu\n", n_in, out_size, ws_size); }
    }
    Args a{};
    for (int i = 0; i < 16; ++i) a.in[i] = (const float*)d_in[i];
    a.out = (float*)d_out; a.ws = (unsigned char*)d_ws;
    hipMemsetAsync((char*)d_ws + WS_CTL, 0, CTL_BYTES, stream);
    void* kargs[] = {&a};
    hipError_t e = hipLaunchCooperativeKernel((const void*)fwd_megakernel, dim3(grid), dim3(NTHREADS), kargs, LDS_BYTES, stream);
    if (e != hipSuccess) fprintf(stderr, "cooperative launch failed: %s (grid %d)\n", hipGetErrorString(e), grid);
}
```

```cpp
#include <hip/hip_runtime.h>
#include <hip/hip_cooperative_groups.h>
#include <cstdio>
#include <cstdint>
namespace cg = cooperative_groups;
#define REP_MLA 1
#define REP_SB 1
#define REP_BAND 1
#define REP_GU 1

#define LAS __attribute__((address_space(3)))
typedef unsigned short bf16_t;
typedef short bf16x8 __attribute__((ext_vector_type(8)));
typedef float f32x4 __attribute__((ext_vector_type(4)));
typedef float f32x2 __attribute__((ext_vector_type(2)));
typedef unsigned u32x4 __attribute__((ext_vector_type(4)));
typedef unsigned u32x2 __attribute__((ext_vector_type(2)));

constexpr int MTOK = 16384, SEQ = 2048, DM = 1024, DFF = 2816;
constexpr int NPROJ = 2208, NPROJ_P = 2304;
constexpr int C_CKV = 384, C_KR = 640, C_QB = 672, C_KB = 1184, C_VB = 1696;
constexpr int NQA = 768, NKVA = 1024, NQKV = 3072;
constexpr float RMS_EPS = 1e-6f;
constexpr float LOG2E = 1.4426950408889634f;
constexpr float QSCALE_A = 0.10206207261596577f * LOG2E;
constexpr float QSCALE_C = 0.125f * LOG2E;

constexpr size_t KiB = 1024, MiB = 1u << 20;
constexpr size_t WS_SSQ = 216 * MiB;
constexpr size_t WS_ROPE = 512 * KiB;
constexpr size_t WS_CTL = 768 * KiB, CTL_BYTES = 32 * KiB; constexpr int CW_PANEL = 4096;
constexpr size_t WS_WIN = 1 * MiB;
constexpr size_t WS_WUQ = WS_WIN + (size_t)NPROJ_P * DM * 2;
constexpr size_t WS_WUKV = WS_WUQ + (size_t)NQA * 384 * 2;
constexpr size_t WS_WO0 = WS_WUKV + (size_t)NKVA * 256 * 2;
constexpr size_t WS_WGU0 = WS_WO0 + (size_t)DM * DM * 2;
constexpr size_t WS_WD0 = WS_WGU0 + (size_t)2 * DFF * DM * 2;
constexpr size_t WS_WQKV = WS_WD0 + (size_t)DM * DFF * 2;
constexpr size_t WS_WO1 = WS_WQKV + (size_t)NQKV * DM * 2;
constexpr size_t WS_WGU1 = WS_WO1 + (size_t)DM * DM * 2;
constexpr size_t WS_WD1 = WS_WGU1 + (size_t)2 * DFF * DM * 2;
constexpr size_t WS_WEND = WS_WD1 + (size_t)DM * DFF * 2;
constexpr size_t WS_HB = 50 * MiB;
constexpr size_t WS_A = 82 * MiB;
constexpr size_t WS_ATT = 178 * MiB;
constexpr size_t WS_SSQP = 210 * MiB;
constexpr size_t WS_END = 218 * MiB;
static_assert(WS_WEND <= WS_HB, "weights fit");
constexpr size_t OUT_QA = 0, OUT_KVA = 24 * MiB;

constexpr int NTHREADS = 512;
constexpr int LDS_BYTES = 147456;

typedef __bf16 bf16x2_t __attribute__((ext_vector_type(2)));
__device__ __forceinline__ unsigned cvt_pk_bf16(float lo, float hi) { const f32x2 v = {lo, hi}; const bf16x2_t b = __builtin_convertvector(v, bf16x2_t); return __builtin_bit_cast(unsigned, b); }
__device__ __forceinline__ float bflo(unsigned w) { return __uint_as_float(w << 16); }
__device__ __forceinline__ float bfhi(unsigned w) { return __uint_as_float(w & 0xffff0000u); }
__device__ __forceinline__ void unpack8(const u32x4 w, float* f) {
    f[0] = bflo(w.x); f[1] = bfhi(w.x); f[2] = bflo(w.y); f[3] = bfhi(w.y); f[4] = bflo(w.z); f[5] = bfhi(w.z); f[6] = bflo(w.w); f[7] = bfhi(w.w);
}
__device__ __forceinline__ float wave_sum(float v) {
#pragma unroll
    for (int o = 1; o < 64; o <<= 1) v += __shfl_xor(v, o);
    return v;
}
__device__ __forceinline__ float dot4(const f32x4 a) { return (a[0] * a[0] + a[1] * a[1]) + (a[2] * a[2] + a[3] * a[3]); }

struct Unit { int pm, pn; };
typedef unsigned long long u64;
__device__ __forceinline__ u64 ssq_fix(float s) { const unsigned hi = (unsigned)s; const unsigned lo = (unsigned)((s - (float)hi) * 4294967296.0f); return ((u64)hi << 32) | (u64)lo; }
__device__ __forceinline__ float ssq_val(const u64 v) { return (float)(unsigned)(v >> 32) + (float)(unsigned)v * 2.3283064365386963e-10f; }
__device__ __forceinline__ float ssq_get(const u64* p, int row) { return ssq_val(p[row]); }
__device__ __forceinline__ void ssq_add(u64* p, int row, float s) { atomicAdd(p + row, ssq_fix(s)); }


template <int MODE> struct EpiScale {
    static constexpr bool PERM = false, AFTER_DRAIN = false;
    bf16_t* O; int ldc; const u64* ssq_in; float inv_n; u64* ssq_a; u64* ssq_b; const f32x2* rope;
    __device__ __forceinline__ void operator()(const f32x4 (&acc)[2][2][4][2], const Unit& u, int wr, int wc, int fr, int fq) const {
        const int cb0 = u.pn * 256 + wc * 32;
        u64 sv[2][4];
#pragma unroll
        for (int ai = 0; ai < 2; ++ai)
#pragma unroll
            for (int m = 0; m < 4; ++m) sv[ai][m] = ssq_in[u.pm * 256 + ai * 128 + wr * 64 + m * 16 + fr];
#pragma unroll
        for (int ai = 0; ai < 2; ++ai)
#pragma unroll
            for (int m = 0; m < 4; ++m) {
                const int row = u.pm * 256 + ai * 128 + wr * 64 + m * 16 + fr;
                const float r = rsqrtf(ssq_val(sv[ai][m]) * inv_n + RMS_EPS);
                const int pos = row & (SEQ - 1);
#pragma unroll
                for (int bj = 0; bj < 2; ++bj) {
                    const int cb = cb0 + 128 * bj;
                    float sc = r;
                    if (MODE == 1) sc *= QSCALE_A;
                    if (MODE == 3) { if (cb < 1024) sc *= QSCALE_C; }
                    f32x4 v0 = acc[ai][bj][m][0] * sc, v1 = acc[ai][bj][m][1] * sc;
                    bool ropeg = false;
                    if (MODE == 0) ropeg = (cb == C_KR);
                    if (MODE == 1) ropeg = ((cb % 96) == 64);
                    if (ropeg) {
#pragma unroll
                        for (int j = 0; j < 4; ++j) { const f32x2 cs = rope[pos * 16 + 4 * fq + j]; const float x1 = v0[j], x2 = v1[j]; v0[j] = x1 * cs.x - x2 * cs.y; v1[j] = x2 * cs.x + x1 * cs.y; }
                    }
                    if (MODE == 0) {
                        if (cb < C_KR) { float s = dot4(v0) + dot4(v1); s += __shfl_xor(s, 16); s += __shfl_xor(s, 32); if (fq == 0) ssq_add(cb < C_CKV ? ssq_a : ssq_b, row, s); }
                    }
                    bf16_t* p = O + (size_t)row * ldc + cb + 4 * fq;
                    u32x2 w0, w1; w0.x = cvt_pk_bf16(v0[0], v0[1]); w0.y = cvt_pk_bf16(v0[2], v0[3]); w1.x = cvt_pk_bf16(v1[0], v1[1]); w1.y = cvt_pk_bf16(v1[2], v1[3]);
                    *(u32x2*)p = w0; *(u32x2*)(p + 16) = w1;
                }
            }
    }
};

struct EpiResid {
    static constexpr bool PERM = false, AFTER_DRAIN = false;
    bf16_t* hb; u64* ssq;
    __device__ __forceinline__ void operator()(const f32x4 (&acc)[2][2][4][2], const Unit& u, int wr, int wc, int fr, int fq) const {
#pragma unroll
        for (int ai = 0; ai < 2; ++ai) {
            u32x2 b[4][2][2];
#pragma unroll
            for (int m = 0; m < 4; ++m)
#pragma unroll
                for (int bj = 0; bj < 2; ++bj)
#pragma unroll
                    for (int n = 0; n < 2; ++n) b[m][bj][n] = *(const u32x2*)(hb + (size_t)(u.pm * 256 + ai * 128 + wr * 64 + m * 16 + fr) * DM + u.pn * 256 + bj * 128 + wc * 32 + 16 * n + 4 * fq);
#pragma unroll
            for (int m = 0; m < 4; ++m) {
                const int row = u.pm * 256 + ai * 128 + wr * 64 + m * 16 + fr;
                float s = 0.f;
#pragma unroll
                for (int bj = 0; bj < 2; ++bj)
#pragma unroll
                    for (int n = 0; n < 2; ++n) {
                        const size_t off = (size_t)row * DM + u.pn * 256 + bj * 128 + wc * 32 + 16 * n + 4 * fq;
                        const f32x4 a = acc[ai][bj][m][n]; const u32x2 bb = b[m][bj][n];
                        f32x4 h; h[0] = bflo(bb.x) + a[0]; h[1] = bfhi(bb.x) + a[1]; h[2] = bflo(bb.y) + a[2]; h[3] = bfhi(bb.y) + a[3];
                        u32x2 w; w.x = cvt_pk_bf16(h[0], h[1]); w.y = cvt_pk_bf16(h[2], h[3]); *(u32x2*)(hb + off) = w;
                        s += dot4(h);
                    }
                s += __shfl_xor(s, 16); s += __shfl_xor(s, 32);
                if (fq == 0) ssq_add(ssq, row, s);
            }
            asm volatile("" ::: "memory");
        }
    }
};

struct EpiSwiglu {
    static constexpr bool PERM = true, AFTER_DRAIN = false;
    bf16_t* O; const u64* ssq_in;
    __device__ __forceinline__ void operator()(const f32x4 (&acc)[2][2][4][2], const Unit& u, int wr, int wc, int fr, int fq) const {
        u64 sv[2][4];
#pragma unroll
        for (int ai = 0; ai < 2; ++ai)
#pragma unroll
            for (int m = 0; m < 4; ++m) sv[ai][m] = ssq_in[u.pm * 256 + ai * 128 + wr * 64 + m * 16 + fr];
#pragma unroll
        for (int ai = 0; ai < 2; ++ai)
#pragma unroll
            for (int m = 0; m < 4; ++m) {
                const int row = u.pm * 256 + ai * 128 + wr * 64 + m * 16 + fr;
                const float r = rsqrtf(ssq_val(sv[ai][m]) * (1.0f / DM) + RMS_EPS);
                float a[8];
#pragma unroll
                for (int n = 0; n < 2; ++n)
#pragma unroll
                    for (int j = 0; j < 4; ++j) { const float g = acc[ai][0][m][n][j] * r, uu = acc[ai][1][m][n][j] * r; a[4 * n + j] = g * __builtin_amdgcn_rcpf(1.0f + __expf(-g)) * uu; }
                u32x4 w; w.x = cvt_pk_bf16(a[0], a[1]); w.y = cvt_pk_bf16(a[2], a[3]); w.z = cvt_pk_bf16(a[4], a[5]); w.w = cvt_pk_bf16(a[6], a[7]);
                *(u32x4*)(O + (size_t)row * DFF + u.pn * 128 + wc * 32 + 8 * fq) = w;
            }
    }
};

struct EpiFinal {
    static constexpr bool PERM = false, AFTER_DRAIN = true;
    const bf16_t* hb; u64* ssq; unsigned* cnt; const float* gfin; float* out;
    __device__ __forceinline__ void operator()(const f32x4 (&)[2][2][4][2], const Unit&, int, int, int, int) const {}
    __device__ __forceinline__ void fused(f32x4 (&acc)[2][2][4][2], const Unit& u, int wr, int wc, int fr, int fq, LAS unsigned char*, int, int) const {
#pragma unroll
        for (int ai = 0; ai < 2; ++ai) {
            u32x2 b[4][2][2];
#pragma unroll
            for (int m = 0; m < 4; ++m)
#pragma unroll
                for (int bj = 0; bj < 2; ++bj)
#pragma unroll
                    for (int n = 0; n < 2; ++n) b[m][bj][n] = *(const u32x2*)(hb + (size_t)(u.pm * 256 + ai * 128 + wr * 64 + m * 16 + fr) * DM + u.pn * 256 + bj * 128 + wc * 32 + 16 * n + 4 * fq);
#pragma unroll
            for (int m = 0; m < 4; ++m) {
                const int row = u.pm * 256 + ai * 128 + wr * 64 + m * 16 + fr;
                float s = 0.f;
#pragma unroll
                for (int bj = 0; bj < 2; ++bj)
#pragma unroll
                    for (int n = 0; n < 2; ++n) {
                        const f32x4 a = acc[ai][bj][m][n]; const u32x2 bb = b[m][bj][n];
                        f32x4 h; h[0] = bflo(bb.x) + a[0]; h[1] = bfhi(bb.x) + a[1]; h[2] = bflo(bb.y) + a[2]; h[3] = bfhi(bb.y) + a[3];
                        acc[ai][bj][m][n] = h; s += dot4(h);
                    }
                s += __shfl_xor(s, 16); s += __shfl_xor(s, 32);
                if (fq == 0) { const u64 prev = atomicAdd(ssq + row, ssq_fix(s)); asm volatile("" :: "v"(prev)); }
            }
            asm volatile("" ::: "memory");
        }
        asm volatile("s_waitcnt vmcnt(0)" ::: "memory");
        __syncthreads();
        if (threadIdx.x == 0) {
            unsigned* c = cnt + 16 * u.pm;
            __hip_atomic_fetch_add(c, 1u, __ATOMIC_RELEASE, __HIP_MEMORY_SCOPE_AGENT);
            unsigned sp = 0;
            while (__hip_atomic_load(c, __ATOMIC_RELAXED, __HIP_MEMORY_SCOPE_AGENT) < 4u) { __builtin_amdgcn_s_sleep(1); if (++sp > (1u << 22)) break; }
            __builtin_amdgcn_fence(__ATOMIC_ACQUIRE, "agent");
            asm volatile("s_waitcnt vmcnt(0)" ::: "memory");
        }
        __syncthreads();
        u64 sv[2][4];
#pragma unroll
        for (int ai = 0; ai < 2; ++ai)
#pragma unroll
            for (int m = 0; m < 4; ++m) sv[ai][m] = __hip_atomic_load(ssq + (u.pm * 256 + ai * 128 + wr * 64 + m * 16 + fr), __ATOMIC_RELAXED, __HIP_MEMORY_SCOPE_AGENT);
        f32x4 g4[2][2];
#pragma unroll
        for (int bj = 0; bj < 2; ++bj)
#pragma unroll
            for (int n = 0; n < 2; ++n) g4[bj][n] = *(const f32x4*)(gfin + u.pn * 256 + bj * 128 + wc * 32 + 16 * n + 4 * fq);
#pragma unroll
        for (int ai = 0; ai < 2; ++ai)
#pragma unroll
            for (int m = 0; m < 4; ++m) {
                const int row = u.pm * 256 + ai * 128 + wr * 64 + m * 16 + fr;
                const float r = rsqrtf(ssq_val(sv[ai][m]) * (1.0f / DM) + RMS_EPS);
#pragma unroll
                for (int bj = 0; bj < 2; ++bj)
#pragma unroll
                    for (int n = 0; n < 2; ++n) *(f32x4*)(out + (size_t)row * DM + u.pn * 256 + bj * 128 + wc * 32 + 16 * n + 4 * fq) = acc[ai][bj][m][n] * r * g4[bj][n];
            }
    }
};

__host__ __device__ __forceinline__ int perm32(int rho) { const int n = rho >> 4, i = rho & 15; return 8 * (i >> 2) + 4 * n + (i & 3); }
template <class Epi>
__device__ __forceinline__ void gemm_naive(const bf16_t* A, int lda, const bf16_t* Bt, int ldb, int nM, int nN, int K, const Epi& E) {
    constexpr bool PERM = Epi::PERM;
    const int tid = threadIdx.x, wid = tid >> 6, lane = tid & 63, wr = wid >> 2, wc = wid & 3, fr = lane & 15, fq = lane >> 4;
    for (int unit = blockIdx.x; unit < nM * nN; unit += gridDim.x) {
        Unit u; u.pm = unit / nN; u.pn = unit % nN;
        f32x4 acc[2][2][4][2];
#pragma unroll
        for (int a = 0; a < 2; ++a)
#pragma unroll
            for (int b = 0; b < 2; ++b)
#pragma unroll
                for (int m = 0; m < 4; ++m)
#pragma unroll
                    for (int n = 0; n < 2; ++n) acc[a][b][m][n] = (f32x4){0.f, 0.f, 0.f, 0.f};
        const bf16_t* Ab = A + (size_t)(u.pm * 256 + wr * 64 + fr) * lda + 8 * fq;
        const bf16_t* Bb = Bt + (size_t)(u.pn * 256 + wc * 32) * ldb + 8 * fq;
        const int br0 = PERM ? perm32(fr) : fr, br1 = PERM ? perm32(16 + fr) : 16 + fr;
        for (int k0 = 0; k0 < K; k0 += 32) {
            bf16x8 af[2][4], bq[2][2];
#pragma unroll
            for (int ai = 0; ai < 2; ++ai)
#pragma unroll
                for (int m = 0; m < 4; ++m) af[ai][m] = *(const bf16x8*)(Ab + (size_t)(ai * 128 + m * 16) * lda + k0);
#pragma unroll
            for (int bj = 0; bj < 2; ++bj) { bq[bj][0] = *(const bf16x8*)(Bb + (size_t)(bj * 128 + br0) * ldb + k0); bq[bj][1] = *(const bf16x8*)(Bb + (size_t)(bj * 128 + br1) * ldb + k0); }
#pragma unroll
            for (int ai = 0; ai < 2; ++ai)
#pragma unroll
                for (int bj = 0; bj < 2; ++bj)
#pragma unroll
                    for (int m = 0; m < 4; ++m)
#pragma unroll
                        for (int n = 0; n < 2; ++n) acc[ai][bj][m][n] = __builtin_amdgcn_mfma_f32_16x16x32_bf16(bq[bj][n], af[ai][m], acc[ai][bj][m][n], 0, 0, 0);
        }
        E(acc, u, wr, wc, fr, fq);
    }
}

#define PG8_LAS __attribute__((address_space(3)))
constexpr int BM = 256, BK = 64, HALF = 128, HTB = HALF * BK * 2  , STAGE_BYTES = 8 * HTB, NXCD = 8, WGM = 8;
__host__ __device__ __forceinline__ int lds_byte(int r, int c) { const int st = (r >> 4) * 2 + (c >> 5), rr = r & 15, cc = c & 31, ob = rr * 64 + cc * 2; return st * 1024 + (ob ^ (((ob >> 9) & 1) << 5)); }
__host__ __device__ __forceinline__ void stage_rc(int b, int& R, int& C) { const int st = b / 1024, sb = b % 1024, swz = sb ^ (((sb >> 9) & 1) << 5); R = (st >> 1) * 16 + swz / 64; C = (st & 1) * 32 + (swz % 64) / 2; }
struct Gemm { const bf16_t* A; const bf16_t* Bt; int M, N, K, lda, ldb; };
struct StaticOrder {
    int nM, nN, nwg, G, c;
    __host__ __device__ void init(int M, int N, int G_, int c_) { nM = M / BM; nN = N / BM; nwg = nM * nN; G = G_; c = c_; }
    __host__ __device__ bool next(int i, Unit& u) const {
        const long L = (long)i * G + c; if (L >= nwg) return false;
        int wgid = (int)L; { const int q = nwg / NXCD, r = nwg % NXCD, xcd = wgid % NXCD, off = wgid / NXCD; wgid = (xcd < r ? xcd * (q + 1) : r * (q + 1) + (xcd - r) * q) + off; }
        const int nig = WGM * nN, gid = wgid / nig, fm = gid * WGM, gsz = (nM - fm) < WGM ? (nM - fm) : WGM;
        u.pm = fm + ((wgid % nig) % gsz); u.pn = (wgid % nig) / gsz; return true;
    }
    __device__ __forceinline__ void a_ready(const Unit&) const {}
    __device__ __forceinline__ void done(const Unit&) const {}
};
template <class Epi, class Sched, bool ALIGN_EPI = false, bool SP2 = false>
__device__ __forceinline__ void gemm_phase(PG8_LAS unsigned char* lds, const Gemm g, const Sched& S, const Epi& E) {
    int tid_ = threadIdx.x; asm volatile("" : "+v"(tid_));
    const int tid = tid_, wid = __builtin_amdgcn_readfirstlane(tid >> 6), lane = tid & 63, wr = wid >> 2, wc = wid & 3, fr = lane & 15, fq = lane >> 4;
    const int K = g.K, nt = K / BK;
    unsigned voffA[2], voffB[2];
#pragma unroll
    for (int i = 0; i < 2; ++i) { int R, C; stage_rc(tid * 16 + i * 8192, R, C); const int Rb = Epi::PERM ? ((R & ~31) + perm32(R & 31)) : R;
        voffA[i] = (unsigned)(R * g.lda + C) * 2u; voffB[i] = (unsigned)(Rb * g.ldb + C) * 2u; }
    const size_t kstep = (size_t)(BK * 2);
    const size_t hstepA = (size_t)HALF * g.lda * 2, hstepB = (size_t)HALF * g.ldb * 2;
    const size_t tstepA = 2 * hstepA, tstepB = 2 * hstepB;
    const unsigned ldsw = (unsigned)wid * 1024u;
    const int aoff = lds_byte(wr * 64 + fr, fq * 8), boff = lds_byte(wc * 32 + fr, fq * 8);
#define PG8_SA(b, h) (((b) * 2 + (h)) * HTB)
#define PG8_SB(b, h) ((4 + (b) * 2 + (h)) * HTB)
#define PG8_STAGE(bufoff, gbase, voff) do { _Pragma("unroll") for (int _i = 0; _i < 2; ++_i) \
        __builtin_amdgcn_global_load_lds((const unsigned*)((const char*)(gbase) + (voff)[_i]), (PG8_LAS unsigned*)(lds + (bufoff) + ldsw + _i * 8192), 16, 0, 0); } while (0)
#define PG8_LDA(dst, b, h) do { _Pragma("unroll") for (int m = 0; m < 4; ++m) _Pragma("unroll") for (int k = 0; k < 2; ++k) dst[m][k] = *(const PG8_LAS bf16x8*)(lds + PG8_SA(b, h) + aoff + m * 2048 + k * 1024); } while (0)
#define PG8_LDB(dst, b, h) do { _Pragma("unroll") for (int n = 0; n < 2; ++n) _Pragma("unroll") for (int k = 0; k < 2; ++k) dst[n][k] = *(const PG8_LAS bf16x8*)(lds + PG8_SB(b, h) + boff + n * 2048 + k * 1024); } while (0)
#define PG8_MMA(ai, bj, At, Bt) do { __builtin_amdgcn_s_setprio(1); _Pragma("unroll") for (int m = 0; m < 4; ++m) _Pragma("unroll") for (int n = 0; n < 2; ++n) _Pragma("unroll") for (int k = 0; k < 2; ++k) \
        acc[ai][bj][m][n] = __builtin_amdgcn_mfma_f32_16x16x32_bf16(Bt[n][k], At[m][k], acc[ai][bj][m][n], 0, 0, 0); __builtin_amdgcn_s_setprio(0); } while (0)
#define PG8_WAIT_V(n) asm volatile("s_waitcnt vmcnt(" #n ")" ::: "memory")
#define PG8_WAIT_L(n) asm volatile("s_waitcnt lgkmcnt(" #n ")" ::: "memory")
#define PG8_BAR __builtin_amdgcn_s_barrier()
#define PG8_SCHED __builtin_amdgcn_sched_barrier(0)
    Unit cur, nxt; int ui = 0;
    if (!S.next(0, cur)) return;
    f32x4 acc[2][2][4][2];
#pragma unroll
    for (int a = 0; a < 2; ++a)
#pragma unroll
        for (int b = 0; b < 2; ++b)
#pragma unroll
            for (int m = 0; m < 4; ++m)
#pragma unroll
                for (int n = 0; n < 2; ++n) acc[a][b][m][n] = (f32x4){0.f, 0.f, 0.f, 0.f};
    bf16x8 At[4][2], B0[2][2], B1[2][2];
    const char* cA = (const char*)g.A + (size_t)cur.pm * tstepA; const char* cB = (const char*)g.Bt + (size_t)cur.pn * tstepB;
    S.a_ready(cur);
    if constexpr (SP2) {
        PG8_STAGE(PG8_SB(0, 0), cB, voffB); PG8_STAGE(PG8_SB(0, 1), cB + hstepB, voffB); PG8_STAGE(PG8_SA(0, 0), cA, voffA); PG8_STAGE(PG8_SA(0, 1), cA + hstepA, voffA);
        if (wr == 1) PG8_BAR;
        PG8_WAIT_V(2); PG8_BAR;
        PG8_STAGE(PG8_SB(1, 0), cB + kstep, voffB); PG8_STAGE(PG8_SA(1, 0), cA + kstep, voffA); PG8_STAGE(PG8_SB(1, 1), cB + hstepB + kstep, voffB);
        PG8_WAIT_V(6); PG8_BAR;
    } else {
        PG8_STAGE(PG8_SB(0, 0), cB, voffB); PG8_STAGE(PG8_SA(0, 0), cA, voffA); PG8_STAGE(PG8_SB(0, 1), cB + hstepB, voffB); PG8_STAGE(PG8_SA(0, 1), cA + hstepA, voffA);
        if (wr == 1) PG8_BAR;
        PG8_WAIT_V(4); PG8_BAR;
        PG8_STAGE(PG8_SB(1, 0), cB + kstep, voffB); PG8_STAGE(PG8_SA(1, 0), cA + kstep, voffA); PG8_STAGE(PG8_SB(1, 1), cB + hstepB + kstep, voffB);
        PG8_WAIT_V(6); PG8_BAR;
    }
    for (;;) {
        const bool has_next = S.next(ui + 1, nxt);
        const char* nA = has_next ? (const char*)g.A + (size_t)nxt.pm * tstepA : cA; const char* nB = has_next ? (const char*)g.Bt + (size_t)nxt.pn * tstepB : cB;
#pragma clang loop unroll(disable)
        for (int t = 0; t < nt; t += 2) {
            const bool last = (t == nt - 2);
            const char* a1 = cA + (size_t)(t + 1) * kstep;
            const char* a2 = last ? nA : cA + (size_t)(t + 2) * kstep; const char* b2 = last ? nB : cB + (size_t)(t + 2) * kstep;
            const char* a3 = a2 + kstep; const char* b3 = b2 + kstep;
            if (last && has_next) S.a_ready(nxt);
            if constexpr (SP2) {
            PG8_LDB(B0, 0, 0); PG8_LDB(B1, 0, 1); PG8_SCHED; PG8_LDA(At, 0, 0); PG8_STAGE(PG8_SA(1, 1), a1 + hstepA, voffA);
            PG8_WAIT_V(8); PG8_WAIT_L(0); PG8_BAR; PG8_MMA(0, 0, At, B0); PG8_MMA(0, 1, At, B1); PG8_BAR; PG8_SCHED;
            PG8_LDA(At, 0, 1); PG8_STAGE(PG8_SB(0, 0), b2, voffB); PG8_STAGE(PG8_SB(0, 1), b2 + hstepB, voffB); PG8_STAGE(PG8_SA(0, 0), a2, voffA);
            PG8_WAIT_V(8); PG8_WAIT_L(0); PG8_BAR; PG8_MMA(1, 0, At, B0); PG8_MMA(1, 1, At, B1); PG8_BAR; PG8_SCHED;
            PG8_LDB(B0, 1, 0); PG8_LDB(B1, 1, 1); PG8_SCHED; PG8_LDA(At, 1, 0); PG8_STAGE(PG8_SA(0, 1), a2 + hstepA, voffA);
            PG8_WAIT_V(8); PG8_WAIT_L(0); PG8_BAR; PG8_MMA(0, 0, At, B0); PG8_MMA(0, 1, At, B1); PG8_BAR; PG8_SCHED;
            PG8_LDA(At, 1, 1); PG8_STAGE(PG8_SB(1, 0), b3, voffB); PG8_STAGE(PG8_SB(1, 1), b3 + hstepB, voffB); PG8_STAGE(PG8_SA(1, 0), a3, voffA);
            PG8_WAIT_V(8); PG8_WAIT_L(0); PG8_BAR; PG8_MMA(1, 0, At, B0); PG8_MMA(1, 1, At, B1); PG8_BAR; PG8_SCHED;
            } else {
            PG8_LDB(B0, 0, 0); PG8_SCHED; PG8_LDA(At, 0, 0); PG8_STAGE(PG8_SA(1, 1), a1 + hstepA, voffA);
            PG8_WAIT_L(8); PG8_BAR; PG8_WAIT_L(0); PG8_MMA(0, 0, At, B0); PG8_BAR; PG8_SCHED;
            PG8_LDB(B1, 0, 1); PG8_STAGE(PG8_SB(0, 0), b2, voffB);
            PG8_BAR; PG8_WAIT_L(0); PG8_MMA(0, 1, At, B1); PG8_BAR;
            PG8_LDA(At, 0, 1); PG8_STAGE(PG8_SA(0, 0), a2, voffA);
            PG8_BAR; PG8_WAIT_L(0); PG8_MMA(1, 0, At, B0); PG8_BAR; PG8_SCHED;
            PG8_STAGE(PG8_SB(0, 1), b2 + hstepB, voffB);
            PG8_WAIT_V(6); PG8_BAR; PG8_MMA(1, 1, At, B1); PG8_BAR;
            PG8_LDB(B0, 1, 0); PG8_SCHED; PG8_LDA(At, 1, 0); PG8_STAGE(PG8_SA(0, 1), a2 + hstepA, voffA);
            PG8_WAIT_L(8); PG8_BAR; PG8_WAIT_L(0); PG8_MMA(0, 0, At, B0); PG8_BAR; PG8_SCHED;
            PG8_LDB(B1, 1, 1); PG8_STAGE(PG8_SB(1, 0), b3, voffB);
            PG8_BAR; PG8_WAIT_L(0); PG8_MMA(0, 1, At, B1); PG8_BAR;
            PG8_LDA(At, 1, 1); PG8_STAGE(PG8_SA(1, 0), a3, voffA);
            PG8_BAR; PG8_WAIT_L(0); PG8_MMA(1, 0, At, B0); PG8_BAR; PG8_SCHED;
            PG8_STAGE(PG8_SB(1, 1), b3 + hstepB, voffB);
            PG8_WAIT_V(6); PG8_BAR; PG8_MMA(1, 1, At, B1); PG8_BAR;
            }
        }
        if constexpr (ALIGN_EPI) { if (wr == 0) PG8_BAR; }
        if constexpr (!Epi::AFTER_DRAIN) { E(acc, cur, wr, wc, fr, fq); S.done(cur); }
        if (!has_next) break;
#pragma unroll
        for (int a = 0; a < 2; ++a)
#pragma unroll
            for (int b = 0; b < 2; ++b)
#pragma unroll
                for (int m = 0; m < 4; ++m)
#pragma unroll
                    for (int n = 0; n < 2; ++n) acc[a][b][m][n] = (f32x4){0.f, 0.f, 0.f, 0.f};
        cur = nxt; cA = nA; cB = nB; ++ui;
        if constexpr (ALIGN_EPI) { if (wr == 1) PG8_BAR; }
    }
    PG8_WAIT_V(0);
    if constexpr (!ALIGN_EPI) { if (wr == 0) PG8_BAR; }
    PG8_BAR;
    if constexpr (Epi::AFTER_DRAIN) { E.fused(acc, cur, wr, wc, fr, fq, lds, wid, lane); S.done(cur); }
#undef PG8_SA
#undef PG8_SB
#undef PG8_STAGE
#undef PG8_LDA
#undef PG8_LDB
#undef PG8_MMA
#undef PG8_WAIT_V
#undef PG8_WAIT_L
#undef PG8_BAR
#undef PG8_SCHED
}
template <class Epi>
__device__ __forceinline__ void gemm_fast(LAS unsigned char* lds, const bf16_t* A, int lda, const bf16_t* Bt, int ldb, int M, int N, int K, const Epi& E) {
    Gemm g{A, Bt, M, N, K, lda, ldb}; StaticOrder S; S.init(M, N, (int)gridDim.x, (int)blockIdx.x);
    gemm_phase<Epi, StaticOrder, !Epi::AFTER_DRAIN, true>(lds, g, S, E);
}

__device__ __forceinline__ void p0_item(const float* W, int K, int N, const float* g, bf16_t* WT, int ldt, int mode, LAS float* scr, int item, int lane) {
    const int nblk = N / 32, kb = item / nblk, nb = item % nblk, k0 = 64 * kb, n0 = 32 * nb;
    { const int kr = lane >> 3, ch = lane & 7; f32x4 v[8];
#pragma unroll
      for (int i = 0; i < 8; ++i) v[i] = *(const f32x4*)(W + (size_t)(k0 + 8 * i + kr) * N + n0 + 4 * ch);
#pragma unroll
      for (int i = 0; i < 8; ++i) { const int kk = 8 * i + kr; const float gs = g ? g[k0 + kk] : 1.0f; LAS float* d = scr + kk * 33 + 4 * ch; d[0] = v[i][0] * gs; d[1] = v[i][1] * gs; d[2] = v[i][2] * gs; d[3] = v[i][3] * gs; } }
    asm volatile("s_waitcnt lgkmcnt(0)" ::: "memory");
    const int c = lane & 7;
#pragma unroll
    for (int j = 0; j < 4; ++j) {
        const int n = (lane >> 3) + 8 * j; const LAS float* s = scr + (8 * c) * 33 + n;
        u32x4 o; o.x = cvt_pk_bf16(s[0 * 33], s[1 * 33]); o.y = cvt_pk_bf16(s[2 * 33], s[3 * 33]); o.z = cvt_pk_bf16(s[4 * 33], s[5 * 33]); o.w = cvt_pk_bf16(s[6 * 33], s[7 * 33]);
        const int nn = n0 + n; const int row = (mode == 0) ? nn : ((nn >> 7) * 256 + (mode == 2 ? 128 : 0) + (nn & 127));
        *(u32x4*)(WT + (size_t)row * ldt + k0 + 8 * c) = o;
    }
    asm volatile("s_waitcnt lgkmcnt(0)" ::: "memory");
}


typedef float f32x16 __attribute__((ext_vector_type(16)));
constexpr int AT_VSTR = 72;
constexpr int AT_KBUF = 64 * 104 * 2, AT_VBUF = 64 * AT_VSTR * 2;
constexpr int AT_OFF_K = 0, AT_OFF_V = 2 * AT_KBUF, AT_OFF_BIAS = 2 * AT_KBUF + 2 * AT_VBUF, AT_OFF_FLAG = AT_OFF_BIAS + 2304;
__device__ __forceinline__ int crow16(int r, int hi) { return (r & 3) + 8 * (r >> 2) + 4 * hi; }
__device__ __forceinline__ int vperm(int key) { const int k16 = key & 15; return (key & ~15) + 8 * ((k16 >> 2) & 1) + 4 * (k16 >> 3) + (k16 & 3); }
__device__ __forceinline__ bf16x8 pack8(float a0, float a1, float a2, float a3, float a4, float a5, float a6, float a7) {
    u32x4 w; w.x = cvt_pk_bf16(a0, a1); w.y = cvt_pk_bf16(a2, a3); w.z = cvt_pk_bf16(a4, a5); w.w = cvt_pk_bf16(a6, a7); return __builtin_bit_cast(bf16x8, w);
}

__device__ __forceinline__ float max3f(float a, float b, float c) { return __builtin_fmaxf(__builtin_fmaxf(a, b), c); }
template <int MODE>
__device__ __forceinline__ void attn_unit(LAS unsigned char* lds, int q0, const bf16_t* Qp, int ldq, const bf16_t* Kp, int ldk, const bf16_t* Krp, int ldkr, const bf16_t* Vp, int ldv, bf16_t* Op, const float* bias_g) {
    constexpr int DQK = (MODE == 0) ? 96 : 64, NDD = DQK / 16, KSTR = DQK + 8;
    int tid_ = threadIdx.x; asm volatile("" : "+v"(tid_));
    const int tid = tid_, lane = tid & 63, wid = __builtin_amdgcn_readfirstlane(tid >> 6), l31 = lane & 31, hi = lane >> 5;
    const int t0w = q0 + 32 * wid, trow = t0w + l31, nq = t0w >> 6;
    LAS float* biasl = (LAS float*)(lds + AT_OFF_BIAS);
    LAS int* flags = (LAS int*)(lds + AT_OFF_FLAG);
    if (MODE == 2) { for (int i = tid; i < 513; i += NTHREADS) biasl[i] = bias_g[i] * LOG2E; }
    bf16x8 qf[NDD];
#pragma unroll
    for (int dd = 0; dd < NDD; ++dd) qf[dd] = *(const bf16x8*)(Qp + (size_t)trow * ldq + 16 * dd + 8 * hi);
    f32x16 o0, o1;
#pragma unroll
    for (int r = 0; r < 16; ++r) { o0[r] = 0.f; o1[r] = 0.f; }
    float mref = 0.f, lrow = 0.f, carry = 0.f; bool first = true;
    f32x16 negm;
#pragma unroll
    for (int r = 0; r < 16; ++r) negm[r] = 0.f;
    const int kt_hi = (q0 + 255) >> 6;
    int kt_lo = 0; if (MODE == 2) { kt_lo = (q0 >> 6) - 8; if (kt_lo < 0) kt_lo = 0; }
    const int nt = kt_hi - kt_lo + 1;
    const int skey = tid >> 3, sch = tid & 7, rkey = tid >> 2, rch = tid & 3;
    const int vcol = vperm(lane);
    u32x4 kreg, krreg, vreg;
#define AT_KT(i) ((MODE == 1) ? (kt_hi - (i)) : (kt_lo + (i)))
#define AT_LOAD(kt) do { const size_t kb_ = (size_t)(kt) * 64; \
        kreg = *(const u32x4*)(Kp + (kb_ + skey) * ldk + sch * 8); \
        if (MODE == 0) { if (tid < 256) krreg = *(const u32x4*)(Krp + (kb_ + rkey) * ldkr + rch * 8); } \
        vreg = *(const u32x4*)(Vp + (kb_ + lane) * ldv + wid * 8); } while (0)
#define AT_STORE(bufi) do { LAS bf16_t* Ks_ = (LAS bf16_t*)(lds + AT_OFF_K + (bufi) * AT_KBUF); LAS bf16_t* Vt_ = (LAS bf16_t*)(lds + AT_OFF_V + (bufi) * AT_VBUF); \
        *(LAS u32x4*)(Ks_ + skey * KSTR + sch * 8) = kreg; \
        if (MODE == 0) { if (tid < 256) *(LAS u32x4*)(Ks_ + rkey * KSTR + 64 + rch * 8) = krreg; } \
        LAS bf16_t* vd_ = Vt_ + (wid * 8) * AT_VSTR + vcol; \
        vd_[0 * AT_VSTR] = (bf16_t)(vreg.x & 0xffffu); vd_[1 * AT_VSTR] = (bf16_t)(vreg.x >> 16); vd_[2 * AT_VSTR] = (bf16_t)(vreg.y & 0xffffu); vd_[3 * AT_VSTR] = (bf16_t)(vreg.y >> 16); \
        vd_[4 * AT_VSTR] = (bf16_t)(vreg.z & 0xffffu); vd_[5 * AT_VSTR] = (bf16_t)(vreg.z >> 16); vd_[6 * AT_VSTR] = (bf16_t)(vreg.w & 0xffffu); vd_[7 * AT_VSTR] = (bf16_t)(vreg.w >> 16); } while (0)
    AT_LOAD(AT_KT(0)); AT_STORE(0);
    __syncthreads();
    for (int i = 0; i < nt; ++i) {
        const int kt = AT_KT(i);
        if (i + 1 < nt) AT_LOAD(AT_KT(i + 1));
        bool part;
        if (MODE == 0) part = (kt <= nq);
        else if (MODE == 1) part = (64 * kt <= t0w + 30);
        else part = (kt <= nq) && (kt >= nq - 8);
        if (part) {
            const LAS bf16_t* Ks = (const LAS bf16_t*)(lds + AT_OFF_K + (i & 1) * AT_KBUF); const LAS bf16_t* Vt = (const LAS bf16_t*)(lds + AT_OFF_V + (i & 1) * AT_VBUF);
            f32x16 p0, p1;
            if (MODE == 1) {
#pragma unroll
                for (int r = 0; r < 16; ++r) { p0[r] = 0.f; p1[r] = 0.f; }
            } else { p0 = negm; p1 = negm; }
            bf16x8 ka[NDD], kb[NDD], va[4], vb[4];
            constexpr int NH = (NDD > 4) ? 4 : NDD;
#pragma unroll
            for (int dd = 0; dd < NH; ++dd) { ka[dd] = *(const LAS bf16x8*)(Ks + l31 * KSTR + 16 * dd + 8 * hi); kb[dd] = *(const LAS bf16x8*)(Ks + (32 + l31) * KSTR + 16 * dd + 8 * hi); }
            __builtin_amdgcn_sched_barrier(0);
#pragma unroll
            for (int dd = 0; dd < NH; ++dd) { p0 = __builtin_amdgcn_mfma_f32_32x32x16_bf16(ka[dd], qf[dd], p0, 0, 0, 0); p1 = __builtin_amdgcn_mfma_f32_32x32x16_bf16(kb[dd], qf[dd], p1, 0, 0, 0);
                if (dd == 0) {
#pragma unroll
                    for (int d2 = NH; d2 < NDD; ++d2) { ka[d2] = *(const LAS bf16x8*)(Ks + l31 * KSTR + 16 * d2 + 8 * hi); kb[d2] = *(const LAS bf16x8*)(Ks + (32 + l31) * KSTR + 16 * d2 + 8 * hi); }
                } }
#pragma unroll
            for (int dd = NH; dd < NDD; ++dd) { p0 = __builtin_amdgcn_mfma_f32_32x32x16_bf16(ka[dd], qf[dd], p0, 0, 0, 0); p1 = __builtin_amdgcn_mfma_f32_32x32x16_bf16(kb[dd], qf[dd], p1, 0, 0, 0); }
            __builtin_amdgcn_sched_barrier(0);
#pragma unroll
            for (int jj = 0; jj < 4; ++jj) { va[jj] = *(const LAS bf16x8*)(Vt + l31 * AT_VSTR + 8 * hi + 16 * jj); vb[jj] = *(const LAS bf16x8*)(Vt + (32 + l31) * AT_VSTR + 8 * hi + 16 * jj); }
            __builtin_amdgcn_sched_barrier(0);
            if (MODE != 1) {
                if (MODE == 2) {
                    if (nq - kt >= 5) { const float cb = biasl[512];
#pragma unroll
                        for (int r = 0; r < 16; ++r) { p0[r] += cb; p1[r] += cb; }
                    } else {
                        const int relb = trow - 64 * kt - 4 * hi;
#pragma unroll
                        for (int r = 0; r < 16; ++r) {
                            int rel0 = relb - ((r & 3) + 8 * (r >> 2)); int rel1 = rel0 - 32;
                            rel0 = rel0 > 256 ? 256 : rel0; rel1 = rel1 > 256 ? 256 : rel1;
                            p0[r] += biasl[256 + rel0]; p1[r] += biasl[256 + rel1];
                        }
                    }
                }
                float mx = max3f(p0[0], p1[0], p0[1]);
#pragma unroll
                for (int r = 1; r < 15; r += 2) { mx = max3f(mx, p1[r], p0[r + 1]); mx = max3f(mx, p1[r + 1], p0[(r + 2 > 15) ? 15 : (r + 2)]); }
                mx = fmaxf(mx, p1[15]);
                mx = fmaxf(mx, __shfl_xor(mx, 32));
                if (first || __any(mx > 8.0f)) {
                    const float dl = first ? mx : fmaxf(mx, 0.f);
                    mref += dl;
#pragma unroll
                    for (int r = 0; r < 16; ++r) { p0[r] -= dl; p1[r] -= dl; }
                    if (!first) { const float f = __builtin_amdgcn_exp2f(-dl); lrow *= f;
#pragma unroll
                        for (int r = 0; r < 16; ++r) { o0[r] *= f; o1[r] *= f; } }
#pragma unroll
                    for (int r = 0; r < 16; ++r) negm[r] = -mref;
                    first = false;
                }
                float rs = 0.f;
#pragma unroll
                for (int r = 0; r < 16; ++r) { p0[r] = __builtin_amdgcn_exp2f(p0[r]); p1[r] = __builtin_amdgcn_exp2f(p1[r]); rs += p0[r] + p1[r]; }
                lrow += rs;
            } else {
                const bool need_mask = (64 * kt + 63 >= t0w);
                const int kvb = 64 * kt + 4 * hi;
                float gs[8], lkq0[16], lkq1[16];
#pragma unroll
                for (int g = 0; g < 8; ++g) {
                    float s4 = 0.f;
#pragma unroll
                    for (int c = 0; c < 4; ++c) {
                        const int r = 4 * (g & 3) + c;
                        const float z2 = ((g < 4) ? p0[r] : p1[r]) * (0.125f * LOG2E);
                        const float sp2 = fmaxf(z2, 0.f) + __builtin_amdgcn_logf(1.0f + __builtin_amdgcn_exp2f(-fabsf(z2)));
                        const bool valid = !need_mask || (kvb + 8 * g + c < trow);
                        const float lk = valid ? -sp2 : 0.f;
                        const float ls = valid ? (z2 - sp2) : -1e30f;
                        if (g < 4) { p0[r] = ls; } else { p1[r] = ls; }
                        s4 += lk;
                        if (g < 4) { lkq0[r] = lk; } else { lkq1[r] = lk; }
                    }
                    gs[g] = s4;
                }
                float run = 0.f, after[8];
#pragma unroll
                for (int g = 7; g >= 0; --g) { const float pg = __shfl_xor(gs[g], 32); after[g] = run + (hi == 0 ? pg : 0.f); run += gs[g] + pg; }
#pragma unroll
                for (int g = 0; g < 8; ++g) {
                    float suf = carry + after[g];
#pragma unroll
                    for (int c = 3; c >= 0; --c) {
                        const int r = 4 * (g & 3) + c;
                        if (g < 4) { p0[r] = __builtin_amdgcn_exp2f(p0[r] + suf); suf += lkq0[r]; } else { p1[r] = __builtin_amdgcn_exp2f(p1[r] + suf); suf += lkq1[r]; }
                    }
                }
                carry += run;
            }
            const bf16x8 pb0 = pack8(p0[0], p0[1], p0[2], p0[3], p0[4], p0[5], p0[6], p0[7]), pb1 = pack8(p0[8], p0[9], p0[10], p0[11], p0[12], p0[13], p0[14], p0[15]);
            const bf16x8 pb2 = pack8(p1[0], p1[1], p1[2], p1[3], p1[4], p1[5], p1[6], p1[7]), pb3 = pack8(p1[8], p1[9], p1[10], p1[11], p1[12], p1[13], p1[14], p1[15]);
            o0 = __builtin_amdgcn_mfma_f32_32x32x16_bf16(va[0], pb0, o0, 0, 0, 0); o1 = __builtin_amdgcn_mfma_f32_32x32x16_bf16(vb[0], pb0, o1, 0, 0, 0);
            o0 = __builtin_amdgcn_mfma_f32_32x32x16_bf16(va[1], pb1, o0, 0, 0, 0); o1 = __builtin_amdgcn_mfma_f32_32x32x16_bf16(vb[1], pb1, o1, 0, 0, 0);
            o0 = __builtin_amdgcn_mfma_f32_32x32x16_bf16(va[2], pb2, o0, 0, 0, 0); o1 = __builtin_amdgcn_mfma_f32_32x32x16_bf16(vb[2], pb2, o1, 0, 0, 0);
            o0 = __builtin_amdgcn_mfma_f32_32x32x16_bf16(va[3], pb3, o0, 0, 0, 0); o1 = __builtin_amdgcn_mfma_f32_32x32x16_bf16(vb[3], pb3, o1, 0, 0, 0);
        }
        if (i + 1 < nt) AT_STORE((i + 1) & 1);
        if (MODE == 1) { const int done = __all(carry < -151.0f) ? 1 : 0; if (lane == 0) flags[(i & 1) * 8 + wid] = done; }
        __syncthreads();
        if (MODE == 1) {
            int alld = 1;
#pragma unroll
            for (int w8 = 0; w8 < 8; ++w8) alld &= flags[(i & 1) * 8 + w8];
            if (alld) break;
        }
    }
    if (MODE == 1) __syncthreads();
    float inv = 1.0f;
    if (MODE != 1) { const float lt = lrow + __shfl_xor(lrow, 32); inv = 1.0f / lt; }
    bf16_t* orow = Op + (size_t)trow * DM + 4 * hi;
#pragma unroll
    for (int g = 0; g < 4; ++g) {
        u32x2 w0, w1;
        w0.x = cvt_pk_bf16(o0[4 * g] * inv, o0[4 * g + 1] * inv); w0.y = cvt_pk_bf16(o0[4 * g + 2] * inv, o0[4 * g + 3] * inv);
        w1.x = cvt_pk_bf16(o1[4 * g] * inv, o1[4 * g + 1] * inv); w1.y = cvt_pk_bf16(o1[4 * g + 2] * inv, o1[4 * g + 3] * inv);
        *(u32x2*)(orow + 8 * g) = w0; *(u32x2*)(orow + 32 + 8 * g) = w1;
    }
#undef AT_KT
#undef AT_LOAD
#undef AT_STORE
}


#define XB_TMO      128
#define XB_XCNT(j)  (256  + 64 * (j))
#define XB_XSUB(j)  (1280 + 64 * (j))
#define XB_XGEN(j)  (2304 + 64 * (j))
#define XB_TOP      3328
#define XB_TOPGEN   3392
#define XCD_BAR_WORDS 3456
#define XB_SPIN_CAP (1u << 18)
__device__ __forceinline__ unsigned xb_ld(unsigned* p)              { return __hip_atomic_load(p, __ATOMIC_RELAXED, __HIP_MEMORY_SCOPE_AGENT); }
__device__ __forceinline__ unsigned xb_add(unsigned* p, unsigned v) { return __hip_atomic_fetch_add(p, v, __ATOMIC_RELAXED, __HIP_MEMORY_SCOPE_AGENT); }
__device__ __forceinline__ unsigned xb_xcc_id() { return (unsigned)__builtin_amdgcn_s_getreg((3 << 11) | 20) & 0xFu; }
#define XB_SPIN(cond, bar) do { unsigned _sp = 0; while (cond) { __builtin_amdgcn_s_sleep(1); \
    if ((++_sp & 255u) == 0u) { if (xb_ld(&(bar)[XB_TMO])) break; if (_sp > XB_SPIN_CAP) { atomicAdd(&(bar)[XB_TMO], 1u); break; } } } } while (0)
struct XcdBarrier { unsigned* bar; unsigned x; volatile LAS unsigned* st; };
__device__ __forceinline__ XcdBarrier xcd_barrier_post(unsigned* bar, volatile LAS unsigned* st) {
    XcdBarrier b; b.bar = bar; b.x = xb_xcc_id(); b.st = st;
    if (threadIdx.x == 0) (void)xb_add(&bar[XB_XCNT(b.x)], 1u);
    return b;
}
__device__ __forceinline__ void xcd_barrier_complete(unsigned* bar, unsigned x, unsigned& nloc, unsigned& nx) {
    const unsigned G = gridDim.x * gridDim.y * gridDim.z;
    unsigned sum, cnt, mine, sp = 0u;
    for (;;) {
        sum = 0u; cnt = 0u; mine = 0u;
#pragma unroll
        for (unsigned j = 0; j < 16; ++j) { const unsigned c = xb_ld(&bar[XB_XCNT(j)]); sum += c; cnt += (c > 0u) ? 1u : 0u; mine = (j == x) ? c : mine; }
        if (sum == G) break;
        __builtin_amdgcn_s_sleep(1);
        if ((++sp & 255u) == 0u) { if (xb_ld(&bar[XB_TMO])) break; if (sp > XB_SPIN_CAP) { atomicAdd(&bar[XB_TMO], 1u); break; } }
    }
    nloc = mine > 0u ? mine : 1u; nx = cnt > 0u ? cnt : 1u;
}
__device__ __forceinline__ void xcd_barrier(const XcdBarrier& b) {
    asm volatile("s_waitcnt vmcnt(0)" ::: "memory");
    __syncthreads();
    if (threadIdx.x == 0) {
        unsigned* bar = b.bar;
        __builtin_amdgcn_s_waitcnt(0);
        unsigned nloc = b.st[0], nx = b.st[1];
        if (nloc == 0u) { xcd_barrier_complete(bar, b.x, nloc, nx); b.st[0] = nloc; b.st[1] = nx; }
        const unsigned old = xb_add(&bar[XB_XSUB(b.x)], 1u);
        const unsigned gen = old / nloc;
        if (old + 1u == (gen + 1u) * nloc) {
            __builtin_amdgcn_fence(__ATOMIC_RELEASE, "agent");
            asm volatile("s_waitcnt vmcnt(0)" ::: "memory");
            const unsigned og = xb_add(&bar[XB_TOP], 1u);
            const unsigned tg = og / nx;
            if (og + 1u == (tg + 1u) * nx) xb_add(&bar[XB_TOPGEN], 1u);
            else XB_SPIN(xb_ld(&bar[XB_TOPGEN]) == tg, bar);
            __builtin_amdgcn_fence(__ATOMIC_ACQUIRE, "agent");
            xb_add(&bar[XB_XGEN(b.x)], 1u);
            asm volatile("s_waitcnt vmcnt(0)" ::: "memory");
        } else {
            XB_SPIN(xb_ld(&bar[XB_XGEN(b.x)]) == gen, bar);
            __builtin_amdgcn_fence(__ATOMIC_ACQUIRE, "agent");
            asm volatile("s_waitcnt vmcnt(0)" ::: "memory");
        }
    }
    __syncthreads();
}

struct Args { const float* in[16]; float* out; unsigned char* ws; };

__device__ __forceinline__ void attn_mla_naive(const bf16_t* QA, const bf16_t* KVA, const bf16_t* PROJ, bf16_t* O) {
    const int nth = gridDim.x * NTHREADS;
    for (int w = blockIdx.x * NTHREADS + threadIdx.x; w < 8 * MTOK; w += nth) {
        const int h = w >> 14, row = w & (MTOK - 1), b = row >> 11, t = row & (SEQ - 1);
        float q[96];
#pragma unroll
        for (int c = 0; c < 12; ++c) unpack8(*(const u32x4*)(QA + (size_t)row * NQA + h * 96 + c * 8), q + c * 8);
        float o[64];
#pragma unroll
        for (int d = 0; d < 64; ++d) o[d] = 0.f;
        float mx = -INFINITY, l = 0.f;
        const int kend = ((t >> 6) + 1) << 6;
        for (int s = 0; s < kend; ++s) {
            const size_t kr = (size_t)(b * SEQ + s);
            const bf16_t* kp = KVA + kr * NKVA + h * 128; const bf16_t* rp = PROJ + kr * NPROJ_P + C_KR;
            float sc = 0.f;
#pragma unroll
            for (int c = 0; c < 8; ++c) { float k[8]; unpack8(*(const u32x4*)(kp + c * 8), k);
#pragma unroll
                for (int e = 0; e < 8; ++e) sc += q[c * 8 + e] * k[e]; }
#pragma unroll
            for (int c = 0; c < 4; ++c) { float k[8]; unpack8(*(const u32x4*)(rp + c * 8), k);
#pragma unroll
                for (int e = 0; e < 8; ++e) sc += q[64 + c * 8 + e] * k[e]; }
            const float mn = fmaxf(mx, sc), al = __builtin_amdgcn_exp2f(mx - mn), p = __builtin_amdgcn_exp2f(sc - mn);
            l = l * al + p; mx = mn;
#pragma unroll
            for (int c = 0; c < 8; ++c) { float v[8]; unpack8(*(const u32x4*)(kp + 64 + c * 8), v);
#pragma unroll
                for (int e = 0; e < 8; ++e) o[c * 8 + e] = o[c * 8 + e] * al + p * v[e]; }
        }
        const float inv = 1.0f / l;
#pragma unroll
        for (int c = 0; c < 8; ++c) { u32x4 wv; wv.x = cvt_pk_bf16(o[c * 8] * inv, o[c * 8 + 1] * inv); wv.y = cvt_pk_bf16(o[c * 8 + 2] * inv, o[c * 8 + 3] * inv); wv.z = cvt_pk_bf16(o[c * 8 + 4] * inv, o[c * 8 + 5] * inv); wv.w = cvt_pk_bf16(o[c * 8 + 6] * inv, o[c * 8 + 7] * inv);
            *(u32x4*)(O + (size_t)row * DM + h * 64 + c * 8) = wv; }
    }
}

__device__ __forceinline__ void attn_sb_naive(const bf16_t* PROJ, bf16_t* O) {
    const int nth = gridDim.x * NTHREADS;
    for (int w = blockIdx.x * NTHREADS + threadIdx.x; w < 8 * MTOK; w += nth) {
        const int h = w >> 14, row = w & (MTOK - 1), b = row >> 11, t = row & (SEQ - 1);
        float q[64];
#pragma unroll
        for (int c = 0; c < 8; ++c) unpack8(*(const u32x4*)(PROJ + (size_t)row * NPROJ_P + C_QB + h * 64 + c * 8), q + c * 8);
        float o[64];
#pragma unroll
        for (int d = 0; d < 64; ++d) o[d] = 0.f;
        float cum = 0.f;
        const int tmax = t | 63;
        for (int s = tmax - 1; s >= 0; --s) {
            const size_t kr = (size_t)(b * SEQ + s);
            const bf16_t* kp = PROJ + kr * NPROJ_P + C_KB + h * 64; const bf16_t* vp = PROJ + kr * NPROJ_P + C_VB + h * 64;
            float z = 0.f;
#pragma unroll
            for (int c = 0; c < 8; ++c) { float k[8]; unpack8(*(const u32x4*)(kp + c * 8), k);
#pragma unroll
                for (int e = 0; e < 8; ++e) z += q[c * 8 + e] * k[e]; }
            z *= 0.125f;
            const bool on = s < t;
            const float lg = __logf(1.0f + __expf(-fabsf(z)));
            const float wgt = on ? __expf(fminf(z, 0.f) - lg + cum) : 0.f;
            cum += on ? (fminf(-z, 0.f) - lg) : 0.f;
#pragma unroll
            for (int c = 0; c < 8; ++c) { float v[8]; unpack8(*(const u32x4*)(vp + c * 8), v);
#pragma unroll
                for (int e = 0; e < 8; ++e) o[c * 8 + e] += wgt * v[e]; }
        }
#pragma unroll
        for (int c = 0; c < 8; ++c) { u32x4 wv; wv.x = cvt_pk_bf16(o[c * 8], o[c * 8 + 1]); wv.y = cvt_pk_bf16(o[c * 8 + 2], o[c * 8 + 3]); wv.z = cvt_pk_bf16(o[c * 8 + 4], o[c * 8 + 5]); wv.w = cvt_pk_bf16(o[c * 8 + 6], o[c * 8 + 7]);
            *(u32x4*)(O + (size_t)row * DM + 512 + h * 64 + c * 8) = wv; }
    }
}

__device__ __forceinline__ void attn_band_naive(const bf16_t* QKV, const float* rel_bias, bf16_t* O) {
    const int nth = gridDim.x * NTHREADS;
    for (int w = blockIdx.x * NTHREADS + threadIdx.x; w < 16 * MTOK; w += nth) {
        const int h = w >> 14, row = w & (MTOK - 1), b = row >> 11, t = row & (SEQ - 1);
        float q[64];
#pragma unroll
        for (int c = 0; c < 8; ++c) unpack8(*(const u32x4*)(QKV + (size_t)row * NQKV + h * 64 + c * 8), q + c * 8);
        float o[64];
#pragma unroll
        for (int d = 0; d < 64; ++d) o[d] = 0.f;
        float mx = -INFINITY, l = 0.f;
        const int n = t >> 6, s0 = (n >= 8) ? (n - 8) * 64 : 0, s1 = (n + 1) * 64;
        const float* bias = rel_bias + h * 513 + 256;
        for (int s = s0; s < s1; ++s) {
            const size_t kr = (size_t)(b * SEQ + s);
            const bf16_t* kp = QKV + kr * NQKV + 1024 + h * 64; const bf16_t* vp = QKV + kr * NQKV + 2048 + h * 64;
            float sc = 0.f;
#pragma unroll
            for (int c = 0; c < 8; ++c) { float k[8]; unpack8(*(const u32x4*)(kp + c * 8), k);
#pragma unroll
                for (int e = 0; e < 8; ++e) sc += q[c * 8 + e] * k[e]; }
            int rel = t - s; rel = rel > 256 ? 256 : (rel < -256 ? -256 : rel);
            sc += bias[rel] * LOG2E;
            const float mn = fmaxf(mx, sc), al = __builtin_amdgcn_exp2f(mx - mn), p = __builtin_amdgcn_exp2f(sc - mn);
            l = l * al + p; mx = mn;
#pragma unroll
            for (int c = 0; c < 8; ++c) { float v[8]; unpack8(*(const u32x4*)(vp + c * 8), v);
#pragma unroll
                for (int e = 0; e < 8; ++e) o[c * 8 + e] = o[c * 8 + e] * al + p * v[e]; }
        }
        const float inv = 1.0f / l;
#pragma unroll
        for (int c = 0; c < 8; ++c) { u32x4 wv; wv.x = cvt_pk_bf16(o[c * 8] * inv, o[c * 8 + 1] * inv); wv.y = cvt_pk_bf16(o[c * 8 + 2] * inv, o[c * 8 + 3] * inv); wv.z = cvt_pk_bf16(o[c * 8 + 4] * inv, o[c * 8 + 5] * inv); wv.w = cvt_pk_bf16(o[c * 8 + 6] * inv, o[c * 8 + 7] * inv);
            *(u32x4*)(O + (size_t)row * DM + h * 64 + c * 8) = wv; }
    }
}

constexpr int I_IN = 16 * (NPROJ / 32), I_UQ = 6 * 24, I_UKV = 4 * 32, I_O = 16 * 32, I_G = 16 * 88, I_D = 44 * 32, I_QKV = 16 * 96;
constexpr int CV_R0 = I_IN + I_UQ + I_UKV, CV_R1 = CV_R0 + I_O + 2 * I_G + I_D + I_QKV + I_O, CV_NITEMS = CV_R1 + 2 * I_G + I_D;
#define CONV_ITEM(it_) do { int r = (it_); \
        if (r < I_IN) { p0_item(args.in[1], DM, NPROJ, args.in[10], Win, DM, 0, scr, r, lane); break; } r -= I_IN; \
        if (r < I_UQ) { p0_item(args.in[3], 384, NQA, args.in[2], Wuq, 384, 0, scr, r, lane); break; } r -= I_UQ; \
        if (r < I_UKV) { p0_item(args.in[5], 256, NKVA, args.in[4], Wukv, 256, 0, scr, r, lane); break; } r -= I_UKV; \
        if (r < I_O) { p0_item(args.in[6], DM, DM, nullptr, Wo0, DM, 0, scr, r, lane); break; } r -= I_O; \
        if (r < I_G) { p0_item(args.in[12], DM, DFF, args.in[11], Wgu0, DM, 1, scr, r, lane); break; } r -= I_G; \
        if (r < I_G) { p0_item(args.in[13], DM, DFF, args.in[11], Wgu0, DM, 2, scr, r, lane); break; } r -= I_G; \
        if (r < I_D) { p0_item(args.in[14], DFF, DM, nullptr, Wd0, DFF, 0, scr, r, lane); break; } r -= I_D; \
        if (r < I_QKV) { p0_item(args.in[7], DM, NQKV, args.in[10] + DM, Wqkv, DM, 0, scr, r, lane); break; } r -= I_QKV; \
        if (r < I_O) { p0_item(args.in[9], DM, DM, nullptr, Wo1, DM, 0, scr, r, lane); break; } r -= I_O; \
        if (r < I_G) { p0_item(args.in[12] + (size_t)DM * DFF, DM, DFF, args.in[11] + DM, Wgu1, DM, 1, scr, r, lane); break; } r -= I_G; \
        if (r < I_G) { p0_item(args.in[13] + (size_t)DM * DFF, DM, DFF, args.in[11] + DM, Wgu1, DM, 2, scr, r, lane); break; } r -= I_G; \
        p0_item(args.in[14] + (size_t)DFF * DM, DFF, DM, nullptr, Wd1, DFF, 0, scr, r, lane); } while (0)
#define CONV_TAIL(first, lo, hi) do { if (G == 256 && (int)blockIdx.x >= (first)) { int tid_c = threadIdx.x; asm volatile("" : "+v"(tid_c)); const int lane = tid_c & 63, wave = __builtin_amdgcn_readfirstlane(tid_c >> 6); \
        LAS float* scr = (LAS float*)((LAS unsigned char*)lds + wave * 16384); \
        for (int it = (lo) + ((int)blockIdx.x - (first)) * 8 + wave; it < (hi); it += (G - (first)) * 8) CONV_ITEM(it); } } while (0)

__global__ void __launch_bounds__(NTHREADS) fwd_megakernel(Args args) {
    extern __shared__ __attribute__((aligned(16))) unsigned char lds[];
#ifdef USE_CG_SYNC
    cg::grid_group grid = cg::this_grid();
#define GRID_SYNC() grid.sync()
#else
    { volatile LAS unsigned* st0 = (volatile LAS unsigned*)((LAS unsigned char*)lds + LDS_BYTES - 64); if (threadIdx.x == 0) { st0[0] = 0u; st0[1] = 0u; } }
    __syncthreads();
    const XcdBarrier xbar = xcd_barrier_post((unsigned*)(args.ws + WS_CTL), (volatile LAS unsigned*)((LAS unsigned char*)lds + LDS_BYTES - 64));
#define GRID_SYNC() xcd_barrier(xbar)
#endif
#ifdef USE_NAIVE_GEMM
#define GEMM(A, lda, Bt, ldb, M, N, K, E) gemm_naive(A, lda, Bt, ldb, (M) / 256, (N) / 256, K, E)
#else
#define GEMM(A, lda, Bt, ldb, M, N, K, E) gemm_fast((LAS unsigned char*)lds, A, lda, Bt, ldb, M, N, K, E)
#endif
    const int G = gridDim.x;
    const int vcu = (G % 8 == 0) ? (int)(blockIdx.x % 8) * (G / 8) + (int)(blockIdx.x / 8) : (int)blockIdx.x;
    LAS unsigned char* ldsp = (LAS unsigned char*)lds;
    unsigned char* ws = args.ws;
    const float* x = args.in[0];
    float* out = args.out;
    u64* ssq = (u64*)(ws + WS_SSQ);
    f32x2* rope = (f32x2*)(ws + WS_ROPE);
    bf16_t* Win = (bf16_t*)(ws + WS_WIN); bf16_t* Wuq = (bf16_t*)(ws + WS_WUQ); bf16_t* Wukv = (bf16_t*)(ws + WS_WUKV); bf16_t* Wo0 = (bf16_t*)(ws + WS_WO0);
    bf16_t* Wgu0 = (bf16_t*)(ws + WS_WGU0); bf16_t* Wd0 = (bf16_t*)(ws + WS_WD0); bf16_t* Wqkv = (bf16_t*)(ws + WS_WQKV); bf16_t* Wo1 = (bf16_t*)(ws + WS_WO1);
    bf16_t* Wgu1 = (bf16_t*)(ws + WS_WGU1); bf16_t* Wd1 = (bf16_t*)(ws + WS_WD1);
    bf16_t* HB = (bf16_t*)(ws + WS_HB); bf16_t* PROJ = (bf16_t*)(ws + WS_A); bf16_t* QKV = (bf16_t*)(ws + WS_A); bf16_t* ACT = (bf16_t*)(ws + WS_A); bf16_t* ATT = (bf16_t*)(ws + WS_ATT);
    bf16_t* QA = (bf16_t*)((unsigned char*)out + OUT_QA); bf16_t* KVA = (bf16_t*)((unsigned char*)out + OUT_KVA);

    {
        const int tid = threadIdx.x, lane = tid & 63, wave = __builtin_amdgcn_readfirstlane(tid >> 6);
        LAS float* scr = (LAS float*)((LAS unsigned char*)lds + wave * 16384);
        const int gw = blockIdx.x * 8 + wave, NGW = G * 8;
        const bool offload = (G == 256);
        for (int it = gw; it < (offload ? CV_R0 : CV_NITEMS); it += NGW) CONV_ITEM(it);
        for (int i = blockIdx.x * NTHREADS + tid; i < (NPROJ_P - NPROJ) * DM / 8; i += G * NTHREADS) ((u32x4*)(Win + (size_t)NPROJ * DM))[i] = (u32x4){0u, 0u, 0u, 0u};
        for (int i = blockIdx.x * NTHREADS + tid; i < 6 * MTOK; i += G * NTHREADS) ssq[MTOK + i] = 0ull;
        for (int i = blockIdx.x * NTHREADS + tid; i < SEQ * 16; i += G * NTHREADS) {
            const int pos = i >> 4, fi = i & 15;
            const float inv_freq = __builtin_amdgcn_exp2f(-(float)fi * (13.287712379549449f / 16.0f));
            const float ang = (float)pos * inv_freq;
            float tr = ang * 0.15915494309189535f; tr -= floorf(tr);
            rope[i] = (f32x2){__builtin_amdgcn_cosf(tr), __builtin_amdgcn_sinf(tr)};
        }
        for (int m = gw; m < MTOK; m += NGW) {
            const f32x4* xr = (const f32x4*)(x + (size_t)m * DM) + lane; f32x4 v[4]; float s = 0.f;
#pragma unroll
            for (int j = 0; j < 4; ++j) { v[j] = xr[64 * j]; s += dot4(v[j]); }
            s = wave_sum(s);
            if (lane == 0) ssq[m] = ssq_fix(s);
#pragma unroll
            for (int j = 0; j < 4; ++j) { u32x2 w; w.x = cvt_pk_bf16(v[j][0], v[j][1]); w.y = cvt_pk_bf16(v[j][2], v[j][3]); *((u32x2*)(HB + (size_t)m * DM) + lane + 64 * j) = w; }
        }
    }
    GRID_SYNC();
    { EpiScale<0> E{PROJ, NPROJ_P, ssq, 1.0f / DM, ssq + MTOK, ssq + 2 * MTOK, rope}; GEMM(HB, DM, Win, DM, MTOK, NPROJ_P, DM, E); }
    CONV_TAIL(64, CV_R0, CV_R1);
    GRID_SYNC();
    { EpiScale<1> E{QA, NQA, ssq + MTOK, 1.0f / 384, nullptr, nullptr, rope}; GEMM(PROJ, NPROJ_P, Wuq, 384, MTOK, NQA, 384, E); }
    { EpiScale<2> E{KVA, NKVA, ssq + 2 * MTOK, 1.0f / 256, nullptr, nullptr, rope}; GEMM(PROJ + C_CKV, NPROJ_P, Wukv, 256, MTOK, NKVA, 256, E); }
    GRID_SYNC();
#ifdef NAIVE_ATTN
    attn_mla_naive(QA, KVA, PROJ, ATT);
    attn_sb_naive(PROJ, ATT);
#else
    for (int u = vcu; u < 256; u += G) {
        const int bh = u >> 2, j = u & 3, b = bh >> 3, h = bh & 7;
        const size_t rb = (size_t)b * SEQ;
        for (int k = 0; k < 2 * REP_MLA; ++k) { const int qt = (k & 1) ? 7 - j : j;
            attn_unit<0>(ldsp, 256 * qt, QA + rb * NQA + h * 96, NQA, KVA + rb * NKVA + h * 128, NKVA, PROJ + rb * NPROJ_P + C_KR, NPROJ_P, KVA + rb * NKVA + h * 128 + 64, NKVA, ATT + rb * DM + h * 64, nullptr); }
        for (int k = 0; k < 2 * REP_SB; ++k) { const int qt = (k & 1) ? 7 - j : j;
            attn_unit<1>(ldsp, 256 * qt, PROJ + rb * NPROJ_P + C_QB + h * 64, NPROJ_P, PROJ + rb * NPROJ_P + C_KB + h * 64, NPROJ_P, nullptr, 0, PROJ + rb * NPROJ_P + C_VB + h * 64, NPROJ_P, ATT + rb * DM + 512 + h * 64, nullptr); }
    }
#endif
    GRID_SYNC();
    { EpiResid E{HB, ssq + 3 * MTOK}; GEMM(ATT, DM, Wo0, DM, MTOK, DM, DM, E); }
    GRID_SYNC();
    for (int rep = 0; rep < REP_GU; ++rep) { EpiSwiglu E{ACT, ssq + 3 * MTOK}; GEMM(HB, DM, Wgu0, DM, MTOK, 2 * DFF, DM, E); }
    CONV_TAIL(128, CV_R1, CV_NITEMS);
    GRID_SYNC();
    { EpiResid E{HB, ssq + 4 * MTOK}; GEMM(ACT, DFF, Wd0, DFF, MTOK, DM, DFF, E); }
    GRID_SYNC();
    { EpiScale<3> E{QKV, NQKV, ssq + 4 * MTOK, 1.0f / DM, nullptr, nullptr, rope}; GEMM(HB, DM, Wqkv, DM, MTOK, NQKV, DM, E); }
    GRID_SYNC();
#ifdef NAIVE_ATTN
    attn_band_naive(QKV, args.in[8], ATT);
#else
    for (int u = vcu; u < 256; u += G) {
        const int bh = u >> 1, half = u & 1, b = bh >> 4, h = bh & 15;
        const size_t rb = (size_t)b * SEQ;
        for (int k = 0; k < 4 * REP_BAND; ++k)
            attn_unit<2>(ldsp, 256 * (2 * (k & 3) + half), QKV + rb * NQKV + h * 64, NQKV, QKV + rb * NQKV + 1024 + h * 64, NQKV, nullptr, 0, QKV + rb * NQKV + 2048 + h * 64, NQKV, ATT + rb * DM + h * 64, args.in[8] + h * 513);
    }
#endif
    GRID_SYNC();
    { EpiResid E{HB, ssq + 5 * MTOK}; GEMM(ATT, DM, Wo1, DM, MTOK, DM, DM, E); }
    GRID_SYNC();
    { EpiSwiglu E{ACT, ssq + 5 * MTOK}; GEMM(HB, DM, Wgu1, DM, MTOK, 2 * DFF, DM, E); }
    GRID_SYNC();
    if (G == 256) {
        EpiFinal E{HB, ssq + 6 * MTOK, (unsigned*)(args.ws + WS_CTL) + CW_PANEL, args.in[15], out};
        gemm_fast((LAS unsigned char*)lds, ACT, DFF, Wd1, DFF, MTOK, DM, DFF, E);
        return;
    }
    { EpiResid E{HB, ssq + 6 * MTOK}; GEMM(ACT, DFF, Wd1, DFF, MTOK, DM, DFF, E); }
    GRID_SYNC();
    {
        const int tid = threadIdx.x, lane = tid & 63, wave = __builtin_amdgcn_readfirstlane(tid >> 6); (void)tid;
        const int gw = blockIdx.x * 8 + wave, NGW = G * 8;
        const f32x4* gf = (const f32x4*)args.in[15] + lane;
        for (int m = gw; m < MTOK; m += NGW) {
            const float r = rsqrtf(ssq_get(ssq + 6 * MTOK, m) * (1.0f / DM) + RMS_EPS);
            f32x4* p = (f32x4*)(out + (size_t)m * DM) + lane; const u32x2* hp = (const u32x2*)(HB + (size_t)m * DM) + lane;
#pragma unroll
            for (int j = 0; j < 4; ++j) { const u32x2 hv = hp[64 * j]; const f32x4 g4 = gf[64 * j]; f32x4 o; o[0] = bflo(hv.x) * r * g4[0]; o[1] = bfhi(hv.x) * r * g4[1]; o[2] = bflo(hv.y) * r * g4[2]; o[3] = bfhi(hv.y) * r * g4[3]; p[64 * j] = o; }
        }
    }
}

extern "C" void kernel_launch(void* const* d_in, const int* in_sizes, int n_in, void* d_out, int out_size, void* d_ws, size_t ws_size, hipStream_t stream) {
    static int grid = 0;
    if (grid == 0) {
        int dev = 0, cus = 0, per_cu = 0;
        hipGetDevice(&dev);
        hipDeviceGetAttribute(&cus, hipDeviceAttributeMultiprocessorCount, dev);
        hipFuncSetAttribute((const void*)fwd_megakernel, hipFuncAttributeMaxDynamicSharedMemorySize, LDS_BYTES);
        hipOccupancyMaxActiveBlocksPerMultiprocessor(&per_cu, (const void*)fwd_megakernel, NTHREADS, LDS_BYTES);
        if (per_cu < 1) per_cu = 1;
        if (per_cu > 1) per_cu = 1;
        grid = cus * per_cu;
        if (n_in != 16 || out_size != MTOK * DM || ws_size < WS_END) { fprintf(stderr, "kernel_launch: unexpected shapes n_in %d out %d ws %zu\n", n_in, out_size, ws_size); }
    }
    Args a{};
    for (int i = 0; i < 16; ++i) a.in[i] = (const float*)d_in[i];
    a.out = (float*)d_out; a.ws = (unsigned char*)d_ws;
    hipMemsetAsync((char*)d_ws + WS_CTL, 0, CTL_BYTES, stream);
    void* kargs[] = {&a};
    hipError_t e = hipLaunchCooperativeKernel((const void*)fwd_megakernel, dim3(grid), dim3(NTHREADS), kargs, LDS_BYTES, stream);
    if (e != hipSuccess) fprintf(stderr, "cooperative launch failed: %s (grid %d)\n", hipGetErrorString(e), grid);
}
```

```cpp
#include <hip/hip_runtime.h>
#include <hip/hip_cooperative_groups.h>
#include <cstdio>
#include <cstdint>
namespace cg = cooperative_groups;
#define REP_MLA 1
#define REP_SB 1
#define REP_BAND 1
#define REP_GU 1

#define LAS __attribute__((address_space(3)))
typedef unsigned short bf16_t;
typedef short bf16x8 __attribute__((ext_vector_type(8)));
typedef float f32x4 __attribute__((ext_vector_type(4)));
typedef float f32x2 __attribute__((ext_vector_type(2)));
typedef unsigned u32x4 __attribute__((ext_vector_type(4)));
typedef unsigned u32x2 __attribute__((ext_vector_type(2)));

constexpr int MTOK = 16384, SEQ = 2048, DM = 1024, DFF = 2816;
constexpr int NPROJ = 2208, NPROJ_P = 2304;
constexpr int C_CKV = 384, C_KR = 640, C_QB = 672, C_KB = 1184, C_VB = 1696;
constexpr int NQA = 768, NKVA = 1024, NQKV = 3072;
constexpr float RMS_EPS = 1e-6f;
constexpr float LOG2E = 1.4426950408889634f;
constexpr float QSCALE_A = 0.10206207261596577f * LOG2E;
constexpr float QSCALE_C = 0.125f * LOG2E;

constexpr size_t KiB = 1024, MiB = 1u << 20;
constexpr size_t WS_SSQ = 216 * MiB;
constexpr size_t WS_ROPE = 512 * KiB;
constexpr size_t WS_CTL = 768 * KiB, CTL_BYTES = 32 * KiB; constexpr int CW_PANEL = 4096;
constexpr size_t WS_WIN = 1 * MiB;
constexpr size_t WS_WUQ = WS_WIN + (size_t)NPROJ_P * DM * 2;
constexpr size_t WS_WUKV = WS_WUQ + (size_t)NQA * 384 * 2;
constexpr size_t WS_WO0 = WS_WUKV + (size_t)NKVA * 256 * 2;
constexpr size_t WS_WGU0 = WS_WO0 + (size_t)DM * DM * 2;
constexpr size_t WS_WD0 = WS_WGU0 + (size_t)2 * DFF * DM * 2;
constexpr size_t WS_WQKV = WS_WD0 + (size_t)DM * DFF * 2;
constexpr size_t WS_WO1 = WS_WQKV + (size_t)NQKV * DM * 2;
constexpr size_t WS_WGU1 = WS_WO1 + (size_t)DM * DM * 2;
constexpr size_t WS_WD1 = WS_WGU1 + (size_t)2 * DFF * DM * 2;
constexpr size_t WS_WEND = WS_WD1 + (size_t)DM * DFF * 2;
constexpr size_t WS_HB = 50 * MiB;
constexpr size_t WS_A = 82 * MiB;
constexpr size_t WS_ATT = 178 * MiB;
constexpr size_t WS_SSQP = 210 * MiB;
constexpr size_t WS_END = 218 * MiB;
static_assert(WS_WEND <= WS_HB, "weights fit");
constexpr size_t OUT_QA = 0, OUT_KVA = 24 * MiB;

constexpr int NTHREADS = 512;
constexpr int LDS_BYTES = 147456;

typedef __bf16 bf16x2_t __attribute__((ext_vector_type(2)));
__device__ __forceinline__ unsigned cvt_pk_bf16(float lo, float hi) { const f32x2 v = {lo, hi}; const bf16x2_t b = __builtin_convertvector(v, bf16x2_t); return __builtin_bit_cast(unsigned, b); }
__device__ __forceinline__ float bflo(unsigned w) { return __uint_as_float(w << 16); }
__device__ __forceinline__ float bfhi(unsigned w) { return __uint_as_float(w & 0xffff0000u); }
__device__ __forceinline__ void unpack8(const u32x4 w, float* f) {
    f[0] = bflo(w.x); f[1] = bfhi(w.x); f[2] = bflo(w.y); f[3] = bfhi(w.y); f[4] = bflo(w.z); f[5] = bfhi(w.z); f[6] = bflo(w.w); f[7] = bfhi(w.w);
}
__device__ __forceinline__ float wave_sum(float v) {
#pragma unroll
    for (int o = 1; o < 64; o <<= 1) v += __shfl_xor(v, o);
    return v;
}
__device__ __forceinline__ float dot4(const f32x4 a) { return (a[0] * a[0] + a[1] * a[1]) + (a[2] * a[2] + a[3] * a[3]); }

struct Unit { int pm, pn; };
typedef unsigned long long u64;
__device__ __forceinline__ u64 ssq_fix(float s) { const unsigned hi = (unsigned)s; const unsigned lo = (unsigned)((s - (float)hi) * 4294967296.0f); return ((u64)hi << 32) | (u64)lo; }
__device__ __forceinline__ float ssq_val(const u64 v) { return (float)(unsigned)(v >> 32) + (float)(unsigned)v * 2.3283064365386963e-10f; }
__device__ __forceinline__ float ssq_get(const u64* p, int row) { return ssq_val(p[row]); }
__device__ __forceinline__ void ssq_add(u64* p, int row, float s) { atomicAdd(p + row, ssq_fix(s)); }


template <int MODE> struct EpiScale {
    static constexpr bool PERM = false, AFTER_DRAIN = false;
    bf16_t* O; int ldc; const u64* ssq_in; float inv_n; u64* ssq_a; u64* ssq_b; const f32x2* rope;
    __device__ __forceinline__ void operator()(const f32x4 (&acc)[2][2][4][2], const Unit& u, int wr, int wc, int fr, int fq) const {
        const int cb0 = u.pn * 256 + wc * 32;
        u64 sv[2][4];
#pragma unroll
        for (int ai = 0; ai < 2; ++ai)
#pragma unroll
            for (int m = 0; m < 4; ++m) sv[ai][m] = ssq_in[u.pm * 256 + ai * 128 + wr * 64 + m * 16 + fr];
#pragma unroll
        for (int ai = 0; ai < 2; ++ai)
#pragma unroll
            for (int m = 0; m < 4; ++m) {
                const int row = u.pm * 256 + ai * 128 + wr * 64 + m * 16 + fr;
                const float r = rsqrtf(ssq_val(sv[ai][m]) * inv_n + RMS_EPS);
                const int pos = row & (SEQ - 1);
#pragma unroll
                for (int bj = 0; bj < 2; ++bj) {
                    const int cb = cb0 + 128 * bj;
                    float sc = r;
                    if (MODE == 1) sc *= QSCALE_A;
                    if (MODE == 3) { if (cb < 1024) sc *= QSCALE_C; }
                    f32x4 v0 = acc[ai][bj][m][0] * sc, v1 = acc[ai][bj][m][1] * sc;
                    bool ropeg = false;
                    if (MODE == 0) ropeg = (cb == C_KR);
                    if (MODE == 1) ropeg = ((cb % 96) == 64);
                    if (ropeg) {
#pragma unroll
                        for (int j = 0; j < 4; ++j) { const f32x2 cs = rope[pos * 16 + 4 * fq + j]; const float x1 = v0[j], x2 = v1[j]; v0[j] = x1 * cs.x - x2 * cs.y; v1[j] = x2 * cs.x + x1 * cs.y; }
                    }
                    if (MODE == 0) {
                        if (cb < C_KR) { float s = dot4(v0) + dot4(v1); s += __shfl_xor(s, 16); s += __shfl_xor(s, 32); if (fq == 0) ssq_add(cb < C_CKV ? ssq_a : ssq_b, row, s); }
                    }
                    bf16_t* p = O + (size_t)row * ldc + cb + 4 * fq;
                    u32x2 w0, w1; w0.x = cvt_pk_bf16(v0[0], v0[1]); w0.y = cvt_pk_bf16(v0[2], v0[3]); w1.x = cvt_pk_bf16(v1[0], v1[1]); w1.y = cvt_pk_bf16(v1[2], v1[3]);
                    *(u32x2*)p = w0; *(u32x2*)(p + 16) = w1;
                }
            }
    }
};

struct EpiResid {
    static constexpr bool PERM = false, AFTER_DRAIN = false;
    bf16_t* hb; u64* ssq;
    __device__ __forceinline__ void operator()(const f32x4 (&acc)[2][2][4][2], const Unit& u, int wr, int wc, int fr, int fq) const {
#pragma unroll
        for (int ai = 0; ai < 2; ++ai) {
            u32x2 b[4][2][2];
#pragma unroll
            for (int m = 0; m < 4; ++m)
#pragma unroll
                for (int bj = 0; bj < 2; ++bj)
#pragma unroll
                    for (int n = 0; n < 2; ++n) b[m][bj][n] = *(const u32x2*)(hb + (size_t)(u.pm * 256 + ai * 128 + wr * 64 + m * 16 + fr) * DM + u.pn * 256 + bj * 128 + wc * 32 + 16 * n + 4 * fq);
#pragma unroll
            for (int m = 0; m < 4; ++m) {
                const int row = u.pm * 256 + ai * 128 + wr * 64 + m * 16 + fr;
                float s = 0.f;
#pragma unroll
                for (int bj = 0; bj < 2; ++bj)
#pragma unroll
                    for (int n = 0; n < 2; ++n) {
                        const size_t off = (size_t)row * DM + u.pn * 256 + bj * 128 + wc * 32 + 16 * n + 4 * fq;
                        const f32x4 a = acc[ai][bj][m][n]; const u32x2 bb = b[m][bj][n];
                        f32x4 h; h[0] = bflo(bb.x) + a[0]; h[1] = bfhi(bb.x) + a[1]; h[2] = bflo(bb.y) + a[2]; h[3] = bfhi(bb.y) + a[3];
                        u32x2 w; w.x = cvt_pk_bf16(h[0], h[1]); w.y = cvt_pk_bf16(h[2], h[3]); *(u32x2*)(hb + off) = w;
                        s += dot4(h);
                    }
                s += __shfl_xor(s, 16); s += __shfl_xor(s, 32);
                if (fq == 0) ssq_add(ssq, row, s);
            }
            asm volatile("" ::: "memory");
        }
    }
};

struct EpiSwiglu {
    static constexpr bool PERM = true, AFTER_DRAIN = false;
    bf16_t* O; const u64* ssq_in;
    __device__ __forceinline__ void operator()(const f32x4 (&acc)[2][2][4][2], const Unit& u, int wr, int wc, int fr, int fq) const {
        u64 sv[2][4];
#pragma unroll
        for (int ai = 0; ai < 2; ++ai)
#pragma unroll
            for (int m = 0; m < 4; ++m) sv[ai][m] = ssq_in[u.pm * 256 + ai * 128 + wr * 64 + m * 16 + fr];
#pragma unroll
        for (int ai = 0; ai < 2; ++ai)
#pragma unroll
            for (int m = 0; m < 4; ++m) {
                const int row = u.pm * 256 + ai * 128 + wr * 64 + m * 16 + fr;
                const float r = rsqrtf(ssq_val(sv[ai][m]) * (1.0f / DM) + RMS_EPS);
                float a[8];
#pragma unroll
                for (int n = 0; n < 2; ++n)
#pragma unroll
                    for (int j = 0; j < 4; ++j) { const float g = acc[ai][0][m][n][j] * r, uu = acc[ai][1][m][n][j] * r; a[4 * n + j] = g * __builtin_amdgcn_rcpf(1.0f + __expf(-g)) * uu; }
                u32x4 w; w.x = cvt_pk_bf16(a[0], a[1]); w.y = cvt_pk_bf16(a[2], a[3]); w.z = cvt_pk_bf16(a[4], a[5]); w.w = cvt_pk_bf16(a[6], a[7]);
                *(u32x4*)(O + (size_t)row * DFF + u.pn * 128 + wc * 32 + 8 * fq) = w;
            }
    }
};

struct EpiFinal {
    static constexpr bool PERM = false, AFTER_DRAIN = true;
    const bf16_t* hb; u64* ssq; unsigned* cnt; const float* gfin; float* out;
    __device__ __forceinline__ void operator()(const f32x4 (&)[2][2][4][2], const Unit&, int, int, int, int) const {}
    __device__ __forceinline__ void fused(f32x4 (&acc)[2][2][4][2], const Unit& u, int wr, int wc, int fr, int fq, LAS unsigned char*, int, int) const {
#pragma unroll
        for (int ai = 0; ai < 2; ++ai) {
            u32x2 b[4][2][2];
#pragma unroll
            for (int m = 0; m < 4; ++m)
#pragma unroll
                for (int bj = 0; bj < 2; ++bj)
#pragma unroll
                    for (int n = 0; n < 2; ++n) b[m][bj][n] = *(const u32x2*)(hb + (size_t)(u.pm * 256 + ai * 128 + wr * 64 + m * 16 + fr) * DM + u.pn * 256 + bj * 128 + wc * 32 + 16 * n + 4 * fq);
#pragma unroll
            for (int m = 0; m < 4; ++m) {
                const int row = u.pm * 256 + ai * 128 + wr * 64 + m * 16 + fr;
                float s = 0.f;
#pragma unroll
                for (int bj = 0; bj < 2; ++bj)
#pragma unroll
                    for (int n = 0; n < 2; ++n) {
                        const f32x4 a = acc[ai][bj][m][n]; const u32x2 bb = b[m][bj][n];
                        f32x4 h; h[0] = bflo(bb.x) + a[0]; h[1] = bfhi(bb.x) + a[1]; h[2] = bflo(bb.y) + a[2]; h[3] = bfhi(bb.y) + a[3];
                        acc[ai][bj][m][n] = h; s += dot4(h);
                    }
                s += __shfl_xor(s, 16); s += __shfl_xor(s, 32);
                if (fq == 0) { const u64 prev = atomicAdd(ssq + row, ssq_fix(s)); asm volatile("" :: "v"(prev)); }
            }
            asm volatile("" ::: "memory");
        }
        asm volatile("s_waitcnt vmcnt(0)" ::: "memory");
        __syncthreads();
        if (threadIdx.x == 0) {
            unsigned* c = cnt + 16 * u.pm;
            __hip_atomic_fetch_add(c, 1u, __ATOMIC_RELEASE, __HIP_MEMORY_SCOPE_AGENT);
            unsigned sp = 0;
            while (__hip_atomic_load(c, __ATOMIC_RELAXED, __HIP_MEMORY_SCOPE_AGENT) < 4u) { __builtin_amdgcn_s_sleep(1); if (++sp > (1u << 22)) break; }
            __builtin_amdgcn_fence(__ATOMIC_ACQUIRE, "agent");
            asm volatile("s_waitcnt vmcnt(0)" ::: "memory");
        }
        __syncthreads();
        u64 sv[2][4];
#pragma unroll
        for (int ai = 0; ai < 2; ++ai)
#pragma unroll
            for (int m = 0; m < 4; ++m) sv[ai][m] = __hip_atomic_load(ssq + (u.pm * 256 + ai * 128 + wr * 64 + m * 16 + fr), __ATOMIC_RELAXED, __HIP_MEMORY_SCOPE_AGENT);
        f32x4 g4[2][2];
#pragma unroll
        for (int bj = 0; bj < 2; ++bj)
#pragma unroll
            for (int n = 0; n < 2; ++n) g4[bj][n] = *(const f32x4*)(gfin + u.pn * 256 + bj * 128 + wc * 32 + 16 * n + 4 * fq);
#pragma unroll
        for (int ai = 0; ai < 2; ++ai)
#pragma unroll
            for (int m = 0; m < 4; ++m) {
                const int row = u.pm * 256 + ai * 128 + wr * 64 + m * 16 + fr;
                const float r = rsqrtf(ssq_val(sv[ai][m]) * (1.0f / DM) + RMS_EPS);
#pragma unroll
                for (int bj = 0; bj < 2; ++bj)
#pragma unroll
                    for (int n = 0; n < 2; ++n) *(f32x4*)(out + (size_t)row * DM + u.pn * 256 + bj * 128 + wc * 32 + 16 * n + 4 * fq) = acc[ai][bj][m][n] * r * g4[bj][n];
            }
    }
};

__host__ __device__ __forceinline__ int perm32(int rho) { const int n = rho >> 4, i = rho & 15; return 8 * (i >> 2) + 4 * n + (i & 3); }
template <class Epi>
__device__ __forceinline__ void gemm_naive(const bf16_t* A, int lda, const bf16_t* Bt, int ldb, int nM, int nN, int K, const Epi& E) {
    constexpr bool PERM = Epi::PERM;
    const int tid = threadIdx.x, wid = tid >> 6, lane = tid & 63, wr = wid >> 2, wc = wid & 3, fr = lane & 15, fq = lane >> 4;
    for (int unit = blockIdx.x; unit < nM * nN; unit += gridDim.x) {
        Unit u; u.pm = unit / nN; u.pn = unit % nN;
        f32x4 acc[2][2][4][2];
#pragma unroll
        for (int a = 0; a < 2; ++a)
#pragma unroll
            for (int b = 0; b < 2; ++b)
#pragma unroll
                for (int m = 0; m < 4; ++m)
#pragma unroll
                    for (int n = 0; n < 2; ++n) acc[a][b][m][n] = (f32x4){0.f, 0.f, 0.f, 0.f};
        const bf16_t* Ab = A + (size_t)(u.pm * 256 + wr * 64 + fr) * lda + 8 * fq;
        const bf16_t* Bb = Bt + (size_t)(u.pn * 256 + wc * 32) * ldb + 8 * fq;
        const int br0 = PERM ? perm32(fr) : fr, br1 = PERM ? perm32(16 + fr) : 16 + fr;
        for (int k0 = 0; k0 < K; k0 += 32) {
            bf16x8 af[2][4], bq[2][2];
#pragma unroll
            for (int ai = 0; ai < 2; ++ai)
#pragma unroll
                for (int m = 0; m < 4; ++m) af[ai][m] = *(const bf16x8*)(Ab + (size_t)(ai * 128 + m * 16) * lda + k0);
#pragma unroll
            for (int bj = 0; bj < 2; ++bj) { bq[bj][0] = *(const bf16x8*)(Bb + (size_t)(bj * 128 + br0) * ldb + k0); bq[bj][1] = *(const bf16x8*)(Bb + (size_t)(bj * 128 + br1) * ldb + k0); }
#pragma unroll
            for (int ai = 0; ai < 2; ++ai)
#pragma unroll
                for (int bj = 0; bj < 2; ++bj)
#pragma unroll
                    for (int m = 0; m < 4; ++m)
#pragma unroll
                        for (int n = 0; n < 2; ++n) acc[ai][bj][m][n] = __builtin_amdgcn_mfma_f32_16x16x32_bf16(bq[bj][n], af[ai][m], acc[ai][bj][m][n], 0, 0, 0);
        }
        E(acc, u, wr, wc, fr, fq);
    }
}

#define PG8_LAS __attribute__((address_space(3)))
constexpr int BM = 256, BK = 64, HALF = 128, HTB = HALF * BK * 2  , STAGE_BYTES = 8 * HTB, NXCD = 8, WGM = 8;
__host__ __device__ __forceinline__ int lds_byte(int r, int c) { const int st = (r >> 4) * 2 + (c >> 5), rr = r & 15, cc = c & 31, ob = rr * 64 + cc * 2; return st * 1024 + (ob ^ (((ob >> 9) & 1) << 5)); }
__host__ __device__ __forceinline__ void stage_rc(int b, int& R, int& C) { const int st = b / 1024, sb = b % 1024, swz = sb ^ (((sb >> 9) & 1) << 5); R = (st >> 1) * 16 + swz / 64; C = (st & 1) * 32 + (swz % 64) / 2; }
struct Gemm { const bf16_t* A; const bf16_t* Bt; int M, N, K, lda, ldb; };
struct StaticOrder {
    int nM, nN, nwg, G, c;
    __host__ __device__ void init(int M, int N, int G_, int c_) { nM = M / BM; nN = N / BM; nwg = nM * nN; G = G_; c = c_; }
    __host__ __device__ bool next(int i, Unit& u) const {
        const long L = (long)i * G + c; if (L >= nwg) return false;
        int wgid = (int)L; { const int q = nwg / NXCD, r = nwg % NXCD, xcd = wgid % NXCD, off = wgid / NXCD; wgid = (xcd < r ? xcd * (q + 1) : r * (q + 1) + (xcd - r) * q) + off; }
        const int nig = WGM * nN, gid = wgid / nig, fm = gid * WGM, gsz = (nM - fm) < WGM ? (nM - fm) : WGM;
        u.pm = fm + ((wgid % nig) % gsz); u.pn = (wgid % nig) / gsz; return true;
    }
    __device__ __forceinline__ void a_ready(const Unit&) const {}
    __device__ __forceinline__ void done(const Unit&) const {}
};
template <class Epi, class Sched, bool ALIGN_EPI = false, bool SP2 = false>
__device__ __forceinline__ void gemm_phase(PG8_LAS unsigned char* lds, const Gemm g, const Sched& S, const Epi& E) {
    int tid_ = threadIdx.x; asm volatile("" : "+v"(tid_));
    const int tid = tid_, wid = __builtin_amdgcn_readfirstlane(tid >> 6), lane = tid & 63, wr = wid >> 2, wc = wid & 3, fr = lane & 15, fq = lane >> 4;
    const int K = g.K, nt = K / BK;
    unsigned voffA[2], voffB[2];
#pragma unroll
    for (int i = 0; i < 2; ++i) { int R, C; stage_rc(tid * 16 + i * 8192, R, C); const int Rb = Epi::PERM ? ((R & ~31) + perm32(R & 31)) : R;
        voffA[i] = (unsigned)(R * g.lda + C) * 2u; voffB[i] = (unsigned)(Rb * g.ldb + C) * 2u; }
    const size_t kstep = (size_t)(BK * 2);
    const size_t hstepA = (size_t)HALF * g.lda * 2, hstepB = (size_t)HALF * g.ldb * 2;
    const size_t tstepA = 2 * hstepA, tstepB = 2 * hstepB;
    const unsigned ldsw = (unsigned)wid * 1024u;
    const int aoff = lds_byte(wr * 64 + fr, fq * 8), boff = lds_byte(wc * 32 + fr, fq * 8);
#define PG8_SA(b, h) (((b) * 2 + (h)) * HTB)
#define PG8_SB(b, h) ((4 + (b) * 2 + (h)) * HTB)
#define PG8_STAGE(bufoff, gbase, voff) do { _Pragma("unroll") for (int _i = 0; _i < 2; ++_i) \
        __builtin_amdgcn_global_load_lds((const unsigned*)((const char*)(gbase) + (voff)[_i]), (PG8_LAS unsigned*)(lds + (bufoff) + ldsw + _i * 8192), 16, 0, 0); } while (0)
#define PG8_LDA(dst, b, h) do { _Pragma("unroll") for (int m = 0; m < 4; ++m) _Pragma("unroll") for (int k = 0; k < 2; ++k) dst[m][k] = *(const PG8_LAS bf16x8*)(lds + PG8_SA(b, h) + aoff + m * 2048 + k * 1024); } while (0)
#define PG8_LDB(dst, b, h) do { _Pragma("unroll") for (int n = 0; n < 2; ++n) _Pragma("unroll") for (int k = 0; k < 2; ++k) dst[n][k] = *(const PG8_LAS bf16x8*)(lds + PG8_SB(b, h) + boff + n * 2048 + k * 1024); } while (0)
#define PG8_MMA(ai, bj, At, Bt) do { __builtin_amdgcn_s_setprio(1); _Pragma("unroll") for (int m = 0; m < 4; ++m) _Pragma("unroll") for (int n = 0; n < 2; ++n) _Pragma("unroll") for (int k = 0; k < 2; ++k) \
        acc[ai][bj][m][n] = __builtin_amdgcn_mfma_f32_16x16x32_bf16(Bt[n][k], At[m][k], acc[ai][bj][m][n], 0, 0, 0); __builtin_amdgcn_s_setprio(0); } while (0)
#define PG8_WAIT_V(n) asm volatile("s_waitcnt vmcnt(" #n ")" ::: "memory")
#define PG8_WAIT_L(n) asm volatile("s_waitcnt lgkmcnt(" #n ")" ::: "memory")
#define PG8_BAR __builtin_amdgcn_s_barrier()
#define PG8_SCHED __builtin_amdgcn_sched_barrier(0)
    Unit cur, nxt; int ui = 0;
    if (!S.next(0, cur)) return;
    f32x4 acc[2][2][4][2];
#pragma unroll
    for (int a = 0; a < 2; ++a)
#pragma unroll
        for (int b = 0; b < 2; ++b)
#pragma unroll
            for (int m = 0; m < 4; ++m)
#pragma unroll
                for (int n = 0; n < 2; ++n) acc[a][b][m][n] = (f32x4){0.f, 0.f, 0.f, 0.f};
    bf16x8 At[4][2], B0[2][2], B1[2][2];
    const char* cA = (const char*)g.A + (size_t)cur.pm * tstepA; const char* cB = (const char*)g.Bt + (size_t)cur.pn * tstepB;
    S.a_ready(cur);
    if constexpr (SP2) {
        PG8_STAGE(PG8_SB(0, 0), cB, voffB); PG8_STAGE(PG8_SB(0, 1), cB + hstepB, voffB); PG8_STAGE(PG8_SA(0, 0), cA, voffA); PG8_STAGE(PG8_SA(0, 1), cA + hstepA, voffA);
        if (wr == 1) PG8_BAR;
        PG8_WAIT_V(2); PG8_BAR;
        PG8_STAGE(PG8_SB(1, 0), cB + kstep, voffB); PG8_STAGE(PG8_SA(1, 0), cA + kstep, voffA); PG8_STAGE(PG8_SB(1, 1), cB + hstepB + kstep, voffB);
        PG8_WAIT_V(6); PG8_BAR;
    } else {
        PG8_STAGE(PG8_SB(0, 0), cB, voffB); PG8_STAGE(PG8_SA(0, 0), cA, voffA); PG8_STAGE(PG8_SB(0, 1), cB + hstepB, voffB); PG8_STAGE(PG8_SA(0, 1), cA + hstepA, voffA);
        if (wr == 1) PG8_BAR;
        PG8_WAIT_V(4); PG8_BAR;
        PG8_STAGE(PG8_SB(1, 0), cB + kstep, voffB); PG8_STAGE(PG8_SA(1, 0), cA + kstep, voffA); PG8_STAGE(PG8_SB(1, 1), cB + hstepB + kstep, voffB);
        PG8_WAIT_V(6); PG8_BAR;
    }
    for (;;) {
        const bool has_next = S.next(ui + 1, nxt);
        const char* nA = has_next ? (const char*)g.A + (size_t)nxt.pm * tstepA : cA; const char* nB = has_next ? (const char*)g.Bt + (size_t)nxt.pn * tstepB : cB;
#pragma clang loop unroll(disable)
        for (int t = 0; t < nt; t += 2) {
            const bool last = (t == nt - 2);
            const char* a1 = cA + (size_t)(t + 1) * kstep;
            const char* a2 = last ? nA : cA + (size_t)(t + 2) * kstep; const char* b2 = last ? nB : cB + (size_t)(t + 2) * kstep;
            const char* a3 = a2 + kstep; const char* b3 = b2 + kstep;
            if (last && has_next) S.a_ready(nxt);
            if constexpr (SP2) {
            PG8_LDB(B0, 0, 0); PG8_LDB(B1, 0, 1); PG8_SCHED; PG8_LDA(At, 0, 0); PG8_STAGE(PG8_SA(1, 1), a1 + hstepA, voffA);
            PG8_WAIT_V(8); PG8_WAIT_L(0); PG8_BAR; PG8_MMA(0, 0, At, B0); PG8_MMA(0, 1, At, B1); PG8_BAR; PG8_SCHED;
            PG8_LDA(At, 0, 1); PG8_STAGE(PG8_SB(0, 0), b2, voffB); PG8_STAGE(PG8_SB(0, 1), b2 + hstepB, voffB); PG8_STAGE(PG8_SA(0, 0), a2, voffA);
            PG8_WAIT_V(8); PG8_WAIT_L(0); PG8_BAR; PG8_MMA(1, 0, At, B0); PG8_MMA(1, 1, At, B1); PG8_BAR; PG8_SCHED;
            PG8_LDB(B0, 1, 0); PG8_LDB(B1, 1, 1); PG8_SCHED; PG8_LDA(At, 1, 0); PG8_STAGE(PG8_SA(0, 1), a2 + hstepA, voffA);
            PG8_WAIT_V(8); PG8_WAIT_L(0); PG8_BAR; PG8_MMA(0, 0, At, B0); PG8_MMA(0, 1, At, B1); PG8_BAR; PG8_SCHED;
            PG8_LDA(At, 1, 1); PG8_STAGE(PG8_SB(1, 0), b3, voffB); PG8_STAGE(PG8_SB(1, 1), b3 + hstepB, voffB); PG8_STAGE(PG8_SA(1, 0), a3, voffA);
            PG8_WAIT_V(8); PG8_WAIT_L(0); PG8_BAR; PG8_MMA(1, 0, At, B0); PG8_MMA(1, 1, At, B1); PG8_BAR; PG8_SCHED;
            } else {
            PG8_LDB(B0, 0, 0); PG8_SCHED; PG8_LDA(At, 0, 0); PG8_STAGE(PG8_SA(1, 1), a1 + hstepA, voffA);
            PG8_WAIT_L(8); PG8_BAR; PG8_WAIT_L(0); PG8_MMA(0, 0, At, B0); PG8_BAR; PG8_SCHED;
            PG8_LDB(B1, 0, 1); PG8_STAGE(PG8_SB(0, 0), b2, voffB);
            PG8_BAR; PG8_WAIT_L(0); PG8_MMA(0, 1, At, B1); PG8_BAR;
            PG8_LDA(At, 0, 1); PG8_STAGE(PG8_SA(0, 0), a2, voffA);
            PG8_BAR; PG8_WAIT_L(0); PG8_MMA(1, 0, At, B0); PG8_BAR; PG8_SCHED;
            PG8_STAGE(PG8_SB(0, 1), b2 + hstepB, voffB);
            PG8_WAIT_V(6); PG8_BAR; PG8_MMA(1, 1, At, B1); PG8_BAR;
            PG8_LDB(B0, 1, 0); PG8_SCHED; PG8_LDA(At, 1, 0); PG8_STAGE(PG8_SA(0, 1), a2 + hstepA, voffA);
            PG8_WAIT_L(8); PG8_BAR; PG8_WAIT_L(0); PG8_MMA(0, 0, At, B0); PG8_BAR; PG8_SCHED;
            PG8_LDB(B1, 1, 1); PG8_STAGE(PG8_SB(1, 0), b3, voffB);
            PG8_BAR; PG8_WAIT_L(0); PG8_MMA(0, 1, At, B1); PG8_BAR;
            PG8_LDA(At, 1, 1); PG8_STAGE(PG8_SA(1, 0), a3, voffA);
            PG8_BAR; PG8_WAIT_L(0); PG8_MMA(1, 0, At, B0); PG8_BAR; PG8_SCHED;
            PG8_STAGE(PG8_SB(1, 1), b3 + hstepB, voffB);
            PG8_WAIT_V(6); PG8_BAR; PG8_MMA(1, 1, At, B1); PG8_BAR;
            }
        }
        if constexpr (ALIGN_EPI) { if (wr == 0) PG8_BAR; }
        if constexpr (!Epi::AFTER_DRAIN) { E(acc, cur, wr, wc, fr, fq); S.done(cur); }
        if (!has_next) break;
#pragma unroll
        for (int a = 0; a < 2; ++a)
#pragma unroll
            for (int b = 0; b < 2; ++b)
#pragma unroll
                for (int m = 0; m < 4; ++m)
#pragma unroll
                    for (int n = 0; n < 2; ++n) acc[a][b][m][n] = (f32x4){0.f, 0.f, 0.f, 0.f};
        cur = nxt; cA = nA; cB = nB; ++ui;
        if constexpr (ALIGN_EPI) { if (wr == 1) PG8_BAR; }
    }
    PG8_WAIT_V(0);
    if constexpr (!ALIGN_EPI) { if (wr == 0) PG8_BAR; }
    PG8_BAR;
    if constexpr (Epi::AFTER_DRAIN) { E.fused(acc, cur, wr, wc, fr, fq, lds, wid, lane); S.done(cur); }
#undef PG8_SA
#undef PG8_SB
#undef PG8_STAGE
#undef PG8_LDA
#undef PG8_LDB
#undef PG8_MMA
#undef PG8_WAIT_V
#undef PG8_WAIT_L
#undef PG8_BAR
#undef PG8_SCHED
}
template <class Epi>
__device__ __forceinline__ void gemm_fast(LAS unsigned char* lds, const bf16_t* A, int lda, const bf16_t* Bt, int ldb, int M, int N, int K, const Epi& E) {
    Gemm g{A, Bt, M, N, K, lda, ldb}; StaticOrder S; S.init(M, N, (int)gridDim.x, (int)blockIdx.x);
    gemm_phase<Epi, StaticOrder, !Epi::AFTER_DRAIN, true>(lds, g, S, E);
}

__device__ __forceinline__ void p0_item(const float* W, int K, int N, const float* g, bf16_t* WT, int ldt, int mode, LAS float* scr, int item, int lane) {
    const int nblk = N / 32, kb = item / nblk, nb = item % nblk, k0 = 64 * kb, n0 = 32 * nb;
    { const int kr = lane >> 3, ch = lane & 7; f32x4 v[8];
#pragma unroll
      for (int i = 0; i < 8; ++i) v[i] = *(const f32x4*)(W + (size_t)(k0 + 8 * i + kr) * N + n0 + 4 * ch);
#pragma unroll
      for (int i = 0; i < 8; ++i) { const int kk = 8 * i + kr; const float gs = g ? g[k0 + kk] : 1.0f; LAS float* d = scr + kk * 33 + 4 * ch; d[0] = v[i][0] * gs; d[1] = v[i][1] * gs; d[2] = v[i][2] * gs; d[3] = v[i][3] * gs; } }
    asm volatile("s_waitcnt lgkmcnt(0)" ::: "memory");
    const int c = lane & 7;
#pragma unroll
    for (int j = 0; j < 4; ++j) {
        const int n = (lane >> 3) + 8 * j; const LAS float* s = scr + (8 * c) * 33 + n;
        u32x4 o; o.x = cvt_pk_bf16(s[0 * 33], s[1 * 33]); o.y = cvt_pk_bf16(s[2 * 33], s[3 * 33]); o.z = cvt_pk_bf16(s[4 * 33], s[5 * 33]); o.w = cvt_pk_bf16(s[6 * 33], s[7 * 33]);
        const int nn = n0 + n; const int row = (mode == 0) ? nn : ((nn >> 7) * 256 + (mode == 2 ? 128 : 0) + (nn & 127));
        *(u32x4*)(WT + (size_t)row * ldt + k0 + 8 * c) = o;
    }
    asm volatile("s_waitcnt lgkmcnt(0)" ::: "memory");
}


typedef float f32x16 __attribute__((ext_vector_type(16)));
constexpr int AT_VSTR = 72;
constexpr int AT_KBUF = 64 * 104 * 2, AT_VBUF = 64 * AT_VSTR * 2;
constexpr int AT_OFF_K = 0, AT_OFF_V = 2 * AT_KBUF, AT_OFF_BIAS = 2 * AT_KBUF + 2 * AT_VBUF, AT_OFF_FLAG = AT_OFF_BIAS + 2304, AT_OFF_H1 = AT_OFF_FLAG + 256;
__device__ __forceinline__ int crow16(int r, int hi) { return (r & 3) + 8 * (r >> 2) + 4 * hi; }
__device__ __forceinline__ int vperm(int key) { const int k16 = key & 15; return (key & ~15) + 8 * ((k16 >> 2) & 1) + 4 * (k16 >> 3) + (k16 & 3); }
__device__ __forceinline__ bf16x8 pack8(float a0, float a1, float a2, float a3, float a4, float a5, float a6, float a7) {
    u32x4 w; w.x = cvt_pk_bf16(a0, a1); w.y = cvt_pk_bf16(a2, a3); w.z = cvt_pk_bf16(a4, a5); w.w = cvt_pk_bf16(a6, a7); return __builtin_bit_cast(bf16x8, w);
}

__device__ __forceinline__ float max3f(float a, float b, float c) { return __builtin_fmaxf(__builtin_fmaxf(a, b), c); }
template <int MODE, bool TWOH = false>
__device__ __forceinline__ void attn_unit(LAS unsigned char* lds, int q0, const bf16_t* Qp, int ldq, const bf16_t* Kp, int ldk, const bf16_t* Krp, int ldkr, const bf16_t* Vp, int ldv, bf16_t* Op, const float* bias_g) {
    constexpr int DQK = (MODE == 0) ? 96 : 64, NDD = DQK / 16, KSTR = DQK + 8;
    int tid_ = threadIdx.x; asm volatile("" : "+v"(tid_));
    const int tid = tid_, lane = tid & 63, wid = __builtin_amdgcn_readfirstlane(tid >> 6), l31 = lane & 31, hi = lane >> 5;
    const int hsel = TWOH ? (wid >> 2) : 0;
    const int t0w = q0 + 32 * (TWOH ? (wid & 3) : wid), trow = t0w + l31, nq = t0w >> 6;
    LAS unsigned char* ldsh = lds + hsel * AT_OFF_H1;
    Qp += hsel * 64; Op += hsel * 64;
    LAS float* biasl = (LAS float*)(ldsh + AT_OFF_BIAS);
    LAS int* flags = (LAS int*)(lds + AT_OFF_FLAG);
    float bz0 = 0.f, bz1 = 0.f, bz2 = 0.f, bz3 = 0.f;
    if (MODE == 2) { bz0 = bias_g[tid]; if (tid == 0) bz1 = bias_g[512]; if (TWOH) { bz2 = bias_g[513 + tid]; if (tid == 0) bz3 = bias_g[513 + 512]; } }
    bf16x8 qf[NDD];
#pragma unroll
    for (int dd = 0; dd < NDD; ++dd) qf[dd] = *(const bf16x8*)(Qp + (size_t)trow * ldq + 16 * dd + 8 * hi);
    f32x16 o0, o1;
#pragma unroll
    for (int r = 0; r < 16; ++r) { o0[r] = 0.f; o1[r] = 0.f; }
    float mref = 0.f, lrow = 0.f, carry = 0.f; bool first = true;
    f32x16 negm;
#pragma unroll
    for (int r = 0; r < 16; ++r) negm[r] = 0.f;
    const int kt_hi = (q0 + (TWOH ? 127 : 255)) >> 6;
    int kt_lo = 0; if (MODE == 2) { kt_lo = (q0 >> 6) - 8; if (kt_lo < 0) kt_lo = 0; }
    const int nt = kt_hi - kt_lo + 1;
    const int skey = tid >> 3, sch = tid & 7, rkey = tid >> 2, rch = tid & 3;
    const int vcol = vperm(lane);
    u32x4 kregA, krregA, vregA, kreg2A, vreg2A, kregB, krregB, vregB, kreg2B, vreg2B;
#define AT_KT(i) ((MODE == 1) ? (kt_hi - (i)) : (kt_lo + (i)))
#define AT_PART(kt) ((MODE == 0) ? ((kt) <= nq) : (MODE == 1) ? (64 * (kt) <= t0w + 30) : (((kt) <= nq) && ((kt) >= nq - 8)))
#define AT_LOAD(kt, S) do { const size_t kb_ = (size_t)(kt) * 64; \
        kreg##S = *(const u32x4*)(Kp + (kb_ + skey) * ldk + sch * 8); \
        if (MODE == 0) { krreg##S = *(const u32x4*)(Krp + (kb_ + (rkey & 63)) * ldkr + rch * 8); }     \
        vreg##S = *(const u32x4*)(Vp + (kb_ + lane) * ldv + wid * 8); \
        if (TWOH) { kreg2##S = *(const u32x4*)(Kp + (kb_ + skey) * ldk + 64 + sch * 8); vreg2##S = *(const u32x4*)(Vp + (kb_ + lane) * ldv + 64 + wid * 8); } } while (0)
#define AT_VT8(dst, v) do { (dst)[0 * AT_VSTR] = (bf16_t)((v).x & 0xffffu); (dst)[1 * AT_VSTR] = (bf16_t)((v).x >> 16); (dst)[2 * AT_VSTR] = (bf16_t)((v).y & 0xffffu); (dst)[3 * AT_VSTR] = (bf16_t)((v).y >> 16); \
        (dst)[4 * AT_VSTR] = (bf16_t)((v).z & 0xffffu); (dst)[5 * AT_VSTR] = (bf16_t)((v).z >> 16); (dst)[6 * AT_VSTR] = (bf16_t)((v).w & 0xffffu); (dst)[7 * AT_VSTR] = (bf16_t)((v).w >> 16); } while (0)
#define AT_STORE(bufi, S) do { LAS bf16_t* Ks_ = (LAS bf16_t*)(lds + AT_OFF_K + (bufi) * AT_KBUF); LAS bf16_t* Vt_ = (LAS bf16_t*)(lds + AT_OFF_V + (bufi) * AT_VBUF); \
        *(LAS u32x4*)(Ks_ + skey * KSTR + sch * 8) = kreg##S; \
        if (MODE == 0) { if (tid < 256) *(LAS u32x4*)(Ks_ + rkey * KSTR + 64 + rch * 8) = krreg##S; } \
        LAS bf16_t* vd_ = Vt_ + (wid * 8) * AT_VSTR + vcol; AT_VT8(vd_, vreg##S); \
        if (TWOH) { LAS bf16_t* Ks2_ = (LAS bf16_t*)(lds + AT_OFF_H1 + AT_OFF_K + (bufi) * AT_KBUF); LAS bf16_t* ve_ = (LAS bf16_t*)(lds + AT_OFF_H1 + AT_OFF_V + (bufi) * AT_VBUF) + (wid * 8) * AT_VSTR + vcol; \
            *(LAS u32x4*)(Ks2_ + skey * KSTR + sch * 8) = kreg2##S; AT_VT8(ve_, vreg2##S); } } while (0)
#define AT_BAR() do { asm volatile("s_waitcnt lgkmcnt(0)" ::: "memory"); __builtin_amdgcn_s_barrier(); asm volatile("" ::: "memory"); } while (0)
    auto compute = [&](int bufo, int kt) __attribute__((always_inline)) {
            const LAS bf16_t* Ks = (const LAS bf16_t*)(ldsh + AT_OFF_K + bufo * AT_KBUF); const LAS bf16_t* Vt = (const LAS bf16_t*)(ldsh + AT_OFF_V + bufo * AT_VBUF);
            f32x16 p0, p1;
            if (MODE == 1) {
#pragma unroll
                for (int r = 0; r < 16; ++r) { p0[r] = 0.f; p1[r] = 0.f; }
            } else { p0 = negm; p1 = negm; }
            bf16x8 ka[NDD], kb[NDD], va[4], vb[4];
            constexpr int NH = (NDD > 4) ? 4 : NDD;
#pragma unroll
            for (int dd = 0; dd < NH; ++dd) { ka[dd] = *(const LAS bf16x8*)(Ks + l31 * KSTR + 16 * dd + 8 * hi); kb[dd] = *(const LAS bf16x8*)(Ks + (32 + l31) * KSTR + 16 * dd + 8 * hi); }
            __builtin_amdgcn_sched_barrier(0);
#pragma unroll
            for (int dd = 0; dd < NH; ++dd) { p0 = __builtin_amdgcn_mfma_f32_32x32x16_bf16(ka[dd], qf[dd], p0, 0, 0, 0); p1 = __builtin_amdgcn_mfma_f32_32x32x16_bf16(kb[dd], qf[dd], p1, 0, 0, 0);
                if (dd == 0) {
#pragma unroll
                    for (int d2 = NH; d2 < NDD; ++d2) { ka[d2] = *(const LAS bf16x8*)(Ks + l31 * KSTR + 16 * d2 + 8 * hi); kb[d2] = *(const LAS bf16x8*)(Ks + (32 + l31) * KSTR + 16 * d2 + 8 * hi); }
                } }
#pragma unroll
            for (int dd = NH; dd < NDD; ++dd) { p0 = __builtin_amdgcn_mfma_f32_32x32x16_bf16(ka[dd], qf[dd], p0, 0, 0, 0); p1 = __builtin_amdgcn_mfma_f32_32x32x16_bf16(kb[dd], qf[dd], p1, 0, 0, 0); }
            __builtin_amdgcn_sched_barrier(0);
            if (MODE != 1) {
#pragma unroll
                for (int jj = 0; jj < 4; ++jj) { va[jj] = *(const LAS bf16x8*)(Vt + l31 * AT_VSTR + 8 * hi + 16 * jj); vb[jj] = *(const LAS bf16x8*)(Vt + (32 + l31) * AT_VSTR + 8 * hi + 16 * jj); }
            }
            __builtin_amdgcn_sched_barrier(0);
            if (MODE != 1) {
                if (MODE == 2) {
                    if (nq - kt >= 5) { const float cb = biasl[512];
#pragma unroll
                        for (int r = 0; r < 16; ++r) { p0[r] += cb; p1[r] += cb; }
                    } else {
                        const int relb = trow - 64 * kt - 4 * hi;
#pragma unroll
                        for (int r = 0; r < 16; ++r) {
                            int rel0 = relb - ((r & 3) + 8 * (r >> 2)); int rel1 = rel0 - 32;
                            rel0 = rel0 > 256 ? 256 : rel0; rel1 = rel1 > 256 ? 256 : rel1;
                            p0[r] += biasl[256 + rel0]; p1[r] += biasl[256 + rel1];
                        }
                    }
                }
                float mx = max3f(p0[0], p1[0], p0[1]);
#pragma unroll
                for (int r = 1; r < 15; r += 2) { mx = max3f(mx, p1[r], p0[r + 1]); mx = max3f(mx, p1[r + 1], p0[(r + 2 > 15) ? 15 : (r + 2)]); }
                mx = fmaxf(mx, p1[15]);
                mx = fmaxf(mx, __shfl_xor(mx, 32));
                if (first || __any(mx > 8.0f)) {
                    const float dl = first ? mx : fmaxf(mx, 0.f);
                    mref += dl;
#pragma unroll
                    for (int r = 0; r < 16; ++r) { p0[r] -= dl; p1[r] -= dl; }
                    if (!first) { const float f = __builtin_amdgcn_exp2f(-dl); lrow *= f;
#pragma unroll
                        for (int r = 0; r < 16; ++r) { o0[r] *= f; o1[r] *= f; } }
#pragma unroll
                    for (int r = 0; r < 16; ++r) negm[r] = -mref;
                    first = false;
                }
                float rs = 0.f;
#pragma unroll
                for (int r = 0; r < 16; ++r) { p0[r] = __builtin_amdgcn_exp2f(p0[r]); p1[r] = __builtin_amdgcn_exp2f(p1[r]); rs += p0[r] + p1[r]; }
                lrow += rs;
            } else {
                const bool need_mask = (64 * kt + 63 >= t0w);
                const int kvb = 64 * kt + 4 * hi;
                float gs[8], lkq0[16], lkq1[16];
#pragma unroll
                for (int g = 0; g < 8; ++g) {
                    float s4 = 0.f;
#pragma unroll
                    for (int c = 0; c < 4; ++c) {
                        const int r = 4 * (g & 3) + c;
                        const float z2 = ((g < 4) ? p0[r] : p1[r]) * (0.125f * LOG2E);
                        const float sp2 = fmaxf(z2, 0.f) + __builtin_amdgcn_logf(1.0f + __builtin_amdgcn_exp2f(-fabsf(z2)));
                        const bool valid = !need_mask || (kvb + 8 * g + c < trow);
                        const float lk = valid ? -sp2 : 0.f;
                        const float ls = valid ? (z2 - sp2) : -1e30f;
                        if (g < 4) { p0[r] = ls; } else { p1[r] = ls; }
                        s4 += lk;
                        if (g < 4) { lkq0[r] = lk; } else { lkq1[r] = lk; }
                    }
                    gs[g] = s4;
                }
                float run = 0.f, after[8];
#pragma unroll
                for (int g = 7; g >= 0; --g) { const float pg = __shfl_xor(gs[g], 32); after[g] = run + (hi == 0 ? pg : 0.f); run += gs[g] + pg; }
#pragma unroll
                for (int g = 0; g < 8; ++g) {
                    float suf = carry + after[g];
#pragma unroll
                    for (int c = 3; c >= 0; --c) {
                        const int r = 4 * (g & 3) + c;
                        if (g < 4) { p0[r] = __builtin_amdgcn_exp2f(p0[r] + suf); suf += lkq0[r]; } else { p1[r] = __builtin_amdgcn_exp2f(p1[r] + suf); suf += lkq1[r]; }
                    }
                }
                carry += run;
            }
            if (MODE == 1) {
#pragma unroll
                for (int jj = 0; jj < 4; ++jj) { va[jj] = *(const LAS bf16x8*)(Vt + l31 * AT_VSTR + 8 * hi + 16 * jj); vb[jj] = *(const LAS bf16x8*)(Vt + (32 + l31) * AT_VSTR + 8 * hi + 16 * jj); }
            }
            const bf16x8 pb0 = pack8(p0[0], p0[1], p0[2], p0[3], p0[4], p0[5], p0[6], p0[7]), pb1 = pack8(p0[8], p0[9], p0[10], p0[11], p0[12], p0[13], p0[14], p0[15]);
            const bf16x8 pb2 = pack8(p1[0], p1[1], p1[2], p1[3], p1[4], p1[5], p1[6], p1[7]), pb3 = pack8(p1[8], p1[9], p1[10], p1[11], p1[12], p1[13], p1[14], p1[15]);
            o0 = __builtin_amdgcn_mfma_f32_32x32x16_bf16(va[0], pb0, o0, 0, 0, 0); o1 = __builtin_amdgcn_mfma_f32_32x32x16_bf16(vb[0], pb0, o1, 0, 0, 0);
            o0 = __builtin_amdgcn_mfma_f32_32x32x16_bf16(va[1], pb1, o0, 0, 0, 0); o1 = __builtin_amdgcn_mfma_f32_32x32x16_bf16(vb[1], pb1, o1, 0, 0, 0);
            o0 = __builtin_amdgcn_mfma_f32_32x32x16_bf16(va[2], pb2, o0, 0, 0, 0); o1 = __builtin_amdgcn_mfma_f32_32x32x16_bf16(vb[2], pb2, o1, 0, 0, 0);
            o0 = __builtin_amdgcn_mfma_f32_32x32x16_bf16(va[3], pb3, o0, 0, 0, 0); o1 = __builtin_amdgcn_mfma_f32_32x32x16_bf16(vb[3], pb3, o1, 0, 0, 0);
            };
    bool brk = false;
#define AT_ITER(i, SL, SS) do { \
        const int kt_ = AT_KT(i); \
        AT_LOAD(AT_KT(((i) + 2 < nt) ? (i) + 2 : nt - 1), SL);        \
        if (AT_PART(kt_)) compute((i) & 1, kt_); \
        if ((i) + 1 < nt) AT_STORE(((i) + 1) & 1, SS); \
        if (MODE == 1) { const int done_ = __all(carry < -151.0f) ? 1 : 0; if (lane == 0) flags[((i) & 1) * 8 + wid] = done_; } \
        AT_BAR(); \
        if (MODE == 1) { int alld_ = 1; \
            _Pragma("unroll") for (int w8 = 0; w8 < 8; ++w8) alld_ &= flags[((i) & 1) * 8 + w8]; \
            if (alld_) brk = true; } } while (0)
    AT_LOAD(AT_KT(0), A);
    AT_LOAD(AT_KT(nt > 1 ? 1 : 0), B);
    if (MODE == 2) { ((LAS float*)(lds + AT_OFF_BIAS))[tid] = bz0 * LOG2E; if (tid == 0) ((LAS float*)(lds + AT_OFF_BIAS))[512] = bz1 * LOG2E;
        if (TWOH) { ((LAS float*)(lds + AT_OFF_H1 + AT_OFF_BIAS))[tid] = bz2 * LOG2E; if (tid == 0) ((LAS float*)(lds + AT_OFF_H1 + AT_OFF_BIAS))[512] = bz3 * LOG2E; } }
    AT_STORE(0, A);
    AT_BAR();
    for (int i = 0; i < nt; i += 2) {
        AT_ITER(i, A, B);
        if (brk || i + 1 >= nt) break;
        AT_ITER(i + 1, B, A);
        if (brk) break;
    }
    if (MODE == 1) { if (brk) AT_BAR(); }
#undef AT_ITER
#undef AT_PART
#undef AT_VT8
#undef AT_BAR
    float inv = 1.0f;
    if (MODE != 1) { const float lt = lrow + __shfl_xor(lrow, 32); inv = 1.0f / lt; }
    bf16_t* orow = Op + (size_t)trow * DM + 4 * hi;
#pragma unroll
    for (int g = 0; g < 4; ++g) {
        u32x2 w0, w1;
        w0.x = cvt_pk_bf16(o0[4 * g] * inv, o0[4 * g + 1] * inv); w0.y = cvt_pk_bf16(o0[4 * g + 2] * inv, o0[4 * g + 3] * inv);
        w1.x = cvt_pk_bf16(o1[4 * g] * inv, o1[4 * g + 1] * inv); w1.y = cvt_pk_bf16(o1[4 * g + 2] * inv, o1[4 * g + 3] * inv);
        *(u32x2*)(orow + 8 * g) = w0; *(u32x2*)(orow + 32 + 8 * g) = w1;
    }
#undef AT_KT
#undef AT_LOAD
#undef AT_STORE
}


#define XB_TMO      128
#define XB_XCNT(j)  (256  + 64 * (j))
#define XB_XSUB(j)  (1280 + 64 * (j))
#define XB_XGEN(j)  (2304 + 64 * (j))
#define XB_TOP      3328
#define XB_TOPGEN   3392
#define XCD_BAR_WORDS 3456
#define XB_SPIN_CAP (1u << 18)
__device__ __forceinline__ unsigned xb_ld(unsigned* p)              { return __hip_atomic_load(p, __ATOMIC_RELAXED, __HIP_MEMORY_SCOPE_AGENT); }
__device__ __forceinline__ unsigned xb_add(unsigned* p, unsigned v) { return __hip_atomic_fetch_add(p, v, __ATOMIC_RELAXED, __HIP_MEMORY_SCOPE_AGENT); }
__device__ __forceinline__ unsigned xb_xcc_id() { return (unsigned)__builtin_amdgcn_s_getreg((3 << 11) | 20) & 0xFu; }
#define XB_SPIN(cond, bar) do { unsigned _sp = 0; while (cond) { __builtin_amdgcn_s_sleep(1); \
    if ((++_sp & 255u) == 0u) { if (xb_ld(&(bar)[XB_TMO])) break; if (_sp > XB_SPIN_CAP) { atomicAdd(&(bar)[XB_TMO], 1u); break; } } } } while (0)
struct XcdBarrier { unsigned* bar; unsigned x; volatile LAS unsigned* st; };
__device__ __forceinline__ XcdBarrier xcd_barrier_post(unsigned* bar, volatile LAS unsigned* st) {
    XcdBarrier b; b.bar = bar; b.x = xb_xcc_id(); b.st = st;
    if (threadIdx.x == 0) (void)xb_add(&bar[XB_XCNT(b.x)], 1u);
    return b;
}
__device__ __forceinline__ void xcd_barrier_complete(unsigned* bar, unsigned x, unsigned& nloc, unsigned& nx) {
    const unsigned G = gridDim.x * gridDim.y * gridDim.z;
    unsigned sum, cnt, mine, sp = 0u;
    for (;;) {
        sum = 0u; cnt = 0u; mine = 0u;
#pragma unroll
        for (unsigned j = 0; j < 16; ++j) { const unsigned c = xb_ld(&bar[XB_XCNT(j)]); sum += c; cnt += (c > 0u) ? 1u : 0u; mine = (j == x) ? c : mine; }
        if (sum == G) break;
        __builtin_amdgcn_s_sleep(1);
        if ((++sp & 255u) == 0u) { if (xb_ld(&bar[XB_TMO])) break; if (sp > XB_SPIN_CAP) { atomicAdd(&bar[XB_TMO], 1u); break; } }
    }
    nloc = mine > 0u ? mine : 1u; nx = cnt > 0u ? cnt : 1u;
}
__device__ __forceinline__ void xcd_barrier(const XcdBarrier& b) {
    asm volatile("s_waitcnt vmcnt(0)" ::: "memory");
    __syncthreads();
    if (threadIdx.x == 0) {
        unsigned* bar = b.bar;
        __builtin_amdgcn_s_waitcnt(0);
        unsigned nloc = b.st[0], nx = b.st[1];
        if (nloc == 0u) { xcd_barrier_complete(bar, b.x, nloc, nx); b.st[0] = nloc; b.st[1] = nx; }
        const unsigned old = xb_add(&bar[XB_XSUB(b.x)], 1u);
        const unsigned gen = old / nloc;
        if (old + 1u == (gen + 1u) * nloc) {
            __builtin_amdgcn_fence(__ATOMIC_RELEASE, "agent");
            asm volatile("s_waitcnt vmcnt(0)" ::: "memory");
            const unsigned og = xb_add(&bar[XB_TOP], 1u);
            const unsigned tg = og / nx;
            if (og + 1u == (tg + 1u) * nx) xb_add(&bar[XB_TOPGEN], 1u);
            else XB_SPIN(xb_ld(&bar[XB_TOPGEN]) == tg, bar);
            __builtin_amdgcn_fence(__ATOMIC_ACQUIRE, "agent");
            xb_add(&bar[XB_XGEN(b.x)], 1u);
            asm volatile("s_waitcnt vmcnt(0)" ::: "memory");
        } else {
            XB_SPIN(xb_ld(&bar[XB_XGEN(b.x)]) == gen, bar);
            __builtin_amdgcn_fence(__ATOMIC_ACQUIRE, "agent");
            asm volatile("s_waitcnt vmcnt(0)" ::: "memory");
        }
    }
    __syncthreads();
}

struct Args { const float* in[16]; float* out; unsigned char* ws; };

__device__ __forceinline__ void attn_mla_naive(const bf16_t* QA, const bf16_t* KVA, const bf16_t* PROJ, bf16_t* O) {
    const int nth = gridDim.x * NTHREADS;
    for (int w = blockIdx.x * NTHREADS + threadIdx.x; w < 8 * MTOK; w += nth) {
        const int h = w >> 14, row = w & (MTOK - 1), b = row >> 11, t = row & (SEQ - 1);
        float q[96];
#pragma unroll
        for (int c = 0; c < 12; ++c) unpack8(*(const u32x4*)(QA + (size_t)row * NQA + h * 96 + c * 8), q + c * 8);
        float o[64];
#pragma unroll
        for (int d = 0; d < 64; ++d) o[d] = 0.f;
        float mx = -INFINITY, l = 0.f;
        const int kend = ((t >> 6) + 1) << 6;
        for (int s = 0; s < kend; ++s) {
            const size_t kr = (size_t)(b * SEQ + s);
            const bf16_t* kp = KVA + kr * NKVA + h * 128; const bf16_t* rp = PROJ + kr * NPROJ_P + C_KR;
            float sc = 0.f;
#pragma unroll
            for (int c = 0; c < 8; ++c) { float k[8]; unpack8(*(const u32x4*)(kp + c * 8), k);
#pragma unroll
                for (int e = 0; e < 8; ++e) sc += q[c * 8 + e] * k[e]; }
#pragma unroll
            for (int c = 0; c < 4; ++c) { float k[8]; unpack8(*(const u32x4*)(rp + c * 8), k);
#pragma unroll
                for (int e = 0; e < 8; ++e) sc += q[64 + c * 8 + e] * k[e]; }
            const float mn = fmaxf(mx, sc), al = __builtin_amdgcn_exp2f(mx - mn), p = __builtin_amdgcn_exp2f(sc - mn);
            l = l * al + p; mx = mn;
#pragma unroll
            for (int c = 0; c < 8; ++c) { float v[8]; unpack8(*(const u32x4*)(kp + 64 + c * 8), v);
#pragma unroll
                for (int e = 0; e < 8; ++e) o[c * 8 + e] = o[c * 8 + e] * al + p * v[e]; }
        }
        const float inv = 1.0f / l;
#pragma unroll
        for (int c = 0; c < 8; ++c) { u32x4 wv; wv.x = cvt_pk_bf16(o[c * 8] * inv, o[c * 8 + 1] * inv); wv.y = cvt_pk_bf16(o[c * 8 + 2] * inv, o[c * 8 + 3] * inv); wv.z = cvt_pk_bf16(o[c * 8 + 4] * inv, o[c * 8 + 5] * inv); wv.w = cvt_pk_bf16(o[c * 8 + 6] * inv, o[c * 8 + 7] * inv);
            *(u32x4*)(O + (size_t)row * DM + h * 64 + c * 8) = wv; }
    }
}

__device__ __forceinline__ void attn_sb_naive(const bf16_t* PROJ, bf16_t* O) {
    const int nth = gridDim.x * NTHREADS;
    for (int w = blockIdx.x * NTHREADS + threadIdx.x; w < 8 * MTOK; w += nth) {
        const int h = w >> 14, row = w & (MTOK - 1), b = row >> 11, t = row & (SEQ - 1);
        float q[64];
#pragma unroll
        for (int c = 0; c < 8; ++c) unpack8(*(const u32x4*)(PROJ + (size_t)row * NPROJ_P + C_QB + h * 64 + c * 8), q + c * 8);
        float o[64];
#pragma unroll
        for (int d = 0; d < 64; ++d) o[d] = 0.f;
        float cum = 0.f;
        const int tmax = t | 63;
        for (int s = tmax - 1; s >= 0; --s) {
            const size_t kr = (size_t)(b * SEQ + s);
            const bf16_t* kp = PROJ + kr * NPROJ_P + C_KB + h * 64; const bf16_t* vp = PROJ + kr * NPROJ_P + C_VB + h * 64;
            float z = 0.f;
#pragma unroll
            for (int c = 0; c < 8; ++c) { float k[8]; unpack8(*(const u32x4*)(kp + c * 8), k);
#pragma unroll
                for (int e = 0; e < 8; ++e) z += q[c * 8 + e] * k[e]; }
            z *= 0.125f;
            const bool on = s < t;
            const float lg = __logf(1.0f + __expf(-fabsf(z)));
            const float wgt = on ? __expf(fminf(z, 0.f) - lg + cum) : 0.f;
            cum += on ? (fminf(-z, 0.f) - lg) : 0.f;
#pragma unroll
            for (int c = 0; c < 8; ++c) { float v[8]; unpack8(*(const u32x4*)(vp + c * 8), v);
#pragma unroll
                for (int e = 0; e < 8; ++e) o[c * 8 + e] += wgt * v[e]; }
        }
#pragma unroll
        for (int c = 0; c < 8; ++c) { u32x4 wv; wv.x = cvt_pk_bf16(o[c * 8], o[c * 8 + 1]); wv.y = cvt_pk_bf16(o[c * 8 + 2], o[c * 8 + 3]); wv.z = cvt_pk_bf16(o[c * 8 + 4], o[c * 8 + 5]); wv.w = cvt_pk_bf16(o[c * 8 + 6], o[c * 8 + 7]);
            *(u32x4*)(O + (size_t)row * DM + 512 + h * 64 + c * 8) = wv; }
    }
}

__device__ __forceinline__ void attn_band_naive(const bf16_t* QKV, const float* rel_bias, bf16_t* O) {
    const int nth = gridDim.x * NTHREADS;
    for (int w = blockIdx.x * NTHREADS + threadIdx.x; w < 16 * MTOK; w += nth) {
        const int h = w >> 14, row = w & (MTOK - 1), b = row >> 11, t = row & (SEQ - 1);
        float q[64];
#pragma unroll
        for (int c = 0; c < 8; ++c) unpack8(*(const u32x4*)(QKV + (size_t)row * NQKV + h * 64 + c * 8), q + c * 8);
        float o[64];
#pragma unroll
        for (int d = 0; d < 64; ++d) o[d] = 0.f;
        float mx = -INFINITY, l = 0.f;
        const int n = t >> 6, s0 = (n >= 8) ? (n - 8) * 64 : 0, s1 = (n + 1) * 64;
        const float* bias = rel_bias + h * 513 + 256;
        for (int s = s0; s < s1; ++s) {
            const size_t kr = (size_t)(b * SEQ + s);
            const bf16_t* kp = QKV + kr * NQKV + 1024 + h * 64; const bf16_t* vp = QKV + kr * NQKV + 2048 + h * 64;
            float sc = 0.f;
#pragma unroll
            for (int c = 0; c < 8; ++c) { float k[8]; unpack8(*(const u32x4*)(kp + c * 8), k);
#pragma unroll
                for (int e = 0; e < 8; ++e) sc += q[c * 8 + e] * k[e]; }
            int rel = t - s; rel = rel > 256 ? 256 : (rel < -256 ? -256 : rel);
            sc += bias[rel] * LOG2E;
            const float mn = fmaxf(mx, sc), al = __builtin_amdgcn_exp2f(mx - mn), p = __builtin_amdgcn_exp2f(sc - mn);
            l = l * al + p; mx = mn;
#pragma unroll
            for (int c = 0; c < 8; ++c) { float v[8]; unpack8(*(const u32x4*)(vp + c * 8), v);
#pragma unroll
                for (int e = 0; e < 8; ++e) o[c * 8 + e] = o[c * 8 + e] * al + p * v[e]; }
        }
        const float inv = 1.0f / l;
#pragma unroll
        for (int c = 0; c < 8; ++c) { u32x4 wv; wv.x = cvt_pk_bf16(o[c * 8] * inv, o[c * 8 + 1] * inv); wv.y = cvt_pk_bf16(o[c * 8 + 2] * inv, o[c * 8 + 3] * inv); wv.z = cvt_pk_bf16(o[c * 8 + 4] * inv, o[c * 8 + 5] * inv); wv.w = cvt_pk_bf16(o[c * 8 + 6] * inv, o[c * 8 + 7] * inv);
            *(u32x4*)(O + (size_t)row * DM + h * 64 + c * 8) = wv; }
    }
}

constexpr int I_IN = 16 * (NPROJ / 32), I_UQ = 6 * 24, I_UKV = 4 * 32, I_O = 16 * 32, I_G = 16 * 88, I_D = 44 * 32, I_QKV = 16 * 96;
constexpr int CV_R0 = I_IN + I_UQ + I_UKV, CV_R1 = CV_R0 + I_O + 2 * I_G + I_D + I_QKV + I_O, CV_NITEMS = CV_R1 + 2 * I_G + I_D;
#define CONV_ITEM(it_) do { int r = (it_); \
        if (r < I_IN) { p0_item(args.in[1], DM, NPROJ, args.in[10], Win, DM, 0, scr, r, lane); break; } r -= I_IN; \
        if (r < I_UQ) { p0_item(args.in[3], 384, NQA, args.in[2], Wuq, 384, 0, scr, r, lane); break; } r -= I_UQ; \
        if (r < I_UKV) { p0_item(args.in[5], 256, NKVA, args.in[4], Wukv, 256, 0, scr, r, lane); break; } r -= I_UKV; \
        if (r < I_O) { p0_item(args.in[6], DM, DM, nullptr, Wo0, DM, 0, scr, r, lane); break; } r -= I_O; \
        if (r < I_G) { p0_item(args.in[12], DM, DFF, args.in[11], Wgu0, DM, 1, scr, r, lane); break; } r -= I_G; \
        if (r < I_G) { p0_item(args.in[13], DM, DFF, args.in[11], Wgu0, DM, 2, scr, r, lane); break; } r -= I_G; \
        if (r < I_D) { p0_item(args.in[14], DFF, DM, nullptr, Wd0, DFF, 0, scr, r, lane); break; } r -= I_D; \
        if (r < I_QKV) { p0_item(args.in[7], DM, NQKV, args.in[10] + DM, Wqkv, DM, 0, scr, r, lane); break; } r -= I_QKV; \
        if (r < I_O) { p0_item(args.in[9], DM, DM, nullptr, Wo1, DM, 0, scr, r, lane); break; } r -= I_O; \
        if (r < I_G) { p0_item(args.in[12] + (size_t)DM * DFF, DM, DFF, args.in[11] + DM, Wgu1, DM, 1, scr, r, lane); break; } r -= I_G; \
        if (r < I_G) { p0_item(args.in[13] + (size_t)DM * DFF, DM, DFF, args.in[11] + DM, Wgu1, DM, 2, scr, r, lane); break; } r -= I_G; \
        p0_item(args.in[14] + (size_t)DFF * DM, DFF, DM, nullptr, Wd1, DFF, 0, scr, r, lane); } while (0)
#define CONV_TAIL(first, lo, hi) do { if (G == 256 && (int)blockIdx.x >= (first)) { int tid_c = threadIdx.x; asm volatile("" : "+v"(tid_c)); const int lane = tid_c & 63, wave = __builtin_amdgcn_readfirstlane(tid_c >> 6); \
        LAS float* scr = (LAS float*)((LAS unsigned char*)lds + wave * 16384); \
        for (int it = (lo) + ((int)blockIdx.x - (first)) * 8 + wave; it < (hi); it += (G - (first)) * 8) CONV_ITEM(it); } } while (0)

__global__ void __launch_bounds__(NTHREADS) fwd_megakernel(Args args) {
    extern __shared__ __attribute__((aligned(16))) unsigned char lds[];
#ifdef USE_CG_SYNC
    cg::grid_group grid = cg::this_grid();
#define GRID_SYNC() grid.sync()
#else
    { volatile LAS unsigned* st0 = (volatile LAS unsigned*)((LAS unsigned char*)lds + LDS_BYTES - 64); if (threadIdx.x == 0) { st0[0] = 0u; st0[1] = 0u; } }
    __syncthreads();
    const XcdBarrier xbar = xcd_barrier_post((unsigned*)(args.ws + WS_CTL), (volatile LAS unsigned*)((LAS unsigned char*)lds + LDS_BYTES - 64));
#define GRID_SYNC() xcd_barrier(xbar)
#endif
#ifdef USE_NAIVE_GEMM
#define GEMM(A, lda, Bt, ldb, M, N, K, E) gemm_naive(A, lda, Bt, ldb, (M) / 256, (N) / 256, K, E)
#else
#define GEMM(A, lda, Bt, ldb, M, N, K, E) gemm_fast((LAS unsigned char*)lds, A, lda, Bt, ldb, M, N, K, E)
#endif
    const int G = gridDim.x;
    const int vcu = (G % 8 == 0) ? (int)(blockIdx.x % 8) * (G / 8) + (int)(blockIdx.x / 8) : (int)blockIdx.x;
    LAS unsigned char* ldsp = (LAS unsigned char*)lds;
    unsigned char* ws = args.ws;
    const float* x = args.in[0];
    float* out = args.out;
    u64* ssq = (u64*)(ws + WS_SSQ);
    f32x2* rope = (f32x2*)(ws + WS_ROPE);
    bf16_t* Win = (bf16_t*)(ws + WS_WIN); bf16_t* Wuq = (bf16_t*)(ws + WS_WUQ); bf16_t* Wukv = (bf16_t*)(ws + WS_WUKV); bf16_t* Wo0 = (bf16_t*)(ws + WS_WO0);
    bf16_t* Wgu0 = (bf16_t*)(ws + WS_WGU0); bf16_t* Wd0 = (bf16_t*)(ws + WS_WD0); bf16_t* Wqkv = (bf16_t*)(ws + WS_WQKV); bf16_t* Wo1 = (bf16_t*)(ws + WS_WO1);
    bf16_t* Wgu1 = (bf16_t*)(ws + WS_WGU1); bf16_t* Wd1 = (bf16_t*)(ws + WS_WD1);
    bf16_t* HB = (bf16_t*)(ws + WS_HB); bf16_t* PROJ = (bf16_t*)(ws + WS_A); bf16_t* QKV = (bf16_t*)(ws + WS_A); bf16_t* ACT = (bf16_t*)(ws + WS_A); bf16_t* ATT = (bf16_t*)(ws + WS_ATT);
    bf16_t* QA = (bf16_t*)((unsigned char*)out + OUT_QA); bf16_t* KVA = (bf16_t*)((unsigned char*)out + OUT_KVA);

    {
        const int tid = threadIdx.x, lane = tid & 63, wave = __builtin_amdgcn_readfirstlane(tid >> 6);
        LAS float* scr = (LAS float*)((LAS unsigned char*)lds + wave * 16384);
        const int gw = blockIdx.x * 8 + wave, NGW = G * 8;
        const bool offload = (G == 256);
        for (int it = gw; it < (offload ? CV_R0 : CV_NITEMS); it += NGW) CONV_ITEM(it);
        for (int i = blockIdx.x * NTHREADS + tid; i < (NPROJ_P - NPROJ) * DM / 8; i += G * NTHREADS) ((u32x4*)(Win + (size_t)NPROJ * DM))[i] = (u32x4){0u, 0u, 0u, 0u};
        for (int i = blockIdx.x * NTHREADS + tid; i < 6 * MTOK; i += G * NTHREADS) ssq[MTOK + i] = 0ull;
        for (int i = blockIdx.x * NTHREADS + tid; i < SEQ * 16; i += G * NTHREADS) {
            const int pos = i >> 4, fi = i & 15;
            const float inv_freq = __builtin_amdgcn_exp2f(-(float)fi * (13.287712379549449f / 16.0f));
            const float ang = (float)pos * inv_freq;
            float tr = ang * 0.15915494309189535f; tr -= floorf(tr);
            rope[i] = (f32x2){__builtin_amdgcn_cosf(tr), __builtin_amdgcn_sinf(tr)};
        }
        for (int m = gw; m < MTOK; m += NGW) {
            const f32x4* xr = (const f32x4*)(x + (size_t)m * DM) + lane; f32x4 v[4]; float s = 0.f;
#pragma unroll
            for (int j = 0; j < 4; ++j) { v[j] = xr[64 * j]; s += dot4(v[j]); }
            s = wave_sum(s);
            if (lane == 0) ssq[m] = ssq_fix(s);
#pragma unroll
            for (int j = 0; j < 4; ++j) { u32x2 w; w.x = cvt_pk_bf16(v[j][0], v[j][1]); w.y = cvt_pk_bf16(v[j][2], v[j][3]); *((u32x2*)(HB + (size_t)m * DM) + lane + 64 * j) = w; }
        }
    }
    GRID_SYNC();
    { EpiScale<0> E{PROJ, NPROJ_P, ssq, 1.0f / DM, ssq + MTOK, ssq + 2 * MTOK, rope}; GEMM(HB, DM, Win, DM, MTOK, NPROJ_P, DM, E); }
    CONV_TAIL(64, CV_R0, CV_R1);
    GRID_SYNC();
    { EpiScale<1> E{QA, NQA, ssq + MTOK, 1.0f / 384, nullptr, nullptr, rope}; GEMM(PROJ, NPROJ_P, Wuq, 384, MTOK, NQA, 384, E); }
    { EpiScale<2> E{KVA, NKVA, ssq + 2 * MTOK, 1.0f / 256, nullptr, nullptr, rope}; GEMM(PROJ + C_CKV, NPROJ_P, Wukv, 256, MTOK, NKVA, 256, E); }
    GRID_SYNC();
#ifdef NAIVE_ATTN
    attn_mla_naive(QA, KVA, PROJ, ATT);
    attn_sb_naive(PROJ, ATT);
#else
    for (int u = vcu; u < 256; u += G) {
        const int bh = u >> 2, j = u & 3, b = bh >> 3, h = bh & 7;
        const size_t rb = (size_t)b * SEQ;
        for (int k = 0; k < 2 * REP_MLA; ++k) { const int qt = (k & 1) ? 7 - j : j;
            attn_unit<0>(ldsp, 256 * qt, QA + rb * NQA + h * 96, NQA, KVA + rb * NKVA + h * 128, NKVA, PROJ + rb * NPROJ_P + C_KR, NPROJ_P, KVA + rb * NKVA + h * 128 + 64, NKVA, ATT + rb * DM + h * 64, nullptr); }
    }
    for (int u = vcu; u < 256; u += G) {
        const int bhp = u >> 3, j = u & 7, b = bhp >> 2, hp = bhp & 3;
        const size_t rb = (size_t)b * SEQ;
        for (int k = 0; k < 2 * REP_SB; ++k) { const int qt = (k & 1) ? 15 - j : j;
            attn_unit<1, true>(ldsp, 128 * qt, PROJ + rb * NPROJ_P + C_QB + hp * 128, NPROJ_P, PROJ + rb * NPROJ_P + C_KB + hp * 128, NPROJ_P, nullptr, 0, PROJ + rb * NPROJ_P + C_VB + hp * 128, NPROJ_P, ATT + rb * DM + 512 + hp * 128, nullptr); }
    }
#endif
    GRID_SYNC();
    { EpiResid E{HB, ssq + 3 * MTOK}; GEMM(ATT, DM, Wo0, DM, MTOK, DM, DM, E); }
    GRID_SYNC();
    for (int rep = 0; rep < REP_GU; ++rep) { EpiSwiglu E{ACT, ssq + 3 * MTOK}; GEMM(HB, DM, Wgu0, DM, MTOK, 2 * DFF, DM, E); }
    CONV_TAIL(128, CV_R1, CV_NITEMS);
    GRID_SYNC();
    { EpiResid E{HB, ssq + 4 * MTOK}; GEMM(ACT, DFF, Wd0, DFF, MTOK, DM, DFF, E); }
    GRID_SYNC();
    { EpiScale<3> E{QKV, NQKV, ssq + 4 * MTOK, 1.0f / DM, nullptr, nullptr, rope}; GEMM(HB, DM, Wqkv, DM, MTOK, NQKV, DM, E); }
    GRID_SYNC();
#ifdef NAIVE_ATTN
    attn_band_naive(QKV, args.in[8], ATT);
#else
    for (int u = vcu; u < 256; u += G) {
        const int bhp = u >> 2, j = u & 3, b = bhp >> 3, hp = bhp & 7;
        const size_t rb = (size_t)b * SEQ;
        for (int k = 0; k < 4 * REP_BAND; ++k) { const int kk = k & 3; const int qt = (kk == 0) ? j : (kk == 1) ? 7 - j : (kk == 2) ? 8 + j : 15 - j;
            attn_unit<2, true>(ldsp, 128 * qt, QKV + rb * NQKV + hp * 128, NQKV, QKV + rb * NQKV + 1024 + hp * 128, NQKV, nullptr, 0, QKV + rb * NQKV + 2048 + hp * 128, NQKV, ATT + rb * DM + hp * 128, args.in[8] + (2 * hp) * 513); }
    }
#endif
    GRID_SYNC();
    { EpiResid E{HB, ssq + 5 * MTOK}; GEMM(ATT, DM, Wo1, DM, MTOK, DM, DM, E); }
    GRID_SYNC();
    { EpiSwiglu E{ACT, ssq + 5 * MTOK}; GEMM(HB, DM, Wgu1, DM, MTOK, 2 * DFF, DM, E); }
    GRID_SYNC();
    if (G == 256) {
        EpiFinal E{HB, ssq + 6 * MTOK, (unsigned*)(args.ws + WS_CTL) + CW_PANEL, args.in[15], out};
        gemm_fast((LAS unsigned char*)lds, ACT, DFF, Wd1, DFF, MTOK, DM, DFF, E);
        return;
    }
    { EpiResid E{HB, ssq + 6 * MTOK}; GEMM(ACT, DFF, Wd1, DFF, MTOK, DM, DFF, E); }
    GRID_SYNC();
    {
        const int tid = threadIdx.x, lane = tid & 63, wave = __builtin_amdgcn_readfirstlane(tid >> 6); (void)tid;
        const int gw = blockIdx.x * 8 + wave, NGW = G * 8;
        const f32x4* gf = (const f32x4*)args.in[15] + lane;
        for (int m = gw; m < MTOK; m += NGW) {
            const float r = rsqrtf(ssq_get(ssq + 6 * MTOK, m) * (1.0f / DM) + RMS_EPS);
            f32x4* p = (f32x4*)(out + (size_t)m * DM) + lane; const u32x2* hp = (const u32x2*)(HB + (size_t)m * DM) + lane;
#pragma unroll
            for (int j = 0; j < 4; ++j) { const u32x2 hv = hp[64 * j]; const f32x4 g4 = gf[64 * j]; f32x4 o; o[0] = bflo(hv.x) * r * g4[0]; o[1] = bfhi(hv.x) * r * g4[1]; o[2] = bflo(hv.y) * r * g4[2]; o[3] = bfhi(hv.y) * r * g4[3]; p[64 * j] = o; }
        }
    }
}

extern "C" void kernel_launch(void* const* d_in, const int* in_sizes, int n_in, void* d_out, int out_size, void* d_ws, size_t ws_size, hipStream_t stream) {
    static int grid = 0;
    if (grid == 0) {
        int dev = 0, cus = 0, per_cu = 0;
        hipGetDevice(&dev);
        hipDeviceGetAttribute(&cus, hipDeviceAttributeMultiprocessorCount, dev);
        hipFuncSetAttribute((const void*)fwd_megakernel, hipFuncAttributeMaxDynamicSharedMemorySize, LDS_BYTES);
        hipOccupancyMaxActiveBlocksPerMultiprocessor(&per_cu, (const void*)fwd_megakernel, NTHREADS, LDS_BYTES);
        if (per_cu < 1) per_cu = 1;
        if (per_cu > 1) per_cu = 1;
        grid = cus * per_cu;
        if (n_in != 16 || out_size != MTOK * DM || ws_size < WS_END) { fprintf(stderr, "kernel_launch: unexpected shapes n_in %d out %d ws %zu\n", n_in, out_size, ws_size); }
    }
    Args a{};
    for (int i = 0; i < 16; ++i) a.in[i] = (const float*)d_in[i];
    a.out = (float*)d_out; a.ws = (unsigned char*)d_ws;
    hipMemsetAsync((char*)d_ws + WS_CTL, 0, CTL_BYTES, stream);
    void* kargs[] = {&a};
    hipError_t e = hipLaunchCooperativeKernel((const void*)fwd_megakernel, dim3(grid), dim3(NTHREADS), kargs, LDS_BYTES, stream);
    if (e != hipSuccess) fprintf(stderr, "cooperative launch failed: %s (grid %d)\n", hipGetErrorString(e), grid);
}
```

```cpp
#include <hip/hip_runtime.h>
#include <hip/hip_cooperative_groups.h>
#include <cstdio>
#include <cstdint>
namespace cg = cooperative_groups;
#define REP_MLA 1
#define REP_SB 1
#define REP_BAND 1
#define REP_GU 1

#define LAS __attribute__((address_space(3)))
typedef unsigned short bf16_t;
typedef short bf16x8 __attribute__((ext_vector_type(8)));
typedef float f32x4 __attribute__((ext_vector_type(4)));
typedef float f32x2 __attribute__((ext_vector_type(2)));
typedef unsigned u32x4 __attribute__((ext_vector_type(4)));
typedef unsigned u32x2 __attribute__((ext_vector_type(2)));

constexpr int MTOK = 16384, SEQ = 2048, DM = 1024, DFF = 2816;
constexpr int NPROJ = 2208, NPROJ_P = 2304;
constexpr int C_CKV = 384, C_KR = 640, C_QB = 672, C_KB = 1184, C_VB = 1696;
constexpr int NQA = 768, NKVA = 1024, NQKV = 3072;
constexpr float RMS_EPS = 1e-6f;
constexpr float LOG2E = 1.4426950408889634f;
constexpr float QSCALE_A = 0.10206207261596577f * LOG2E;
constexpr float QSCALE_C = 0.125f * LOG2E;

constexpr size_t KiB = 1024, MiB = 1u << 20;
constexpr size_t WS_SSQ = 216 * MiB;
constexpr size_t WS_ROPE = 512 * KiB;
constexpr size_t WS_CTL = 768 * KiB, CTL_BYTES = 32 * KiB; constexpr int CW_PANEL = 4096;
constexpr size_t WS_WIN = 1 * MiB;
constexpr size_t WS_WUQ = WS_WIN + (size_t)NPROJ_P * DM * 2;
constexpr size_t WS_WUKV = WS_WUQ + (size_t)NQA * 384 * 2;
constexpr size_t WS_WO0 = WS_WUKV + (size_t)NKVA * 256 * 2;
constexpr size_t WS_WGU0 = WS_WO0 + (size_t)DM * DM * 2;
constexpr size_t WS_WD0 = WS_WGU0 + (size_t)2 * DFF * DM * 2;
constexpr size_t WS_WQKV = WS_WD0 + (size_t)DM * DFF * 2;
constexpr size_t WS_WO1 = WS_WQKV + (size_t)NQKV * DM * 2;
constexpr size_t WS_WGU1 = WS_WO1 + (size_t)DM * DM * 2;
constexpr size_t WS_WD1 = WS_WGU1 + (size_t)2 * DFF * DM * 2;
constexpr size_t WS_WEND = WS_WD1 + (size_t)DM * DFF * 2;
constexpr size_t WS_HB = 50 * MiB;
constexpr size_t WS_A = 82 * MiB;
constexpr size_t WS_ATT = 178 * MiB;
constexpr size_t WS_SSQP = 210 * MiB;
constexpr size_t WS_END = 218 * MiB;
static_assert(WS_WEND <= WS_HB, "weights fit");
constexpr size_t OUT_QA = 0, OUT_KVA = 24 * MiB;

constexpr int NTHREADS = 512;
constexpr int LDS_BYTES = 147456;

typedef __bf16 bf16x2_t __attribute__((ext_vector_type(2)));
__device__ __forceinline__ unsigned cvt_pk_bf16(float lo, float hi) { const f32x2 v = {lo, hi}; const bf16x2_t b = __builtin_convertvector(v, bf16x2_t); return __builtin_bit_cast(unsigned, b); }
__device__ __forceinline__ float bflo(unsigned w) { return __uint_as_float(w << 16); }
__device__ __forceinline__ float bfhi(unsigned w) { return __uint_as_float(w & 0xffff0000u); }
__device__ __forceinline__ void unpack8(const u32x4 w, float* f) {
    f[0] = bflo(w.x); f[1] = bfhi(w.x); f[2] = bflo(w.y); f[3] = bfhi(w.y); f[4] = bflo(w.z); f[5] = bfhi(w.z); f[6] = bflo(w.w); f[7] = bfhi(w.w);
}
__device__ __forceinline__ float wave_sum(float v) {
#pragma unroll
    for (int o = 1; o < 64; o <<= 1) v += __shfl_xor(v, o);
    return v;
}
__device__ __forceinline__ float dot4(const f32x4 a) { return (a[0] * a[0] + a[1] * a[1]) + (a[2] * a[2] + a[3] * a[3]); }

struct Unit { int pm, pn; };
typedef unsigned long long u64;
__device__ __forceinline__ u64 ssq_fix(float s) { const unsigned hi = (unsigned)s; const unsigned lo = (unsigned)((s - (float)hi) * 4294967296.0f); return ((u64)hi << 32) | (u64)lo; }
__device__ __forceinline__ float ssq_val(const u64 v) { return (float)(unsigned)(v >> 32) + (float)(unsigned)v * 2.3283064365386963e-10f; }
__device__ __forceinline__ float ssq_get(const u64* p, int row) { return ssq_val(p[row]); }
__device__ __forceinline__ void ssq_add(u64* p, int row, float s) { atomicAdd(p + row, ssq_fix(s)); }


template <int MODE> struct EpiScale {
    static constexpr bool PERM = true, AFTER_DRAIN = false;
    bf16_t* O; int ldc; const u64* ssq_in; float inv_n; u64* ssq_a; u64* ssq_b; const f32x2* rope;
    __device__ __forceinline__ void operator()(const f32x4 (&acc)[2][2][4][2], const Unit& u, int wr, int wc, int fr, int fq) const {
        const int cb0 = u.pn * 256 + wc * 32;
        u64 sv[2][4];
#pragma unroll
        for (int ai = 0; ai < 2; ++ai)
#pragma unroll
            for (int m = 0; m < 4; ++m) sv[ai][m] = ssq_in[u.pm * 256 + ai * 128 + wr * 64 + m * 16 + fr];
#pragma unroll
        for (int ai = 0; ai < 2; ++ai)
#pragma unroll
            for (int m = 0; m < 4; ++m) {
                const int row = u.pm * 256 + ai * 128 + wr * 64 + m * 16 + fr;
                const float r = rsqrtf(ssq_val(sv[ai][m]) * inv_n + RMS_EPS);
                const int pos = row & (SEQ - 1);
#pragma unroll
                for (int bj = 0; bj < 2; ++bj) {
                    const int cb = cb0 + 128 * bj;
                    float sc = r;
                    if (MODE == 1) sc *= QSCALE_A;
                    f32x4 v0 = acc[ai][bj][m][0] * sc, v1 = acc[ai][bj][m][1] * sc;
                    bool ropeg = false;
                    if (MODE == 0) ropeg = (cb == C_KR);
                    if (MODE == 1) ropeg = ((cb % 96) == 64);
                    if (ropeg) {
                        const float sgn = (fq < 2) ? -1.0f : 1.0f;
                        const f32x2* rp = rope + pos * 16 + 8 * (fq & 1);
#pragma unroll
                        for (int j = 0; j < 4; ++j) {
                            const float o0 = __shfl_xor(v0[j], 32), o1 = __shfl_xor(v1[j], 32); const f32x2 c0 = rp[j], c1 = rp[4 + j];
                            v0[j] = v0[j] * c0.x + sgn * o0 * c0.y; v1[j] = v1[j] * c1.x + sgn * o1 * c1.y;
                        }
                    }
                    if (MODE == 0) {
                        if (cb < C_KR) { float s = dot4(v0) + dot4(v1); s += __shfl_xor(s, 16); s += __shfl_xor(s, 32); if (fq == 0) ssq_add(cb < C_CKV ? ssq_a : ssq_b, row, s); }
                    }
                    u32x4 w; w.x = cvt_pk_bf16(v0[0], v0[1]); w.y = cvt_pk_bf16(v0[2], v0[3]); w.z = cvt_pk_bf16(v1[0], v1[1]); w.w = cvt_pk_bf16(v1[2], v1[3]);
                    *(u32x4*)(O + (size_t)row * ldc + cb + 8 * fq) = w;
                }
            }
    }
};

template <int MODE> struct EpiScaleP {
    static constexpr bool PERM = true, AFTER_DRAIN = false;
    bf16_t* O; int ldc; const u64* ssq_in; float inv_n;
    __device__ __forceinline__ void operator()(const f32x4 (&acc)[2][2][4][2], const Unit& u, int wr, int wc, int fr, int fq) const {
        const int cb0 = u.pn * 256 + wc * 32;
        u64 sv[2][4];
#pragma unroll
        for (int ai = 0; ai < 2; ++ai)
#pragma unroll
            for (int m = 0; m < 4; ++m) sv[ai][m] = ssq_in[u.pm * 256 + ai * 128 + wr * 64 + m * 16 + fr];
#pragma unroll
        for (int ai = 0; ai < 2; ++ai)
#pragma unroll
            for (int m = 0; m < 4; ++m) {
                const int row = u.pm * 256 + ai * 128 + wr * 64 + m * 16 + fr;
                const float r = rsqrtf(ssq_val(sv[ai][m]) * inv_n + RMS_EPS);
#pragma unroll
                for (int bj = 0; bj < 2; ++bj) {
                    const int cb = cb0 + 128 * bj;
                    float sc = r;
                    if (MODE == 3) { if (cb < 1024) sc *= QSCALE_C; }
                    const f32x4 v0 = acc[ai][bj][m][0] * sc, v1 = acc[ai][bj][m][1] * sc;
                    u32x4 w; w.x = cvt_pk_bf16(v0[0], v0[1]); w.y = cvt_pk_bf16(v0[2], v0[3]); w.z = cvt_pk_bf16(v1[0], v1[1]); w.w = cvt_pk_bf16(v1[2], v1[3]);
                    *(u32x4*)(O + (size_t)row * ldc + cb + 8 * fq) = w;
                }
            }
    }
};

struct EpiResid {
    static constexpr bool PERM = true, AFTER_DRAIN = false;
    bf16_t* hb; u64* ssq;
    __device__ __forceinline__ void operator()(const f32x4 (&acc)[2][2][4][2], const Unit& u, int wr, int wc, int fr, int fq) const {
#pragma unroll
        for (int ai = 0; ai < 2; ++ai) {
            u32x4 b[4][2];
#pragma unroll
            for (int m = 0; m < 4; ++m)
#pragma unroll
                for (int bj = 0; bj < 2; ++bj) b[m][bj] = *(const u32x4*)(hb + (size_t)(u.pm * 256 + ai * 128 + wr * 64 + m * 16 + fr) * DM + u.pn * 256 + bj * 128 + wc * 32 + 8 * fq);
#pragma unroll
            for (int m = 0; m < 4; ++m) {
                const int row = u.pm * 256 + ai * 128 + wr * 64 + m * 16 + fr;
                float s = 0.f;
#pragma unroll
                for (int bj = 0; bj < 2; ++bj) {
                    const f32x4 a0 = acc[ai][bj][m][0], a1 = acc[ai][bj][m][1]; const u32x4 bb = b[m][bj];
                    f32x4 h0, h1; h0[0] = bflo(bb.x) + a0[0]; h0[1] = bfhi(bb.x) + a0[1]; h0[2] = bflo(bb.y) + a0[2]; h0[3] = bfhi(bb.y) + a0[3];
                    h1[0] = bflo(bb.z) + a1[0]; h1[1] = bfhi(bb.z) + a1[1]; h1[2] = bflo(bb.w) + a1[2]; h1[3] = bfhi(bb.w) + a1[3];
                    u32x4 w; w.x = cvt_pk_bf16(h0[0], h0[1]); w.y = cvt_pk_bf16(h0[2], h0[3]); w.z = cvt_pk_bf16(h1[0], h1[1]); w.w = cvt_pk_bf16(h1[2], h1[3]);
                    *(u32x4*)(hb + (size_t)row * DM + u.pn * 256 + bj * 128 + wc * 32 + 8 * fq) = w;
                    s += dot4(h0) + dot4(h1);
                }
                s += __shfl_xor(s, 16); s += __shfl_xor(s, 32);
                if (fq == 0) ssq_add(ssq, row, s);
            }
            asm volatile("" ::: "memory");
        }
    }
};

struct EpiSwiglu {
    static constexpr bool PERM = true, AFTER_DRAIN = false;
    bf16_t* O; const u64* ssq_in;
    __device__ __forceinline__ void operator()(const f32x4 (&acc)[2][2][4][2], const Unit& u, int wr, int wc, int fr, int fq) const {
        u64 sv[2][4];
#pragma unroll
        for (int ai = 0; ai < 2; ++ai)
#pragma unroll
            for (int m = 0; m < 4; ++m) sv[ai][m] = ssq_in[u.pm * 256 + ai * 128 + wr * 64 + m * 16 + fr];
#pragma unroll
        for (int ai = 0; ai < 2; ++ai)
#pragma unroll
            for (int m = 0; m < 4; ++m) {
                const int row = u.pm * 256 + ai * 128 + wr * 64 + m * 16 + fr;
                const float r = rsqrtf(ssq_val(sv[ai][m]) * (1.0f / DM) + RMS_EPS);
                float a[8];
#pragma unroll
                for (int n = 0; n < 2; ++n)
#pragma unroll
                    for (int j = 0; j < 4; ++j) { const float g = acc[ai][0][m][n][j] * r, uu = acc[ai][1][m][n][j] * r; a[4 * n + j] = g * __builtin_amdgcn_rcpf(1.0f + __expf(-g)) * uu; }
                u32x4 w; w.x = cvt_pk_bf16(a[0], a[1]); w.y = cvt_pk_bf16(a[2], a[3]); w.z = cvt_pk_bf16(a[4], a[5]); w.w = cvt_pk_bf16(a[6], a[7]);
                *(u32x4*)(O + (size_t)row * DFF + u.pn * 128 + wc * 32 + 8 * fq) = w;
            }
    }
};

struct EpiFinal {
    static constexpr bool PERM = true, AFTER_DRAIN = true;
    const bf16_t* hb; u64* ssq; unsigned* cnt; const float* gfin; float* out;
    __device__ __forceinline__ void operator()(const f32x4 (&)[2][2][4][2], const Unit&, int, int, int, int) const {}
    __device__ __forceinline__ void fused(f32x4 (&acc)[2][2][4][2], const Unit& u, int wr, int wc, int fr, int fq, LAS unsigned char*, int, int) const {
#pragma unroll
        for (int ai = 0; ai < 2; ++ai) {
            u32x4 b[4][2];
#pragma unroll
            for (int m = 0; m < 4; ++m)
#pragma unroll
                for (int bj = 0; bj < 2; ++bj) b[m][bj] = *(const u32x4*)(hb + (size_t)(u.pm * 256 + ai * 128 + wr * 64 + m * 16 + fr) * DM + u.pn * 256 + bj * 128 + wc * 32 + 8 * fq);
#pragma unroll
            for (int m = 0; m < 4; ++m) {
                const int row = u.pm * 256 + ai * 128 + wr * 64 + m * 16 + fr;
                float s = 0.f;
#pragma unroll
                for (int bj = 0; bj < 2; ++bj) {
                    const f32x4 a0 = acc[ai][bj][m][0], a1 = acc[ai][bj][m][1]; const u32x4 bb = b[m][bj];
                    f32x4 h0, h1; h0[0] = bflo(bb.x) + a0[0]; h0[1] = bfhi(bb.x) + a0[1]; h0[2] = bflo(bb.y) + a0[2]; h0[3] = bfhi(bb.y) + a0[3];
                    h1[0] = bflo(bb.z) + a1[0]; h1[1] = bfhi(bb.z) + a1[1]; h1[2] = bflo(bb.w) + a1[2]; h1[3] = bfhi(bb.w) + a1[3];
                    acc[ai][bj][m][0] = h0; acc[ai][bj][m][1] = h1; s += dot4(h0) + dot4(h1);
                }
                s += __shfl_xor(s, 16); s += __shfl_xor(s, 32);
                if (fq == 0) { const u64 prev = atomicAdd(ssq + row, ssq_fix(s)); asm volatile("" :: "v"(prev)); }
            }
            asm volatile("" ::: "memory");
        }
        asm volatile("s_waitcnt vmcnt(0)" ::: "memory");
        __syncthreads();
        if (threadIdx.x == 0) {
            unsigned* c = cnt + 16 * u.pm;
            __hip_atomic_fetch_add(c, 1u, __ATOMIC_RELEASE, __HIP_MEMORY_SCOPE_AGENT);
            unsigned sp = 0;
            while (__hip_atomic_load(c, __ATOMIC_RELAXED, __HIP_MEMORY_SCOPE_AGENT) < 4u) { __builtin_amdgcn_s_sleep(1); if (++sp > (1u << 22)) break; }
            __builtin_amdgcn_fence(__ATOMIC_ACQUIRE, "agent");
            asm volatile("s_waitcnt vmcnt(0)" ::: "memory");
        }
        __syncthreads();
        u64 sv[2][4];
#pragma unroll
        for (int ai = 0; ai < 2; ++ai)
#pragma unroll
            for (int m = 0; m < 4; ++m) sv[ai][m] = __hip_atomic_load(ssq + (u.pm * 256 + ai * 128 + wr * 64 + m * 16 + fr), __ATOMIC_RELAXED, __HIP_MEMORY_SCOPE_AGENT);
        f32x4 g4[2][2];
#pragma unroll
        for (int bj = 0; bj < 2; ++bj)
#pragma unroll
            for (int n = 0; n < 2; ++n) g4[bj][n] = *(const f32x4*)(gfin + u.pn * 256 + bj * 128 + wc * 32 + 8 * fq + 4 * n);
#pragma unroll
        for (int ai = 0; ai < 2; ++ai)
#pragma unroll
            for (int m = 0; m < 4; ++m) {
                const int row = u.pm * 256 + ai * 128 + wr * 64 + m * 16 + fr;
                const float r = rsqrtf(ssq_val(sv[ai][m]) * (1.0f / DM) + RMS_EPS);
#pragma unroll
                for (int bj = 0; bj < 2; ++bj)
#pragma unroll
                    for (int n = 0; n < 2; ++n) *(f32x4*)(out + (size_t)row * DM + u.pn * 256 + bj * 128 + wc * 32 + 8 * fq + 4 * n) = acc[ai][bj][m][n] * r * g4[bj][n];
            }
    }
};

__host__ __device__ __forceinline__ int perm32(int rho) { const int n = rho >> 4, i = rho & 15; return 8 * (i >> 2) + 4 * n + (i & 3); }
template <class Epi>
__device__ __forceinline__ void gemm_naive(const bf16_t* A, int lda, const bf16_t* Bt, int ldb, int nM, int nN, int K, const Epi& E) {
    constexpr bool PERM = Epi::PERM;
    const int tid = threadIdx.x, wid = tid >> 6, lane = tid & 63, wr = wid >> 2, wc = wid & 3, fr = lane & 15, fq = lane >> 4;
    for (int unit = blockIdx.x; unit < nM * nN; unit += gridDim.x) {
        Unit u; u.pm = unit / nN; u.pn = unit % nN;
        f32x4 acc[2][2][4][2];
#pragma unroll
        for (int a = 0; a < 2; ++a)
#pragma unroll
            for (int b = 0; b < 2; ++b)
#pragma unroll
                for (int m = 0; m < 4; ++m)
#pragma unroll
                    for (int n = 0; n < 2; ++n) acc[a][b][m][n] = (f32x4){0.f, 0.f, 0.f, 0.f};
        const bf16_t* Ab = A + (size_t)(u.pm * 256 + wr * 64 + fr) * lda + 8 * fq;
        const bf16_t* Bb = Bt + (size_t)(u.pn * 256 + wc * 32) * ldb + 8 * fq;
        const int br0 = PERM ? perm32(fr) : fr, br1 = PERM ? perm32(16 + fr) : 16 + fr;
        for (int k0 = 0; k0 < K; k0 += 32) {
            bf16x8 af[2][4], bq[2][2];
#pragma unroll
            for (int ai = 0; ai < 2; ++ai)
#pragma unroll
                for (int m = 0; m < 4; ++m) af[ai][m] = *(const bf16x8*)(Ab + (size_t)(ai * 128 + m * 16) * lda + k0);
#pragma unroll
            for (int bj = 0; bj < 2; ++bj) { bq[bj][0] = *(const bf16x8*)(Bb + (size_t)(bj * 128 + br0) * ldb + k0); bq[bj][1] = *(const bf16x8*)(Bb + (size_t)(bj * 128 + br1) * ldb + k0); }
#pragma unroll
            for (int ai = 0; ai < 2; ++ai)
#pragma unroll
                for (int bj = 0; bj < 2; ++bj)
#pragma unroll
                    for (int m = 0; m < 4; ++m)
#pragma unroll
                        for (int n = 0; n < 2; ++n) acc[ai][bj][m][n] = __builtin_amdgcn_mfma_f32_16x16x32_bf16(bq[bj][n], af[ai][m], acc[ai][bj][m][n], 0, 0, 0);
        }
        E(acc, u, wr, wc, fr, fq);
    }
}

#define PG8_LAS __attribute__((address_space(3)))
constexpr int BM = 256, BK = 64, HALF = 128, HTB = HALF * BK * 2  , STAGE_BYTES = 8 * HTB, NXCD = 8, WGM = 8;
__host__ __device__ __forceinline__ int lds_byte(int r, int c) { const int st = (r >> 4) * 2 + (c >> 5), rr = r & 15, cc = c & 31, ob = rr * 64 + cc * 2; return st * 1024 + (ob ^ (((ob >> 9) & 1) << 5)); }
__host__ __device__ __forceinline__ void stage_rc(int b, int& R, int& C) { const int st = b / 1024, sb = b % 1024, swz = sb ^ (((sb >> 9) & 1) << 5); R = (st >> 1) * 16 + swz / 64; C = (st & 1) * 32 + (swz % 64) / 2; }
struct Gemm { const bf16_t* A; const bf16_t* Bt; int M, N, K, lda, ldb; };
struct StaticOrder {
    int nM, nN, nwg, G, c;
    __host__ __device__ void init(int M, int N, int G_, int c_) { nM = M / BM; nN = N / BM; nwg = nM * nN; G = G_; c = c_; }
    __host__ __device__ bool next(int i, Unit& u) const {
        const long L = (long)i * G + c; if (L >= nwg) return false;
        int wgid = (int)L; { const int q = nwg / NXCD, r = nwg % NXCD, xcd = wgid % NXCD, off = wgid / NXCD; wgid = (xcd < r ? xcd * (q + 1) : r * (q + 1) + (xcd - r) * q) + off; }
        const int nig = WGM * nN, gid = wgid / nig, fm = gid * WGM, gsz = (nM - fm) < WGM ? (nM - fm) : WGM;
        u.pm = fm + ((wgid % nig) % gsz); u.pn = (wgid % nig) / gsz; return true;
    }
    __device__ __forceinline__ void a_ready(const Unit&) const {}
    __device__ __forceinline__ void done(const Unit&) const {}
};
template <class Epi, class Sched, bool ALIGN_EPI = false, bool SP2 = false>
__device__ __forceinline__ void gemm_phase(PG8_LAS unsigned char* lds, const Gemm g, const Sched& S, const Epi& E) {
    int tid_ = threadIdx.x; asm volatile("" : "+v"(tid_));
    const int tid = tid_, wid = __builtin_amdgcn_readfirstlane(tid >> 6), lane = tid & 63, wr = wid >> 2, wc = wid & 3, fr = lane & 15, fq = lane >> 4;
    const int K = g.K, nt = K / BK;
    unsigned voffA[2], voffB[2];
#pragma unroll
    for (int i = 0; i < 2; ++i) { int R, C; stage_rc(tid * 16 + i * 8192, R, C); const int Rb = Epi::PERM ? ((R & ~31) + perm32(R & 31)) : R;
        voffA[i] = (unsigned)(R * g.lda + C) * 2u; voffB[i] = (unsigned)(Rb * g.ldb + C) * 2u; }
    const size_t kstep = (size_t)(BK * 2);
    const size_t hstepA = (size_t)HALF * g.lda * 2, hstepB = (size_t)HALF * g.ldb * 2;
    const size_t tstepA = 2 * hstepA, tstepB = 2 * hstepB;
    const unsigned ldsw = (unsigned)wid * 1024u;
    const int aoff = lds_byte(wr * 64 + fr, fq * 8), boff = lds_byte(wc * 32 + fr, fq * 8);
#define PG8_SA(b, h) (((b) * 2 + (h)) * HTB)
#define PG8_SB(b, h) ((4 + (b) * 2 + (h)) * HTB)
#define PG8_STAGE(bufoff, gbase, voff) do { _Pragma("unroll") for (int _i = 0; _i < 2; ++_i) \
        __builtin_amdgcn_global_load_lds((const unsigned*)((const char*)(gbase) + (voff)[_i]), (PG8_LAS unsigned*)(lds + (bufoff) + ldsw + _i * 8192), 16, 0, 0); } while (0)
#define PG8_LDA(dst, b, h) do { _Pragma("unroll") for (int m = 0; m < 4; ++m) _Pragma("unroll") for (int k = 0; k < 2; ++k) dst[m][k] = *(const PG8_LAS bf16x8*)(lds + PG8_SA(b, h) + aoff + m * 2048 + k * 1024); } while (0)
#define PG8_LDB(dst, b, h) do { _Pragma("unroll") for (int n = 0; n < 2; ++n) _Pragma("unroll") for (int k = 0; k < 2; ++k) dst[n][k] = *(const PG8_LAS bf16x8*)(lds + PG8_SB(b, h) + boff + n * 2048 + k * 1024); } while (0)
#define PG8_MMA(ai, bj, At, Bt) do { __builtin_amdgcn_s_setprio(1); _Pragma("unroll") for (int m = 0; m < 4; ++m) _Pragma("unroll") for (int n = 0; n < 2; ++n) _Pragma("unroll") for (int k = 0; k < 2; ++k) \
        acc[ai][bj][m][n] = __builtin_amdgcn_mfma_f32_16x16x32_bf16(Bt[n][k], At[m][k], acc[ai][bj][m][n], 0, 0, 0); __builtin_amdgcn_s_setprio(0); } while (0)
#define PG8_WAIT_V(n) asm volatile("s_waitcnt vmcnt(" #n ")" ::: "memory")
#define PG8_WAIT_L(n) asm volatile("s_waitcnt lgkmcnt(" #n ")" ::: "memory")
#define PG8_BAR __builtin_amdgcn_s_barrier()
#define PG8_SCHED __builtin_amdgcn_sched_barrier(0)
    Unit cur, nxt; int ui = 0;
    if (!S.next(0, cur)) return;
    f32x4 acc[2][2][4][2];
#pragma unroll
    for (int a = 0; a < 2; ++a)
#pragma unroll
        for (int b = 0; b < 2; ++b)
#pragma unroll
            for (int m = 0; m < 4; ++m)
#pragma unroll
                for (int n = 0; n < 2; ++n) acc[a][b][m][n] = (f32x4){0.f, 0.f, 0.f, 0.f};
    bf16x8 At[4][2], B0[2][2], B1[2][2];
    const char* cA = (const char*)g.A + (size_t)cur.pm * tstepA; const char* cB = (const char*)g.Bt + (size_t)cur.pn * tstepB;
    S.a_ready(cur);
    if constexpr (SP2) {
        PG8_STAGE(PG8_SB(0, 0), cB, voffB); PG8_STAGE(PG8_SB(0, 1), cB + hstepB, voffB); PG8_STAGE(PG8_SA(0, 0), cA, voffA); PG8_STAGE(PG8_SA(0, 1), cA + hstepA, voffA);
        if (wr == 1) PG8_BAR;
        PG8_WAIT_V(2); PG8_BAR;
        PG8_STAGE(PG8_SB(1, 0), cB + kstep, voffB); PG8_STAGE(PG8_SA(1, 0), cA + kstep, voffA); PG8_STAGE(PG8_SB(1, 1), cB + hstepB + kstep, voffB);
        PG8_WAIT_V(6); PG8_BAR;
    } else {
        PG8_STAGE(PG8_SB(0, 0), cB, voffB); PG8_STAGE(PG8_SA(0, 0), cA, voffA); PG8_STAGE(PG8_SB(0, 1), cB + hstepB, voffB); PG8_STAGE(PG8_SA(0, 1), cA + hstepA, voffA);
        if (wr == 1) PG8_BAR;
        PG8_WAIT_V(4); PG8_BAR;
        PG8_STAGE(PG8_SB(1, 0), cB + kstep, voffB); PG8_STAGE(PG8_SA(1, 0), cA + kstep, voffA); PG8_STAGE(PG8_SB(1, 1), cB + hstepB + kstep, voffB);
        PG8_WAIT_V(6); PG8_BAR;
    }
    for (;;) {
        const bool has_next = S.next(ui + 1, nxt);
        const char* nA = has_next ? (const char*)g.A + (size_t)nxt.pm * tstepA : cA; const char* nB = has_next ? (const char*)g.Bt + (size_t)nxt.pn * tstepB : cB;
#pragma clang loop unroll(disable)
        for (int t = 0; t < nt; t += 2) {
            const bool last = (t == nt - 2);
            const char* a1 = cA + (size_t)(t + 1) * kstep;
            const char* a2 = last ? nA : cA + (size_t)(t + 2) * kstep; const char* b2 = last ? nB : cB + (size_t)(t + 2) * kstep;
            const char* a3 = a2 + kstep; const char* b3 = b2 + kstep;
            if (last && has_next) S.a_ready(nxt);
            if constexpr (SP2) {
            PG8_LDB(B0, 0, 0); PG8_LDB(B1, 0, 1); PG8_SCHED; PG8_LDA(At, 0, 0); PG8_STAGE(PG8_SA(1, 1), a1 + hstepA, voffA);
            PG8_WAIT_V(8); PG8_WAIT_L(0); PG8_BAR; PG8_MMA(0, 0, At, B0); PG8_MMA(0, 1, At, B1); PG8_BAR; PG8_SCHED;
            PG8_LDA(At, 0, 1); PG8_STAGE(PG8_SB(0, 0), b2, voffB); PG8_STAGE(PG8_SB(0, 1), b2 + hstepB, voffB); PG8_STAGE(PG8_SA(0, 0), a2, voffA);
            PG8_WAIT_V(8); PG8_WAIT_L(0); PG8_BAR; PG8_MMA(1, 0, At, B0); PG8_MMA(1, 1, At, B1); PG8_BAR; PG8_SCHED;
            PG8_LDB(B0, 1, 0); PG8_LDB(B1, 1, 1); PG8_SCHED; PG8_LDA(At, 1, 0); PG8_STAGE(PG8_SA(0, 1), a2 + hstepA, voffA);
            PG8_WAIT_V(8); PG8_WAIT_L(0); PG8_BAR; PG8_MMA(0, 0, At, B0); PG8_MMA(0, 1, At, B1); PG8_BAR; PG8_SCHED;
            PG8_LDA(At, 1, 1); PG8_STAGE(PG8_SB(1, 0), b3, voffB); PG8_STAGE(PG8_SB(1, 1), b3 + hstepB, voffB); PG8_STAGE(PG8_SA(1, 0), a3, voffA);
            PG8_WAIT_V(8); PG8_WAIT_L(0); PG8_BAR; PG8_MMA(1, 0, At, B0); PG8_MMA(1, 1, At, B1); PG8_BAR; PG8_SCHED;
            } else {
            PG8_LDB(B0, 0, 0); PG8_SCHED; PG8_LDA(At, 0, 0); PG8_STAGE(PG8_SA(1, 1), a1 + hstepA, voffA);
            PG8_WAIT_L(8); PG8_BAR; PG8_WAIT_L(0); PG8_MMA(0, 0, At, B0); PG8_BAR; PG8_SCHED;
            PG8_LDB(B1, 0, 1); PG8_STAGE(PG8_SB(0, 0), b2, voffB);
            PG8_BAR; PG8_WAIT_L(0); PG8_MMA(0, 1, At, B1); PG8_BAR;
            PG8_LDA(At, 0, 1); PG8_STAGE(PG8_SA(0, 0), a2, voffA);
            PG8_BAR; PG8_WAIT_L(0); PG8_MMA(1, 0, At, B0); PG8_BAR; PG8_SCHED;
            PG8_STAGE(PG8_SB(0, 1), b2 + hstepB, voffB);
            PG8_WAIT_V(6); PG8_BAR; PG8_MMA(1, 1, At, B1); PG8_BAR;
            PG8_LDB(B0, 1, 0); PG8_SCHED; PG8_LDA(At, 1, 0); PG8_STAGE(PG8_SA(0, 1), a2 + hstepA, voffA);
            PG8_WAIT_L(8); PG8_BAR; PG8_WAIT_L(0); PG8_MMA(0, 0, At, B0); PG8_BAR; PG8_SCHED;
            PG8_LDB(B1, 1, 1); PG8_STAGE(PG8_SB(1, 0), b3, voffB);
            PG8_BAR; PG8_WAIT_L(0); PG8_MMA(0, 1, At, B1); PG8_BAR;
            PG8_LDA(At, 1, 1); PG8_STAGE(PG8_SA(1, 0), a3, voffA);
            PG8_BAR; PG8_WAIT_L(0); PG8_MMA(1, 0, At, B0); PG8_BAR; PG8_SCHED;
            PG8_STAGE(PG8_SB(1, 1), b3 + hstepB, voffB);
            PG8_WAIT_V(6); PG8_BAR; PG8_MMA(1, 1, At, B1); PG8_BAR;
            }
        }
        if constexpr (ALIGN_EPI) { if (wr == 0) PG8_BAR; }
        if constexpr (!Epi::AFTER_DRAIN) { E(acc, cur, wr, wc, fr, fq); S.done(cur); }
        if (!has_next) break;
#pragma unroll
        for (int a = 0; a < 2; ++a)
#pragma unroll
            for (int b = 0; b < 2; ++b)
#pragma unroll
                for (int m = 0; m < 4; ++m)
#pragma unroll
                    for (int n = 0; n < 2; ++n) acc[a][b][m][n] = (f32x4){0.f, 0.f, 0.f, 0.f};
        cur = nxt; cA = nA; cB = nB; ++ui;
        if constexpr (ALIGN_EPI) { if (wr == 1) PG8_BAR; }
    }
    PG8_WAIT_V(0);
    if constexpr (!ALIGN_EPI) { if (wr == 0) PG8_BAR; }
    PG8_BAR;
    if constexpr (Epi::AFTER_DRAIN) { E.fused(acc, cur, wr, wc, fr, fq, lds, wid, lane); S.done(cur); }
#undef PG8_SA
#undef PG8_SB
#undef PG8_STAGE
#undef PG8_LDA
#undef PG8_LDB
#undef PG8_MMA
#undef PG8_WAIT_V
#undef PG8_WAIT_L
#undef PG8_BAR
#undef PG8_SCHED
}
template <class Epi>
__device__ __forceinline__ void gemm_fast(LAS unsigned char* lds, const bf16_t* A, int lda, const bf16_t* Bt, int ldb, int M, int N, int K, const Epi& E) {
    Gemm g{A, Bt, M, N, K, lda, ldb}; StaticOrder S; S.init(M, N, (int)gridDim.x, (int)blockIdx.x);
    gemm_phase<Epi, StaticOrder, !Epi::AFTER_DRAIN, true>(lds, g, S, E);
}

__device__ __forceinline__ void p0_item(const float* W, int K, int N, const float* g, bf16_t* WT, int ldt, int mode, LAS float* scr, int item, int lane) {
    const int nblk = N / 32, kb = item / nblk, nb = item % nblk, k0 = 64 * kb, n0 = 32 * nb;
    { const int kr = lane >> 3, ch = lane & 7; f32x4 v[8];
#pragma unroll
      for (int i = 0; i < 8; ++i) v[i] = *(const f32x4*)(W + (size_t)(k0 + 8 * i + kr) * N + n0 + 4 * ch);
#pragma unroll
      for (int i = 0; i < 8; ++i) { const int kk = 8 * i + kr; const float gs = g ? g[k0 + kk] : 1.0f; LAS float* d = scr + kk * 33 + 4 * ch; d[0] = v[i][0] * gs; d[1] = v[i][1] * gs; d[2] = v[i][2] * gs; d[3] = v[i][3] * gs; } }
    asm volatile("s_waitcnt lgkmcnt(0)" ::: "memory");
    const int c = lane & 7;
#pragma unroll
    for (int j = 0; j < 4; ++j) {
        const int n = (lane >> 3) + 8 * j; const LAS float* s = scr + (8 * c) * 33 + n;
        u32x4 o; o.x = cvt_pk_bf16(s[0 * 33], s[1 * 33]); o.y = cvt_pk_bf16(s[2 * 33], s[3 * 33]); o.z = cvt_pk_bf16(s[4 * 33], s[5 * 33]); o.w = cvt_pk_bf16(s[6 * 33], s[7 * 33]);
        const int nn = n0 + n; const int row = (mode == 0) ? nn : ((nn >> 7) * 256 + (mode == 2 ? 128 : 0) + (nn & 127));
        *(u32x4*)(WT + (size_t)row * ldt + k0 + 8 * c) = o;
    }
    asm volatile("s_waitcnt lgkmcnt(0)" ::: "memory");
}


typedef float f32x16 __attribute__((ext_vector_type(16)));
constexpr int AT_VSTR = 72;
constexpr int AT_KBUF = 64 * 104 * 2, AT_VBUF = 64 * AT_VSTR * 2;
constexpr int AT_OFF_K = 0, AT_OFF_V = 2 * AT_KBUF, AT_OFF_BIAS = 2 * AT_KBUF + 2 * AT_VBUF, AT_OFF_FLAG = AT_OFF_BIAS + 2304, AT_OFF_H1 = AT_OFF_FLAG + 256;
__device__ __forceinline__ int crow16(int r, int hi) { return (r & 3) + 8 * (r >> 2) + 4 * hi; }
__device__ __forceinline__ int vperm(int key) { const int k16 = key & 15; return (key & ~15) + 8 * ((k16 >> 2) & 1) + 4 * (k16 >> 3) + (k16 & 3); }
__device__ __forceinline__ bf16x8 pack8(float a0, float a1, float a2, float a3, float a4, float a5, float a6, float a7) {
    u32x4 w; w.x = cvt_pk_bf16(a0, a1); w.y = cvt_pk_bf16(a2, a3); w.z = cvt_pk_bf16(a4, a5); w.w = cvt_pk_bf16(a6, a7); return __builtin_bit_cast(bf16x8, w);
}

__device__ __forceinline__ float max3f(float a, float b, float c) { return __builtin_fmaxf(__builtin_fmaxf(a, b), c); }
template <int MODE, bool TWOH = false>
__device__ __forceinline__ void attn_unit(LAS unsigned char* lds, int q0, const bf16_t* Qp, int ldq, const bf16_t* Kp, int ldk, const bf16_t* Krp, int ldkr, const bf16_t* Vp, int ldv, bf16_t* Op, const float* bias_g) {
    constexpr int DQK = (MODE == 0) ? 96 : 64, NDD = DQK / 16, KSTR = DQK + 8;
    int tid_ = threadIdx.x; asm volatile("" : "+v"(tid_));
    const int tid = tid_, lane = tid & 63, wid = __builtin_amdgcn_readfirstlane(tid >> 6), l31 = lane & 31, hi = lane >> 5;
    const int hsel = TWOH ? (wid >> 2) : 0;
    const int t0w = q0 + 32 * (TWOH ? (wid & 3) : wid), trow = t0w + l31, nq = t0w >> 6;
    LAS unsigned char* ldsh = lds + hsel * AT_OFF_H1;
    Qp += hsel * 64; Op += hsel * 64;
    LAS float* biasl = (LAS float*)(ldsh + AT_OFF_BIAS);
    LAS int* flags = (LAS int*)(lds + AT_OFF_FLAG);
    float bz0 = 0.f, bz1 = 0.f, bz2 = 0.f, bz3 = 0.f;
    if (MODE == 2) { bz0 = bias_g[tid]; if (tid == 0) bz1 = bias_g[512]; if (TWOH) { bz2 = bias_g[513 + tid]; if (tid == 0) bz3 = bias_g[513 + 512]; } }
    bf16x8 qf[NDD];
#pragma unroll
    for (int dd = 0; dd < NDD; ++dd) qf[dd] = *(const bf16x8*)(Qp + (size_t)trow * ldq + 16 * dd + 8 * hi);
    f32x16 o0, o1;
#pragma unroll
    for (int r = 0; r < 16; ++r) { o0[r] = 0.f; o1[r] = 0.f; }
    float mref = 0.f, lrow = 0.f, carry = 0.f; bool first = true;
    f32x16 negm;
#pragma unroll
    for (int r = 0; r < 16; ++r) negm[r] = 0.f;
    const int kt_hi = (q0 + (TWOH ? 127 : 255)) >> 6;
    int kt_lo = 0; if (MODE == 2) { kt_lo = (q0 >> 6) - 8; if (kt_lo < 0) kt_lo = 0; }
    const int nt = kt_hi - kt_lo + 1;
    const int skey = tid >> 3, sch = tid & 7, rkey = tid >> 2, rch = tid & 3;
    const int vcol = vperm(lane);
    u32x4 kregA, krregA, vregA, kreg2A, vreg2A, kregB, krregB, vregB, kreg2B, vreg2B;
#define AT_KT(i) ((MODE == 1) ? (kt_hi - (i)) : (kt_lo + (i)))
#define AT_PART(kt) ((MODE == 0) ? ((kt) <= nq) : (MODE == 1) ? (64 * (kt) <= t0w + 30) : (((kt) <= nq) && ((kt) >= nq - 8)))
#define AT_LOAD(kt, S) do { const size_t kb_ = (size_t)(kt) * 64; \
        kreg##S = *(const u32x4*)(Kp + (kb_ + skey) * ldk + sch * 8); \
        if (MODE == 0) { krreg##S = *(const u32x4*)(Krp + (kb_ + (rkey & 63)) * ldkr + rch * 8); }     \
        vreg##S = *(const u32x4*)(Vp + (kb_ + lane) * ldv + wid * 8); \
        if (TWOH) { kreg2##S = *(const u32x4*)(Kp + (kb_ + skey) * ldk + 64 + sch * 8); vreg2##S = *(const u32x4*)(Vp + (kb_ + lane) * ldv + 64 + wid * 8); } } while (0)
#define AT_VT8(dst, v) do { (dst)[0 * AT_VSTR] = (bf16_t)((v).x & 0xffffu); (dst)[1 * AT_VSTR] = (bf16_t)((v).x >> 16); (dst)[2 * AT_VSTR] = (bf16_t)((v).y & 0xffffu); (dst)[3 * AT_VSTR] = (bf16_t)((v).y >> 16); \
        (dst)[4 * AT_VSTR] = (bf16_t)((v).z & 0xffffu); (dst)[5 * AT_VSTR] = (bf16_t)((v).z >> 16); (dst)[6 * AT_VSTR] = (bf16_t)((v).w & 0xffffu); (dst)[7 * AT_VSTR] = (bf16_t)((v).w >> 16); } while (0)
#define AT_STORE(bufi, S) do { LAS bf16_t* Ks_ = (LAS bf16_t*)(lds + AT_OFF_K + (bufi) * AT_KBUF); LAS bf16_t* Vt_ = (LAS bf16_t*)(lds + AT_OFF_V + (bufi) * AT_VBUF); \
        *(LAS u32x4*)(Ks_ + skey * KSTR + sch * 8) = kreg##S; \
        if (MODE == 0) { if (tid < 256) *(LAS u32x4*)(Ks_ + rkey * KSTR + 64 + rch * 8) = krreg##S; } \
        LAS bf16_t* vd_ = Vt_ + (wid * 8) * AT_VSTR + vcol; AT_VT8(vd_, vreg##S); \
        if (TWOH) { LAS bf16_t* Ks2_ = (LAS bf16_t*)(lds + AT_OFF_H1 + AT_OFF_K + (bufi) * AT_KBUF); LAS bf16_t* ve_ = (LAS bf16_t*)(lds + AT_OFF_H1 + AT_OFF_V + (bufi) * AT_VBUF) + (wid * 8) * AT_VSTR + vcol; \
            *(LAS u32x4*)(Ks2_ + skey * KSTR + sch * 8) = kreg2##S; AT_VT8(ve_, vreg2##S); } } while (0)
#define AT_BAR() do { asm volatile("s_waitcnt lgkmcnt(0)" ::: "memory"); __builtin_amdgcn_s_barrier(); asm volatile("" ::: "memory"); } while (0)
    auto compute = [&](int bufo, int kt) __attribute__((always_inline)) {
            const LAS bf16_t* Ks = (const LAS bf16_t*)(ldsh + AT_OFF_K + bufo * AT_KBUF); const LAS bf16_t* Vt = (const LAS bf16_t*)(ldsh + AT_OFF_V + bufo * AT_VBUF);
            f32x16 p0, p1;
            if (MODE == 1) {
#pragma unroll
                for (int r = 0; r < 16; ++r) { p0[r] = 0.f; p1[r] = 0.f; }
            } else { p0 = negm; p1 = negm; }
            bf16x8 ka[NDD], kb[NDD], va[4], vb[4];
            constexpr int NH = (NDD > 4) ? 4 : NDD;
#pragma unroll
            for (int dd = 0; dd < NH; ++dd) { ka[dd] = *(const LAS bf16x8*)(Ks + l31 * KSTR + 16 * dd + 8 * hi); kb[dd] = *(const LAS bf16x8*)(Ks + (32 + l31) * KSTR + 16 * dd + 8 * hi); }
            __builtin_amdgcn_sched_barrier(0);
#pragma unroll
            for (int dd = 0; dd < NH; ++dd) { p0 = __builtin_amdgcn_mfma_f32_32x32x16_bf16(ka[dd], qf[dd], p0, 0, 0, 0); p1 = __builtin_amdgcn_mfma_f32_32x32x16_bf16(kb[dd], qf[dd], p1, 0, 0, 0);
                if (dd == 0) {
#pragma unroll
                    for (int d2 = NH; d2 < NDD; ++d2) { ka[d2] = *(const LAS bf16x8*)(Ks + l31 * KSTR + 16 * d2 + 8 * hi); kb[d2] = *(const LAS bf16x8*)(Ks + (32 + l31) * KSTR + 16 * d2 + 8 * hi); }
                } }
#pragma unroll
            for (int dd = NH; dd < NDD; ++dd) { p0 = __builtin_amdgcn_mfma_f32_32x32x16_bf16(ka[dd], qf[dd], p0, 0, 0, 0); p1 = __builtin_amdgcn_mfma_f32_32x32x16_bf16(kb[dd], qf[dd], p1, 0, 0, 0); }
            __builtin_amdgcn_sched_barrier(0);
            if (MODE != 1) {
#pragma unroll
                for (int jj = 0; jj < 4; ++jj) { va[jj] = *(const LAS bf16x8*)(Vt + l31 * AT_VSTR + 8 * hi + 16 * jj); vb[jj] = *(const LAS bf16x8*)(Vt + (32 + l31) * AT_VSTR + 8 * hi + 16 * jj); }
            }
            __builtin_amdgcn_sched_barrier(0);
            if (MODE != 1) {
                if (MODE == 2) {
                    if (nq - kt >= 5) { const float cb = biasl[512];
#pragma unroll
                        for (int r = 0; r < 16; ++r) { p0[r] += cb; p1[r] += cb; }
                    } else {
                        const int relb = trow - 64 * kt - 4 * hi;
#pragma unroll
                        for (int r = 0; r < 16; ++r) {
                            int rel0 = relb - ((r & 3) + 8 * (r >> 2)); int rel1 = rel0 - 32;
                            rel0 = rel0 > 256 ? 256 : rel0; rel1 = rel1 > 256 ? 256 : rel1;
                            p0[r] += biasl[256 + rel0]; p1[r] += biasl[256 + rel1];
                        }
                    }
                }
                float mx = max3f(p0[0], p1[0], p0[1]);
#pragma unroll
                for (int r = 1; r < 15; r += 2) { mx = max3f(mx, p1[r], p0[r + 1]); mx = max3f(mx, p1[r + 1], p0[(r + 2 > 15) ? 15 : (r + 2)]); }
                mx = fmaxf(mx, p1[15]);
                mx = fmaxf(mx, __shfl_xor(mx, 32));
                if (first || __any(mx > 8.0f)) {
                    const float dl = first ? mx : fmaxf(mx, 0.f);
                    mref += dl;
#pragma unroll
                    for (int r = 0; r < 16; ++r) { p0[r] -= dl; p1[r] -= dl; }
                    if (!first) { const float f = __builtin_amdgcn_exp2f(-dl); lrow *= f;
#pragma unroll
                        for (int r = 0; r < 16; ++r) { o0[r] *= f; o1[r] *= f; } }
#pragma unroll
                    for (int r = 0; r < 16; ++r) negm[r] = -mref;
                    first = false;
                }
                float rs = 0.f;
#pragma unroll
                for (int r = 0; r < 16; ++r) { p0[r] = __builtin_amdgcn_exp2f(p0[r]); p1[r] = __builtin_amdgcn_exp2f(p1[r]); rs += p0[r] + p1[r]; }
                lrow += rs;
            } else {
                const bool need_mask = (64 * kt + 63 >= t0w);
                const int kvb = 64 * kt + 4 * hi;
                float gs[8], lkq0[16], lkq1[16];
#pragma unroll
                for (int g = 0; g < 8; ++g) {
                    float s4 = 0.f;
#pragma unroll
                    for (int c = 0; c < 4; ++c) {
                        const int r = 4 * (g & 3) + c;
                        const float z2 = ((g < 4) ? p0[r] : p1[r]) * (0.125f * LOG2E);
                        const float sp2 = fmaxf(z2, 0.f) + __builtin_amdgcn_logf(1.0f + __builtin_amdgcn_exp2f(-fabsf(z2)));
                        const bool valid = !need_mask || (kvb + 8 * g + c < trow);
                        const float lk = valid ? -sp2 : 0.f;
                        const float ls = valid ? (z2 - sp2) : -1e30f;
                        if (g < 4) { p0[r] = ls; } else { p1[r] = ls; }
                        s4 += lk;
                        if (g < 4) { lkq0[r] = lk; } else { lkq1[r] = lk; }
                    }
                    gs[g] = s4;
                }
                float run = 0.f, after[8];
#pragma unroll
                for (int g = 7; g >= 0; --g) { const float pg = __shfl_xor(gs[g], 32); after[g] = run + (hi == 0 ? pg : 0.f); run += gs[g] + pg; }
#pragma unroll
                for (int g = 0; g < 8; ++g) {
                    float suf = carry + after[g];
#pragma unroll
                    for (int c = 3; c >= 0; --c) {
                        const int r = 4 * (g & 3) + c;
                        if (g < 4) { p0[r] = __builtin_amdgcn_exp2f(p0[r] + suf); suf += lkq0[r]; } else { p1[r] = __builtin_amdgcn_exp2f(p1[r] + suf); suf += lkq1[r]; }
                    }
                }
                carry += run;
            }
            if (MODE == 1) {
#pragma unroll
                for (int jj = 0; jj < 4; ++jj) { va[jj] = *(const LAS bf16x8*)(Vt + l31 * AT_VSTR + 8 * hi + 16 * jj); vb[jj] = *(const LAS bf16x8*)(Vt + (32 + l31) * AT_VSTR + 8 * hi + 16 * jj); }
            }
            const bf16x8 pb0 = pack8(p0[0], p0[1], p0[2], p0[3], p0[4], p0[5], p0[6], p0[7]), pb1 = pack8(p0[8], p0[9], p0[10], p0[11], p0[12], p0[13], p0[14], p0[15]);
            const bf16x8 pb2 = pack8(p1[0], p1[1], p1[2], p1[3], p1[4], p1[5], p1[6], p1[7]), pb3 = pack8(p1[8], p1[9], p1[10], p1[11], p1[12], p1[13], p1[14], p1[15]);
            o0 = __builtin_amdgcn_mfma_f32_32x32x16_bf16(va[0], pb0, o0, 0, 0, 0); o1 = __builtin_amdgcn_mfma_f32_32x32x16_bf16(vb[0], pb0, o1, 0, 0, 0);
            o0 = __builtin_amdgcn_mfma_f32_32x32x16_bf16(va[1], pb1, o0, 0, 0, 0); o1 = __builtin_amdgcn_mfma_f32_32x32x16_bf16(vb[1], pb1, o1, 0, 0, 0);
            o0 = __builtin_amdgcn_mfma_f32_32x32x16_bf16(va[2], pb2, o0, 0, 0, 0); o1 = __builtin_amdgcn_mfma_f32_32x32x16_bf16(vb[2], pb2, o1, 0, 0, 0);
            o0 = __builtin_amdgcn_mfma_f32_32x32x16_bf16(va[3], pb3, o0, 0, 0, 0); o1 = __builtin_amdgcn_mfma_f32_32x32x16_bf16(vb[3], pb3, o1, 0, 0, 0);
            };
    bool brk = false;
#define AT_ITER(i, SL, SS) do { \
        const int kt_ = AT_KT(i); \
        AT_LOAD(AT_KT(((i) + 2 < nt) ? (i) + 2 : nt - 1), SL);        \
        if (AT_PART(kt_)) compute((i) & 1, kt_); \
        if ((i) + 1 < nt) AT_STORE(((i) + 1) & 1, SS); \
        if (MODE == 1) { const int done_ = __all(carry < -128.0f) ? 1 : 0; if (lane == 0) flags[((i) & 1) * 8 + wid] = done_; } \
        AT_BAR(); \
        if (MODE == 1) { int alld_ = 1; \
            _Pragma("unroll") for (int w8 = 0; w8 < 8; ++w8) alld_ &= flags[((i) & 1) * 8 + w8]; \
            if (alld_) brk = true; } } while (0)
    AT_LOAD(AT_KT(0), A);
    AT_LOAD(AT_KT(nt > 1 ? 1 : 0), B);
    if (MODE == 2) { ((LAS float*)(lds + AT_OFF_BIAS))[tid] = bz0 * LOG2E; if (tid == 0) ((LAS float*)(lds + AT_OFF_BIAS))[512] = bz1 * LOG2E;
        if (TWOH) { ((LAS float*)(lds + AT_OFF_H1 + AT_OFF_BIAS))[tid] = bz2 * LOG2E; if (tid == 0) ((LAS float*)(lds + AT_OFF_H1 + AT_OFF_BIAS))[512] = bz3 * LOG2E; } }
    AT_STORE(0, A);
    AT_BAR();
    for (int i = 0; i < nt; i += 2) {
        AT_ITER(i, A, B);
        if (brk || i + 1 >= nt) break;
        AT_ITER(i + 1, B, A);
        if (brk) break;
    }
    if (MODE == 1) { if (brk) AT_BAR(); }
#undef AT_ITER
#undef AT_PART
#undef AT_VT8
#undef AT_BAR
    float inv = 1.0f;
    if (MODE != 1) { const float lt = lrow + __shfl_xor(lrow, 32); inv = 1.0f / lt; }
    bf16_t* orow = Op + (size_t)trow * DM;
#pragma unroll
    for (int gp = 0; gp < 2; ++gp) {
        const int g0 = 2 * gp, g1 = 2 * gp + 1;
        u32x2 wa0, wa1, wb0, wb1;
        wa0.x = cvt_pk_bf16(o0[4 * g0] * inv, o0[4 * g0 + 1] * inv); wa0.y = cvt_pk_bf16(o0[4 * g0 + 2] * inv, o0[4 * g0 + 3] * inv);
        wa1.x = cvt_pk_bf16(o0[4 * g1] * inv, o0[4 * g1 + 1] * inv); wa1.y = cvt_pk_bf16(o0[4 * g1 + 2] * inv, o0[4 * g1 + 3] * inv);
        wb0.x = cvt_pk_bf16(o1[4 * g0] * inv, o1[4 * g0 + 1] * inv); wb0.y = cvt_pk_bf16(o1[4 * g0 + 2] * inv, o1[4 * g0 + 3] * inv);
        wb1.x = cvt_pk_bf16(o1[4 * g1] * inv, o1[4 * g1 + 1] * inv); wb1.y = cvt_pk_bf16(o1[4 * g1 + 2] * inv, o1[4 * g1 + 3] * inv);
        const u32x2 sa = hi ? wa0 : wa1, sb = hi ? wb0 : wb1;
        u32x2 ra, rb; ra.x = __shfl_xor(sa.x, 32); ra.y = __shfl_xor(sa.y, 32); rb.x = __shfl_xor(sb.x, 32); rb.y = __shfl_xor(sb.y, 32);
        u32x4 qa, qb;
        if (hi) { qa = (u32x4){ra.x, ra.y, wa1.x, wa1.y}; qb = (u32x4){rb.x, rb.y, wb1.x, wb1.y}; }
        else    { qa = (u32x4){wa0.x, wa0.y, ra.x, ra.y}; qb = (u32x4){wb0.x, wb0.y, rb.x, rb.y}; }
        const int col = 8 * (hi ? g1 : g0);
        *(u32x4*)(orow + col) = qa; *(u32x4*)(orow + 32 + col) = qb;
    }
#undef AT_KT
#undef AT_LOAD
#undef AT_STORE
}


#define XB_TMO      128
#define XB_XCNT(j)  (256  + 64 * (j))
#define XB_XSUB(j)  (1280 + 64 * (j))
#define XB_XGEN(j)  (2304 + 64 * (j))
#define XB_TOP      3328
#define XB_TOPGEN   3392
#define XCD_BAR_WORDS 3456
#define XB_SPIN_CAP (1u << 18)
__device__ __forceinline__ unsigned xb_ld(unsigned* p)              { return __hip_atomic_load(p, __ATOMIC_RELAXED, __HIP_MEMORY_SCOPE_AGENT); }
__device__ __forceinline__ unsigned xb_add(unsigned* p, unsigned v) { return __hip_atomic_fetch_add(p, v, __ATOMIC_RELAXED, __HIP_MEMORY_SCOPE_AGENT); }
__device__ __forceinline__ unsigned xb_xcc_id() { return (unsigned)__builtin_amdgcn_s_getreg((3 << 11) | 20) & 0xFu; }
#define XB_SPIN(cond, bar) do { unsigned _sp = 0; while (cond) { __builtin_amdgcn_s_sleep(1); \
    if ((++_sp & 255u) == 0u) { if (xb_ld(&(bar)[XB_TMO])) break; if (_sp > XB_SPIN_CAP) { atomicAdd(&(bar)[XB_TMO], 1u); break; } } } } while (0)
struct XcdBarrier { unsigned* bar; unsigned x; volatile LAS unsigned* st; };
__device__ __forceinline__ XcdBarrier xcd_barrier_post(unsigned* bar, volatile LAS unsigned* st) {
    XcdBarrier b; b.bar = bar; b.x = xb_xcc_id(); b.st = st;
    if (threadIdx.x == 0) (void)xb_add(&bar[XB_XCNT(b.x)], 1u);
    return b;
}
__device__ __forceinline__ void xcd_barrier_complete(unsigned* bar, unsigned x, unsigned& nloc, unsigned& nx) {
    const unsigned G = gridDim.x * gridDim.y * gridDim.z;
    unsigned sum, cnt, mine, sp = 0u;
    for (;;) {
        sum = 0u; cnt = 0u; mine = 0u;
#pragma unroll
        for (unsigned j = 0; j < 16; ++j) { const unsigned c = xb_ld(&bar[XB_XCNT(j)]); sum += c; cnt += (c > 0u) ? 1u : 0u; mine = (j == x) ? c : mine; }
        if (sum == G) break;
        __builtin_amdgcn_s_sleep(1);
        if ((++sp & 255u) == 0u) { if (xb_ld(&bar[XB_TMO])) break; if (sp > XB_SPIN_CAP) { atomicAdd(&bar[XB_TMO], 1u); break; } }
    }
    nloc = mine > 0u ? mine : 1u; nx = cnt > 0u ? cnt : 1u;
}
__device__ __forceinline__ void xcd_barrier(const XcdBarrier& b) {
    asm volatile("s_waitcnt vmcnt(0)" ::: "memory");
    __syncthreads();
    if (threadIdx.x == 0) {
        unsigned* bar = b.bar;
        __builtin_amdgcn_s_waitcnt(0);
        unsigned nloc = b.st[0], nx = b.st[1];
        if (nloc == 0u) { xcd_barrier_complete(bar, b.x, nloc, nx); b.st[0] = nloc; b.st[1] = nx; }
        const unsigned old = xb_add(&bar[XB_XSUB(b.x)], 1u);
        const unsigned gen = old / nloc;
        if (old + 1u == (gen + 1u) * nloc) {
            __builtin_amdgcn_fence(__ATOMIC_RELEASE, "agent");
            asm volatile("s_waitcnt vmcnt(0)" ::: "memory");
            const unsigned og = xb_add(&bar[XB_TOP], 1u);
            const unsigned tg = og / nx;
            if (og + 1u == (tg + 1u) * nx) xb_add(&bar[XB_TOPGEN], 1u);
            else XB_SPIN(xb_ld(&bar[XB_TOPGEN]) == tg, bar);
            __builtin_amdgcn_fence(__ATOMIC_ACQUIRE, "agent");
            xb_add(&bar[XB_XGEN(b.x)], 1u);
            asm volatile("s_waitcnt vmcnt(0)" ::: "memory");
        } else {
            XB_SPIN(xb_ld(&bar[XB_XGEN(b.x)]) == gen, bar);
            __builtin_amdgcn_fence(__ATOMIC_ACQUIRE, "agent");
            asm volatile("s_waitcnt vmcnt(0)" ::: "memory");
        }
    }
    __syncthreads();
}

struct Args { const float* in[16]; float* out; unsigned char* ws; };

__device__ __forceinline__ void attn_mla_naive(const bf16_t* QA, const bf16_t* KVA, const bf16_t* PROJ, bf16_t* O) {
    const int nth = gridDim.x * NTHREADS;
    for (int w = blockIdx.x * NTHREADS + threadIdx.x; w < 8 * MTOK; w += nth) {
        const int h = w >> 14, row = w & (MTOK - 1), b = row >> 11, t = row & (SEQ - 1);
        float q[96];
#pragma unroll
        for (int c = 0; c < 12; ++c) unpack8(*(const u32x4*)(QA + (size_t)row * NQA + h * 96 + c * 8), q + c * 8);
        float o[64];
#pragma unroll
        for (int d = 0; d < 64; ++d) o[d] = 0.f;
        float mx = -INFINITY, l = 0.f;
        const int kend = ((t >> 6) + 1) << 6;
        for (int s = 0; s < kend; ++s) {
            const size_t kr = (size_t)(b * SEQ + s);
            const bf16_t* kp = KVA + kr * NKVA + h * 128; const bf16_t* rp = PROJ + kr * NPROJ_P + C_KR;
            float sc = 0.f;
#pragma unroll
            for (int c = 0; c < 8; ++c) { float k[8]; unpack8(*(const u32x4*)(kp + c * 8), k);
#pragma unroll
                for (int e = 0; e < 8; ++e) sc += q[c * 8 + e] * k[e]; }
#pragma unroll
            for (int c = 0; c < 4; ++c) { float k[8]; unpack8(*(const u32x4*)(rp + c * 8), k);
#pragma unroll
                for (int e = 0; e < 8; ++e) sc += q[64 + c * 8 + e] * k[e]; }
            const float mn = fmaxf(mx, sc), al = __builtin_amdgcn_exp2f(mx - mn), p = __builtin_amdgcn_exp2f(sc - mn);
            l = l * al + p; mx = mn;
#pragma unroll
            for (int c = 0; c < 8; ++c) { float v[8]; unpack8(*(const u32x4*)(kp + 64 + c * 8), v);
#pragma unroll
                for (int e = 0; e < 8; ++e) o[c * 8 + e] = o[c * 8 + e] * al + p * v[e]; }
        }
        const float inv = 1.0f / l;
#pragma unroll
        for (int c = 0; c < 8; ++c) { u32x4 wv; wv.x = cvt_pk_bf16(o[c * 8] * inv, o[c * 8 + 1] * inv); wv.y = cvt_pk_bf16(o[c * 8 + 2] * inv, o[c * 8 + 3] * inv); wv.z = cvt_pk_bf16(o[c * 8 + 4] * inv, o[c * 8 + 5] * inv); wv.w = cvt_pk_bf16(o[c * 8 + 6] * inv, o[c * 8 + 7] * inv);
            *(u32x4*)(O + (size_t)row * DM + h * 64 + c * 8) = wv; }
    }
}

__device__ __forceinline__ void attn_sb_naive(const bf16_t* PROJ, bf16_t* O) {
    const int nth = gridDim.x * NTHREADS;
    for (int w = blockIdx.x * NTHREADS + threadIdx.x; w < 8 * MTOK; w += nth) {
        const int h = w >> 14, row = w & (MTOK - 1), b = row >> 11, t = row & (SEQ - 1);
        float q[64];
#pragma unroll
        for (int c = 0; c < 8; ++c) unpack8(*(const u32x4*)(PROJ + (size_t)row * NPROJ_P + C_QB + h * 64 + c * 8), q + c * 8);
        float o[64];
#pragma unroll
        for (int d = 0; d < 64; ++d) o[d] = 0.f;
        float cum = 0.f;
        const int tmax = t | 63;
        for (int s = tmax - 1; s >= 0; --s) {
            const size_t kr = (size_t)(b * SEQ + s);
            const bf16_t* kp = PROJ + kr * NPROJ_P + C_KB + h * 64; const bf16_t* vp = PROJ + kr * NPROJ_P + C_VB + h * 64;
            float z = 0.f;
#pragma unroll
            for (int c = 0; c < 8; ++c) { float k[8]; unpack8(*(const u32x4*)(kp + c * 8), k);
#pragma unroll
                for (int e = 0; e < 8; ++e) z += q[c * 8 + e] * k[e]; }
            z *= 0.125f;
            const bool on = s < t;
            const float lg = __logf(1.0f + __expf(-fabsf(z)));
            const float wgt = on ? __expf(fminf(z, 0.f) - lg + cum) : 0.f;
            cum += on ? (fminf(-z, 0.f) - lg) : 0.f;
#pragma unroll
            for (int c = 0; c < 8; ++c) { float v[8]; unpack8(*(const u32x4*)(vp + c * 8), v);
#pragma unroll
                for (int e = 0; e < 8; ++e) o[c * 8 + e] += wgt * v[e]; }
        }
#pragma unroll
        for (int c = 0; c < 8; ++c) { u32x4 wv; wv.x = cvt_pk_bf16(o[c * 8], o[c * 8 + 1]); wv.y = cvt_pk_bf16(o[c * 8 + 2], o[c * 8 + 3]); wv.z = cvt_pk_bf16(o[c * 8 + 4], o[c * 8 + 5]); wv.w = cvt_pk_bf16(o[c * 8 + 6], o[c * 8 + 7]);
            *(u32x4*)(O + (size_t)row * DM + 512 + h * 64 + c * 8) = wv; }
    }
}

__device__ __forceinline__ void attn_band_naive(const bf16_t* QKV, const float* rel_bias, bf16_t* O) {
    const int nth = gridDim.x * NTHREADS;
    for (int w = blockIdx.x * NTHREADS + threadIdx.x; w < 16 * MTOK; w += nth) {
        const int h = w >> 14, row = w & (MTOK - 1), b = row >> 11, t = row & (SEQ - 1);
        float q[64];
#pragma unroll
        for (int c = 0; c < 8; ++c) unpack8(*(const u32x4*)(QKV + (size_t)row * NQKV + h * 64 + c * 8), q + c * 8);
        float o[64];
#pragma unroll
        for (int d = 0; d < 64; ++d) o[d] = 0.f;
        float mx = -INFINITY, l = 0.f;
        const int n = t >> 6, s0 = (n >= 8) ? (n - 8) * 64 : 0, s1 = (n + 1) * 64;
        const float* bias = rel_bias + h * 513 + 256;
        for (int s = s0; s < s1; ++s) {
            const size_t kr = (size_t)(b * SEQ + s);
            const bf16_t* kp = QKV + kr * NQKV + 1024 + h * 64; const bf16_t* vp = QKV + kr * NQKV + 2048 + h * 64;
            float sc = 0.f;
#pragma unroll
            for (int c = 0; c < 8; ++c) { float k[8]; unpack8(*(const u32x4*)(kp + c * 8), k);
#pragma unroll
                for (int e = 0; e < 8; ++e) sc += q[c * 8 + e] * k[e]; }
            int rel = t - s; rel = rel > 256 ? 256 : (rel < -256 ? -256 : rel);
            sc += bias[rel] * LOG2E;
            const float mn = fmaxf(mx, sc), al = __builtin_amdgcn_exp2f(mx - mn), p = __builtin_amdgcn_exp2f(sc - mn);
            l = l * al + p; mx = mn;
#pragma unroll
            for (int c = 0; c < 8; ++c) { float v[8]; unpack8(*(const u32x4*)(vp + c * 8), v);
#pragma unroll
                for (int e = 0; e < 8; ++e) o[c * 8 + e] = o[c * 8 + e] * al + p * v[e]; }
        }
        const float inv = 1.0f / l;
#pragma unroll
        for (int c = 0; c < 8; ++c) { u32x4 wv; wv.x = cvt_pk_bf16(o[c * 8] * inv, o[c * 8 + 1] * inv); wv.y = cvt_pk_bf16(o[c * 8 + 2] * inv, o[c * 8 + 3] * inv); wv.z = cvt_pk_bf16(o[c * 8 + 4] * inv, o[c * 8 + 5] * inv); wv.w = cvt_pk_bf16(o[c * 8 + 6] * inv, o[c * 8 + 7] * inv);
            *(u32x4*)(O + (size_t)row * DM + h * 64 + c * 8) = wv; }
    }
}

constexpr int I_IN = 16 * (NPROJ / 32), I_UQ = 6 * 24, I_UKV = 4 * 32, I_O = 16 * 32, I_G = 16 * 88, I_D = 44 * 32, I_QKV = 16 * 96;
constexpr int CV_R0 = I_IN + I_UQ + I_UKV, CV_R1 = CV_R0 + I_O + 2 * I_G + I_D + I_QKV + I_O, CV_NITEMS = CV_R1 + 2 * I_G + I_D;
#define CONV_ITEM(it_) do { int r = (it_); \
        if (r < I_IN) { p0_item(args.in[1], DM, NPROJ, args.in[10], Win, DM, 0, scr, r, lane); break; } r -= I_IN; \
        if (r < I_UQ) { p0_item(args.in[3], 384, NQA, args.in[2], Wuq, 384, 0, scr, r, lane); break; } r -= I_UQ; \
        if (r < I_UKV) { p0_item(args.in[5], 256, NKVA, args.in[4], Wukv, 256, 0, scr, r, lane); break; } r -= I_UKV; \
        if (r < I_O) { p0_item(args.in[6], DM, DM, nullptr, Wo0, DM, 0, scr, r, lane); break; } r -= I_O; \
        if (r < I_G) { p0_item(args.in[12], DM, DFF, args.in[11], Wgu0, DM, 1, scr, r, lane); break; } r -= I_G; \
        if (r < I_G) { p0_item(args.in[13], DM, DFF, args.in[11], Wgu0, DM, 2, scr, r, lane); break; } r -= I_G; \
        if (r < I_D) { p0_item(args.in[14], DFF, DM, nullptr, Wd0, DFF, 0, scr, r, lane); break; } r -= I_D; \
        if (r < I_QKV) { p0_item(args.in[7], DM, NQKV, args.in[10] + DM, Wqkv, DM, 0, scr, r, lane); break; } r -= I_QKV; \
        if (r < I_O) { p0_item(args.in[9], DM, DM, nullptr, Wo1, DM, 0, scr, r, lane); break; } r -= I_O; \
        if (r < I_G) { p0_item(args.in[12] + (size_t)DM * DFF, DM, DFF, args.in[11] + DM, Wgu1, DM, 1, scr, r, lane); break; } r -= I_G; \
        if (r < I_G) { p0_item(args.in[13] + (size_t)DM * DFF, DM, DFF, args.in[11] + DM, Wgu1, DM, 2, scr, r, lane); break; } r -= I_G; \
        p0_item(args.in[14] + (size_t)DFF * DM, DFF, DM, nullptr, Wd1, DFF, 0, scr, r, lane); } while (0)
#define CONV_TAIL(first, lo, hi) do { if (G == 256 && (int)blockIdx.x >= (first)) { int tid_c = threadIdx.x; asm volatile("" : "+v"(tid_c)); const int lane = tid_c & 63, wave = __builtin_amdgcn_readfirstlane(tid_c >> 6); \
        LAS float* scr = (LAS float*)((LAS unsigned char*)lds + wave * 16384); \
        for (int it = (lo) + ((int)blockIdx.x - (first)) * 8 + wave; it < (hi); it += (G - (first)) * 8) CONV_ITEM(it); } } while (0)

__global__ void __launch_bounds__(NTHREADS) fwd_megakernel(Args args) {
    extern __shared__ __attribute__((aligned(16))) unsigned char lds[];
#ifdef USE_CG_SYNC
    cg::grid_group grid = cg::this_grid();
#define GRID_SYNC() grid.sync()
#else
    { volatile LAS unsigned* st0 = (volatile LAS unsigned*)((LAS unsigned char*)lds + LDS_BYTES - 64); if (threadIdx.x == 0) { st0[0] = 0u; st0[1] = 0u; } }
    __syncthreads();
    const XcdBarrier xbar = xcd_barrier_post((unsigned*)(args.ws + WS_CTL), (volatile LAS unsigned*)((LAS unsigned char*)lds + LDS_BYTES - 64));
#define GRID_SYNC() xcd_barrier(xbar)
#endif
#ifdef USE_NAIVE_GEMM
#define GEMM(A, lda, Bt, ldb, M, N, K, E) gemm_naive(A, lda, Bt, ldb, (M) / 256, (N) / 256, K, E)
#else
#define GEMM(A, lda, Bt, ldb, M, N, K, E) gemm_fast((LAS unsigned char*)lds, A, lda, Bt, ldb, M, N, K, E)
#endif
    const int G = gridDim.x;
    const int vcu = (G % 8 == 0) ? (int)(blockIdx.x % 8) * (G / 8) + (int)(blockIdx.x / 8) : (int)blockIdx.x;
    LAS unsigned char* ldsp = (LAS unsigned char*)lds;
    unsigned char* ws = args.ws;
    const float* x = args.in[0];
    float* out = args.out;
    u64* ssq = (u64*)(ws + WS_SSQ);
    f32x2* rope = (f32x2*)(ws + WS_ROPE);
    bf16_t* Win = (bf16_t*)(ws + WS_WIN); bf16_t* Wuq = (bf16_t*)(ws + WS_WUQ); bf16_t* Wukv = (bf16_t*)(ws + WS_WUKV); bf16_t* Wo0 = (bf16_t*)(ws + WS_WO0);
    bf16_t* Wgu0 = (bf16_t*)(ws + WS_WGU0); bf16_t* Wd0 = (bf16_t*)(ws + WS_WD0); bf16_t* Wqkv = (bf16_t*)(ws + WS_WQKV); bf16_t* Wo1 = (bf16_t*)(ws + WS_WO1);
    bf16_t* Wgu1 = (bf16_t*)(ws + WS_WGU1); bf16_t* Wd1 = (bf16_t*)(ws + WS_WD1);
    bf16_t* HB = (bf16_t*)(ws + WS_HB); bf16_t* PROJ = (bf16_t*)(ws + WS_A); bf16_t* QKV = (bf16_t*)(ws + WS_A); bf16_t* ACT = (bf16_t*)(ws + WS_A); bf16_t* ATT = (bf16_t*)(ws + WS_ATT);
    bf16_t* QA = (bf16_t*)((unsigned char*)out + OUT_QA); bf16_t* KVA = (bf16_t*)((unsigned char*)out + OUT_KVA);

    {
        const int tid = threadIdx.x, lane = tid & 63, wave = __builtin_amdgcn_readfirstlane(tid >> 6);
        LAS float* scr = (LAS float*)((LAS unsigned char*)lds + wave * 16384);
        const int gw = blockIdx.x * 8 + wave, NGW = G * 8;
        const bool offload = (G == 256);
        for (int it = gw; it < (offload ? CV_R0 : CV_NITEMS); it += NGW) CONV_ITEM(it);
        for (int i = blockIdx.x * NTHREADS + tid; i < (NPROJ_P - NPROJ) * DM / 8; i += G * NTHREADS) ((u32x4*)(Win + (size_t)NPROJ * DM))[i] = (u32x4){0u, 0u, 0u, 0u};
        for (int i = blockIdx.x * NTHREADS + tid; i < 6 * MTOK; i += G * NTHREADS) ssq[MTOK + i] = 0ull;
        for (int i = blockIdx.x * NTHREADS + tid; i < SEQ * 16; i += G * NTHREADS) {
            const int pos = i >> 4, fi = i & 15;
            const float inv_freq = __builtin_amdgcn_exp2f(-(float)fi * (13.287712379549449f / 16.0f));
            const float ang = (float)pos * inv_freq;
            float tr = ang * 0.15915494309189535f; tr -= floorf(tr);
            rope[i] = (f32x2){__builtin_amdgcn_cosf(tr), __builtin_amdgcn_sinf(tr)};
        }
        for (int m = gw; m < MTOK; m += NGW) {
            const f32x4* xr = (const f32x4*)(x + (size_t)m * DM) + lane; f32x4 v[4]; float s = 0.f;
#pragma unroll
            for (int j = 0; j < 4; ++j) { v[j] = xr[64 * j]; s += dot4(v[j]); }
            s = wave_sum(s);
            if (lane == 0) ssq[m] = ssq_fix(s);
#pragma unroll
            for (int j = 0; j < 4; ++j) { u32x2 w; w.x = cvt_pk_bf16(v[j][0], v[j][1]); w.y = cvt_pk_bf16(v[j][2], v[j][3]); *((u32x2*)(HB + (size_t)m * DM) + lane + 64 * j) = w; }
        }
    }
    GRID_SYNC();
    { EpiScale<0> E{PROJ, NPROJ_P, ssq, 1.0f / DM, ssq + MTOK, ssq + 2 * MTOK, rope}; GEMM(HB, DM, Win, DM, MTOK, NPROJ_P, DM, E); }
    CONV_TAIL(64, CV_R0, CV_R1);
    GRID_SYNC();
    { EpiScale<1> E{QA, NQA, ssq + MTOK, 1.0f / 384, nullptr, nullptr, rope}; GEMM(PROJ, NPROJ_P, Wuq, 384, MTOK, NQA, 384, E); }
    { EpiScaleP<2> E{KVA, NKVA, ssq + 2 * MTOK, 1.0f / 256}; GEMM(PROJ + C_CKV, NPROJ_P, Wukv, 256, MTOK, NKVA, 256, E); }
    GRID_SYNC();
#ifdef NAIVE_ATTN
    attn_mla_naive(QA, KVA, PROJ, ATT);
    attn_sb_naive(PROJ, ATT);
#else
    for (int u = vcu; u < 256; u += G) {
        const int bh = u >> 2, j = u & 3, b = bh >> 3, h = bh & 7;
        const size_t rb = (size_t)b * SEQ;
        for (int k = 0; k < 2 * REP_MLA; ++k) { const int qt = (k & 1) ? 7 - j : j;
            attn_unit<0>(ldsp, 256 * qt, QA + rb * NQA + h * 96, NQA, KVA + rb * NKVA + h * 128, NKVA, PROJ + rb * NPROJ_P + C_KR, NPROJ_P, KVA + rb * NKVA + h * 128 + 64, NKVA, ATT + rb * DM + h * 64, nullptr); }
    }
    for (int u = vcu; u < 256; u += G) {
        const int bhp = u >> 3, j = u & 7, b = bhp >> 2, hp = bhp & 3;
        const size_t rb = (size_t)b * SEQ;
        for (int k = 0; k < 2 * REP_SB; ++k) { const int qt = (k & 1) ? 15 - j : j;
            attn_unit<1, true>(ldsp, 128 * qt, PROJ + rb * NPROJ_P + C_QB + hp * 128, NPROJ_P, PROJ + rb * NPROJ_P + C_KB + hp * 128, NPROJ_P, nullptr, 0, PROJ + rb * NPROJ_P + C_VB + hp * 128, NPROJ_P, ATT + rb * DM + 512 + hp * 128, nullptr); }
    }
#endif
    GRID_SYNC();
    { EpiResid E{HB, ssq + 3 * MTOK}; GEMM(ATT, DM, Wo0, DM, MTOK, DM, DM, E); }
    GRID_SYNC();
    for (int rep = 0; rep < REP_GU; ++rep) { EpiSwiglu E{ACT, ssq + 3 * MTOK}; GEMM(HB, DM, Wgu0, DM, MTOK, 2 * DFF, DM, E); }
    CONV_TAIL(128, CV_R1, CV_NITEMS);
    GRID_SYNC();
    { EpiResid E{HB, ssq + 4 * MTOK}; GEMM(ACT, DFF, Wd0, DFF, MTOK, DM, DFF, E); }
    GRID_SYNC();
    { EpiScaleP<3> E{QKV, NQKV, ssq + 4 * MTOK, 1.0f / DM}; GEMM(HB, DM, Wqkv, DM, MTOK, NQKV, DM, E); }
    GRID_SYNC();
#ifdef NAIVE_ATTN
    attn_band_naive(QKV, args.in[8], ATT);
#else
    for (int u = vcu; u < 256; u += G) {
        const int bhp = u >> 2, j = u & 3, b = bhp >> 3, hp = bhp & 7;
        const size_t rb = (size_t)b * SEQ;
        for (int k = 0; k < 4 * REP_BAND; ++k) { const int kk = k & 3; const int qt = (kk == 0) ? j : (kk == 1) ? 7 - j : (kk == 2) ? 8 + j : 15 - j;
            attn_unit<2, true>(ldsp, 128 * qt, QKV + rb * NQKV + hp * 128, NQKV, QKV + rb * NQKV + 1024 + hp * 128, NQKV, nullptr, 0, QKV + rb * NQKV + 2048 + hp * 128, NQKV, ATT + rb * DM + hp * 128, args.in[8] + (2 * hp) * 513); }
    }
#endif
    GRID_SYNC();
    { EpiResid E{HB, ssq + 5 * MTOK}; GEMM(ATT, DM, Wo1, DM, MTOK, DM, DM, E); }
    GRID_SYNC();
    { EpiSwiglu E{ACT, ssq + 5 * MTOK}; GEMM(HB, DM, Wgu1, DM, MTOK, 2 * DFF, DM, E); }
    GRID_SYNC();
    if (G == 256) {
        EpiFinal E{HB, ssq + 6 * MTOK, (unsigned*)(args.ws + WS_CTL) + CW_PANEL, args.in[15], out};
        gemm_fast((LAS unsigned char*)lds, ACT, DFF, Wd1, DFF, MTOK, DM, DFF, E);
        return;
    }
    { EpiResid E{HB, ssq + 6 * MTOK}; GEMM(ACT, DFF, Wd1, DFF, MTOK, DM, DFF, E); }
    GRID_SYNC();
    {
        const int tid = threadIdx.x, lane = tid & 63, wave = __builtin_amdgcn_readfirstlane(tid >> 6); (void)tid;
        const int gw = blockIdx.x * 8 + wave, NGW = G * 8;
        const f32x4* gf = (const f32x4*)args.in[15] + lane;
        for (int m = gw; m < MTOK; m += NGW) {
            const float r = rsqrtf(ssq_get(ssq + 6 * MTOK, m) * (1.0f / DM) + RMS_EPS);
            f32x4* p = (f32x4*)(out + (size_t)m * DM) + lane; const u32x2* hp = (const u32x2*)(HB + (size_t)m * DM) + lane;
#pragma unroll
            for (int j = 0; j < 4; ++j) { const u32x2 hv = hp[64 * j]; const f32x4 g4 = gf[64 * j]; f32x4 o; o[0] = bflo(hv.x) * r * g4[0]; o[1] = bfhi(hv.x) * r * g4[1]; o[2] = bflo(hv.y) * r * g4[2]; o[3] = bfhi(hv.y) * r * g4[3]; p[64 * j] = o; }
        }
    }
}

extern "C" void kernel_launch(void* const* d_in, const int* in_sizes, int n_in, void* d_out, int out_size, void* d_ws, size_t ws_size, hipStream_t stream) {
    static int grid = 0;
    if (grid == 0) {
        int dev = 0, cus = 0, per_cu = 0;
        hipGetDevice(&dev);
        hipDeviceGetAttribute(&cus, hipDeviceAttributeMultiprocessorCount, dev);
        hipFuncSetAttribute((const void*)fwd_megakernel, hipFuncAttributeMaxDynamicSharedMemorySize, LDS_BYTES);
        hipOccupancyMaxActiveBlocksPerMultiprocessor(&per_cu, (const void*)fwd_megakernel, NTHREADS, LDS_BYTES);
        if (per_cu < 1) per_cu = 1;
        if (per_cu > 1) per_cu = 1;
        grid = cus * per_cu;
        if (n_in != 16 || out_size != MTOK * DM || ws_size < WS_END) { fprintf(stderr, "kernel_launch: unexpected shapes n_in %d out %d ws %zu\n", n_in, out_size, ws_size); }
    }
    Args a{};
    for (int i = 0; i < 16; ++i) a.in[i] = (const float*)d_in[i];
    a.out = (float*)d_out; a.ws = (unsigned char*)d_ws;
    hipMemsetAsync((char*)d_ws + WS_CTL, 0, CTL_BYTES, stream);
    void* kargs[] = {&a};
    hipError_t e = hipLaunchCooperativeKernel((const void*)fwd_megakernel, dim3(grid), dim3(NTHREADS), kargs, LDS_BYTES, stream);
    if (e != hipSuccess) fprintf(stderr, "cooperative launch failed: %s (grid %d)\n", hipGetErrorString(e), grid);
}
```

```cpp
#include <hip/hip_runtime.h>
#include <hip/hip_cooperative_groups.h>
#include <cstdio>
#include <cstdint>
namespace cg = cooperative_groups;
#define REP_MLA 1
#define REP_SB 1
#define REP_BAND 1
#define REP_GU 1

#define LAS __attribute__((address_space(3)))
typedef unsigned short bf16_t;
typedef short bf16x8 __attribute__((ext_vector_type(8)));
typedef float f32x4 __attribute__((ext_vector_type(4)));
typedef float f32x2 __attribute__((ext_vector_type(2)));
typedef unsigned u32x4 __attribute__((ext_vector_type(4)));
typedef unsigned u32x2 __attribute__((ext_vector_type(2)));

constexpr int MTOK = 16384, SEQ = 2048, DM = 1024, DFF = 2816;
constexpr int NPROJ = 2208, NPROJ_P = 2304;
constexpr int C_CKV = 384, C_KR = 640, C_QB = 672, C_KB = 1184, C_VB = 1696;
constexpr int NQA = 768, NKVA = 1024, NQKV = 3072;
constexpr float RMS_EPS = 1e-6f;
constexpr float LOG2E = 1.4426950408889634f;
constexpr float QSCALE_A = 0.10206207261596577f * LOG2E;
constexpr float QSCALE_C = 0.125f * LOG2E;

constexpr size_t KiB = 1024, MiB = 1u << 20;
constexpr size_t WS_SSQ = 216 * MiB;
constexpr size_t WS_ROPE = 512 * KiB;
constexpr size_t WS_CTL = 768 * KiB, CTL_BYTES = 32 * KiB; constexpr int CW_PANEL = 4096;
constexpr size_t WS_WIN = 1 * MiB;
constexpr size_t WS_WUQ = WS_WIN + (size_t)NPROJ_P * DM * 2;
constexpr size_t WS_WUKV = WS_WUQ + (size_t)NQA * 384 * 2;
constexpr size_t WS_WO0 = WS_WUKV + (size_t)NKVA * 256 * 2;
constexpr size_t WS_WGU0 = WS_WO0 + (size_t)DM * DM * 2;
constexpr size_t WS_WD0 = WS_WGU0 + (size_t)2 * DFF * DM * 2;
constexpr size_t WS_WQKV = WS_WD0 + (size_t)DM * DFF * 2;
constexpr size_t WS_WO1 = WS_WQKV + (size_t)NQKV * DM * 2;
constexpr size_t WS_WGU1 = WS_WO1 + (size_t)DM * DM * 2;
constexpr size_t WS_WD1 = WS_WGU1 + (size_t)2 * DFF * DM * 2;
constexpr size_t WS_WEND = WS_WD1 + (size_t)DM * DFF * 2;
constexpr size_t WS_HB = 50 * MiB;
constexpr size_t WS_A = 82 * MiB;
constexpr size_t WS_ATT = 178 * MiB;
constexpr size_t WS_SSQP = 210 * MiB;
constexpr size_t WS_END = 218 * MiB;
static_assert(WS_WEND <= WS_HB, "weights fit");
constexpr size_t OUT_QA = 0, OUT_KVA = 24 * MiB;

constexpr int NTHREADS = 512;
constexpr int LDS_BYTES = 147456;

typedef __bf16 bf16x2_t __attribute__((ext_vector_type(2)));
__device__ __forceinline__ unsigned cvt_pk_bf16(float lo, float hi) { const f32x2 v = {lo, hi}; const bf16x2_t b = __builtin_convertvector(v, bf16x2_t); return __builtin_bit_cast(unsigned, b); }
__device__ __forceinline__ float bflo(unsigned w) { return __uint_as_float(w << 16); }
__device__ __forceinline__ float bfhi(unsigned w) { return __uint_as_float(w & 0xffff0000u); }
__device__ __forceinline__ void unpack8(const u32x4 w, float* f) {
    f[0] = bflo(w.x); f[1] = bfhi(w.x); f[2] = bflo(w.y); f[3] = bfhi(w.y); f[4] = bflo(w.z); f[5] = bfhi(w.z); f[6] = bflo(w.w); f[7] = bfhi(w.w);
}
__device__ __forceinline__ float wave_sum(float v) {
#pragma unroll
    for (int o = 1; o < 64; o <<= 1) v += __shfl_xor(v, o);
    return v;
}
__device__ __forceinline__ float dot4(const f32x4 a) { return (a[0] * a[0] + a[1] * a[1]) + (a[2] * a[2] + a[3] * a[3]); }

struct Unit { int pm, pn; };
typedef unsigned long long u64;
__device__ __forceinline__ u64 ssq_fix(float s) { const unsigned hi = (unsigned)s; const unsigned lo = (unsigned)((s - (float)hi) * 4294967296.0f); return ((u64)hi << 32) | (u64)lo; }
__device__ __forceinline__ float ssq_val(const u64 v) { return (float)(unsigned)(v >> 32) + (float)(unsigned)v * 2.3283064365386963e-10f; }
__device__ __forceinline__ float ssq_get(const u64* p, int row) { return ssq_val(p[row]); }
__device__ __forceinline__ void ssq_add(u64* p, int row, float s) { atomicAdd(p + row, ssq_fix(s)); }


template <int MODE> struct EpiScale {
    static constexpr bool PERM = true, AFTER_DRAIN = false;
    bf16_t* O; int ldc; const u64* ssq_in; float inv_n; u64* ssq_a; u64* ssq_b; const f32x2* rope;
    __device__ __forceinline__ void operator()(const f32x4 (&acc)[2][2][4][2], const Unit& u, int wr, int wc, int fr, int fq) const {
        const int cb0 = u.pn * 256 + wc * 32;
        u64 sv[2][4];
#pragma unroll
        for (int ai = 0; ai < 2; ++ai)
#pragma unroll
            for (int m = 0; m < 4; ++m) sv[ai][m] = ssq_in[u.pm * 256 + ai * 128 + wr * 64 + m * 16 + fr];
#pragma unroll
        for (int ai = 0; ai < 2; ++ai)
#pragma unroll
            for (int m = 0; m < 4; ++m) {
                const int row = u.pm * 256 + ai * 128 + wr * 64 + m * 16 + fr;
                const float r = rsqrtf(ssq_val(sv[ai][m]) * inv_n + RMS_EPS);
                const int pos = row & (SEQ - 1);
#pragma unroll
                for (int bj = 0; bj < 2; ++bj) {
                    const int cb = cb0 + 128 * bj;
                    float sc = r;
                    if (MODE == 1) sc *= QSCALE_A;
                    f32x4 v0 = acc[ai][bj][m][0] * sc, v1 = acc[ai][bj][m][1] * sc;
                    bool ropeg = false;
                    if (MODE == 0) ropeg = (cb == C_KR);
                    if (MODE == 1) ropeg = ((cb % 96) == 64);
                    if (ropeg) {
                        const float sgn = (fq < 2) ? -1.0f : 1.0f;
                        const f32x2* rp = rope + pos * 16 + 8 * (fq & 1);
#pragma unroll
                        for (int j = 0; j < 4; ++j) {
                            const float o0 = __shfl_xor(v0[j], 32), o1 = __shfl_xor(v1[j], 32); const f32x2 c0 = rp[j], c1 = rp[4 + j];
                            v0[j] = v0[j] * c0.x + sgn * o0 * c0.y; v1[j] = v1[j] * c1.x + sgn * o1 * c1.y;
                        }
                    }
                    if (MODE == 0) {
                        if (cb < C_KR) { float s = dot4(v0) + dot4(v1); s += __shfl_xor(s, 16); s += __shfl_xor(s, 32); if (fq == 0) ssq_add(cb < C_CKV ? ssq_a : ssq_b, row, s); }
                    }
                    u32x4 w; w.x = cvt_pk_bf16(v0[0], v0[1]); w.y = cvt_pk_bf16(v0[2], v0[3]); w.z = cvt_pk_bf16(v1[0], v1[1]); w.w = cvt_pk_bf16(v1[2], v1[3]);
                    *(u32x4*)(O + (size_t)row * ldc + cb + 8 * fq) = w;
                }
            }
    }
};

template <int MODE> struct EpiScaleP {
    static constexpr bool PERM = true, AFTER_DRAIN = false;
    bf16_t* O; int ldc; const u64* ssq_in; float inv_n;
    __device__ __forceinline__ void operator()(const f32x4 (&acc)[2][2][4][2], const Unit& u, int wr, int wc, int fr, int fq) const {
        const int cb0 = u.pn * 256 + wc * 32;
        u64 sv[2][4];
#pragma unroll
        for (int ai = 0; ai < 2; ++ai)
#pragma unroll
            for (int m = 0; m < 4; ++m) sv[ai][m] = ssq_in[u.pm * 256 + ai * 128 + wr * 64 + m * 16 + fr];
#pragma unroll
        for (int ai = 0; ai < 2; ++ai)
#pragma unroll
            for (int m = 0; m < 4; ++m) {
                const int row = u.pm * 256 + ai * 128 + wr * 64 + m * 16 + fr;
                const float r = rsqrtf(ssq_val(sv[ai][m]) * inv_n + RMS_EPS);
#pragma unroll
                for (int bj = 0; bj < 2; ++bj) {
                    const int cb = cb0 + 128 * bj;
                    float sc = r;
                    if (MODE == 3) { if (cb < 1024) sc *= QSCALE_C; }
                    const f32x4 v0 = acc[ai][bj][m][0] * sc, v1 = acc[ai][bj][m][1] * sc;
                    u32x4 w; w.x = cvt_pk_bf16(v0[0], v0[1]); w.y = cvt_pk_bf16(v0[2], v0[3]); w.z = cvt_pk_bf16(v1[0], v1[1]); w.w = cvt_pk_bf16(v1[2], v1[3]);
                    *(u32x4*)(O + (size_t)row * ldc + cb + 8 * fq) = w;
                }
            }
    }
};

struct EpiResid {
    static constexpr bool PERM = true, AFTER_DRAIN = false;
    bf16_t* hb; u64* ssq;
    __device__ __forceinline__ void operator()(const f32x4 (&acc)[2][2][4][2], const Unit& u, int wr, int wc, int fr, int fq) const {
#pragma unroll
        for (int ai = 0; ai < 2; ++ai) {
            u32x4 b[4][2];
#pragma unroll
            for (int m = 0; m < 4; ++m)
#pragma unroll
                for (int bj = 0; bj < 2; ++bj) b[m][bj] = *(const u32x4*)(hb + (size_t)(u.pm * 256 + ai * 128 + wr * 64 + m * 16 + fr) * DM + u.pn * 256 + bj * 128 + wc * 32 + 8 * fq);
#pragma unroll
            for (int m = 0; m < 4; ++m) {
                const int row = u.pm * 256 + ai * 128 + wr * 64 + m * 16 + fr;
                float s = 0.f;
#pragma unroll
                for (int bj = 0; bj < 2; ++bj) {
                    const f32x4 a0 = acc[ai][bj][m][0], a1 = acc[ai][bj][m][1]; const u32x4 bb = b[m][bj];
                    f32x4 h0, h1; h0[0] = bflo(bb.x) + a0[0]; h0[1] = bfhi(bb.x) + a0[1]; h0[2] = bflo(bb.y) + a0[2]; h0[3] = bfhi(bb.y) + a0[3];
                    h1[0] = bflo(bb.z) + a1[0]; h1[1] = bfhi(bb.z) + a1[1]; h1[2] = bflo(bb.w) + a1[2]; h1[3] = bfhi(bb.w) + a1[3];
                    u32x4 w; w.x = cvt_pk_bf16(h0[0], h0[1]); w.y = cvt_pk_bf16(h0[2], h0[3]); w.z = cvt_pk_bf16(h1[0], h1[1]); w.w = cvt_pk_bf16(h1[2], h1[3]);
                    *(u32x4*)(hb + (size_t)row * DM + u.pn * 256 + bj * 128 + wc * 32 + 8 * fq) = w;
                    s += dot4(h0) + dot4(h1);
                }
                s += __shfl_xor(s, 16); s += __shfl_xor(s, 32);
                if (fq == 0) ssq_add(ssq, row, s);
            }
            asm volatile("" ::: "memory");
        }
    }
};

struct EpiSwiglu {
    static constexpr bool PERM = true, AFTER_DRAIN = false;
    bf16_t* O; const u64* ssq_in;
    __device__ __forceinline__ void operator()(const f32x4 (&acc)[2][2][4][2], const Unit& u, int wr, int wc, int fr, int fq) const {
        u64 sv[2][4];
#pragma unroll
        for (int ai = 0; ai < 2; ++ai)
#pragma unroll
            for (int m = 0; m < 4; ++m) sv[ai][m] = ssq_in[u.pm * 256 + ai * 128 + wr * 64 + m * 16 + fr];
#pragma unroll
        for (int ai = 0; ai < 2; ++ai)
#pragma unroll
            for (int m = 0; m < 4; ++m) {
                const int row = u.pm * 256 + ai * 128 + wr * 64 + m * 16 + fr;
                const float r = rsqrtf(ssq_val(sv[ai][m]) * (1.0f / DM) + RMS_EPS);
                float a[8];
#pragma unroll
                for (int n = 0; n < 2; ++n)
#pragma unroll
                    for (int j = 0; j < 4; ++j) { const float g = acc[ai][0][m][n][j] * r, uu = acc[ai][1][m][n][j] * r; a[4 * n + j] = g * __builtin_amdgcn_rcpf(1.0f + __expf(-g)) * uu; }
                u32x4 w; w.x = cvt_pk_bf16(a[0], a[1]); w.y = cvt_pk_bf16(a[2], a[3]); w.z = cvt_pk_bf16(a[4], a[5]); w.w = cvt_pk_bf16(a[6], a[7]);
                *(u32x4*)(O + (size_t)row * DFF + u.pn * 128 + wc * 32 + 8 * fq) = w;
            }
    }
};

struct EpiFinal {
    static constexpr bool PERM = true, AFTER_DRAIN = true;
    const bf16_t* hb; u64* ssq; unsigned* cnt; const float* gfin; float* out;
    __device__ __forceinline__ void operator()(const f32x4 (&)[2][2][4][2], const Unit&, int, int, int, int) const {}
    __device__ __forceinline__ void fused(f32x4 (&acc)[2][2][4][2], const Unit& u, int wr, int wc, int fr, int fq, LAS unsigned char*, int, int) const {
#pragma unroll
        for (int ai = 0; ai < 2; ++ai) {
            u32x4 b[4][2];
#pragma unroll
            for (int m = 0; m < 4; ++m)
#pragma unroll
                for (int bj = 0; bj < 2; ++bj) b[m][bj] = *(const u32x4*)(hb + (size_t)(u.pm * 256 + ai * 128 + wr * 64 + m * 16 + fr) * DM + u.pn * 256 + bj * 128 + wc * 32 + 8 * fq);
#pragma unroll
            for (int m = 0; m < 4; ++m) {
                const int row = u.pm * 256 + ai * 128 + wr * 64 + m * 16 + fr;
                float s = 0.f;
#pragma unroll
                for (int bj = 0; bj < 2; ++bj) {
                    const f32x4 a0 = acc[ai][bj][m][0], a1 = acc[ai][bj][m][1]; const u32x4 bb = b[m][bj];
                    f32x4 h0, h1; h0[0] = bflo(bb.x) + a0[0]; h0[1] = bfhi(bb.x) + a0[1]; h0[2] = bflo(bb.y) + a0[2]; h0[3] = bfhi(bb.y) + a0[3];
                    h1[0] = bflo(bb.z) + a1[0]; h1[1] = bfhi(bb.z) + a1[1]; h1[2] = bflo(bb.w) + a1[2]; h1[3] = bfhi(bb.w) + a1[3];
                    acc[ai][bj][m][0] = h0; acc[ai][bj][m][1] = h1; s += dot4(h0) + dot4(h1);
                }
                s += __shfl_xor(s, 16); s += __shfl_xor(s, 32);
                if (fq == 0) { const u64 prev = atomicAdd(ssq + row, ssq_fix(s)); asm volatile("" :: "v"(prev)); }
            }
            asm volatile("" ::: "memory");
        }
        asm volatile("s_waitcnt vmcnt(0)" ::: "memory");
        __syncthreads();
        if (threadIdx.x == 0) {
            unsigned* c = cnt + 16 * u.pm;
            __hip_atomic_fetch_add(c, 1u, __ATOMIC_RELEASE, __HIP_MEMORY_SCOPE_AGENT);
            unsigned sp = 0;
            while (__hip_atomic_load(c, __ATOMIC_RELAXED, __HIP_MEMORY_SCOPE_AGENT) < 4u) { __builtin_amdgcn_s_sleep(1); if (++sp > (1u << 22)) break; }
            __builtin_amdgcn_fence(__ATOMIC_ACQUIRE, "agent");
            asm volatile("s_waitcnt vmcnt(0)" ::: "memory");
        }
        __syncthreads();
        u64 sv[2][4];
#pragma unroll
        for (int ai = 0; ai < 2; ++ai)
#pragma unroll
            for (int m = 0; m < 4; ++m) sv[ai][m] = __hip_atomic_load(ssq + (u.pm * 256 + ai * 128 + wr * 64 + m * 16 + fr), __ATOMIC_RELAXED, __HIP_MEMORY_SCOPE_AGENT);
        f32x4 g4[2][2];
#pragma unroll
        for (int bj = 0; bj < 2; ++bj)
#pragma unroll
            for (int n = 0; n < 2; ++n) g4[bj][n] = *(const f32x4*)(gfin + u.pn * 256 + bj * 128 + wc * 32 + 8 * fq + 4 * n);
#pragma unroll
        for (int ai = 0; ai < 2; ++ai)
#pragma unroll
            for (int m = 0; m < 4; ++m) {
                const int row = u.pm * 256 + ai * 128 + wr * 64 + m * 16 + fr;
                const float r = rsqrtf(ssq_val(sv[ai][m]) * (1.0f / DM) + RMS_EPS);
#pragma unroll
                for (int bj = 0; bj < 2; ++bj)
#pragma unroll
                    for (int n = 0; n < 2; ++n) *(f32x4*)(out + (size_t)row * DM + u.pn * 256 + bj * 128 + wc * 32 + 8 * fq + 4 * n) = acc[ai][bj][m][n] * r * g4[bj][n];
            }
    }
};

__host__ __device__ __forceinline__ int perm32(int rho) { const int n = rho >> 4, i = rho & 15; return 8 * (i >> 2) + 4 * n + (i & 3); }
template <class Epi>
__device__ __forceinline__ void gemm_naive(const bf16_t* A, int lda, const bf16_t* Bt, int ldb, int nM, int nN, int K, const Epi& E) {
    constexpr bool PERM = Epi::PERM;
    const int tid = threadIdx.x, wid = tid >> 6, lane = tid & 63, wr = wid >> 2, wc = wid & 3, fr = lane & 15, fq = lane >> 4;
    for (int unit = blockIdx.x; unit < nM * nN; unit += gridDim.x) {
        Unit u; u.pm = unit / nN; u.pn = unit % nN;
        f32x4 acc[2][2][4][2];
#pragma unroll
        for (int a = 0; a < 2; ++a)
#pragma unroll
            for (int b = 0; b < 2; ++b)
#pragma unroll
                for (int m = 0; m < 4; ++m)
#pragma unroll
                    for (int n = 0; n < 2; ++n) acc[a][b][m][n] = (f32x4){0.f, 0.f, 0.f, 0.f};
        const bf16_t* Ab = A + (size_t)(u.pm * 256 + wr * 64 + fr) * lda + 8 * fq;
        const bf16_t* Bb = Bt + (size_t)(u.pn * 256 + wc * 32) * ldb + 8 * fq;
        const int br0 = PERM ? perm32(fr) : fr, br1 = PERM ? perm32(16 + fr) : 16 + fr;
        for (int k0 = 0; k0 < K; k0 += 32) {
            bf16x8 af[2][4], bq[2][2];
#pragma unroll
            for (int ai = 0; ai < 2; ++ai)
#pragma unroll
                for (int m = 0; m < 4; ++m) af[ai][m] = *(const bf16x8*)(Ab + (size_t)(ai * 128 + m * 16) * lda + k0);
#pragma unroll
            for (int bj = 0; bj < 2; ++bj) { bq[bj][0] = *(const bf16x8*)(Bb + (size_t)(bj * 128 + br0) * ldb + k0); bq[bj][1] = *(const bf16x8*)(Bb + (size_t)(bj * 128 + br1) * ldb + k0); }
#pragma unroll
            for (int ai = 0; ai < 2; ++ai)
#pragma unroll
                for (int bj = 0; bj < 2; ++bj)
#pragma unroll
                    for (int m = 0; m < 4; ++m)
#pragma unroll
                        for (int n = 0; n < 2; ++n) acc[ai][bj][m][n] = __builtin_amdgcn_mfma_f32_16x16x32_bf16(bq[bj][n], af[ai][m], acc[ai][bj][m][n], 0, 0, 0);
        }
        E(acc, u, wr, wc, fr, fq);
    }
}

#define PG8_LAS __attribute__((address_space(3)))
constexpr int BM = 256, BK = 64, HALF = 128, HTB = HALF * BK * 2  , STAGE_BYTES = 8 * HTB, NXCD = 8, WGM = 8;
__host__ __device__ __forceinline__ int lds_byte(int r, int c) { const int st = (r >> 4) * 2 + (c >> 5), rr = r & 15, cc = c & 31, ob = rr * 64 + cc * 2; return st * 1024 + (ob ^ (((ob >> 9) & 1) << 5)); }
__host__ __device__ __forceinline__ void stage_rc(int b, int& R, int& C) { const int st = b / 1024, sb = b % 1024, swz = sb ^ (((sb >> 9) & 1) << 5); R = (st >> 1) * 16 + swz / 64; C = (st & 1) * 32 + (swz % 64) / 2; }
struct Gemm { const bf16_t* A; const bf16_t* Bt; int M, N, K, lda, ldb; };
struct StaticOrder {
    int nM, nN, nwg, G, c;
    __host__ __device__ void init(int M, int N, int G_, int c_) { nM = M / BM; nN = N / BM; nwg = nM * nN; G = G_; c = c_; }
    __host__ __device__ bool next(int i, Unit& u) const {
        const long L = (long)i * G + c; if (L >= nwg) return false;
        int wgid = (int)L; { const int q = nwg / NXCD, r = nwg % NXCD, xcd = wgid % NXCD, off = wgid / NXCD; wgid = (xcd < r ? xcd * (q + 1) : r * (q + 1) + (xcd - r) * q) + off; }
        const int nig = WGM * nN, gid = wgid / nig, fm = gid * WGM, gsz = (nM - fm) < WGM ? (nM - fm) : WGM;
        u.pm = fm + ((wgid % nig) % gsz); u.pn = (wgid % nig) / gsz; return true;
    }
    __device__ __forceinline__ void a_ready(const Unit&) const {}
    __device__ __forceinline__ void done(const Unit&) const {}
};
template <class Epi, class Sched, bool ALIGN_EPI = false, bool SP2 = false>
__device__ __forceinline__ void gemm_phase(PG8_LAS unsigned char* lds, const Gemm g, const Sched& S, const Epi& E) {
    int tid_ = threadIdx.x; asm volatile("" : "+v"(tid_));
    const int tid = tid_, wid = __builtin_amdgcn_readfirstlane(tid >> 6), lane = tid & 63, wr = wid >> 2, wc = wid & 3, fr = lane & 15, fq = lane >> 4;
    const int K = g.K, nt = K / BK;
    unsigned voffA[2], voffB[2];
#pragma unroll
    for (int i = 0; i < 2; ++i) { int R, C; stage_rc(tid * 16 + i * 8192, R, C); const int Rb = Epi::PERM ? ((R & ~31) + perm32(R & 31)) : R;
        voffA[i] = (unsigned)(R * g.lda + C) * 2u; voffB[i] = (unsigned)(Rb * g.ldb + C) * 2u; }
    const size_t kstep = (size_t)(BK * 2);
    const size_t hstepA = (size_t)HALF * g.lda * 2, hstepB = (size_t)HALF * g.ldb * 2;
    const size_t tstepA = 2 * hstepA, tstepB = 2 * hstepB;
    const unsigned ldsw = (unsigned)wid * 1024u;
    const int aoff = lds_byte(wr * 64 + fr, fq * 8), boff = lds_byte(wc * 32 + fr, fq * 8);
#define PG8_SA(b, h) (((b) * 2 + (h)) * HTB)
#define PG8_SB(b, h) ((4 + (b) * 2 + (h)) * HTB)
#define PG8_STAGE(bufoff, gbase, voff) do { _Pragma("unroll") for (int _i = 0; _i < 2; ++_i) \
        __builtin_amdgcn_global_load_lds((const unsigned*)((const char*)(gbase) + (voff)[_i]), (PG8_LAS unsigned*)(lds + (bufoff) + ldsw + _i * 8192), 16, 0, 0); } while (0)
#define PG8_LDA(dst, b, h) do { _Pragma("unroll") for (int m = 0; m < 4; ++m) _Pragma("unroll") for (int k = 0; k < 2; ++k) dst[m][k] = *(const PG8_LAS bf16x8*)(lds + PG8_SA(b, h) + aoff + m * 2048 + k * 1024); } while (0)
#define PG8_LDB(dst, b, h) do { _Pragma("unroll") for (int n = 0; n < 2; ++n) _Pragma("unroll") for (int k = 0; k < 2; ++k) dst[n][k] = *(const PG8_LAS bf16x8*)(lds + PG8_SB(b, h) + boff + n * 2048 + k * 1024); } while (0)
#define PG8_MMA(ai, bj, At, Bt) do { __builtin_amdgcn_s_setprio(1); _Pragma("unroll") for (int m = 0; m < 4; ++m) _Pragma("unroll") for (int n = 0; n < 2; ++n) _Pragma("unroll") for (int k = 0; k < 2; ++k) \
        acc[ai][bj][m][n] = __builtin_amdgcn_mfma_f32_16x16x32_bf16(Bt[n][k], At[m][k], acc[ai][bj][m][n], 0, 0, 0); __builtin_amdgcn_s_setprio(0); } while (0)
#define PG8_WAIT_V(n) asm volatile("s_waitcnt vmcnt(" #n ")" ::: "memory")
#define PG8_WAIT_L(n) asm volatile("s_waitcnt lgkmcnt(" #n ")" ::: "memory")
#define PG8_BAR __builtin_amdgcn_s_barrier()
#define PG8_SCHED __builtin_amdgcn_sched_barrier(0)
    Unit cur, nxt; int ui = 0;
    if (!S.next(0, cur)) return;
    f32x4 acc[2][2][4][2];
#pragma unroll
    for (int a = 0; a < 2; ++a)
#pragma unroll
        for (int b = 0; b < 2; ++b)
#pragma unroll
            for (int m = 0; m < 4; ++m)
#pragma unroll
                for (int n = 0; n < 2; ++n) acc[a][b][m][n] = (f32x4){0.f, 0.f, 0.f, 0.f};
    bf16x8 At[4][2], B0[2][2], B1[2][2];
    const char* cA = (const char*)g.A + (size_t)cur.pm * tstepA; const char* cB = (const char*)g.Bt + (size_t)cur.pn * tstepB;
    S.a_ready(cur);
    if constexpr (SP2) {
        PG8_STAGE(PG8_SB(0, 0), cB, voffB); PG8_STAGE(PG8_SB(0, 1), cB + hstepB, voffB); PG8_STAGE(PG8_SA(0, 0), cA, voffA); PG8_STAGE(PG8_SA(0, 1), cA + hstepA, voffA);
        if (wr == 1) PG8_BAR;
        PG8_WAIT_V(2); PG8_BAR;
        PG8_STAGE(PG8_SB(1, 0), cB + kstep, voffB); PG8_STAGE(PG8_SA(1, 0), cA + kstep, voffA); PG8_STAGE(PG8_SB(1, 1), cB + hstepB + kstep, voffB);
        PG8_WAIT_V(6); PG8_BAR;
    } else {
        PG8_STAGE(PG8_SB(0, 0), cB, voffB); PG8_STAGE(PG8_SA(0, 0), cA, voffA); PG8_STAGE(PG8_SB(0, 1), cB + hstepB, voffB); PG8_STAGE(PG8_SA(0, 1), cA + hstepA, voffA);
        if (wr == 1) PG8_BAR;
        PG8_WAIT_V(4); PG8_BAR;
        PG8_STAGE(PG8_SB(1, 0), cB + kstep, voffB); PG8_STAGE(PG8_SA(1, 0), cA + kstep, voffA); PG8_STAGE(PG8_SB(1, 1), cB + hstepB + kstep, voffB);
        PG8_WAIT_V(6); PG8_BAR;
    }
    for (;;) {
        const bool has_next = S.next(ui + 1, nxt);
        const char* nA = has_next ? (const char*)g.A + (size_t)nxt.pm * tstepA : cA; const char* nB = has_next ? (const char*)g.Bt + (size_t)nxt.pn * tstepB : cB;
#pragma clang loop unroll(disable)
        for (int t = 0; t < nt; t += 2) {
            const bool last = (t == nt - 2);
            const char* a1 = cA + (size_t)(t + 1) * kstep;
            const char* a2 = last ? nA : cA + (size_t)(t + 2) * kstep; const char* b2 = last ? nB : cB + (size_t)(t + 2) * kstep;
            const char* a3 = a2 + kstep; const char* b3 = b2 + kstep;
            if (last && has_next) S.a_ready(nxt);
            if constexpr (SP2) {
            PG8_LDB(B0, 0, 0); PG8_LDB(B1, 0, 1); PG8_SCHED; PG8_LDA(At, 0, 0); PG8_STAGE(PG8_SA(1, 1), a1 + hstepA, voffA);
            PG8_WAIT_V(8); PG8_WAIT_L(0); PG8_BAR; PG8_MMA(0, 0, At, B0); PG8_MMA(0, 1, At, B1); PG8_BAR; PG8_SCHED;
            PG8_LDA(At, 0, 1); PG8_STAGE(PG8_SB(0, 0), b2, voffB); PG8_STAGE(PG8_SB(0, 1), b2 + hstepB, voffB); PG8_STAGE(PG8_SA(0, 0), a2, voffA);
            PG8_WAIT_V(8); PG8_WAIT_L(0); PG8_BAR; PG8_MMA(1, 0, At, B0); PG8_MMA(1, 1, At, B1); PG8_BAR; PG8_SCHED;
            PG8_LDB(B0, 1, 0); PG8_LDB(B1, 1, 1); PG8_SCHED; PG8_LDA(At, 1, 0); PG8_STAGE(PG8_SA(0, 1), a2 + hstepA, voffA);
            PG8_WAIT_V(8); PG8_WAIT_L(0); PG8_BAR; PG8_MMA(0, 0, At, B0); PG8_MMA(0, 1, At, B1); PG8_BAR; PG8_SCHED;
            PG8_LDA(At, 1, 1); PG8_STAGE(PG8_SB(1, 0), b3, voffB); PG8_STAGE(PG8_SB(1, 1), b3 + hstepB, voffB); PG8_STAGE(PG8_SA(1, 0), a3, voffA);
            PG8_WAIT_V(8); PG8_WAIT_L(0); PG8_BAR; PG8_MMA(1, 0, At, B0); PG8_MMA(1, 1, At, B1); PG8_BAR; PG8_SCHED;
            } else {
            PG8_LDB(B0, 0, 0); PG8_SCHED; PG8_LDA(At, 0, 0); PG8_STAGE(PG8_SA(1, 1), a1 + hstepA, voffA);
            PG8_WAIT_L(8); PG8_BAR; PG8_WAIT_L(0); PG8_MMA(0, 0, At, B0); PG8_BAR; PG8_SCHED;
            PG8_LDB(B1, 0, 1); PG8_STAGE(PG8_SB(0, 0), b2, voffB);
            PG8_BAR; PG8_WAIT_L(0); PG8_MMA(0, 1, At, B1); PG8_BAR;
            PG8_LDA(At, 0, 1); PG8_STAGE(PG8_SA(0, 0), a2, voffA);
            PG8_BAR; PG8_WAIT_L(0); PG8_MMA(1, 0, At, B0); PG8_BAR; PG8_SCHED;
            PG8_STAGE(PG8_SB(0, 1), b2 + hstepB, voffB);
            PG8_WAIT_V(6); PG8_BAR; PG8_MMA(1, 1, At, B1); PG8_BAR;
            PG8_LDB(B0, 1, 0); PG8_SCHED; PG8_LDA(At, 1, 0); PG8_STAGE(PG8_SA(0, 1), a2 + hstepA, voffA);
            PG8_WAIT_L(8); PG8_BAR; PG8_WAIT_L(0); PG8_MMA(0, 0, At, B0); PG8_BAR; PG8_SCHED;
            PG8_LDB(B1, 1, 1); PG8_STAGE(PG8_SB(1, 0), b3, voffB);
            PG8_BAR; PG8_WAIT_L(0); PG8_MMA(0, 1, At, B1); PG8_BAR;
            PG8_LDA(At, 1, 1); PG8_STAGE(PG8_SA(1, 0), a3, voffA);
            PG8_BAR; PG8_WAIT_L(0); PG8_MMA(1, 0, At, B0); PG8_BAR; PG8_SCHED;
            PG8_STAGE(PG8_SB(1, 1), b3 + hstepB, voffB);
            PG8_WAIT_V(6); PG8_BAR; PG8_MMA(1, 1, At, B1); PG8_BAR;
            }
        }
        if constexpr (ALIGN_EPI) { if (wr == 0) PG8_BAR; }
        if constexpr (!Epi::AFTER_DRAIN) { E(acc, cur, wr, wc, fr, fq); S.done(cur); }
        if (!has_next) break;
#pragma unroll
        for (int a = 0; a < 2; ++a)
#pragma unroll
            for (int b = 0; b < 2; ++b)
#pragma unroll
                for (int m = 0; m < 4; ++m)
#pragma unroll
                    for (int n = 0; n < 2; ++n) acc[a][b][m][n] = (f32x4){0.f, 0.f, 0.f, 0.f};
        cur = nxt; cA = nA; cB = nB; ++ui;
        if constexpr (ALIGN_EPI) { if (wr == 1) PG8_BAR; }
    }
    PG8_WAIT_V(0);
    if constexpr (!ALIGN_EPI) { if (wr == 0) PG8_BAR; }
    PG8_BAR;
    if constexpr (Epi::AFTER_DRAIN) { E.fused(acc, cur, wr, wc, fr, fq, lds, wid, lane); S.done(cur); }
#undef PG8_SA
#undef PG8_SB
#undef PG8_STAGE
#undef PG8_LDA
#undef PG8_LDB
#undef PG8_MMA
#undef PG8_WAIT_V
#undef PG8_WAIT_L
#undef PG8_BAR
#undef PG8_SCHED
}
template <class Epi>
__device__ __forceinline__ void gemm_fast(LAS unsigned char* lds, const bf16_t* A, int lda, const bf16_t* Bt, int ldb, int M, int N, int K, const Epi& E) {
    Gemm g{A, Bt, M, N, K, lda, ldb}; StaticOrder S; S.init(M, N, (int)gridDim.x, (int)blockIdx.x);
    gemm_phase<Epi, StaticOrder, !Epi::AFTER_DRAIN, true>(lds, g, S, E);
}

__device__ __forceinline__ void p0_item(const float* W, int K, int N, const float* g, bf16_t* WT, int ldt, int mode, LAS float* scr, int item, int lane) {
    const int nblk = N / 32, kb = item / nblk, nb = item % nblk, k0 = 64 * kb, n0 = 32 * nb;
    { const int kr = lane >> 3, ch = lane & 7; f32x4 v[8];
#pragma unroll
      for (int i = 0; i < 8; ++i) v[i] = __builtin_nontemporal_load((const f32x4*)(W + (size_t)(k0 + 8 * i + kr) * N + n0 + 4 * ch));
#pragma unroll
      for (int i = 0; i < 8; ++i) { const int kk = 8 * i + kr; const float gs = g ? g[k0 + kk] : 1.0f; LAS float* d = scr + kk * 33 + 4 * ch; d[0] = v[i][0] * gs; d[1] = v[i][1] * gs; d[2] = v[i][2] * gs; d[3] = v[i][3] * gs; } }
    asm volatile("s_waitcnt lgkmcnt(0)" ::: "memory");
    const int c = lane & 7;
#pragma unroll
    for (int j = 0; j < 4; ++j) {
        const int n = (lane >> 3) + 8 * j; const LAS float* s = scr + (8 * c) * 33 + n;
        u32x4 o; o.x = cvt_pk_bf16(s[0 * 33], s[1 * 33]); o.y = cvt_pk_bf16(s[2 * 33], s[3 * 33]); o.z = cvt_pk_bf16(s[4 * 33], s[5 * 33]); o.w = cvt_pk_bf16(s[6 * 33], s[7 * 33]);
        const int nn = n0 + n; const int row = (mode == 0) ? nn : ((nn >> 7) * 256 + (mode == 2 ? 128 : 0) + (nn & 127));
        *(u32x4*)(WT + (size_t)row * ldt + k0 + 8 * c) = o;
    }
    asm volatile("s_waitcnt lgkmcnt(0)" ::: "memory");
}


typedef float f32x16 __attribute__((ext_vector_type(16)));
constexpr int AT_VSTR = 72;
constexpr int AT_KBUF = 64 * 104 * 2, AT_VBUF = 64 * AT_VSTR * 2;
constexpr int AT_OFF_K = 0, AT_OFF_V = 2 * AT_KBUF, AT_OFF_BIAS = 2 * AT_KBUF + 2 * AT_VBUF, AT_OFF_FLAG = AT_OFF_BIAS + 2304, AT_OFF_H1 = AT_OFF_FLAG + 256;
__device__ __forceinline__ int crow16(int r, int hi) { return (r & 3) + 8 * (r >> 2) + 4 * hi; }
__device__ __forceinline__ int vperm(int key) { const int k16 = key & 15; return (key & ~15) + 8 * ((k16 >> 2) & 1) + 4 * (k16 >> 3) + (k16 & 3); }
__device__ __forceinline__ bf16x8 pack8(float a0, float a1, float a2, float a3, float a4, float a5, float a6, float a7) {
    u32x4 w; w.x = cvt_pk_bf16(a0, a1); w.y = cvt_pk_bf16(a2, a3); w.z = cvt_pk_bf16(a4, a5); w.w = cvt_pk_bf16(a6, a7); return __builtin_bit_cast(bf16x8, w);
}

__device__ __forceinline__ float max3f(float a, float b, float c) { return __builtin_fmaxf(__builtin_fmaxf(a, b), c); }
template <int MODE, bool TWOH = false>
__device__ __forceinline__ void attn_unit(LAS unsigned char* lds, int q0, const bf16_t* Qp, int ldq, const bf16_t* Kp, int ldk, const bf16_t* Krp, int ldkr, const bf16_t* Vp, int ldv, bf16_t* Op, const float* bias_g) {
    constexpr int DQK = (MODE == 0) ? 96 : 64, NDD = DQK / 16, KSTR = DQK + 8;
    int tid_ = threadIdx.x; asm volatile("" : "+v"(tid_));
    const int tid = tid_, lane = tid & 63, wid = __builtin_amdgcn_readfirstlane(tid >> 6), l31 = lane & 31, hi = lane >> 5;
    const int hsel = TWOH ? (wid >> 2) : 0;
    const int t0w = q0 + 32 * (TWOH ? (wid & 3) : wid), trow = t0w + l31, nq = t0w >> 6;
    LAS unsigned char* ldsh = lds + hsel * AT_OFF_H1;
    Qp += hsel * 64; Op += hsel * 64;
    LAS float* biasl = (LAS float*)(ldsh + AT_OFF_BIAS);
    LAS int* flags = (LAS int*)(lds + AT_OFF_FLAG);
    float bz0 = 0.f, bz1 = 0.f, bz2 = 0.f, bz3 = 0.f;
    if (MODE == 2) { bz0 = bias_g[tid]; if (tid == 0) bz1 = bias_g[512]; if (TWOH) { bz2 = bias_g[513 + tid]; if (tid == 0) bz3 = bias_g[513 + 512]; } }
    bf16x8 qf[NDD];
#pragma unroll
    for (int dd = 0; dd < NDD; ++dd) qf[dd] = *(const bf16x8*)(Qp + (size_t)trow * ldq + 16 * dd + 8 * hi);
    f32x16 o0, o1;
#pragma unroll
    for (int r = 0; r < 16; ++r) { o0[r] = 0.f; o1[r] = 0.f; }
    float mref = 0.f, lrow = 0.f, carry = 0.f; bool first = true;
    f32x16 negm;
#pragma unroll
    for (int r = 0; r < 16; ++r) negm[r] = 0.f;
    const int kt_hi = (q0 + (TWOH ? 127 : 255)) >> 6;
    int kt_lo = 0; if (MODE == 2) { kt_lo = (q0 >> 6) - 8; if (kt_lo < 0) kt_lo = 0; }
    const int nt = kt_hi - kt_lo + 1;
    const int skey = tid >> 3, sch = tid & 7, rkey = tid >> 2, rch = tid & 3;
    const int vcol = vperm(lane);
    u32x4 kregA, krregA, vregA, kreg2A, vreg2A, kregB, krregB, vregB, kreg2B, vreg2B;
#define AT_KT(i) ((MODE == 1) ? (kt_hi - (i)) : (kt_lo + (i)))
#define AT_PART(kt) ((MODE == 0) ? ((kt) <= nq) : (MODE == 1) ? (64 * (kt) <= t0w + 30) : (((kt) <= nq) && ((kt) >= nq - 8)))
#define AT_LOAD(kt, S) do { const size_t kb_ = (size_t)(kt) * 64; \
        kreg##S = *(const u32x4*)(Kp + (kb_ + skey) * ldk + sch * 8); \
        if (MODE == 0) { krreg##S = *(const u32x4*)(Krp + (kb_ + (rkey & 63)) * ldkr + rch * 8); }     \
        vreg##S = *(const u32x4*)(Vp + (kb_ + lane) * ldv + wid * 8); \
        if (TWOH) { kreg2##S = *(const u32x4*)(Kp + (kb_ + skey) * ldk + 64 + sch * 8); vreg2##S = *(const u32x4*)(Vp + (kb_ + lane) * ldv + 64 + wid * 8); } } while (0)
#define AT_VT8(dst, v) do { (dst)[0 * AT_VSTR] = (bf16_t)((v).x & 0xffffu); (dst)[1 * AT_VSTR] = (bf16_t)((v).x >> 16); (dst)[2 * AT_VSTR] = (bf16_t)((v).y & 0xffffu); (dst)[3 * AT_VSTR] = (bf16_t)((v).y >> 16); \
        (dst)[4 * AT_VSTR] = (bf16_t)((v).z & 0xffffu); (dst)[5 * AT_VSTR] = (bf16_t)((v).z >> 16); (dst)[6 * AT_VSTR] = (bf16_t)((v).w & 0xffffu); (dst)[7 * AT_VSTR] = (bf16_t)((v).w >> 16); } while (0)
#define AT_STORE(bufi, S) do { LAS bf16_t* Ks_ = (LAS bf16_t*)(lds + AT_OFF_K + (bufi) * AT_KBUF); LAS bf16_t* Vt_ = (LAS bf16_t*)(lds + AT_OFF_V + (bufi) * AT_VBUF); \
        *(LAS u32x4*)(Ks_ + skey * KSTR + sch * 8) = kreg##S; \
        if (MODE == 0) { if (tid < 256) *(LAS u32x4*)(Ks_ + rkey * KSTR + 64 + rch * 8) = krreg##S; } \
        LAS bf16_t* vd_ = Vt_ + (wid * 8) * AT_VSTR + vcol; AT_VT8(vd_, vreg##S); \
        if (TWOH) { LAS bf16_t* Ks2_ = (LAS bf16_t*)(lds + AT_OFF_H1 + AT_OFF_K + (bufi) * AT_KBUF); LAS bf16_t* ve_ = (LAS bf16_t*)(lds + AT_OFF_H1 + AT_OFF_V + (bufi) * AT_VBUF) + (wid * 8) * AT_VSTR + vcol; \
            *(LAS u32x4*)(Ks2_ + skey * KSTR + sch * 8) = kreg2##S; AT_VT8(ve_, vreg2##S); } } while (0)
#define AT_BAR() do { asm volatile("s_waitcnt lgkmcnt(0)" ::: "memory"); __builtin_amdgcn_s_barrier(); asm volatile("" ::: "memory"); } while (0)
    auto compute = [&](int bufo, int kt) __attribute__((always_inline)) {
            const LAS bf16_t* Ks = (const LAS bf16_t*)(ldsh + AT_OFF_K + bufo * AT_KBUF); const LAS bf16_t* Vt = (const LAS bf16_t*)(ldsh + AT_OFF_V + bufo * AT_VBUF);
            f32x16 p0, p1;
            if (MODE == 1) {
#pragma unroll
                for (int r = 0; r < 16; ++r) { p0[r] = 0.f; p1[r] = 0.f; }
            } else { p0 = negm; p1 = negm; }
            bf16x8 ka[NDD], kb[NDD], va[4], vb[4];
            constexpr int NH = (NDD > 4) ? 4 : NDD;
#pragma unroll
            for (int dd = 0; dd < NH; ++dd) { ka[dd] = *(const LAS bf16x8*)(Ks + l31 * KSTR + 16 * dd + 8 * hi); kb[dd] = *(const LAS bf16x8*)(Ks + (32 + l31) * KSTR + 16 * dd + 8 * hi); }
            __builtin_amdgcn_sched_barrier(0);
#pragma unroll
            for (int dd = 0; dd < NH; ++dd) { p0 = __builtin_amdgcn_mfma_f32_32x32x16_bf16(ka[dd], qf[dd], p0, 0, 0, 0); p1 = __builtin_amdgcn_mfma_f32_32x32x16_bf16(kb[dd], qf[dd], p1, 0, 0, 0);
                if (dd == 0) {
#pragma unroll
                    for (int d2 = NH; d2 < NDD; ++d2) { ka[d2] = *(const LAS bf16x8*)(Ks + l31 * KSTR + 16 * d2 + 8 * hi); kb[d2] = *(const LAS bf16x8*)(Ks + (32 + l31) * KSTR + 16 * d2 + 8 * hi); }
                } }
#pragma unroll
            for (int dd = NH; dd < NDD; ++dd) { p0 = __builtin_amdgcn_mfma_f32_32x32x16_bf16(ka[dd], qf[dd], p0, 0, 0, 0); p1 = __builtin_amdgcn_mfma_f32_32x32x16_bf16(kb[dd], qf[dd], p1, 0, 0, 0); }
            __builtin_amdgcn_sched_barrier(0);
            if (MODE != 1) {
#pragma unroll
                for (int jj = 0; jj < 4; ++jj) { va[jj] = *(const LAS bf16x8*)(Vt + l31 * AT_VSTR + 8 * hi + 16 * jj); vb[jj] = *(const LAS bf16x8*)(Vt + (32 + l31) * AT_VSTR + 8 * hi + 16 * jj); }
            }
            __builtin_amdgcn_sched_barrier(0);
            if (MODE != 1) {
                if (MODE == 2) {
                    if (nq - kt >= 5) { const float cb = biasl[512];
#pragma unroll
                        for (int r = 0; r < 16; ++r) { p0[r] += cb; p1[r] += cb; }
                    } else {
                        const int relb = trow - 64 * kt - 4 * hi;
#pragma unroll
                        for (int r = 0; r < 16; ++r) {
                            int rel0 = relb - ((r & 3) + 8 * (r >> 2)); int rel1 = rel0 - 32;
                            rel0 = rel0 > 256 ? 256 : rel0; rel1 = rel1 > 256 ? 256 : rel1;
                            p0[r] += biasl[256 + rel0]; p1[r] += biasl[256 + rel1];
                        }
                    }
                }
                float mx = max3f(p0[0], p1[0], p0[1]);
#pragma unroll
                for (int r = 1; r < 15; r += 2) { mx = max3f(mx, p1[r], p0[r + 1]); mx = max3f(mx, p1[r + 1], p0[(r + 2 > 15) ? 15 : (r + 2)]); }
                mx = fmaxf(mx, p1[15]);
                mx = fmaxf(mx, __shfl_xor(mx, 32));
                if (first || __any(mx > 8.0f)) {
                    const float dl = first ? mx : fmaxf(mx, 0.f);
                    mref += dl;
#pragma unroll
                    for (int r = 0; r < 16; ++r) { p0[r] -= dl; p1[r] -= dl; }
                    if (!first) { const float f = __builtin_amdgcn_exp2f(-dl); lrow *= f;
#pragma unroll
                        for (int r = 0; r < 16; ++r) { o0[r] *= f; o1[r] *= f; } }
#pragma unroll
                    for (int r = 0; r < 16; ++r) negm[r] = -mref;
                    first = false;
                }
                float rs = 0.f;
#pragma unroll
                for (int r = 0; r < 16; ++r) { p0[r] = __builtin_amdgcn_exp2f(p0[r]); p1[r] = __builtin_amdgcn_exp2f(p1[r]); rs += p0[r] + p1[r]; }
                lrow += rs;
            } else {
                const bool need_mask = (64 * kt + 63 >= t0w);
                const int kvb = 64 * kt + 4 * hi;
                float gs[8], lkq0[16], lkq1[16];
#pragma unroll
                for (int g = 0; g < 8; ++g) {
                    float s4 = 0.f;
#pragma unroll
                    for (int c = 0; c < 4; ++c) {
                        const int r = 4 * (g & 3) + c;
                        const float z2 = ((g < 4) ? p0[r] : p1[r]) * (0.125f * LOG2E);
                        const float sp2 = fmaxf(z2, 0.f) + __builtin_amdgcn_logf(1.0f + __builtin_amdgcn_exp2f(-fabsf(z2)));
                        const bool valid = !need_mask || (kvb + 8 * g + c < trow);
                        const float lk = valid ? -sp2 : 0.f;
                        const float ls = valid ? (z2 - sp2) : -1e30f;
                        if (g < 4) { p0[r] = ls; } else { p1[r] = ls; }
                        s4 += lk;
                        if (g < 4) { lkq0[r] = lk; } else { lkq1[r] = lk; }
                    }
                    gs[g] = s4;
                }
                float run = 0.f, after[8];
#pragma unroll
                for (int g = 7; g >= 0; --g) { const float pg = __shfl_xor(gs[g], 32); after[g] = run + (hi == 0 ? pg : 0.f); run += gs[g] + pg; }
#pragma unroll
                for (int g = 0; g < 8; ++g) {
                    float suf = carry + after[g];
#pragma unroll
                    for (int c = 3; c >= 0; --c) {
                        const int r = 4 * (g & 3) + c;
                        if (g < 4) { p0[r] = __builtin_amdgcn_exp2f(p0[r] + suf); suf += lkq0[r]; } else { p1[r] = __builtin_amdgcn_exp2f(p1[r] + suf); suf += lkq1[r]; }
                    }
                }
                carry += run;
            }
            if (MODE == 1) {
#pragma unroll
                for (int jj = 0; jj < 4; ++jj) { va[jj] = *(const LAS bf16x8*)(Vt + l31 * AT_VSTR + 8 * hi + 16 * jj); vb[jj] = *(const LAS bf16x8*)(Vt + (32 + l31) * AT_VSTR + 8 * hi + 16 * jj); }
            }
            const bf16x8 pb0 = pack8(p0[0], p0[1], p0[2], p0[3], p0[4], p0[5], p0[6], p0[7]), pb1 = pack8(p0[8], p0[9], p0[10], p0[11], p0[12], p0[13], p0[14], p0[15]);
            const bf16x8 pb2 = pack8(p1[0], p1[1], p1[2], p1[3], p1[4], p1[5], p1[6], p1[7]), pb3 = pack8(p1[8], p1[9], p1[10], p1[11], p1[12], p1[13], p1[14], p1[15]);
            o0 = __builtin_amdgcn_mfma_f32_32x32x16_bf16(va[0], pb0, o0, 0, 0, 0); o1 = __builtin_amdgcn_mfma_f32_32x32x16_bf16(vb[0], pb0, o1, 0, 0, 0);
            o0 = __builtin_amdgcn_mfma_f32_32x32x16_bf16(va[1], pb1, o0, 0, 0, 0); o1 = __builtin_amdgcn_mfma_f32_32x32x16_bf16(vb[1], pb1, o1, 0, 0, 0);
            o0 = __builtin_amdgcn_mfma_f32_32x32x16_bf16(va[2], pb2, o0, 0, 0, 0); o1 = __builtin_amdgcn_mfma_f32_32x32x16_bf16(vb[2], pb2, o1, 0, 0, 0);
            o0 = __builtin_amdgcn_mfma_f32_32x32x16_bf16(va[3], pb3, o0, 0, 0, 0); o1 = __builtin_amdgcn_mfma_f32_32x32x16_bf16(vb[3], pb3, o1, 0, 0, 0);
            };
    bool brk = false;
#define AT_ITER(i, SL, SS) do { \
        const int kt_ = AT_KT(i); \
        AT_LOAD(AT_KT(((i) + 2 < nt) ? (i) + 2 : nt - 1), SL);        \
        if (AT_PART(kt_)) compute((i) & 1, kt_); \
        if ((i) + 1 < nt) AT_STORE(((i) + 1) & 1, SS); \
        if (MODE == 1) { const int done_ = __all(carry < -128.0f) ? 1 : 0; if (lane == 0) flags[((i) & 1) * 8 + wid] = done_; } \
        AT_BAR(); \
        if (MODE == 1) { int alld_ = 1; \
            _Pragma("unroll") for (int w8 = 0; w8 < 8; ++w8) alld_ &= flags[((i) & 1) * 8 + w8]; \
            if (alld_) brk = true; } } while (0)
    AT_LOAD(AT_KT(0), A);
    AT_LOAD(AT_KT(nt > 1 ? 1 : 0), B);
    if (MODE == 2) { ((LAS float*)(lds + AT_OFF_BIAS))[tid] = bz0 * LOG2E; if (tid == 0) ((LAS float*)(lds + AT_OFF_BIAS))[512] = bz1 * LOG2E;
        if (TWOH) { ((LAS float*)(lds + AT_OFF_H1 + AT_OFF_BIAS))[tid] = bz2 * LOG2E; if (tid == 0) ((LAS float*)(lds + AT_OFF_H1 + AT_OFF_BIAS))[512] = bz3 * LOG2E; } }
    AT_STORE(0, A);
    AT_BAR();
    for (int i = 0; i < nt; i += 2) {
        AT_ITER(i, A, B);
        if (brk || i + 1 >= nt) break;
        AT_ITER(i + 1, B, A);
        if (brk) break;
    }
    if (MODE == 1) { if (brk) AT_BAR(); }
#undef AT_ITER
#undef AT_PART
#undef AT_VT8
#undef AT_BAR
    float inv = 1.0f;
    if (MODE != 1) { const float lt = lrow + __shfl_xor(lrow, 32); inv = 1.0f / lt; }
    bf16_t* orow = Op + (size_t)trow * DM;
#pragma unroll
    for (int gp = 0; gp < 2; ++gp) {
        const int g0 = 2 * gp, g1 = 2 * gp + 1;
        u32x2 wa0, wa1, wb0, wb1;
        wa0.x = cvt_pk_bf16(o0[4 * g0] * inv, o0[4 * g0 + 1] * inv); wa0.y = cvt_pk_bf16(o0[4 * g0 + 2] * inv, o0[4 * g0 + 3] * inv);
        wa1.x = cvt_pk_bf16(o0[4 * g1] * inv, o0[4 * g1 + 1] * inv); wa1.y = cvt_pk_bf16(o0[4 * g1 + 2] * inv, o0[4 * g1 + 3] * inv);
        wb0.x = cvt_pk_bf16(o1[4 * g0] * inv, o1[4 * g0 + 1] * inv); wb0.y = cvt_pk_bf16(o1[4 * g0 + 2] * inv, o1[4 * g0 + 3] * inv);
        wb1.x = cvt_pk_bf16(o1[4 * g1] * inv, o1[4 * g1 + 1] * inv); wb1.y = cvt_pk_bf16(o1[4 * g1 + 2] * inv, o1[4 * g1 + 3] * inv);
        const u32x2 sa = hi ? wa0 : wa1, sb = hi ? wb0 : wb1;
        u32x2 ra, rb; ra.x = __shfl_xor(sa.x, 32); ra.y = __shfl_xor(sa.y, 32); rb.x = __shfl_xor(sb.x, 32); rb.y = __shfl_xor(sb.y, 32);
        u32x4 qa, qb;
        if (hi) { qa = (u32x4){ra.x, ra.y, wa1.x, wa1.y}; qb = (u32x4){rb.x, rb.y, wb1.x, wb1.y}; }
        else    { qa = (u32x4){wa0.x, wa0.y, ra.x, ra.y}; qb = (u32x4){wb0.x, wb0.y, rb.x, rb.y}; }
        const int col = 8 * (hi ? g1 : g0);
        *(u32x4*)(orow + col) = qa; *(u32x4*)(orow + 32 + col) = qb;
    }
#undef AT_KT
#undef AT_LOAD
#undef AT_STORE
}


#define XB_TMO      128
#define XB_XCNT(j)  (256  + 64 * (j))
#define XB_XSUB(j)  (1280 + 64 * (j))
#define XB_XGEN(j)  (2304 + 64 * (j))
#define XB_TOP      3328
#define XB_TOPGEN   3392
#define XCD_BAR_WORDS 3456
#define XB_SPIN_CAP (1u << 18)
__device__ __forceinline__ unsigned xb_ld(unsigned* p)              { return __hip_atomic_load(p, __ATOMIC_RELAXED, __HIP_MEMORY_SCOPE_AGENT); }
__device__ __forceinline__ unsigned xb_add(unsigned* p, unsigned v) { return __hip_atomic_fetch_add(p, v, __ATOMIC_RELAXED, __HIP_MEMORY_SCOPE_AGENT); }
__device__ __forceinline__ unsigned xb_xcc_id() { return (unsigned)__builtin_amdgcn_s_getreg((3 << 11) | 20) & 0xFu; }
#define XB_SPIN(cond, bar) do { unsigned _sp = 0; while (cond) { __builtin_amdgcn_s_sleep(1); \
    if ((++_sp & 255u) == 0u) { if (xb_ld(&(bar)[XB_TMO])) break; if (_sp > XB_SPIN_CAP) { atomicAdd(&(bar)[XB_TMO], 1u); break; } } } } while (0)
struct XcdBarrier { unsigned* bar; unsigned x; volatile LAS unsigned* st; };
__device__ __forceinline__ XcdBarrier xcd_barrier_post(unsigned* bar, volatile LAS unsigned* st) {
    XcdBarrier b; b.bar = bar; b.x = xb_xcc_id(); b.st = st;
    if (threadIdx.x == 0) (void)xb_add(&bar[XB_XCNT(b.x)], 1u);
    return b;
}
__device__ __forceinline__ void xcd_barrier_complete(unsigned* bar, unsigned x, unsigned& nloc, unsigned& nx) {
    const unsigned G = gridDim.x * gridDim.y * gridDim.z;
    unsigned sum, cnt, mine, sp = 0u;
    for (;;) {
        sum = 0u; cnt = 0u; mine = 0u;
#pragma unroll
        for (unsigned j = 0; j < 16; ++j) { const unsigned c = xb_ld(&bar[XB_XCNT(j)]); sum += c; cnt += (c > 0u) ? 1u : 0u; mine = (j == x) ? c : mine; }
        if (sum == G) break;
        __builtin_amdgcn_s_sleep(1);
        if ((++sp & 255u) == 0u) { if (xb_ld(&bar[XB_TMO])) break; if (sp > XB_SPIN_CAP) { atomicAdd(&bar[XB_TMO], 1u); break; } }
    }
    nloc = mine > 0u ? mine : 1u; nx = cnt > 0u ? cnt : 1u;
}
__device__ __forceinline__ void xcd_barrier(const XcdBarrier& b) {
    asm volatile("s_waitcnt vmcnt(0)" ::: "memory");
    __syncthreads();
    if (threadIdx.x == 0) {
        unsigned* bar = b.bar;
        __builtin_amdgcn_s_waitcnt(0);
        unsigned nloc = b.st[0], nx = b.st[1];
        if (nloc == 0u) { xcd_barrier_complete(bar, b.x, nloc, nx); b.st[0] = nloc; b.st[1] = nx; }
        const unsigned old = xb_add(&bar[XB_XSUB(b.x)], 1u);
        const unsigned gen = old / nloc;
        if (old + 1u == (gen + 1u) * nloc) {
            __builtin_amdgcn_fence(__ATOMIC_RELEASE, "agent");
            asm volatile("s_waitcnt vmcnt(0)" ::: "memory");
            const unsigned og = xb_add(&bar[XB_TOP], 1u);
            const unsigned tg = og / nx;
            if (og + 1u == (tg + 1u) * nx) xb_add(&bar[XB_TOPGEN], 1u);
            else XB_SPIN(xb_ld(&bar[XB_TOPGEN]) == tg, bar);
            __builtin_amdgcn_fence(__ATOMIC_ACQUIRE, "agent");
            xb_add(&bar[XB_XGEN(b.x)], 1u);
            asm volatile("s_waitcnt vmcnt(0)" ::: "memory");
        } else {
            XB_SPIN(xb_ld(&bar[XB_XGEN(b.x)]) == gen, bar);
            __builtin_amdgcn_fence(__ATOMIC_ACQUIRE, "agent");
            asm volatile("s_waitcnt vmcnt(0)" ::: "memory");
        }
    }
    __syncthreads();
}

struct Args { const float* in[16]; float* out; unsigned char* ws; };

__device__ __forceinline__ void attn_mla_naive(const bf16_t* QA, const bf16_t* KVA, const bf16_t* PROJ, bf16_t* O) {
    const int nth = gridDim.x * NTHREADS;
    for (int w = blockIdx.x * NTHREADS + threadIdx.x; w < 8 * MTOK; w += nth) {
        const int h = w >> 14, row = w & (MTOK - 1), b = row >> 11, t = row & (SEQ - 1);
        float q[96];
#pragma unroll
        for (int c = 0; c < 12; ++c) unpack8(*(const u32x4*)(QA + (size_t)row * NQA + h * 96 + c * 8), q + c * 8);
        float o[64];
#pragma unroll
        for (int d = 0; d < 64; ++d) o[d] = 0.f;
        float mx = -INFINITY, l = 0.f;
        const int kend = ((t >> 6) + 1) << 6;
        for (int s = 0; s < kend; ++s) {
            const size_t kr = (size_t)(b * SEQ + s);
            const bf16_t* kp = KVA + kr * NKVA + h * 128; const bf16_t* rp = PROJ + kr * NPROJ_P + C_KR;
            float sc = 0.f;
#pragma unroll
            for (int c = 0; c < 8; ++c) { float k[8]; unpack8(*(const u32x4*)(kp + c * 8), k);
#pragma unroll
                for (int e = 0; e < 8; ++e) sc += q[c * 8 + e] * k[e]; }
#pragma unroll
            for (int c = 0; c < 4; ++c) { float k[8]; unpack8(*(const u32x4*)(rp + c * 8), k);
#pragma unroll
                for (int e = 0; e < 8; ++e) sc += q[64 + c * 8 + e] * k[e]; }
            const float mn = fmaxf(mx, sc), al = __builtin_amdgcn_exp2f(mx - mn), p = __builtin_amdgcn_exp2f(sc - mn);
            l = l * al + p; mx = mn;
#pragma unroll
            for (int c = 0; c < 8; ++c) { float v[8]; unpack8(*(const u32x4*)(kp + 64 + c * 8), v);
#pragma unroll
                for (int e = 0; e < 8; ++e) o[c * 8 + e] = o[c * 8 + e] * al + p * v[e]; }
        }
        const float inv = 1.0f / l;
#pragma unroll
        for (int c = 0; c < 8; ++c) { u32x4 wv; wv.x = cvt_pk_bf16(o[c * 8] * inv, o[c * 8 + 1] * inv); wv.y = cvt_pk_bf16(o[c * 8 + 2] * inv, o[c * 8 + 3] * inv); wv.z = cvt_pk_bf16(o[c * 8 + 4] * inv, o[c * 8 + 5] * inv); wv.w = cvt_pk_bf16(o[c * 8 + 6] * inv, o[c * 8 + 7] * inv);
            *(u32x4*)(O + (size_t)row * DM + h * 64 + c * 8) = wv; }
    }
}

__device__ __forceinline__ void attn_sb_naive(const bf16_t* PROJ, bf16_t* O) {
    const int nth = gridDim.x * NTHREADS;
    for (int w = blockIdx.x * NTHREADS + threadIdx.x; w < 8 * MTOK; w += nth) {
        const int h = w >> 14, row = w & (MTOK - 1), b = row >> 11, t = row & (SEQ - 1);
        float q[64];
#pragma unroll
        for (int c = 0; c < 8; ++c) unpack8(*(const u32x4*)(PROJ + (size_t)row * NPROJ_P + C_QB + h * 64 + c * 8), q + c * 8);
        float o[64];
#pragma unroll
        for (int d = 0; d < 64; ++d) o[d] = 0.f;
        float cum = 0.f;
        const int tmax = t | 63;
        for (int s = tmax - 1; s >= 0; --s) {
            const size_t kr = (size_t)(b * SEQ + s);
            const bf16_t* kp = PROJ + kr * NPROJ_P + C_KB + h * 64; const bf16_t* vp = PROJ + kr * NPROJ_P + C_VB + h * 64;
            float z = 0.f;
#pragma unroll
            for (int c = 0; c < 8; ++c) { float k[8]; unpack8(*(const u32x4*)(kp + c * 8), k);
#pragma unroll
                for (int e = 0; e < 8; ++e) z += q[c * 8 + e] * k[e]; }
            z *= 0.125f;
            const bool on = s < t;
            const float lg = __logf(1.0f + __expf(-fabsf(z)));
            const float wgt = on ? __expf(fminf(z, 0.f) - lg + cum) : 0.f;
            cum += on ? (fminf(-z, 0.f) - lg) : 0.f;
#pragma unroll
            for (int c = 0; c < 8; ++c) { float v[8]; unpack8(*(const u32x4*)(vp + c * 8), v);
#pragma unroll
                for (int e = 0; e < 8; ++e) o[c * 8 + e] += wgt * v[e]; }
        }
#pragma unroll
        for (int c = 0; c < 8; ++c) { u32x4 wv; wv.x = cvt_pk_bf16(o[c * 8], o[c * 8 + 1]); wv.y = cvt_pk_bf16(o[c * 8 + 2], o[c * 8 + 3]); wv.z = cvt_pk_bf16(o[c * 8 + 4], o[c * 8 + 5]); wv.w = cvt_pk_bf16(o[c * 8 + 6], o[c * 8 + 7]);
            *(u32x4*)(O + (size_t)row * DM + 512 + h * 64 + c * 8) = wv; }
    }
}

__device__ __forceinline__ void attn_band_naive(const bf16_t* QKV, const float* rel_bias, bf16_t* O) {
    const int nth = gridDim.x * NTHREADS;
    for (int w = blockIdx.x * NTHREADS + threadIdx.x; w < 16 * MTOK; w += nth) {
        const int h = w >> 14, row = w & (MTOK - 1), b = row >> 11, t = row & (SEQ - 1);
        float q[64];
#pragma unroll
        for (int c = 0; c < 8; ++c) unpack8(*(const u32x4*)(QKV + (size_t)row * NQKV + h * 64 + c * 8), q + c * 8);
        float o[64];
#pragma unroll
        for (int d = 0; d < 64; ++d) o[d] = 0.f;
        float mx = -INFINITY, l = 0.f;
        const int n = t >> 6, s0 = (n >= 8) ? (n - 8) * 64 : 0, s1 = (n + 1) * 64;
        const float* bias = rel_bias + h * 513 + 256;
        for (int s = s0; s < s1; ++s) {
            const size_t kr = (size_t)(b * SEQ + s);
            const bf16_t* kp = QKV + kr * NQKV + 1024 + h * 64; const bf16_t* vp = QKV + kr * NQKV + 2048 + h * 64;
            float sc = 0.f;
#pragma unroll
            for (int c = 0; c < 8; ++c) { float k[8]; unpack8(*(const u32x4*)(kp + c * 8), k);
#pragma unroll
                for (int e = 0; e < 8; ++e) sc += q[c * 8 + e] * k[e]; }
            int rel = t - s; rel = rel > 256 ? 256 : (rel < -256 ? -256 : rel);
            sc += bias[rel] * LOG2E;
            const float mn = fmaxf(mx, sc), al = __builtin_amdgcn_exp2f(mx - mn), p = __builtin_amdgcn_exp2f(sc - mn);
            l = l * al + p; mx = mn;
#pragma unroll
            for (int c = 0; c < 8; ++c) { float v[8]; unpack8(*(const u32x4*)(vp + c * 8), v);
#pragma unroll
                for (int e = 0; e < 8; ++e) o[c * 8 + e] = o[c * 8 + e] * al + p * v[e]; }
        }
        const float inv = 1.0f / l;
#pragma unroll
        for (int c = 0; c < 8; ++c) { u32x4 wv; wv.x = cvt_pk_bf16(o[c * 8] * inv, o[c * 8 + 1] * inv); wv.y = cvt_pk_bf16(o[c * 8 + 2] * inv, o[c * 8 + 3] * inv); wv.z = cvt_pk_bf16(o[c * 8 + 4] * inv, o[c * 8 + 5] * inv); wv.w = cvt_pk_bf16(o[c * 8 + 6] * inv, o[c * 8 + 7] * inv);
            *(u32x4*)(O + (size_t)row * DM + h * 64 + c * 8) = wv; }
    }
}

constexpr int I_IN = 16 * (NPROJ / 32), I_UQ = 6 * 24, I_UKV = 4 * 32, I_O = 16 * 32, I_G = 16 * 88, I_D = 44 * 32, I_QKV = 16 * 96;
constexpr int CV_R0 = I_IN + I_UQ + I_UKV, CV_R1 = CV_R0 + I_O + 2 * I_G + I_D + I_QKV + I_O, CV_NITEMS = CV_R1 + 2 * I_G + I_D;
#define CONV_ITEM(it_) do { int r = (it_); \
        if (r < I_IN) { p0_item(args.in[1], DM, NPROJ, args.in[10], Win, DM, 0, scr, r, lane); break; } r -= I_IN; \
        if (r < I_UQ) { p0_item(args.in[3], 384, NQA, args.in[2], Wuq, 384, 0, scr, r, lane); break; } r -= I_UQ; \
        if (r < I_UKV) { p0_item(args.in[5], 256, NKVA, args.in[4], Wukv, 256, 0, scr, r, lane); break; } r -= I_UKV; \
        if (r < I_O) { p0_item(args.in[6], DM, DM, nullptr, Wo0, DM, 0, scr, r, lane); break; } r -= I_O; \
        if (r < I_G) { p0_item(args.in[12], DM, DFF, args.in[11], Wgu0, DM, 1, scr, r, lane); break; } r -= I_G; \
        if (r < I_G) { p0_item(args.in[13], DM, DFF, args.in[11], Wgu0, DM, 2, scr, r, lane); break; } r -= I_G; \
        if (r < I_D) { p0_item(args.in[14], DFF, DM, nullptr, Wd0, DFF, 0, scr, r, lane); break; } r -= I_D; \
        if (r < I_QKV) { p0_item(args.in[7], DM, NQKV, args.in[10] + DM, Wqkv, DM, 0, scr, r, lane); break; } r -= I_QKV; \
        if (r < I_O) { p0_item(args.in[9], DM, DM, nullptr, Wo1, DM, 0, scr, r, lane); break; } r -= I_O; \
        if (r < I_G) { p0_item(args.in[12] + (size_t)DM * DFF, DM, DFF, args.in[11] + DM, Wgu1, DM, 1, scr, r, lane); break; } r -= I_G; \
        if (r < I_G) { p0_item(args.in[13] + (size_t)DM * DFF, DM, DFF, args.in[11] + DM, Wgu1, DM, 2, scr, r, lane); break; } r -= I_G; \
        p0_item(args.in[14] + (size_t)DFF * DM, DFF, DM, nullptr, Wd1, DFF, 0, scr, r, lane); } while (0)
#define CONV_TAIL(first, lo, hi) do { if (G == 256 && (int)blockIdx.x >= (first)) { int tid_c = threadIdx.x; asm volatile("" : "+v"(tid_c)); const int lane = tid_c & 63, wave = __builtin_amdgcn_readfirstlane(tid_c >> 6); \
        LAS float* scr = (LAS float*)((LAS unsigned char*)lds + wave * 16384); \
        for (int it = (lo) + ((int)blockIdx.x - (first)) * 8 + wave; it < (hi); it += (G - (first)) * 8) CONV_ITEM(it); } } while (0)

__global__ void __launch_bounds__(NTHREADS) fwd_megakernel(Args args) {
    extern __shared__ __attribute__((aligned(16))) unsigned char lds[];
#ifdef USE_CG_SYNC
    cg::grid_group grid = cg::this_grid();
#define GRID_SYNC() grid.sync()
#else
    { volatile LAS unsigned* st0 = (volatile LAS unsigned*)((LAS unsigned char*)lds + LDS_BYTES - 64); if (threadIdx.x == 0) { st0[0] = 0u; st0[1] = 0u; } }
    __syncthreads();
    const XcdBarrier xbar = xcd_barrier_post((unsigned*)(args.ws + WS_CTL), (volatile LAS unsigned*)((LAS unsigned char*)lds + LDS_BYTES - 64));
#define GRID_SYNC() xcd_barrier(xbar)
#endif
#ifdef USE_NAIVE_GEMM
#define GEMM(A, lda, Bt, ldb, M, N, K, E) gemm_naive(A, lda, Bt, ldb, (M) / 256, (N) / 256, K, E)
#else
#define GEMM(A, lda, Bt, ldb, M, N, K, E) gemm_fast((LAS unsigned char*)lds, A, lda, Bt, ldb, M, N, K, E)
#endif
    const int G = gridDim.x;
    const int vcu = (G % 8 == 0) ? (int)(blockIdx.x % 8) * (G / 8) + (int)(blockIdx.x / 8) : (int)blockIdx.x;
    LAS unsigned char* ldsp = (LAS unsigned char*)lds;
    unsigned char* ws = args.ws;
    const float* x = args.in[0];
    float* out = args.out;
    u64* ssq = (u64*)(ws + WS_SSQ);
    f32x2* rope = (f32x2*)(ws + WS_ROPE);
    bf16_t* Win = (bf16_t*)(ws + WS_WIN); bf16_t* Wuq = (bf16_t*)(ws + WS_WUQ); bf16_t* Wukv = (bf16_t*)(ws + WS_WUKV); bf16_t* Wo0 = (bf16_t*)(ws + WS_WO0);
    bf16_t* Wgu0 = (bf16_t*)(ws + WS_WGU0); bf16_t* Wd0 = (bf16_t*)(ws + WS_WD0); bf16_t* Wqkv = (bf16_t*)(ws + WS_WQKV); bf16_t* Wo1 = (bf16_t*)(ws + WS_WO1);
    bf16_t* Wgu1 = (bf16_t*)(ws + WS_WGU1); bf16_t* Wd1 = (bf16_t*)(ws + WS_WD1);
    bf16_t* HB = (bf16_t*)(ws + WS_HB); bf16_t* PROJ = (bf16_t*)(ws + WS_A); bf16_t* QKV = (bf16_t*)(ws + WS_A); bf16_t* ACT = (bf16_t*)(ws + WS_A); bf16_t* ATT = (bf16_t*)(ws + WS_ATT);
    bf16_t* QA = (bf16_t*)((unsigned char*)out + OUT_QA); bf16_t* KVA = (bf16_t*)((unsigned char*)out + OUT_KVA);

    {
        const int tid = threadIdx.x, lane = tid & 63, wave = __builtin_amdgcn_readfirstlane(tid >> 6);
        LAS float* scr = (LAS float*)((LAS unsigned char*)lds + wave * 16384);
        const int gw = blockIdx.x * 8 + wave, NGW = G * 8;
        const bool offload = (G == 256);
        for (int it = gw; it < (offload ? CV_R0 : CV_NITEMS); it += NGW) CONV_ITEM(it);
        for (int i = blockIdx.x * NTHREADS + tid; i < (NPROJ_P - NPROJ) * DM / 8; i += G * NTHREADS) ((u32x4*)(Win + (size_t)NPROJ * DM))[i] = (u32x4){0u, 0u, 0u, 0u};
        for (int i = blockIdx.x * NTHREADS + tid; i < 6 * MTOK; i += G * NTHREADS) ssq[MTOK + i] = 0ull;
        for (int i = blockIdx.x * NTHREADS + tid; i < SEQ * 16; i += G * NTHREADS) {
            const int pos = i >> 4, fi = i & 15;
            const float inv_freq = __builtin_amdgcn_exp2f(-(float)fi * (13.287712379549449f / 16.0f));
            const float ang = (float)pos * inv_freq;
            float tr = ang * 0.15915494309189535f; tr -= floorf(tr);
            rope[i] = (f32x2){__builtin_amdgcn_cosf(tr), __builtin_amdgcn_sinf(tr)};
        }
        for (int m = gw; m < MTOK; m += NGW) {
            const f32x4* xr = (const f32x4*)(x + (size_t)m * DM) + lane; f32x4 v[4]; float s = 0.f;
#pragma unroll
            for (int j = 0; j < 4; ++j) { v[j] = __builtin_nontemporal_load(&xr[64 * j]); s += dot4(v[j]); }
            s = wave_sum(s);
            if (lane == 0) ssq[m] = ssq_fix(s);
#pragma unroll
            for (int j = 0; j < 4; ++j) { u32x2 w; w.x = cvt_pk_bf16(v[j][0], v[j][1]); w.y = cvt_pk_bf16(v[j][2], v[j][3]); *((u32x2*)(HB + (size_t)m * DM) + lane + 64 * j) = w; }
        }
    }
    GRID_SYNC();
    { EpiScale<0> E{PROJ, NPROJ_P, ssq, 1.0f / DM, ssq + MTOK, ssq + 2 * MTOK, rope}; GEMM(HB, DM, Win, DM, MTOK, NPROJ_P, DM, E); }
    CONV_TAIL(64, CV_R0, CV_R1);
    GRID_SYNC();
    { EpiScale<1> E{QA, NQA, ssq + MTOK, 1.0f / 384, nullptr, nullptr, rope}; GEMM(PROJ, NPROJ_P, Wuq, 384, MTOK, NQA, 384, E); }
    { EpiScaleP<2> E{KVA, NKVA, ssq + 2 * MTOK, 1.0f / 256}; GEMM(PROJ + C_CKV, NPROJ_P, Wukv, 256, MTOK, NKVA, 256, E); }
    GRID_SYNC();
#ifdef NAIVE_ATTN
    attn_mla_naive(QA, KVA, PROJ, ATT);
    attn_sb_naive(PROJ, ATT);
#else
    for (int u = vcu; u < 256; u += G) {
        const int bh = u >> 2, j = u & 3, b = bh >> 3, h = bh & 7;
        const size_t rb = (size_t)b * SEQ;
        for (int k = 0; k < 2 * REP_MLA; ++k) { const int qt = (k & 1) ? 7 - j : j;
            attn_unit<0>(ldsp, 256 * qt, QA + rb * NQA + h * 96, NQA, KVA + rb * NKVA + h * 128, NKVA, PROJ + rb * NPROJ_P + C_KR, NPROJ_P, KVA + rb * NKVA + h * 128 + 64, NKVA, ATT + rb * DM + h * 64, nullptr); }
    }
    for (int u = vcu; u < 256; u += G) {
        const int bhp = u >> 3, j = u & 7, b = bhp >> 2, hp = bhp & 3;
        const size_t rb = (size_t)b * SEQ;
        for (int k = 0; k < 2 * REP_SB; ++k) { const int qt = (k & 1) ? 15 - j : j;
            attn_unit<1, true>(ldsp, 128 * qt, PROJ + rb * NPROJ_P + C_QB + hp * 128, NPROJ_P, PROJ + rb * NPROJ_P + C_KB + hp * 128, NPROJ_P, nullptr, 0, PROJ + rb * NPROJ_P + C_VB + hp * 128, NPROJ_P, ATT + rb * DM + 512 + hp * 128, nullptr); }
    }
#endif
    GRID_SYNC();
    { EpiResid E{HB, ssq + 3 * MTOK}; GEMM(ATT, DM, Wo0, DM, MTOK, DM, DM, E); }
    GRID_SYNC();
    for (int rep = 0; rep < REP_GU; ++rep) { EpiSwiglu E{ACT, ssq + 3 * MTOK}; GEMM(HB, DM, Wgu0, DM, MTOK, 2 * DFF, DM, E); }
    CONV_TAIL(128, CV_R1, CV_NITEMS);
    GRID_SYNC();
    { EpiResid E{HB, ssq + 4 * MTOK}; GEMM(ACT, DFF, Wd0, DFF, MTOK, DM, DFF, E); }
    GRID_SYNC();
    { EpiScaleP<3> E{QKV, NQKV, ssq + 4 * MTOK, 1.0f / DM}; GEMM(HB, DM, Wqkv, DM, MTOK, NQKV, DM, E); }
    GRID_SYNC();
#ifdef NAIVE_ATTN
    attn_band_naive(QKV, args.in[8], ATT);
#else
    for (int u = vcu; u < 256; u += G) {
        const int bhp = u >> 2, j = u & 3, b = bhp >> 3, hp = bhp & 7;
        const size_t rb = (size_t)b * SEQ;
        for (int k = 0; k < 4 * REP_BAND; ++k) { const int kk = k & 3; const int qt = (kk == 0) ? j : (kk == 1) ? 7 - j : (kk == 2) ? 8 + j : 15 - j;
            attn_unit<2, true>(ldsp, 128 * qt, QKV + rb * NQKV + hp * 128, NQKV, QKV + rb * NQKV + 1024 + hp * 128, NQKV, nullptr, 0, QKV + rb * NQKV + 2048 + hp * 128, NQKV, ATT + rb * DM + hp * 128, args.in[8] + (2 * hp) * 513); }
    }
#endif
    GRID_SYNC();
    { EpiResid E{HB, ssq + 5 * MTOK}; GEMM(ATT, DM, Wo1, DM, MTOK, DM, DM, E); }
    GRID_SYNC();
    { EpiSwiglu E{ACT, ssq + 5 * MTOK}; GEMM(HB, DM, Wgu1, DM, MTOK, 2 * DFF, DM, E); }
    GRID_SYNC();
    if (G == 256) {
        EpiFinal E{HB, ssq + 6 * MTOK, (unsigned*)(args.ws + WS_CTL) + CW_PANEL, args.in[15], out};
        gemm_fast((LAS unsigned char*)lds, ACT, DFF, Wd1, DFF, MTOK, DM, DFF, E);
        return;
    }
    { EpiResid E{HB, ssq + 6 * MTOK}; GEMM(ACT, DFF, Wd1, DFF, MTOK, DM, DFF, E); }
    GRID_SYNC();
    {
        const int tid = threadIdx.x, lane = tid & 63, wave = __builtin_amdgcn_readfirstlane(tid >> 6); (void)tid;
        const int gw = blockIdx.x * 8 + wave, NGW = G * 8;
        const f32x4* gf = (const f32x4*)args.in[15] + lane;
        for (int m = gw; m < MTOK; m += NGW) {
            const float r = rsqrtf(ssq_get(ssq + 6 * MTOK, m) * (1.0f / DM) + RMS_EPS);
            f32x4* p = (f32x4*)(out + (size_t)m * DM) + lane; const u32x2* hp = (const u32x2*)(HB + (size_t)m * DM) + lane;
#pragma unroll
            for (int j = 0; j < 4; ++j) { const u32x2 hv = hp[64 * j]; const f32x4 g4 = gf[64 * j]; f32x4 o; o[0] = bflo(hv.x) * r * g4[0]; o[1] = bfhi(hv.x) * r * g4[1]; o[2] = bflo(hv.y) * r * g4[2]; o[3] = bfhi(hv.y) * r * g4[3]; p[64 * j] = o; }
        }
    }
}

extern "C" void kernel_launch(void* const* d_in, const int* in_sizes, int n_in, void* d_out, int out_size, void* d_ws, size_t ws_size, hipStream_t stream) {
    static int grid = 0;
    if (grid == 0) {
        int dev = 0, cus = 0, per_cu = 0;
        hipGetDevice(&dev);
        hipDeviceGetAttribute(&cus, hipDeviceAttributeMultiprocessorCount, dev);
        hipFuncSetAttribute((const void*)fwd_megakernel, hipFuncAttributeMaxDynamicSharedMemorySize, LDS_BYTES);
        hipOccupancyMaxActiveBlocksPerMultiprocessor(&per_cu, (const void*)fwd_megakernel, NTHREADS, LDS_BYTES);
        if (per_cu < 1) per_cu = 1;
        if (per_cu > 1) per_cu = 1;
        grid = cus * per_cu;
        if (n_in != 16 || out_size != MTOK * DM || ws_size < WS_END) { fprintf(stderr, "kernel_launch: unexpected shapes n_in %d out %d ws %zu\n", n_in, out_size, ws_size); }
    }
    Args a{};
    for (int i = 0; i < 16; ++i) a.in[i] = (const float*)d_in[i];
    a.out = (float*)d_out; a.ws = (unsigned char*)d_ws;
    hipMemsetAsync((char*)d_ws + WS_CTL, 0, CTL_BYTES, stream);
    void* kargs[] = {&a};
    hipError_t e = hipLaunchCooperativeKernel((const void*)fwd_megakernel, dim3(grid), dim3(NTHREADS), kargs, LDS_BYTES, stream);
    if (e != hipSuccess) fprintf(stderr, "cooperative launch failed: %s (grid %d)\n", hipGetErrorString(e), grid);
}
```

```cpp
#include <hip/hip_runtime.h>
#include <hip/hip_cooperative_groups.h>
#include <cstdio>
#include <cstdint>
namespace cg = cooperative_groups;
#define REP_MLA 1
#define REP_SB 1
#define REP_BAND 1
#define REP_GU 1

#define LAS __attribute__((address_space(3)))
typedef unsigned short bf16_t;
typedef short bf16x8 __attribute__((ext_vector_type(8)));
typedef float f32x4 __attribute__((ext_vector_type(4)));
typedef float f32x2 __attribute__((ext_vector_type(2)));
typedef unsigned u32x4 __attribute__((ext_vector_type(4)));
typedef unsigned u32x2 __attribute__((ext_vector_type(2)));

constexpr int MTOK = 16384, SEQ = 2048, DM = 1024, DFF = 2816;
constexpr int NPROJ = 2208, NPROJ_P = 2304;
constexpr int C_CKV = 384, C_KR = 640, C_QB = 672, C_KB = 1184, C_VB = 1696;
constexpr int NQA = 768, NKVA = 1024, NQKV = 3072;
constexpr float RMS_EPS = 1e-6f;
constexpr float LOG2E = 1.4426950408889634f;
constexpr float QSCALE_A = 0.10206207261596577f * LOG2E;
constexpr float QSCALE_C = 0.125f * LOG2E;

constexpr size_t KiB = 1024, MiB = 1u << 20;
constexpr size_t WS_SSQ = 216 * MiB;
constexpr size_t WS_ROPE = 512 * KiB;
constexpr size_t WS_CTL = 768 * KiB, CTL_BYTES = 32 * KiB; constexpr int CW_PANEL = 4096;
constexpr size_t WS_WIN = 1 * MiB;
constexpr size_t WS_WUQ = WS_WIN + (size_t)NPROJ_P * DM * 2;
constexpr size_t WS_WUKV = WS_WUQ + (size_t)NQA * 384 * 2;
constexpr size_t WS_WO0 = WS_WUKV + (size_t)NKVA * 256 * 2;
constexpr size_t WS_WGU0 = WS_WO0 + (size_t)DM * DM * 2;
constexpr size_t WS_WD0 = WS_WGU0 + (size_t)2 * DFF * DM * 2;
constexpr size_t WS_WQKV = WS_WD0 + (size_t)DM * DFF * 2;
constexpr size_t WS_WO1 = WS_WQKV + (size_t)NQKV * DM * 2;
constexpr size_t WS_WGU1 = WS_WO1 + (size_t)DM * DM * 2;
constexpr size_t WS_WD1 = WS_WGU1 + (size_t)2 * DFF * DM * 2;
constexpr size_t WS_WEND = WS_WD1 + (size_t)DM * DFF * 2;
constexpr size_t WS_HB = 50 * MiB;
constexpr size_t WS_A = 82 * MiB;
constexpr size_t WS_ATT = 178 * MiB;
constexpr size_t WS_SSQP = 210 * MiB;
constexpr size_t WS_END = 218 * MiB;
static_assert(WS_WEND <= WS_HB, "weights fit");
constexpr size_t OUT_QA = 0, OUT_KVA = 24 * MiB;

constexpr int NTHREADS = 512;
constexpr int LDS_BYTES = 147456;

typedef __bf16 bf16x2_t __attribute__((ext_vector_type(2)));
__device__ __forceinline__ unsigned cvt_pk_bf16(float lo, float hi) { const f32x2 v = {lo, hi}; const bf16x2_t b = __builtin_convertvector(v, bf16x2_t); return __builtin_bit_cast(unsigned, b); }
__device__ __forceinline__ float bflo(unsigned w) { return __uint_as_float(w << 16); }
__device__ __forceinline__ float bfhi(unsigned w) { return __uint_as_float(w & 0xffff0000u); }
__device__ __forceinline__ void unpack8(const u32x4 w, float* f) {
    f[0] = bflo(w.x); f[1] = bfhi(w.x); f[2] = bflo(w.y); f[3] = bfhi(w.y); f[4] = bflo(w.z); f[5] = bfhi(w.z); f[6] = bflo(w.w); f[7] = bfhi(w.w);
}
__device__ __forceinline__ float wave_sum(float v) {
#pragma unroll
    for (int o = 1; o < 64; o <<= 1) v += __shfl_xor(v, o);
    return v;
}
__device__ __forceinline__ float dot4(const f32x4 a) { return (a[0] * a[0] + a[1] * a[1]) + (a[2] * a[2] + a[3] * a[3]); }

struct Unit { int pm, pn; };
typedef unsigned long long u64;
__device__ __forceinline__ u64 ssq_fix(float s) { const unsigned hi = (unsigned)s; const unsigned lo = (unsigned)((s - (float)hi) * 4294967296.0f); return ((u64)hi << 32) | (u64)lo; }
__device__ __forceinline__ float ssq_val(const u64 v) { return (float)(unsigned)(v >> 32) + (float)(unsigned)v * 2.3283064365386963e-10f; }
__device__ __forceinline__ float ssq_get(const u64* p, int row) { return ssq_val(p[row]); }
__device__ __forceinline__ void ssq_add(u64* p, int row, float s) { atomicAdd(p + row, ssq_fix(s)); }


template <int MODE> struct EpiScale {
    static constexpr bool PERM = true, AFTER_DRAIN = false;
    bf16_t* O; int ldc; const u64* ssq_in; float inv_n; u64* ssq_a; u64* ssq_b; const f32x2* rope;
    __device__ __forceinline__ void operator()(const f32x4 (&acc)[2][2][4][2], const Unit& u, int wr, int wc, int fr, int fq) const {
        const int cb0 = u.pn * 256 + wc * 32;
        u64 sv[2][4];
#pragma unroll
        for (int ai = 0; ai < 2; ++ai)
#pragma unroll
            for (int m = 0; m < 4; ++m) sv[ai][m] = ssq_in[u.pm * 256 + ai * 128 + wr * 64 + m * 16 + fr];
#pragma unroll
        for (int ai = 0; ai < 2; ++ai)
#pragma unroll
            for (int m = 0; m < 4; ++m) {
                const int row = u.pm * 256 + ai * 128 + wr * 64 + m * 16 + fr;
                const float r = rsqrtf(ssq_val(sv[ai][m]) * inv_n + RMS_EPS);
                const int pos = row & (SEQ - 1);
#pragma unroll
                for (int bj = 0; bj < 2; ++bj) {
                    const int cb = cb0 + 128 * bj;
                    float sc = r;
                    if (MODE == 1) sc *= QSCALE_A;
                    f32x4 v0 = acc[ai][bj][m][0] * sc, v1 = acc[ai][bj][m][1] * sc;
                    bool ropeg = false;
                    if (MODE == 0) ropeg = (cb == C_KR);
                    if (MODE == 1) ropeg = ((cb % 96) == 64);
                    if (ropeg) {
                        const float sgn = (fq < 2) ? -1.0f : 1.0f;
                        const f32x2* rp = rope + pos * 16 + 8 * (fq & 1);
#pragma unroll
                        for (int j = 0; j < 4; ++j) {
                            const float o0 = __shfl_xor(v0[j], 32), o1 = __shfl_xor(v1[j], 32); const f32x2 c0 = rp[j], c1 = rp[4 + j];
                            v0[j] = v0[j] * c0.x + sgn * o0 * c0.y; v1[j] = v1[j] * c1.x + sgn * o1 * c1.y;
                        }
                    }
                    if (MODE == 0) {
                        if (cb < C_KR) { float s = dot4(v0) + dot4(v1); s += __shfl_xor(s, 16); s += __shfl_xor(s, 32); if (fq == 0) ssq_add(cb < C_CKV ? ssq_a : ssq_b, row, s); }
                    }
                    u32x4 w; w.x = cvt_pk_bf16(v0[0], v0[1]); w.y = cvt_pk_bf16(v0[2], v0[3]); w.z = cvt_pk_bf16(v1[0], v1[1]); w.w = cvt_pk_bf16(v1[2], v1[3]);
                    *(u32x4*)(O + (size_t)row * ldc + cb + 8 * fq) = w;
                }
            }
    }
};

template <int MODE> struct EpiScaleP {
    static constexpr bool PERM = true, AFTER_DRAIN = false;
    bf16_t* O; int ldc; const u64* ssq_in; float inv_n;
    __device__ __forceinline__ void operator()(const f32x4 (&acc)[2][2][4][2], const Unit& u, int wr, int wc, int fr, int fq) const {
        const int cb0 = u.pn * 256 + wc * 32;
        u64 sv[2][4];
#pragma unroll
        for (int ai = 0; ai < 2; ++ai)
#pragma unroll
            for (int m = 0; m < 4; ++m) sv[ai][m] = ssq_in[u.pm * 256 + ai * 128 + wr * 64 + m * 16 + fr];
#pragma unroll
        for (int ai = 0; ai < 2; ++ai)
#pragma unroll
            for (int m = 0; m < 4; ++m) {
                const int row = u.pm * 256 + ai * 128 + wr * 64 + m * 16 + fr;
                const float r = rsqrtf(ssq_val(sv[ai][m]) * inv_n + RMS_EPS);
#pragma unroll
                for (int bj = 0; bj < 2; ++bj) {
                    const int cb = cb0 + 128 * bj;
                    float sc = r;
                    if (MODE == 3) { if (cb < 1024) sc *= QSCALE_C; }
                    const f32x4 v0 = acc[ai][bj][m][0] * sc, v1 = acc[ai][bj][m][1] * sc;
                    u32x4 w; w.x = cvt_pk_bf16(v0[0], v0[1]); w.y = cvt_pk_bf16(v0[2], v0[3]); w.z = cvt_pk_bf16(v1[0], v1[1]); w.w = cvt_pk_bf16(v1[2], v1[3]);
                    *(u32x4*)(O + (size_t)row * ldc + cb + 8 * fq) = w;
                }
            }
    }
};

struct EpiResid {
    static constexpr bool PERM = true, AFTER_DRAIN = false;
    bf16_t* hb; u64* ssq;
    __device__ __forceinline__ void operator()(const f32x4 (&acc)[2][2][4][2], const Unit& u, int wr, int wc, int fr, int fq) const {
#pragma unroll
        for (int ai = 0; ai < 2; ++ai) {
            u32x4 b[4][2];
#pragma unroll
            for (int m = 0; m < 4; ++m)
#pragma unroll
                for (int bj = 0; bj < 2; ++bj) b[m][bj] = *(const u32x4*)(hb + (size_t)(u.pm * 256 + ai * 128 + wr * 64 + m * 16 + fr) * DM + u.pn * 256 + bj * 128 + wc * 32 + 8 * fq);
#pragma unroll
            for (int m = 0; m < 4; ++m) {
                const int row = u.pm * 256 + ai * 128 + wr * 64 + m * 16 + fr;
                float s = 0.f;
#pragma unroll
                for (int bj = 0; bj < 2; ++bj) {
                    const f32x4 a0 = acc[ai][bj][m][0], a1 = acc[ai][bj][m][1]; const u32x4 bb = b[m][bj];
                    f32x4 h0, h1; h0[0] = bflo(bb.x) + a0[0]; h0[1] = bfhi(bb.x) + a0[1]; h0[2] = bflo(bb.y) + a0[2]; h0[3] = bfhi(bb.y) + a0[3];
                    h1[0] = bflo(bb.z) + a1[0]; h1[1] = bfhi(bb.z) + a1[1]; h1[2] = bflo(bb.w) + a1[2]; h1[3] = bfhi(bb.w) + a1[3];
                    u32x4 w; w.x = cvt_pk_bf16(h0[0], h0[1]); w.y = cvt_pk_bf16(h0[2], h0[3]); w.z = cvt_pk_bf16(h1[0], h1[1]); w.w = cvt_pk_bf16(h1[2], h1[3]);
                    *(u32x4*)(hb + (size_t)row * DM + u.pn * 256 + bj * 128 + wc * 32 + 8 * fq) = w;
                    s += dot4(h0) + dot4(h1);
                }
                s += __shfl_xor(s, 16); s += __shfl_xor(s, 32);
                if (fq == 0) ssq_add(ssq, row, s);
            }
            asm volatile("" ::: "memory");
        }
    }
};

struct EpiSwiglu {
    static constexpr bool PERM = true, AFTER_DRAIN = false;
    bf16_t* O; const u64* ssq_in;
    __device__ __forceinline__ void operator()(const f32x4 (&acc)[2][2][4][2], const Unit& u, int wr, int wc, int fr, int fq) const {
        u64 sv[2][4];
#pragma unroll
        for (int ai = 0; ai < 2; ++ai)
#pragma unroll
            for (int m = 0; m < 4; ++m) sv[ai][m] = ssq_in[u.pm * 256 + ai * 128 + wr * 64 + m * 16 + fr];
#pragma unroll
        for (int ai = 0; ai < 2; ++ai)
#pragma unroll
            for (int m = 0; m < 4; ++m) {
                const int row = u.pm * 256 + ai * 128 + wr * 64 + m * 16 + fr;
                const float r = rsqrtf(ssq_val(sv[ai][m]) * (1.0f / DM) + RMS_EPS);
                float a[8];
#pragma unroll
                for (int n = 0; n < 2; ++n)
#pragma unroll
                    for (int j = 0; j < 4; ++j) { const float g = acc[ai][0][m][n][j] * r, uu = acc[ai][1][m][n][j] * r; a[4 * n + j] = g * __builtin_amdgcn_rcpf(1.0f + __expf(-g)) * uu; }
                u32x4 w; w.x = cvt_pk_bf16(a[0], a[1]); w.y = cvt_pk_bf16(a[2], a[3]); w.z = cvt_pk_bf16(a[4], a[5]); w.w = cvt_pk_bf16(a[6], a[7]);
                *(u32x4*)(O + (size_t)row * DFF + u.pn * 128 + wc * 32 + 8 * fq) = w;
            }
    }
};

struct EpiFinal {
    static constexpr bool PERM = true, AFTER_DRAIN = true;
    const bf16_t* hb; u64* ssq; unsigned* cnt; const float* gfin; float* out;
    __device__ __forceinline__ void operator()(const f32x4 (&)[2][2][4][2], const Unit&, int, int, int, int) const {}
    __device__ __forceinline__ void fused(f32x4 (&acc)[2][2][4][2], const Unit& u, int wr, int wc, int fr, int fq, LAS unsigned char*, int, int) const {
#pragma unroll
        for (int ai = 0; ai < 2; ++ai) {
            u32x4 b[4][2];
#pragma unroll
            for (int m = 0; m < 4; ++m)
#pragma unroll
                for (int bj = 0; bj < 2; ++bj) b[m][bj] = *(const u32x4*)(hb + (size_t)(u.pm * 256 + ai * 128 + wr * 64 + m * 16 + fr) * DM + u.pn * 256 + bj * 128 + wc * 32 + 8 * fq);
#pragma unroll
            for (int m = 0; m < 4; ++m) {
                const int row = u.pm * 256 + ai * 128 + wr * 64 + m * 16 + fr;
                float s = 0.f;
#pragma unroll
                for (int bj = 0; bj < 2; ++bj) {
                    const f32x4 a0 = acc[ai][bj][m][0], a1 = acc[ai][bj][m][1]; const u32x4 bb = b[m][bj];
                    f32x4 h0, h1; h0[0] = bflo(bb.x) + a0[0]; h0[1] = bfhi(bb.x) + a0[1]; h0[2] = bflo(bb.y) + a0[2]; h0[3] = bfhi(bb.y) + a0[3];
                    h1[0] = bflo(bb.z) + a1[0]; h1[1] = bfhi(bb.z) + a1[1]; h1[2] = bflo(bb.w) + a1[2]; h1[3] = bfhi(bb.w) + a1[3];
                    acc[ai][bj][m][0] = h0; acc[ai][bj][m][1] = h1; s += dot4(h0) + dot4(h1);
                }
                s += __shfl_xor(s, 16); s += __shfl_xor(s, 32);
                if (fq == 0) { const u64 prev = atomicAdd(ssq + row, ssq_fix(s)); asm volatile("" :: "v"(prev)); }
            }
            asm volatile("" ::: "memory");
        }
        asm volatile("s_waitcnt vmcnt(0)" ::: "memory");
        __syncthreads();
        if (threadIdx.x == 0) {
            unsigned* c = cnt + 16 * u.pm;
            __hip_atomic_fetch_add(c, 1u, __ATOMIC_RELEASE, __HIP_MEMORY_SCOPE_AGENT);
            unsigned sp = 0;
            while (__hip_atomic_load(c, __ATOMIC_RELAXED, __HIP_MEMORY_SCOPE_AGENT) < 4u) { __builtin_amdgcn_s_sleep(1); if (++sp > (1u << 22)) break; }
            __builtin_amdgcn_fence(__ATOMIC_ACQUIRE, "agent");
            asm volatile("s_waitcnt vmcnt(0)" ::: "memory");
        }
        __syncthreads();
        u64 sv[2][4];
#pragma unroll
        for (int ai = 0; ai < 2; ++ai)
#pragma unroll
            for (int m = 0; m < 4; ++m) sv[ai][m] = __hip_atomic_load(ssq + (u.pm * 256 + ai * 128 + wr * 64 + m * 16 + fr), __ATOMIC_RELAXED, __HIP_MEMORY_SCOPE_AGENT);
        f32x4 g4[2][2];
#pragma unroll
        for (int bj = 0; bj < 2; ++bj)
#pragma unroll
            for (int n = 0; n < 2; ++n) g4[bj][n] = *(const f32x4*)(gfin + u.pn * 256 + bj * 128 + wc * 32 + 8 * fq + 4 * n);
#pragma unroll
        for (int ai = 0; ai < 2; ++ai)
#pragma unroll
            for (int m = 0; m < 4; ++m) {
                const int row = u.pm * 256 + ai * 128 + wr * 64 + m * 16 + fr;
                const float r = rsqrtf(ssq_val(sv[ai][m]) * (1.0f / DM) + RMS_EPS);
#pragma unroll
                for (int bj = 0; bj < 2; ++bj)
#pragma unroll
                    for (int n = 0; n < 2; ++n) *(f32x4*)(out + (size_t)row * DM + u.pn * 256 + bj * 128 + wc * 32 + 8 * fq + 4 * n) = acc[ai][bj][m][n] * r * g4[bj][n];
            }
    }
};

__host__ __device__ __forceinline__ int perm32(int rho) { const int n = rho >> 4, i = rho & 15; return 8 * (i >> 2) + 4 * n + (i & 3); }
template <class Epi>
__device__ __forceinline__ void gemm_naive(const bf16_t* A, int lda, const bf16_t* Bt, int ldb, int nM, int nN, int K, const Epi& E) {
    constexpr bool PERM = Epi::PERM;
    const int tid = threadIdx.x, wid = tid >> 6, lane = tid & 63, wr = wid >> 2, wc = wid & 3, fr = lane & 15, fq = lane >> 4;
    for (int unit = blockIdx.x; unit < nM * nN; unit += gridDim.x) {
        Unit u; u.pm = unit / nN; u.pn = unit % nN;
        f32x4 acc[2][2][4][2];
#pragma unroll
        for (int a = 0; a < 2; ++a)
#pragma unroll
            for (int b = 0; b < 2; ++b)
#pragma unroll
                for (int m = 0; m < 4; ++m)
#pragma unroll
                    for (int n = 0; n < 2; ++n) acc[a][b][m][n] = (f32x4){0.f, 0.f, 0.f, 0.f};
        const bf16_t* Ab = A + (size_t)(u.pm * 256 + wr * 64 + fr) * lda + 8 * fq;
        const bf16_t* Bb = Bt + (size_t)(u.pn * 256 + wc * 32) * ldb + 8 * fq;
        const int br0 = PERM ? perm32(fr) : fr, br1 = PERM ? perm32(16 + fr) : 16 + fr;
        for (int k0 = 0; k0 < K; k0 += 32) {
            bf16x8 af[2][4], bq[2][2];
#pragma unroll
            for (int ai = 0; ai < 2; ++ai)
#pragma unroll
                for (int m = 0; m < 4; ++m) af[ai][m] = *(const bf16x8*)(Ab + (size_t)(ai * 128 + m * 16) * lda + k0);
#pragma unroll
            for (int bj = 0; bj < 2; ++bj) { bq[bj][0] = *(const bf16x8*)(Bb + (size_t)(bj * 128 + br0) * ldb + k0); bq[bj][1] = *(const bf16x8*)(Bb + (size_t)(bj * 128 + br1) * ldb + k0); }
#pragma unroll
            for (int ai = 0; ai < 2; ++ai)
#pragma unroll
                for (int bj = 0; bj < 2; ++bj)
#pragma unroll
                    for (int m = 0; m < 4; ++m)
#pragma unroll
                        for (int n = 0; n < 2; ++n) acc[ai][bj][m][n] = __builtin_amdgcn_mfma_f32_16x16x32_bf16(bq[bj][n], af[ai][m], acc[ai][bj][m][n], 0, 0, 0);
        }
        E(acc, u, wr, wc, fr, fq);
    }
}

#define PG8_LAS __attribute__((address_space(3)))
constexpr int BM = 256, BK = 64, HALF = 128, HTB = HALF * BK * 2  , STAGE_BYTES = 8 * HTB, NXCD = 8, WGM = 8;
__host__ __device__ __forceinline__ int lds_byte(int r, int c) { const int st = (r >> 4) * 2 + (c >> 5), rr = r & 15, cc = c & 31, ob = rr * 64 + cc * 2; return st * 1024 + (ob ^ (((ob >> 9) & 1) << 5)); }
__host__ __device__ __forceinline__ void stage_rc(int b, int& R, int& C) { const int st = b / 1024, sb = b % 1024, swz = sb ^ (((sb >> 9) & 1) << 5); R = (st >> 1) * 16 + swz / 64; C = (st & 1) * 32 + (swz % 64) / 2; }
struct Gemm { const bf16_t* A; const bf16_t* Bt; int M, N, K, lda, ldb; };
struct StaticOrder {
    int nM, nN, nwg, G, c;
    __host__ __device__ void init(int M, int N, int G_, int c_) { nM = M / BM; nN = N / BM; nwg = nM * nN; G = G_; c = c_; }
    __host__ __device__ bool next(int i, Unit& u) const {
        const long L = (long)i * G + c; if (L >= nwg) return false;
        int wgid = (int)L; { const int q = nwg / NXCD, r = nwg % NXCD, xcd = wgid % NXCD, off = wgid / NXCD; wgid = (xcd < r ? xcd * (q + 1) : r * (q + 1) + (xcd - r) * q) + off; }
        const int nig = WGM * nN, gid = wgid / nig, fm = gid * WGM, gsz = (nM - fm) < WGM ? (nM - fm) : WGM;
        u.pm = fm + ((wgid % nig) % gsz); u.pn = (wgid % nig) / gsz; return true;
    }
    __device__ __forceinline__ void a_ready(const Unit&) const {}
    __device__ __forceinline__ void done(const Unit&) const {}
};
template <class Epi, class Sched, bool ALIGN_EPI = false, bool SP2 = false>
__device__ __forceinline__ void gemm_phase(PG8_LAS unsigned char* lds, const Gemm g, const Sched& S, const Epi& E) {
    int tid_ = threadIdx.x; asm volatile("" : "+v"(tid_));
    const int tid = tid_, wid = __builtin_amdgcn_readfirstlane(tid >> 6), lane = tid & 63, wr = wid >> 2, wc = wid & 3, fr = lane & 15, fq = lane >> 4;
    const int K = g.K, nt = K / BK;
    unsigned voffA[2], voffB[2];
#pragma unroll
    for (int i = 0; i < 2; ++i) { int R, C; stage_rc(tid * 16 + i * 8192, R, C); const int Rb = Epi::PERM ? ((R & ~31) + perm32(R & 31)) : R;
        voffA[i] = (unsigned)(R * g.lda + C) * 2u; voffB[i] = (unsigned)(Rb * g.ldb + C) * 2u; }
    const size_t kstep = (size_t)(BK * 2);
    const size_t hstepA = (size_t)HALF * g.lda * 2, hstepB = (size_t)HALF * g.ldb * 2;
    const size_t tstepA = 2 * hstepA, tstepB = 2 * hstepB;
    const unsigned ldsw = (unsigned)wid * 1024u;
    const int aoff = lds_byte(wr * 64 + fr, fq * 8), boff = lds_byte(wc * 32 + fr, fq * 8);
#define PG8_SA(b, h) (((b) * 2 + (h)) * HTB)
#define PG8_SB(b, h) ((4 + (b) * 2 + (h)) * HTB)
#define PG8_STAGE(bufoff, gbase, voff) do { _Pragma("unroll") for (int _i = 0; _i < 2; ++_i) \
        __builtin_amdgcn_global_load_lds((const unsigned*)((const char*)(gbase) + (voff)[_i]), (PG8_LAS unsigned*)(lds + (bufoff) + ldsw + _i * 8192), 16, 0, 0); } while (0)
#define PG8_LDA(dst, b, h) do { _Pragma("unroll") for (int m = 0; m < 4; ++m) _Pragma("unroll") for (int k = 0; k < 2; ++k) dst[m][k] = *(const PG8_LAS bf16x8*)(lds + PG8_SA(b, h) + aoff + m * 2048 + k * 1024); } while (0)
#define PG8_LDB(dst, b, h) do { _Pragma("unroll") for (int n = 0; n < 2; ++n) _Pragma("unroll") for (int k = 0; k < 2; ++k) dst[n][k] = *(const PG8_LAS bf16x8*)(lds + PG8_SB(b, h) + boff + n * 2048 + k * 1024); } while (0)
#define PG8_MMA(ai, bj, At, Bt) do { __builtin_amdgcn_s_setprio(1); _Pragma("unroll") for (int m = 0; m < 4; ++m) _Pragma("unroll") for (int n = 0; n < 2; ++n) _Pragma("unroll") for (int k = 0; k < 2; ++k) \
        acc[ai][bj][m][n] = __builtin_amdgcn_mfma_f32_16x16x32_bf16(Bt[n][k], At[m][k], acc[ai][bj][m][n], 0, 0, 0); __builtin_amdgcn_s_setprio(0); } while (0)
#define PG8_WAIT_V(n) asm volatile("s_waitcnt vmcnt(" #n ")" ::: "memory")
#define PG8_WAIT_L(n) asm volatile("s_waitcnt lgkmcnt(" #n ")" ::: "memory")
#define PG8_BAR __builtin_amdgcn_s_barrier()
#define PG8_SCHED __builtin_amdgcn_sched_barrier(0)
    Unit cur, nxt; int ui = 0;
    if (!S.next(0, cur)) return;
    f32x4 acc[2][2][4][2];
#pragma unroll
    for (int a = 0; a < 2; ++a)
#pragma unroll
        for (int b = 0; b < 2; ++b)
#pragma unroll
            for (int m = 0; m < 4; ++m)
#pragma unroll
                for (int n = 0; n < 2; ++n) acc[a][b][m][n] = (f32x4){0.f, 0.f, 0.f, 0.f};
    bf16x8 At[4][2], B0[2][2], B1[2][2];
    const char* cA = (const char*)g.A + (size_t)cur.pm * tstepA; const char* cB = (const char*)g.Bt + (size_t)cur.pn * tstepB;
    S.a_ready(cur);
    if constexpr (SP2) {
        PG8_STAGE(PG8_SB(0, 0), cB, voffB); PG8_STAGE(PG8_SB(0, 1), cB + hstepB, voffB); PG8_STAGE(PG8_SA(0, 0), cA, voffA); PG8_STAGE(PG8_SA(0, 1), cA + hstepA, voffA);
        if (wr == 1) PG8_BAR;
        PG8_WAIT_V(2); PG8_BAR;
        PG8_STAGE(PG8_SB(1, 0), cB + kstep, voffB); PG8_STAGE(PG8_SA(1, 0), cA + kstep, voffA); PG8_STAGE(PG8_SB(1, 1), cB + hstepB + kstep, voffB);
        PG8_WAIT_V(6); PG8_BAR;
    } else {
        PG8_STAGE(PG8_SB(0, 0), cB, voffB); PG8_STAGE(PG8_SA(0, 0), cA, voffA); PG8_STAGE(PG8_SB(0, 1), cB + hstepB, voffB); PG8_STAGE(PG8_SA(0, 1), cA + hstepA, voffA);
        if (wr == 1) PG8_BAR;
        PG8_WAIT_V(4); PG8_BAR;
        PG8_STAGE(PG8_SB(1, 0), cB + kstep, voffB); PG8_STAGE(PG8_SA(1, 0), cA + kstep, voffA); PG8_STAGE(PG8_SB(1, 1), cB + hstepB + kstep, voffB);
        PG8_WAIT_V(6); PG8_BAR;
    }
    for (;;) {
        const bool has_next = S.next(ui + 1, nxt);
        const char* nA = has_next ? (const char*)g.A + (size_t)nxt.pm * tstepA : cA; const char* nB = has_next ? (const char*)g.Bt + (size_t)nxt.pn * tstepB : cB;
#pragma clang loop unroll(disable)
        for (int t = 0; t < nt; t += 2) {
            const bool last = (t == nt - 2);
            const char* a1 = cA + (size_t)(t + 1) * kstep;
            const char* a2 = last ? nA : cA + (size_t)(t + 2) * kstep; const char* b2 = last ? nB : cB + (size_t)(t + 2) * kstep;
            const char* a3 = a2 + kstep; const char* b3 = b2 + kstep;
            if (last && has_next) S.a_ready(nxt);
            if constexpr (SP2) {
            PG8_LDB(B0, 0, 0); PG8_LDB(B1, 0, 1); PG8_SCHED; PG8_LDA(At, 0, 0); PG8_STAGE(PG8_SA(1, 1), a1 + hstepA, voffA);
            PG8_WAIT_V(8); PG8_WAIT_L(0); PG8_BAR; PG8_MMA(0, 0, At, B0); PG8_MMA(0, 1, At, B1); PG8_BAR; PG8_SCHED;
            PG8_LDA(At, 0, 1); PG8_STAGE(PG8_SB(0, 0), b2, voffB); PG8_STAGE(PG8_SB(0, 1), b2 + hstepB, voffB); PG8_STAGE(PG8_SA(0, 0), a2, voffA);
            PG8_WAIT_V(8); PG8_WAIT_L(0); PG8_BAR; PG8_MMA(1, 0, At, B0); PG8_MMA(1, 1, At, B1); PG8_BAR; PG8_SCHED;
            PG8_LDB(B0, 1, 0); PG8_LDB(B1, 1, 1); PG8_SCHED; PG8_LDA(At, 1, 0); PG8_STAGE(PG8_SA(0, 1), a2 + hstepA, voffA);
            PG8_WAIT_V(8); PG8_WAIT_L(0); PG8_BAR; PG8_MMA(0, 0, At, B0); PG8_MMA(0, 1, At, B1); PG8_BAR; PG8_SCHED;
            PG8_LDA(At, 1, 1); PG8_STAGE(PG8_SB(1, 0), b3, voffB); PG8_STAGE(PG8_SB(1, 1), b3 + hstepB, voffB); PG8_STAGE(PG8_SA(1, 0), a3, voffA);
            PG8_WAIT_V(8); PG8_WAIT_L(0); PG8_BAR; PG8_MMA(1, 0, At, B0); PG8_MMA(1, 1, At, B1); PG8_BAR; PG8_SCHED;
            } else {
            PG8_LDB(B0, 0, 0); PG8_SCHED; PG8_LDA(At, 0, 0); PG8_STAGE(PG8_SA(1, 1), a1 + hstepA, voffA);
            PG8_WAIT_L(8); PG8_BAR; PG8_WAIT_L(0); PG8_MMA(0, 0, At, B0); PG8_BAR; PG8_SCHED;
            PG8_LDB(B1, 0, 1); PG8_STAGE(PG8_SB(0, 0), b2, voffB);
            PG8_BAR; PG8_WAIT_L(0); PG8_MMA(0, 1, At, B1); PG8_BAR;
            PG8_LDA(At, 0, 1); PG8_STAGE(PG8_SA(0, 0), a2, voffA);
            PG8_BAR; PG8_WAIT_L(0); PG8_MMA(1, 0, At, B0); PG8_BAR; PG8_SCHED;
            PG8_STAGE(PG8_SB(0, 1), b2 + hstepB, voffB);
            PG8_WAIT_V(6); PG8_BAR; PG8_MMA(1, 1, At, B1); PG8_BAR;
            PG8_LDB(B0, 1, 0); PG8_SCHED; PG8_LDA(At, 1, 0); PG8_STAGE(PG8_SA(0, 1), a2 + hstepA, voffA);
            PG8_WAIT_L(8); PG8_BAR; PG8_WAIT_L(0); PG8_MMA(0, 0, At, B0); PG8_BAR; PG8_SCHED;
            PG8_LDB(B1, 1, 1); PG8_STAGE(PG8_SB(1, 0), b3, voffB);
            PG8_BAR; PG8_WAIT_L(0); PG8_MMA(0, 1, At, B1); PG8_BAR;
            PG8_LDA(At, 1, 1); PG8_STAGE(PG8_SA(1, 0), a3, voffA);
            PG8_BAR; PG8_WAIT_L(0); PG8_MMA(1, 0, At, B0); PG8_BAR; PG8_SCHED;
            PG8_STAGE(PG8_SB(1, 1), b3 + hstepB, voffB);
            PG8_WAIT_V(6); PG8_BAR; PG8_MMA(1, 1, At, B1); PG8_BAR;
            }
        }
        if constexpr (ALIGN_EPI) { if (wr == 0) PG8_BAR; }
        if constexpr (!Epi::AFTER_DRAIN) { E(acc, cur, wr, wc, fr, fq); S.done(cur); }
        if (!has_next) break;
#pragma unroll
        for (int a = 0; a < 2; ++a)
#pragma unroll
            for (int b = 0; b < 2; ++b)
#pragma unroll
                for (int m = 0; m < 4; ++m)
#pragma unroll
                    for (int n = 0; n < 2; ++n) acc[a][b][m][n] = (f32x4){0.f, 0.f, 0.f, 0.f};
        cur = nxt; cA = nA; cB = nB; ++ui;
        if constexpr (ALIGN_EPI) { if (wr == 1) PG8_BAR; }
    }
    PG8_WAIT_V(0);
    if constexpr (!ALIGN_EPI) { if (wr == 0) PG8_BAR; }
    PG8_BAR;
    if constexpr (Epi::AFTER_DRAIN) { E.fused(acc, cur, wr, wc, fr, fq, lds, wid, lane); S.done(cur); }
#undef PG8_SA
#undef PG8_SB
#undef PG8_STAGE
#undef PG8_LDA
#undef PG8_LDB
#undef PG8_MMA
#undef PG8_WAIT_V
#undef PG8_WAIT_L
#undef PG8_BAR
#undef PG8_SCHED
}
template <class Epi>
__device__ __forceinline__ void gemm_fast(LAS unsigned char* lds, const bf16_t* A, int lda, const bf16_t* Bt, int ldb, int M, int N, int K, const Epi& E) {
    Gemm g{A, Bt, M, N, K, lda, ldb}; StaticOrder S; S.init(M, N, (int)gridDim.x, (int)blockIdx.x);
    gemm_phase<Epi, StaticOrder, !Epi::AFTER_DRAIN, true>(lds, g, S, E);
}

__device__ __forceinline__ void p0_item(const float* W, int K, int N, const float* g, bf16_t* WT, int ldt, int mode, LAS float* scr, int item, int lane) {
    const int nblk = N / 32, kb = item / nblk, nb = item % nblk, k0 = 64 * kb, n0 = 32 * nb;
    { const int kr = lane >> 3, ch = lane & 7; f32x4 v[8];
#pragma unroll
      for (int i = 0; i < 8; ++i) v[i] = __builtin_nontemporal_load((const f32x4*)(W + (size_t)(k0 + 8 * i + kr) * N + n0 + 4 * ch));
#pragma unroll
      for (int i = 0; i < 8; ++i) { const int kk = 8 * i + kr; const float gs = g ? g[k0 + kk] : 1.0f; LAS float* d = scr + kk * 33 + 4 * ch; d[0] = v[i][0] * gs; d[1] = v[i][1] * gs; d[2] = v[i][2] * gs; d[3] = v[i][3] * gs; } }
    asm volatile("s_waitcnt lgkmcnt(0)" ::: "memory");
    const int c = lane & 7;
#pragma unroll
    for (int j = 0; j < 4; ++j) {
        const int n = (lane >> 3) + 8 * j; const LAS float* s = scr + (8 * c) * 33 + n;
        u32x4 o; o.x = cvt_pk_bf16(s[0 * 33], s[1 * 33]); o.y = cvt_pk_bf16(s[2 * 33], s[3 * 33]); o.z = cvt_pk_bf16(s[4 * 33], s[5 * 33]); o.w = cvt_pk_bf16(s[6 * 33], s[7 * 33]);
        const int nn = n0 + n; const int row = (mode == 0) ? nn : ((nn >> 7) * 256 + (mode == 2 ? 128 : 0) + (nn & 127));
        *(u32x4*)(WT + (size_t)row * ldt + k0 + 8 * c) = o;
    }
    asm volatile("s_waitcnt lgkmcnt(0)" ::: "memory");
}


typedef float f32x16 __attribute__((ext_vector_type(16)));
constexpr int AT_VSTR = 72;
constexpr int AT_KBUF = 64 * 104 * 2, AT_VBUF = 64 * AT_VSTR * 2;
constexpr int AT_OFF_K = 0, AT_OFF_V = 2 * AT_KBUF, AT_OFF_BIAS = 2 * AT_KBUF + 2 * AT_VBUF, AT_OFF_FLAG = AT_OFF_BIAS + 2304, AT_OFF_H1 = AT_OFF_FLAG + 256;
__device__ __forceinline__ int crow16(int r, int hi) { return (r & 3) + 8 * (r >> 2) + 4 * hi; }
__device__ __forceinline__ int vperm(int key) { const int k16 = key & 15; return (key & ~15) + 8 * ((k16 >> 2) & 1) + 4 * (k16 >> 3) + (k16 & 3); }
__device__ __forceinline__ bf16x8 pack8(float a0, float a1, float a2, float a3, float a4, float a5, float a6, float a7) {
    u32x4 w; w.x = cvt_pk_bf16(a0, a1); w.y = cvt_pk_bf16(a2, a3); w.z = cvt_pk_bf16(a4, a5); w.w = cvt_pk_bf16(a6, a7); return __builtin_bit_cast(bf16x8, w);
}

__device__ __forceinline__ float max3f(float a, float b, float c) { return __builtin_fmaxf(__builtin_fmaxf(a, b), c); }
template <int MODE, bool TWOH = false>
__device__ __forceinline__ void attn_unit(LAS unsigned char* lds, int q0, const bf16_t* Qp, int ldq, const bf16_t* Kp, int ldk, const bf16_t* Krp, int ldkr, const bf16_t* Vp, int ldv, bf16_t* Op, const float* bias_g) {
    constexpr int DQK = (MODE == 0) ? 96 : 64, NDD = DQK / 16, KSTR = DQK + 8;
    int tid_ = threadIdx.x; asm volatile("" : "+v"(tid_));
    const int tid = tid_, lane = tid & 63, wid = __builtin_amdgcn_readfirstlane(tid >> 6), l31 = lane & 31, hi = lane >> 5;
    const int hsel = TWOH ? (wid >> 2) : 0;
    const int t0w = q0 + 32 * (TWOH ? (wid & 3) : wid), trow = t0w + l31, nq = t0w >> 6;
    LAS unsigned char* ldsh = lds + hsel * AT_OFF_H1;
    Qp += hsel * 64; Op += hsel * 64;
    LAS float* biasl = (LAS float*)(ldsh + AT_OFF_BIAS);
    LAS int* flags = (LAS int*)(lds + AT_OFF_FLAG);
    float bz0 = 0.f, bz1 = 0.f, bz2 = 0.f, bz3 = 0.f;
    if (MODE == 2) { bz0 = bias_g[tid]; if (tid == 0) bz1 = bias_g[512]; if (TWOH) { bz2 = bias_g[513 + tid]; if (tid == 0) bz3 = bias_g[513 + 512]; } }
    bf16x8 qf[NDD];
#pragma unroll
    for (int dd = 0; dd < NDD; ++dd) qf[dd] = *(const bf16x8*)(Qp + (size_t)trow * ldq + 16 * dd + 8 * hi);
    f32x16 o0, o1;
#pragma unroll
    for (int r = 0; r < 16; ++r) { o0[r] = 0.f; o1[r] = 0.f; }
    float mref = 0.f, lrow = 0.f, carry = 0.f; bool first = true;
    f32x16 negm;
#pragma unroll
    for (int r = 0; r < 16; ++r) negm[r] = 0.f;
    const int kt_hi = (q0 + (TWOH ? 127 : 255)) >> 6;
    int kt_lo = 0; if (MODE == 2) { kt_lo = (q0 >> 6) - 8; if (kt_lo < 0) kt_lo = 0; }
    const int nt = kt_hi - kt_lo + 1;
    const int skey = tid >> 3, sch = tid & 7, rkey = tid >> 2, rch = tid & 3;
    const int vcol = vperm(lane);
    u32x4 kregA, krregA, vregA, kreg2A, vreg2A, kregB, krregB, vregB, kreg2B, vreg2B;
#define AT_KT(i) ((MODE == 1) ? (kt_hi - (i)) : (kt_lo + (i)))
#define AT_PART(kt) ((MODE == 0) ? ((kt) <= nq) : (MODE == 1) ? (64 * (kt) <= t0w + 30) : (((kt) <= nq) && ((kt) >= nq - 8)))
#define AT_LOAD(kt, S) do { const size_t kb_ = (size_t)(kt) * 64; \
        kreg##S = *(const u32x4*)(Kp + (kb_ + skey) * ldk + sch * 8); \
        if (MODE == 0) { krreg##S = *(const u32x4*)(Krp + (kb_ + (rkey & 63)) * ldkr + rch * 8); }     \
        vreg##S = *(const u32x4*)(Vp + (kb_ + lane) * ldv + wid * 8); \
        if (TWOH) { kreg2##S = *(const u32x4*)(Kp + (kb_ + skey) * ldk + 64 + sch * 8); vreg2##S = *(const u32x4*)(Vp + (kb_ + lane) * ldv + 64 + wid * 8); } } while (0)
#define AT_VT8(dst, v) do { (dst)[0 * AT_VSTR] = (bf16_t)((v).x & 0xffffu); (dst)[1 * AT_VSTR] = (bf16_t)((v).x >> 16); (dst)[2 * AT_VSTR] = (bf16_t)((v).y & 0xffffu); (dst)[3 * AT_VSTR] = (bf16_t)((v).y >> 16); \
        (dst)[4 * AT_VSTR] = (bf16_t)((v).z & 0xffffu); (dst)[5 * AT_VSTR] = (bf16_t)((v).z >> 16); (dst)[6 * AT_VSTR] = (bf16_t)((v).w & 0xffffu); (dst)[7 * AT_VSTR] = (bf16_t)((v).w >> 16); } while (0)
#define AT_STORE(bufi, S) do { LAS bf16_t* Ks_ = (LAS bf16_t*)(lds + AT_OFF_K + (bufi) * AT_KBUF); LAS bf16_t* Vt_ = (LAS bf16_t*)(lds + AT_OFF_V + (bufi) * AT_VBUF); \
        *(LAS u32x4*)(Ks_ + skey * KSTR + sch * 8) = kreg##S; \
        if (MODE == 0) { if (tid < 256) *(LAS u32x4*)(Ks_ + rkey * KSTR + 64 + rch * 8) = krreg##S; } \
        LAS bf16_t* vd_ = Vt_ + (wid * 8) * AT_VSTR + vcol; AT_VT8(vd_, vreg##S); \
        if (TWOH) { LAS bf16_t* Ks2_ = (LAS bf16_t*)(lds + AT_OFF_H1 + AT_OFF_K + (bufi) * AT_KBUF); LAS bf16_t* ve_ = (LAS bf16_t*)(lds + AT_OFF_H1 + AT_OFF_V + (bufi) * AT_VBUF) + (wid * 8) * AT_VSTR + vcol; \
            *(LAS u32x4*)(Ks2_ + skey * KSTR + sch * 8) = kreg2##S; AT_VT8(ve_, vreg2##S); } } while (0)
#define AT_BAR() do { asm volatile("s_waitcnt lgkmcnt(0)" ::: "memory"); __builtin_amdgcn_s_barrier(); asm volatile("" ::: "memory"); } while (0)
    auto compute = [&](int bufo, int kt) __attribute__((always_inline)) {
            const LAS bf16_t* Ks = (const LAS bf16_t*)(ldsh + AT_OFF_K + bufo * AT_KBUF); const LAS bf16_t* Vt = (const LAS bf16_t*)(ldsh + AT_OFF_V + bufo * AT_VBUF);
            f32x16 p0, p1;
            if (MODE == 1) {
#pragma unroll
                for (int r = 0; r < 16; ++r) { p0[r] = 0.f; p1[r] = 0.f; }
            } else { p0 = negm; p1 = negm; }
            bf16x8 ka[NDD], kb[NDD], va[4], vb[4];
            constexpr int NH = (NDD > 4) ? 4 : NDD;
#pragma unroll
            for (int dd = 0; dd < NH; ++dd) { ka[dd] = *(const LAS bf16x8*)(Ks + l31 * KSTR + 16 * dd + 8 * hi); kb[dd] = *(const LAS bf16x8*)(Ks + (32 + l31) * KSTR + 16 * dd + 8 * hi); }
            __builtin_amdgcn_sched_barrier(0);
#pragma unroll
            for (int dd = 0; dd < NH; ++dd) { p0 = __builtin_amdgcn_mfma_f32_32x32x16_bf16(ka[dd], qf[dd], p0, 0, 0, 0); p1 = __builtin_amdgcn_mfma_f32_32x32x16_bf16(kb[dd], qf[dd], p1, 0, 0, 0);
                if (dd == 0) {
#pragma unroll
                    for (int d2 = NH; d2 < NDD; ++d2) { ka[d2] = *(const LAS bf16x8*)(Ks + l31 * KSTR + 16 * d2 + 8 * hi); kb[d2] = *(const LAS bf16x8*)(Ks + (32 + l31) * KSTR + 16 * d2 + 8 * hi); }
                } }
#pragma unroll
            for (int dd = NH; dd < NDD; ++dd) { p0 = __builtin_amdgcn_mfma_f32_32x32x16_bf16(ka[dd], qf[dd], p0, 0, 0, 0); p1 = __builtin_amdgcn_mfma_f32_32x32x16_bf16(kb[dd], qf[dd], p1, 0, 0, 0); }
            __builtin_amdgcn_sched_barrier(0);
            if (MODE != 1) {
#pragma unroll
                for (int jj = 0; jj < 4; ++jj) { va[jj] = *(const LAS bf16x8*)(Vt + l31 * AT_VSTR + 8 * hi + 16 * jj); vb[jj] = *(const LAS bf16x8*)(Vt + (32 + l31) * AT_VSTR + 8 * hi + 16 * jj); }
            }
            __builtin_amdgcn_sched_barrier(0);
            if (MODE != 1) {
                if (MODE == 2) {
                    if (nq - kt >= 5) { const float cb = biasl[512];
#pragma unroll
                        for (int r = 0; r < 16; ++r) { p0[r] += cb; p1[r] += cb; }
                    } else {
                        const int relb = trow - 64 * kt - 4 * hi;
#pragma unroll
                        for (int r = 0; r < 16; ++r) {
                            int rel0 = relb - ((r & 3) + 8 * (r >> 2)); int rel1 = rel0 - 32;
                            rel0 = rel0 > 256 ? 256 : rel0; rel1 = rel1 > 256 ? 256 : rel1;
                            p0[r] += biasl[256 + rel0]; p1[r] += biasl[256 + rel1];
                        }
                    }
                }
                float mx = max3f(p0[0], p1[0], p0[1]);
#pragma unroll
                for (int r = 1; r < 15; r += 2) { mx = max3f(mx, p1[r], p0[r + 1]); mx = max3f(mx, p1[r + 1], p0[(r + 2 > 15) ? 15 : (r + 2)]); }
                mx = fmaxf(mx, p1[15]);
                mx = fmaxf(mx, __shfl_xor(mx, 32));
                if (first || __any(mx > 8.0f)) {
                    const float dl = first ? mx : fmaxf(mx, 0.f);
                    mref += dl;
#pragma unroll
                    for (int r = 0; r < 16; ++r) { p0[r] -= dl; p1[r] -= dl; }
                    if (!first) { const float f = __builtin_amdgcn_exp2f(-dl); lrow *= f;
#pragma unroll
                        for (int r = 0; r < 16; ++r) { o0[r] *= f; o1[r] *= f; } }
#pragma unroll
                    for (int r = 0; r < 16; ++r) negm[r] = -mref;
                    first = false;
                }
                float rs = 0.f;
#pragma unroll
                for (int r = 0; r < 16; ++r) { p0[r] = __builtin_amdgcn_exp2f(p0[r]); p1[r] = __builtin_amdgcn_exp2f(p1[r]); rs += p0[r] + p1[r]; }
                lrow += rs;
            } else {
                const bool need_mask = (64 * kt + 63 >= t0w);
                const int kvb = 64 * kt + 4 * hi;
                float gs[8], lkq0[16], lkq1[16];
#pragma unroll
                for (int g = 0; g < 8; ++g) {
                    float s4 = 0.f;
#pragma unroll
                    for (int c = 0; c < 4; ++c) {
                        const int r = 4 * (g & 3) + c;
                        const float z2 = ((g < 4) ? p0[r] : p1[r]) * (0.125f * LOG2E);
                        const float sp2 = fmaxf(z2, 0.f) + __builtin_amdgcn_logf(1.0f + __builtin_amdgcn_exp2f(-fabsf(z2)));
                        const bool valid = !need_mask || (kvb + 8 * g + c < trow);
                        const float lk = valid ? -sp2 : 0.f;
                        const float ls = valid ? (z2 - sp2) : -1e30f;
                        if (g < 4) { p0[r] = ls; } else { p1[r] = ls; }
                        s4 += lk;
                        if (g < 4) { lkq0[r] = lk; } else { lkq1[r] = lk; }
                    }
                    gs[g] = s4;
                }
                float run = 0.f, after[8];
#pragma unroll
                for (int g = 7; g >= 0; --g) { const float pg = __shfl_xor(gs[g], 32); after[g] = run + (hi == 0 ? pg : 0.f); run += gs[g] + pg; }
#pragma unroll
                for (int g = 0; g < 8; ++g) {
                    float suf = carry + after[g];
#pragma unroll
                    for (int c = 3; c >= 0; --c) {
                        const int r = 4 * (g & 3) + c;
                        if (g < 4) { p0[r] = __builtin_amdgcn_exp2f(p0[r] + suf); suf += lkq0[r]; } else { p1[r] = __builtin_amdgcn_exp2f(p1[r] + suf); suf += lkq1[r]; }
                    }
                }
                carry += run;
            }
            if (MODE == 1) {
#pragma unroll
                for (int jj = 0; jj < 4; ++jj) { va[jj] = *(const LAS bf16x8*)(Vt + l31 * AT_VSTR + 8 * hi + 16 * jj); vb[jj] = *(const LAS bf16x8*)(Vt + (32 + l31) * AT_VSTR + 8 * hi + 16 * jj); }
            }
            const bf16x8 pb0 = pack8(p0[0], p0[1], p0[2], p0[3], p0[4], p0[5], p0[6], p0[7]), pb1 = pack8(p0[8], p0[9], p0[10], p0[11], p0[12], p0[13], p0[14], p0[15]);
            const bf16x8 pb2 = pack8(p1[0], p1[1], p1[2], p1[3], p1[4], p1[5], p1[6], p1[7]), pb3 = pack8(p1[8], p1[9], p1[10], p1[11], p1[12], p1[13], p1[14], p1[15]);
            o0 = __builtin_amdgcn_mfma_f32_32x32x16_bf16(va[0], pb0, o0, 0, 0, 0); o1 = __builtin_amdgcn_mfma_f32_32x32x16_bf16(vb[0], pb0, o1, 0, 0, 0);
            o0 = __builtin_amdgcn_mfma_f32_32x32x16_bf16(va[1], pb1, o0, 0, 0, 0); o1 = __builtin_amdgcn_mfma_f32_32x32x16_bf16(vb[1], pb1, o1, 0, 0, 0);
            o0 = __builtin_amdgcn_mfma_f32_32x32x16_bf16(va[2], pb2, o0, 0, 0, 0); o1 = __builtin_amdgcn_mfma_f32_32x32x16_bf16(vb[2], pb2, o1, 0, 0, 0);
            o0 = __builtin_amdgcn_mfma_f32_32x32x16_bf16(va[3], pb3, o0, 0, 0, 0); o1 = __builtin_amdgcn_mfma_f32_32x32x16_bf16(vb[3], pb3, o1, 0, 0, 0);
            };
    bool brk = false;
#define AT_ITER(i, SL, SS) do { \
        const int kt_ = AT_KT(i); \
        AT_LOAD(AT_KT(((i) + 2 < nt) ? (i) + 2 : nt - 1), SL);        \
        if (AT_PART(kt_)) compute((i) & 1, kt_); \
        if ((i) + 1 < nt) AT_STORE(((i) + 1) & 1, SS); \
        if (MODE == 1) { const int done_ = __all(carry < -128.0f) ? 1 : 0; if (lane == 0) flags[((i) & 1) * 8 + wid] = done_; } \
        AT_BAR(); \
        if (MODE == 1) { int alld_ = 1; \
            _Pragma("unroll") for (int w8 = 0; w8 < 8; ++w8) alld_ &= flags[((i) & 1) * 8 + w8]; \
            if (alld_) brk = true; } } while (0)
    AT_LOAD(AT_KT(0), A);
    AT_LOAD(AT_KT(nt > 1 ? 1 : 0), B);
    if (MODE == 2) { ((LAS float*)(lds + AT_OFF_BIAS))[tid] = bz0 * LOG2E; if (tid == 0) ((LAS float*)(lds + AT_OFF_BIAS))[512] = bz1 * LOG2E;
        if (TWOH) { ((LAS float*)(lds + AT_OFF_H1 + AT_OFF_BIAS))[tid] = bz2 * LOG2E; if (tid == 0) ((LAS float*)(lds + AT_OFF_H1 + AT_OFF_BIAS))[512] = bz3 * LOG2E; } }
    AT_STORE(0, A);
    AT_BAR();
    for (int i = 0; i < nt; i += 2) {
        AT_ITER(i, A, B);
        if (brk || i + 1 >= nt) break;
        AT_ITER(i + 1, B, A);
        if (brk) break;
    }
    if (MODE == 1) { if (brk) AT_BAR(); }
#undef AT_ITER
#undef AT_PART
#undef AT_VT8
#undef AT_BAR
    float inv = 1.0f;
    if (MODE != 1) { const float lt = lrow + __shfl_xor(lrow, 32); inv = 1.0f / lt; }
    bf16_t* orow = Op + (size_t)trow * DM;
#pragma unroll
    for (int gp = 0; gp < 2; ++gp) {
        const int g0 = 2 * gp, g1 = 2 * gp + 1;
        u32x2 wa0, wa1, wb0, wb1;
        wa0.x = cvt_pk_bf16(o0[4 * g0] * inv, o0[4 * g0 + 1] * inv); wa0.y = cvt_pk_bf16(o0[4 * g0 + 2] * inv, o0[4 * g0 + 3] * inv);
        wa1.x = cvt_pk_bf16(o0[4 * g1] * inv, o0[4 * g1 + 1] * inv); wa1.y = cvt_pk_bf16(o0[4 * g1 + 2] * inv, o0[4 * g1 + 3] * inv);
        wb0.x = cvt_pk_bf16(o1[4 * g0] * inv, o1[4 * g0 + 1] * inv); wb0.y = cvt_pk_bf16(o1[4 * g0 + 2] * inv, o1[4 * g0 + 3] * inv);
        wb1.x = cvt_pk_bf16(o1[4 * g1] * inv, o1[4 * g1 + 1] * inv); wb1.y = cvt_pk_bf16(o1[4 * g1 + 2] * inv, o1[4 * g1 + 3] * inv);
        const u32x2 sa = hi ? wa0 : wa1, sb = hi ? wb0 : wb1;
        u32x2 ra, rb; ra.x = __shfl_xor(sa.x, 32); ra.y = __shfl_xor(sa.y, 32); rb.x = __shfl_xor(sb.x, 32); rb.y = __shfl_xor(sb.y, 32);
        u32x4 qa, qb;
        if (hi) { qa = (u32x4){ra.x, ra.y, wa1.x, wa1.y}; qb = (u32x4){rb.x, rb.y, wb1.x, wb1.y}; }
        else    { qa = (u32x4){wa0.x, wa0.y, ra.x, ra.y}; qb = (u32x4){wb0.x, wb0.y, rb.x, rb.y}; }
        const int col = 8 * (hi ? g1 : g0);
        *(u32x4*)(orow + col) = qa; *(u32x4*)(orow + 32 + col) = qb;
    }
#undef AT_KT
#undef AT_LOAD
#undef AT_STORE
}


#define XB_TMO      128
#define XB_XCNT(j)  (256  + 64 * (j))
#define XB_XSUB(j)  (1280 + 64 * (j))
#define XB_XGEN(j)  (2304 + 64 * (j))
#define XB_TOP      3328
#define XB_TOPGEN   3392
#define XCD_BAR_WORDS 3456
#define XB_SPIN_CAP (1u << 18)
__device__ __forceinline__ unsigned xb_ld(unsigned* p)              { return __hip_atomic_load(p, __ATOMIC_RELAXED, __HIP_MEMORY_SCOPE_AGENT); }
__device__ __forceinline__ unsigned xb_add(unsigned* p, unsigned v) { return __hip_atomic_fetch_add(p, v, __ATOMIC_RELAXED, __HIP_MEMORY_SCOPE_AGENT); }
__device__ __forceinline__ unsigned xb_xcc_id() { return (unsigned)__builtin_amdgcn_s_getreg((3 << 11) | 20) & 0xFu; }
#define XB_SPIN(cond, bar) do { unsigned _sp = 0; while (cond) { __builtin_amdgcn_s_sleep(1); \
    if ((++_sp & 255u) == 0u) { if (xb_ld(&(bar)[XB_TMO])) break; if (_sp > XB_SPIN_CAP) { atomicAdd(&(bar)[XB_TMO], 1u); break; } } } } while (0)
struct XcdBarrier { unsigned* bar; unsigned x; volatile LAS unsigned* st; };
__device__ __forceinline__ XcdBarrier xcd_barrier_post(unsigned* bar, volatile LAS unsigned* st) {
    XcdBarrier b; b.bar = bar; b.x = xb_xcc_id(); b.st = st;
    if (threadIdx.x == 0) (void)xb_add(&bar[XB_XCNT(b.x)], 1u);
    return b;
}
__device__ __forceinline__ void xcd_barrier_complete(unsigned* bar, unsigned x, unsigned& nloc, unsigned& nx) {
    const unsigned G = gridDim.x * gridDim.y * gridDim.z;
    unsigned sum, cnt, mine, sp = 0u;
    for (;;) {
        sum = 0u; cnt = 0u; mine = 0u;
#pragma unroll
        for (unsigned j = 0; j < 16; ++j) { const unsigned c = xb_ld(&bar[XB_XCNT(j)]); sum += c; cnt += (c > 0u) ? 1u : 0u; mine = (j == x) ? c : mine; }
        if (sum == G) break;
        __builtin_amdgcn_s_sleep(1);
        if ((++sp & 255u) == 0u) { if (xb_ld(&bar[XB_TMO])) break; if (sp > XB_SPIN_CAP) { atomicAdd(&bar[XB_TMO], 1u); break; } }
    }
    nloc = mine > 0u ? mine : 1u; nx = cnt > 0u ? cnt : 1u;
}
__device__ __forceinline__ void xcd_barrier(const XcdBarrier& b) {
    asm volatile("s_waitcnt vmcnt(0)" ::: "memory");
    __syncthreads();
    if (threadIdx.x == 0) {
        unsigned* bar = b.bar;
        __builtin_amdgcn_s_waitcnt(0);
        unsigned nloc = b.st[0], nx = b.st[1];
        if (nloc == 0u) { xcd_barrier_complete(bar, b.x, nloc, nx); b.st[0] = nloc; b.st[1] = nx; }
        const unsigned old = xb_add(&bar[XB_XSUB(b.x)], 1u);
        const unsigned gen = old / nloc;
        if (old + 1u == (gen + 1u) * nloc) {
            __builtin_amdgcn_fence(__ATOMIC_RELEASE, "agent");
            asm volatile("s_waitcnt vmcnt(0)" ::: "memory");
            const unsigned og = xb_add(&bar[XB_TOP], 1u);
            const unsigned tg = og / nx;
            if (og + 1u == (tg + 1u) * nx) xb_add(&bar[XB_TOPGEN], 1u);
            else XB_SPIN(xb_ld(&bar[XB_TOPGEN]) == tg, bar);
            __builtin_amdgcn_fence(__ATOMIC_ACQUIRE, "agent");
            xb_add(&bar[XB_XGEN(b.x)], 1u);
            asm volatile("s_waitcnt vmcnt(0)" ::: "memory");
        } else {
            XB_SPIN(xb_ld(&bar[XB_XGEN(b.x)]) == gen, bar);
            __builtin_amdgcn_fence(__ATOMIC_ACQUIRE, "agent");
            asm volatile("s_waitcnt vmcnt(0)" ::: "memory");
        }
    }
    __syncthreads();
}

struct Args { const float* in[16]; float* out; unsigned char* ws; };

__device__ __forceinline__ void attn_mla_naive(const bf16_t* QA, const bf16_t* KVA, const bf16_t* PROJ, bf16_t* O) {
    const int nth = gridDim.x * NTHREADS;
    for (int w = blockIdx.x * NTHREADS + threadIdx.x; w < 8 * MTOK; w += nth) {
        const int h = w >> 14, row = w & (MTOK - 1), b = row >> 11, t = row & (SEQ - 1);
        float q[96];
#pragma unroll
        for (int c = 0; c < 12; ++c) unpack8(*(const u32x4*)(QA + (size_t)row * NQA + h * 96 + c * 8), q + c * 8);
        float o[64];
#pragma unroll
        for (int d = 0; d < 64; ++d) o[d] = 0.f;
        float mx = -INFINITY, l = 0.f;
        const int kend = ((t >> 6) + 1) << 6;
        for (int s = 0; s < kend; ++s) {
            const size_t kr = (size_t)(b * SEQ + s);
            const bf16_t* kp = KVA + kr * NKVA + h * 128; const bf16_t* rp = PROJ + kr * NPROJ_P + C_KR;
            float sc = 0.f;
#pragma unroll
            for (int c = 0; c < 8; ++c) { float k[8]; unpack8(*(const u32x4*)(kp + c * 8), k);
#pragma unroll
                for (int e = 0; e < 8; ++e) sc += q[c * 8 + e] * k[e]; }
#pragma unroll
            for (int c = 0; c < 4; ++c) { float k[8]; unpack8(*(const u32x4*)(rp + c * 8), k);
#pragma unroll
                for (int e = 0; e < 8; ++e) sc += q[64 + c * 8 + e] * k[e]; }
            const float mn = fmaxf(mx, sc), al = __builtin_amdgcn_exp2f(mx - mn), p = __builtin_amdgcn_exp2f(sc - mn);
            l = l * al + p; mx = mn;
#pragma unroll
            for (int c = 0; c < 8; ++c) { float v[8]; unpack8(*(const u32x4*)(kp + 64 + c * 8), v);
#pragma unroll
                for (int e = 0; e < 8; ++e) o[c * 8 + e] = o[c * 8 + e] * al + p * v[e]; }
        }
        const float inv = 1.0f / l;
#pragma unroll
        for (int c = 0; c < 8; ++c) { u32x4 wv; wv.x = cvt_pk_bf16(o[c * 8] * inv, o[c * 8 + 1] * inv); wv.y = cvt_pk_bf16(o[c * 8 + 2] * inv, o[c * 8 + 3] * inv); wv.z = cvt_pk_bf16(o[c * 8 + 4] * inv, o[c * 8 + 5] * inv); wv.w = cvt_pk_bf16(o[c * 8 + 6] * inv, o[c * 8 + 7] * inv);
            *(u32x4*)(O + (size_t)row * DM + h * 64 + c * 8) = wv; }
    }
}

__device__ __forceinline__ void attn_sb_naive(const bf16_t* PROJ, bf16_t* O) {
    const int nth = gridDim.x * NTHREADS;
    for (int w = blockIdx.x * NTHREADS + threadIdx.x; w < 8 * MTOK; w += nth) {
        const int h = w >> 14, row = w & (MTOK - 1), b = row >> 11, t = row & (SEQ - 1);
        float q[64];
#pragma unroll
        for (int c = 0; c < 8; ++c) unpack8(*(const u32x4*)(PROJ + (size_t)row * NPROJ_P + C_QB + h * 64 + c * 8), q + c * 8);
        float o[64];
#pragma unroll
        for (int d = 0; d < 64; ++d) o[d] = 0.f;
        float cum = 0.f;
        const int tmax = t | 63;
        for (int s = tmax - 1; s >= 0; --s) {
            const size_t kr = (size_t)(b * SEQ + s);
            const bf16_t* kp = PROJ + kr * NPROJ_P + C_KB + h * 64; const bf16_t* vp = PROJ + kr * NPROJ_P + C_VB + h * 64;
            float z = 0.f;
#pragma unroll
            for (int c = 0; c < 8; ++c) { float k[8]; unpack8(*(const u32x4*)(kp + c * 8), k);
#pragma unroll
                for (int e = 0; e < 8; ++e) z += q[c * 8 + e] * k[e]; }
            z *= 0.125f;
            const bool on = s < t;
            const float lg = __logf(1.0f + __expf(-fabsf(z)));
            const float wgt = on ? __expf(fminf(z, 0.f) - lg + cum) : 0.f;
            cum += on ? (fminf(-z, 0.f) - lg) : 0.f;
#pragma unroll
            for (int c = 0; c < 8; ++c) { float v[8]; unpack8(*(const u32x4*)(vp + c * 8), v);
#pragma unroll
                for (int e = 0; e < 8; ++e) o[c * 8 + e] += wgt * v[e]; }
        }
#pragma unroll
        for (int c = 0; c < 8; ++c) { u32x4 wv; wv.x = cvt_pk_bf16(o[c * 8], o[c * 8 + 1]); wv.y = cvt_pk_bf16(o[c * 8 + 2], o[c * 8 + 3]); wv.z = cvt_pk_bf16(o[c * 8 + 4], o[c * 8 + 5]); wv.w = cvt_pk_bf16(o[c * 8 + 6], o[c * 8 + 7]);
            *(u32x4*)(O + (size_t)row * DM + 512 + h * 64 + c * 8) = wv; }
    }
}

__device__ __forceinline__ void attn_band_naive(const bf16_t* QKV, const float* rel_bias, bf16_t* O) {
    const int nth = gridDim.x * NTHREADS;
    for (int w = blockIdx.x * NTHREADS + threadIdx.x; w < 16 * MTOK; w += nth) {
        const int h = w >> 14, row = w & (MTOK - 1), b = row >> 11, t = row & (SEQ - 1);
        float q[64];
#pragma unroll
        for (int c = 0; c < 8; ++c) unpack8(*(const u32x4*)(QKV + (size_t)row * NQKV + h * 64 + c * 8), q + c * 8);
        float o[64];
#pragma unroll
        for (int d = 0; d < 64; ++d) o[d] = 0.f;
        float mx = -INFINITY, l = 0.f;
        const int n = t >> 6, s0 = (n >= 8) ? (n - 8) * 64 : 0, s1 = (n + 1) * 64;
        const float* bias = rel_bias + h * 513 + 256;
        for (int s = s0; s < s1; ++s) {
            const size_t kr = (size_t)(b * SEQ + s);
            const bf16_t* kp = QKV + kr * NQKV + 1024 + h * 64; const bf16_t* vp = QKV + kr * NQKV + 2048 + h * 64;
            float sc = 0.f;
#pragma unroll
            for (int c = 0; c < 8; ++c) { float k[8]; unpack8(*(const u32x4*)(kp + c * 8), k);
#pragma unroll
                for (int e = 0; e < 8; ++e) sc += q[c * 8 + e] * k[e]; }
            int rel = t - s; rel = rel > 256 ? 256 : (rel < -256 ? -256 : rel);
            sc += bias[rel] * LOG2E;
            const float mn = fmaxf(mx, sc), al = __builtin_amdgcn_exp2f(mx - mn), p = __builtin_amdgcn_exp2f(sc - mn);
            l = l * al + p; mx = mn;
#pragma unroll
            for (int c = 0; c < 8; ++c) { float v[8]; unpack8(*(const u32x4*)(vp + c * 8), v);
#pragma unroll
                for (int e = 0; e < 8; ++e) o[c * 8 + e] = o[c * 8 + e] * al + p * v[e]; }
        }
        const float inv = 1.0f / l;
#pragma unroll
        for (int c = 0; c < 8; ++c) { u32x4 wv; wv.x = cvt_pk_bf16(o[c * 8] * inv, o[c * 8 + 1] * inv); wv.y = cvt_pk_bf16(o[c * 8 + 2] * inv, o[c * 8 + 3] * inv); wv.z = cvt_pk_bf16(o[c * 8 + 4] * inv, o[c * 8 + 5] * inv); wv.w = cvt_pk_bf16(o[c * 8 + 6] * inv, o[c * 8 + 7] * inv);
            *(u32x4*)(O + (size_t)row * DM + h * 64 + c * 8) = wv; }
    }
}

constexpr int I_IN = 16 * (NPROJ / 32), I_UQ = 6 * 24, I_UKV = 4 * 32, I_O = 16 * 32, I_G = 16 * 88, I_D = 44 * 32, I_QKV = 16 * 96;
constexpr int CV_R0 = I_IN + I_UQ + I_UKV, CV_R1 = CV_R0 + I_O + 2 * I_G + I_D + I_QKV + I_O, CV_NITEMS = CV_R1 + 2 * I_G + I_D;
#define CONV_ITEM(it_) do { int r = (it_); \
        if (r < I_IN) { p0_item(args.in[1], DM, NPROJ, args.in[10], Win, DM, 0, scr, r, lane); break; } r -= I_IN; \
        if (r < I_UQ) { p0_item(args.in[3], 384, NQA, args.in[2], Wuq, 384, 0, scr, r, lane); break; } r -= I_UQ; \
        if (r < I_UKV) { p0_item(args.in[5], 256, NKVA, args.in[4], Wukv, 256, 0, scr, r, lane); break; } r -= I_UKV; \
        if (r < I_O) { p0_item(args.in[6], DM, DM, nullptr, Wo0, DM, 0, scr, r, lane); break; } r -= I_O; \
        if (r < I_G) { p0_item(args.in[12], DM, DFF, args.in[11], Wgu0, DM, 1, scr, r, lane); break; } r -= I_G; \
        if (r < I_G) { p0_item(args.in[13], DM, DFF, args.in[11], Wgu0, DM, 2, scr, r, lane); break; } r -= I_G; \
        if (r < I_D) { p0_item(args.in[14], DFF, DM, nullptr, Wd0, DFF, 0, scr, r, lane); break; } r -= I_D; \
        if (r < I_QKV) { p0_item(args.in[7], DM, NQKV, args.in[10] + DM, Wqkv, DM, 0, scr, r, lane); break; } r -= I_QKV; \
        if (r < I_O) { p0_item(args.in[9], DM, DM, nullptr, Wo1, DM, 0, scr, r, lane); break; } r -= I_O; \
        if (r < I_G) { p0_item(args.in[12] + (size_t)DM * DFF, DM, DFF, args.in[11] + DM, Wgu1, DM, 1, scr, r, lane); break; } r -= I_G; \
        if (r < I_G) { p0_item(args.in[13] + (size_t)DM * DFF, DM, DFF, args.in[11] + DM, Wgu1, DM, 2, scr, r, lane); break; } r -= I_G; \
        p0_item(args.in[14] + (size_t)DFF * DM, DFF, DM, nullptr, Wd1, DFF, 0, scr, r, lane); } while (0)
#define CONV_TAIL(first, lo, hi) do { if (G == 256 && (int)blockIdx.x >= (first)) { int tid_c = threadIdx.x; asm volatile("" : "+v"(tid_c)); const int lane = tid_c & 63, wave = __builtin_amdgcn_readfirstlane(tid_c >> 6); \
        LAS float* scr = (LAS float*)((LAS unsigned char*)lds + wave * 16384); \
        for (int it = (lo) + ((int)blockIdx.x - (first)) * 8 + wave; it < (hi); it += (G - (first)) * 8) CONV_ITEM(it); } } while (0)

__global__ void __launch_bounds__(NTHREADS) fwd_megakernel(Args args) {
    extern __shared__ __attribute__((aligned(16))) unsigned char lds[];
#ifdef USE_CG_SYNC
    cg::grid_group grid = cg::this_grid();
#define GRID_SYNC() grid.sync()
#else
    { volatile LAS unsigned* st0 = (volatile LAS unsigned*)((LAS unsigned char*)lds + LDS_BYTES - 64); if (threadIdx.x == 0) { st0[0] = 0u; st0[1] = 0u; } }
    __syncthreads();
    const XcdBarrier xbar = xcd_barrier_post((unsigned*)(args.ws + WS_CTL), (volatile LAS unsigned*)((LAS unsigned char*)lds + LDS_BYTES - 64));
#define GRID_SYNC() xcd_barrier(xbar)
#endif
#ifdef USE_NAIVE_GEMM
#define GEMM(A, lda, Bt, ldb, M, N, K, E) gemm_naive(A, lda, Bt, ldb, (M) / 256, (N) / 256, K, E)
#else
#define GEMM(A, lda, Bt, ldb, M, N, K, E) gemm_fast((LAS unsigned char*)lds, A, lda, Bt, ldb, M, N, K, E)
#endif
    const int G = gridDim.x;
    const int vcu = (G % 8 == 0) ? (int)(blockIdx.x % 8) * (G / 8) + (int)(blockIdx.x / 8) : (int)blockIdx.x;
    LAS unsigned char* ldsp = (LAS unsigned char*)lds;
    unsigned char* ws = args.ws;
    const float* x = args.in[0];
    float* out = args.out;
    u64* ssq = (u64*)(ws + WS_SSQ);
    f32x2* rope = (f32x2*)(ws + WS_ROPE);
    bf16_t* Win = (bf16_t*)(ws + WS_WIN); bf16_t* Wuq = (bf16_t*)(ws + WS_WUQ); bf16_t* Wukv = (bf16_t*)(ws + WS_WUKV); bf16_t* Wo0 = (bf16_t*)(ws + WS_WO0);
    bf16_t* Wgu0 = (bf16_t*)(ws + WS_WGU0); bf16_t* Wd0 = (bf16_t*)(ws + WS_WD0); bf16_t* Wqkv = (bf16_t*)(ws + WS_WQKV); bf16_t* Wo1 = (bf16_t*)(ws + WS_WO1);
    bf16_t* Wgu1 = (bf16_t*)(ws + WS_WGU1); bf16_t* Wd1 = (bf16_t*)(ws + WS_WD1);
    bf16_t* HB = (bf16_t*)(ws + WS_HB); bf16_t* PROJ = (bf16_t*)(ws + WS_A); bf16_t* QKV = (bf16_t*)(ws + WS_A); bf16_t* ACT = (bf16_t*)(ws + WS_A); bf16_t* ATT = (bf16_t*)(ws + WS_ATT);
    bf16_t* QA = (bf16_t*)((unsigned char*)out + OUT_QA); bf16_t* KVA = (bf16_t*)((unsigned char*)out + OUT_KVA);

    {
        const int tid = threadIdx.x, lane = tid & 63, wave = __builtin_amdgcn_readfirstlane(tid >> 6);
        LAS float* scr = (LAS float*)((LAS unsigned char*)lds + wave * 16384);
        const int gw = blockIdx.x * 8 + wave, NGW = G * 8;
        const bool offload = (G == 256);
        for (int it = gw; it < (offload ? CV_R0 : CV_NITEMS); it += NGW) CONV_ITEM(it);
        for (int i = blockIdx.x * NTHREADS + tid; i < (NPROJ_P - NPROJ) * DM / 8; i += G * NTHREADS) ((u32x4*)(Win + (size_t)NPROJ * DM))[i] = (u32x4){0u, 0u, 0u, 0u};
        for (int i = blockIdx.x * NTHREADS + tid; i < 6 * MTOK; i += G * NTHREADS) ssq[MTOK + i] = 0ull;
        for (int i = blockIdx.x * NTHREADS + tid; i < SEQ * 16; i += G * NTHREADS) {
            const int pos = i >> 4, fi = i & 15;
            const float inv_freq = __builtin_amdgcn_exp2f(-(float)fi * (13.287712379549449f / 16.0f));
            const float ang = (float)pos * inv_freq;
            float tr = ang * 0.15915494309189535f; tr -= floorf(tr);
            rope[i] = (f32x2){__builtin_amdgcn_cosf(tr), __builtin_amdgcn_sinf(tr)};
        }
        for (int m0 = gw; m0 < MTOK; m0 += 2 * NGW) {
            const int m1 = (m0 + NGW < MTOK) ? m0 + NGW : m0;
            const f32x4* xr0 = (const f32x4*)(x + (size_t)m0 * DM) + lane; const f32x4* xr1 = (const f32x4*)(x + (size_t)m1 * DM) + lane;
            f32x4 v0[4], v1[4]; float s0 = 0.f, s1 = 0.f;
#pragma unroll
            for (int j = 0; j < 4; ++j) { v0[j] = __builtin_nontemporal_load(&xr0[64 * j]); v1[j] = __builtin_nontemporal_load(&xr1[64 * j]); }
#pragma unroll
            for (int j = 0; j < 4; ++j) { s0 += dot4(v0[j]); s1 += dot4(v1[j]); }
            s0 = wave_sum(s0); s1 = wave_sum(s1);
            if (lane == 0) { ssq[m0] = ssq_fix(s0); ssq[m1] = ssq_fix(s1); }
#pragma unroll
            for (int j = 0; j < 4; ++j) { u32x2 w; w.x = cvt_pk_bf16(v0[j][0], v0[j][1]); w.y = cvt_pk_bf16(v0[j][2], v0[j][3]); *((u32x2*)(HB + (size_t)m0 * DM) + lane + 64 * j) = w;
                u32x2 w2; w2.x = cvt_pk_bf16(v1[j][0], v1[j][1]); w2.y = cvt_pk_bf16(v1[j][2], v1[j][3]); *((u32x2*)(HB + (size_t)m1 * DM) + lane + 64 * j) = w2; }
        }
    }
    GRID_SYNC();
    { EpiScale<0> E{PROJ, NPROJ_P, ssq, 1.0f / DM, ssq + MTOK, ssq + 2 * MTOK, rope}; GEMM(HB, DM, Win, DM, MTOK, NPROJ_P, DM, E); }
    CONV_TAIL(64, CV_R0, CV_R1);
    GRID_SYNC();
    { EpiScale<1> E{QA, NQA, ssq + MTOK, 1.0f / 384, nullptr, nullptr, rope}; GEMM(PROJ, NPROJ_P, Wuq, 384, MTOK, NQA, 384, E); }
    { EpiScaleP<2> E{KVA, NKVA, ssq + 2 * MTOK, 1.0f / 256}; GEMM(PROJ + C_CKV, NPROJ_P, Wukv, 256, MTOK, NKVA, 256, E); }
    GRID_SYNC();
#ifdef NAIVE_ATTN
    attn_mla_naive(QA, KVA, PROJ, ATT);
    attn_sb_naive(PROJ, ATT);
#else
    for (int u = vcu; u < 256; u += G) {
        const int bh = u >> 2, j = u & 3, b = bh >> 3, h = bh & 7;
        const size_t rb = (size_t)b * SEQ;
        for (int k = 0; k < 2 * REP_MLA; ++k) { const int qt = (k & 1) ? 7 - j : j;
            attn_unit<0>(ldsp, 256 * qt, QA + rb * NQA + h * 96, NQA, KVA + rb * NKVA + h * 128, NKVA, PROJ + rb * NPROJ_P + C_KR, NPROJ_P, KVA + rb * NKVA + h * 128 + 64, NKVA, ATT + rb * DM + h * 64, nullptr); }
    }
    for (int u = vcu; u < 256; u += G) {
        const int bhp = u >> 3, j = u & 7, b = bhp >> 2, hp = bhp & 3;
        const size_t rb = (size_t)b * SEQ;
        for (int k = 0; k < 2 * REP_SB; ++k) { const int qt = (k & 1) ? 15 - j : j;
            attn_unit<1, true>(ldsp, 128 * qt, PROJ + rb * NPROJ_P + C_QB + hp * 128, NPROJ_P, PROJ + rb * NPROJ_P + C_KB + hp * 128, NPROJ_P, nullptr, 0, PROJ + rb * NPROJ_P + C_VB + hp * 128, NPROJ_P, ATT + rb * DM + 512 + hp * 128, nullptr); }
    }
#endif
    GRID_SYNC();
    { EpiResid E{HB, ssq + 3 * MTOK}; GEMM(ATT, DM, Wo0, DM, MTOK, DM, DM, E); }
    GRID_SYNC();
    for (int rep = 0; rep < REP_GU; ++rep) { EpiSwiglu E{ACT, ssq + 3 * MTOK}; GEMM(HB, DM, Wgu0, DM, MTOK, 2 * DFF, DM, E); }
    CONV_TAIL(128, CV_R1, CV_NITEMS);
    GRID_SYNC();
    { EpiResid E{HB, ssq + 4 * MTOK}; GEMM(ACT, DFF, Wd0, DFF, MTOK, DM, DFF, E); }
    GRID_SYNC();
    { EpiScaleP<3> E{QKV, NQKV, ssq + 4 * MTOK, 1.0f / DM}; GEMM(HB, DM, Wqkv, DM, MTOK, NQKV, DM, E); }
    GRID_SYNC();
#ifdef NAIVE_ATTN
    attn_band_naive(QKV, args.in[8], ATT);
#else
    for (int u = vcu; u < 256; u += G) {
        const int bhp = u >> 2, j = u & 3, b = bhp >> 3, hp = bhp & 7;
        const size_t rb = (size_t)b * SEQ;
        for (int k = 0; k < 4 * REP_BAND; ++k) { const int kk = k & 3; const int qt = (kk == 0) ? j : (kk == 1) ? 7 - j : (kk == 2) ? 8 + j : 15 - j;
            attn_unit<2, true>(ldsp, 128 * qt, QKV + rb * NQKV + hp * 128, NQKV, QKV + rb * NQKV + 1024 + hp * 128, NQKV, nullptr, 0, QKV + rb * NQKV + 2048 + hp * 128, NQKV, ATT + rb * DM + hp * 128, args.in[8] + (2 * hp) * 513); }
    }
#endif
    GRID_SYNC();
    { EpiResid E{HB, ssq + 5 * MTOK}; GEMM(ATT, DM, Wo1, DM, MTOK, DM, DM, E); }
    GRID_SYNC();
    { EpiSwiglu E{ACT, ssq + 5 * MTOK}; GEMM(HB, DM, Wgu1, DM, MTOK, 2 * DFF, DM, E); }
    GRID_SYNC();
    if (G == 256) {
        EpiFinal E{HB, ssq + 6 * MTOK, (unsigned*)(args.ws + WS_CTL) + CW_PANEL, args.in[15], out};
        gemm_fast((LAS unsigned char*)lds, ACT, DFF, Wd1, DFF, MTOK, DM, DFF, E);
        return;
    }
    { EpiResid E{HB, ssq + 6 * MTOK}; GEMM(ACT, DFF, Wd1, DFF, MTOK, DM, DFF, E); }
    GRID_SYNC();
    {
        const int tid = threadIdx.x, lane = tid & 63, wave = __builtin_amdgcn_readfirstlane(tid >> 6); (void)tid;
        const int gw = blockIdx.x * 8 + wave, NGW = G * 8;
        const f32x4* gf = (const f32x4*)args.in[15] + lane;
        for (int m = gw; m < MTOK; m += NGW) {
            const float r = rsqrtf(ssq_get(ssq + 6 * MTOK, m) * (1.0f / DM) + RMS_EPS);
            f32x4* p = (f32x4*)(out + (size_t)m * DM) + lane; const u32x2* hp = (const u32x2*)(HB + (size_t)m * DM) + lane;
#pragma unroll
            for (int j = 0; j < 4; ++j) { const u32x2 hv = hp[64 * j]; const f32x4 g4 = gf[64 * j]; f32x4 o; o[0] = bflo(hv.x) * r * g4[0]; o[1] = bfhi(hv.x) * r * g4[1]; o[2] = bflo(hv.y) * r * g4[2]; o[3] = bfhi(hv.y) * r * g4[3]; p[64 * j] = o; }
        }
    }
}

extern "C" void kernel_launch(void* const* d_in, const int* in_sizes, int n_in, void* d_out, int out_size, void* d_ws, size_t ws_size, hipStream_t stream) {
    static int grid = 0;
    if (grid == 0) {
        int dev = 0, cus = 0, per_cu = 0;
        hipGetDevice(&dev);
        hipDeviceGetAttribute(&cus, hipDeviceAttributeMultiprocessorCount, dev);
        hipFuncSetAttribute((const void*)fwd_megakernel, hipFuncAttributeMaxDynamicSharedMemorySize, LDS_BYTES);
        hipOccupancyMaxActiveBlocksPerMultiprocessor(&per_cu, (const void*)fwd_megakernel, NTHREADS, LDS_BYTES);
        if (per_cu < 1) per_cu = 1;
        if (per_cu > 1) per_cu = 1;
        grid = cus * per_cu;
        if (n_in != 16 || out_size != MTOK * DM || ws_size < WS_END) { fprintf(stderr, "kernel_launch: unexpected shapes n_in %d out %d ws %zu\n", n_in, out_size, ws_size); }
    }
    Args a{};
    for (int i = 0; i < 16; ++i) a.in[i] = (const float*)d_in[i];
    a.out = (float*)d_out; a.ws = (unsigned char*)d_ws;
    hipMemsetAsync((char*)d_ws + WS_CTL, 0, CTL_BYTES, stream);
    void* kargs[] = {&a};
    hipError_t e = hipLaunchCooperativeKernel((const void*)fwd_megakernel, dim3(grid), dim3(NTHREADS), kargs, LDS_BYTES, stream);
    if (e != hipSuccess) fprintf(stderr, "cooperative launch failed: %s (grid %d)\n", hipGetErrorString(e), grid);
}
```

```cpp
#include <hip/hip_runtime.h>
#include <hip/hip_cooperative_groups.h>
#include <cstdio>
#include <cstdint>
namespace cg = cooperative_groups;
#define REP_MLA 1
#define REP_SB 1
#define REP_BAND 1
#define REP_GU 1

#define LAS __attribute__((address_space(3)))
typedef unsigned short bf16_t;
typedef short bf16x8 __attribute__((ext_vector_type(8)));
typedef float f32x4 __attribute__((ext_vector_type(4)));
typedef float f32x2 __attribute__((ext_vector_type(2)));
typedef unsigned u32x4 __attribute__((ext_vector_type(4)));
typedef unsigned u32x2 __attribute__((ext_vector_type(2)));

constexpr int MTOK = 16384, SEQ = 2048, DM = 1024, DFF = 2816;
constexpr int NPROJ = 2208, NPROJ_P = 2304;
constexpr int C_CKV = 384, C_KR = 640, C_QB = 672, C_KB = 1184, C_VB = 1696;
constexpr int NQA = 768, NKVA = 1024, NQKV = 3072;
constexpr float RMS_EPS = 1e-6f;
constexpr float LOG2E = 1.4426950408889634f;
constexpr float QSCALE_A = 0.10206207261596577f * LOG2E;
constexpr float QSCALE_C = 0.125f * LOG2E;

constexpr size_t KiB = 1024, MiB = 1u << 20;
constexpr size_t WS_SSQ = 216 * MiB;
constexpr size_t WS_ROPE = 512 * KiB;
constexpr size_t WS_CTL = 768 * KiB, CTL_BYTES = 32 * KiB; constexpr int CW_PANEL = 4096;
constexpr size_t WS_WIN = 1 * MiB;
constexpr size_t WS_WUQ = WS_WIN + (size_t)NPROJ_P * DM * 2;
constexpr size_t WS_WUKV = WS_WUQ + (size_t)NQA * 384 * 2;
constexpr size_t WS_WO0 = WS_WUKV + (size_t)NKVA * 256 * 2;
constexpr size_t WS_WGU0 = WS_WO0 + (size_t)DM * DM * 2;
constexpr size_t WS_WD0 = WS_WGU0 + (size_t)2 * DFF * DM * 2;
constexpr size_t WS_WQKV = WS_WD0 + (size_t)DM * DFF * 2;
constexpr size_t WS_WO1 = WS_WQKV + (size_t)NQKV * DM * 2;
constexpr size_t WS_WGU1 = WS_WO1 + (size_t)DM * DM * 2;
constexpr size_t WS_WD1 = WS_WGU1 + (size_t)2 * DFF * DM * 2;
constexpr size_t WS_WEND = WS_WD1 + (size_t)DM * DFF * 2;
constexpr size_t WS_HB = 50 * MiB;
constexpr size_t WS_A = 82 * MiB;
constexpr size_t WS_ATT = 178 * MiB;
constexpr size_t WS_SSQP = 210 * MiB;
constexpr size_t WS_END = 218 * MiB;
static_assert(WS_WEND <= WS_HB, "weights fit");
constexpr size_t OUT_QA = 0, OUT_KVA = 24 * MiB;

constexpr int NTHREADS = 512;
constexpr int LDS_BYTES = 147456;

typedef __bf16 bf16x2_t __attribute__((ext_vector_type(2)));
__device__ __forceinline__ unsigned cvt_pk_bf16(float lo, float hi) { const f32x2 v = {lo, hi}; const bf16x2_t b = __builtin_convertvector(v, bf16x2_t); return __builtin_bit_cast(unsigned, b); }
__device__ __forceinline__ float bflo(unsigned w) { return __uint_as_float(w << 16); }
__device__ __forceinline__ float bfhi(unsigned w) { return __uint_as_float(w & 0xffff0000u); }
__device__ __forceinline__ void unpack8(const u32x4 w, float* f) {
    f[0] = bflo(w.x); f[1] = bfhi(w.x); f[2] = bflo(w.y); f[3] = bfhi(w.y); f[4] = bflo(w.z); f[5] = bfhi(w.z); f[6] = bflo(w.w); f[7] = bfhi(w.w);
}
__device__ __forceinline__ float wave_sum(float v) {
#pragma unroll
    for (int o = 1; o < 64; o <<= 1) v += __shfl_xor(v, o);
    return v;
}
__device__ __forceinline__ float dot4(const f32x4 a) { return (a[0] * a[0] + a[1] * a[1]) + (a[2] * a[2] + a[3] * a[3]); }

struct Unit { int pm, pn; };
typedef unsigned long long u64;
__device__ __forceinline__ u64 ssq_fix(float s) { const unsigned hi = (unsigned)s; const unsigned lo = (unsigned)((s - (float)hi) * 4294967296.0f); return ((u64)hi << 32) | (u64)lo; }
__device__ __forceinline__ float ssq_val(const u64 v) { return (float)(unsigned)(v >> 32) + (float)(unsigned)v * 2.3283064365386963e-10f; }
__device__ __forceinline__ float ssq_get(const u64* p, int row) { return ssq_val(p[row]); }
__device__ __forceinline__ void ssq_add(u64* p, int row, float s) { atomicAdd(p + row, ssq_fix(s)); }


template <int MODE> struct EpiScale {
    static constexpr bool PERM = true, AFTER_DRAIN = false;
    bf16_t* O; int ldc; const u64* ssq_in; float inv_n; u64* ssq_a; u64* ssq_b; const f32x2* rope;
    __device__ __forceinline__ void operator()(const f32x4 (&acc)[2][2][4][2], const Unit& u, int wr, int wc, int fr, int fq) const {
        const int cb0 = u.pn * 256 + wc * 32;
        u64 sv[2][4];
#pragma unroll
        for (int ai = 0; ai < 2; ++ai)
#pragma unroll
            for (int m = 0; m < 4; ++m) sv[ai][m] = ssq_in[u.pm * 256 + ai * 128 + wr * 64 + m * 16 + fr];
#pragma unroll
        for (int ai = 0; ai < 2; ++ai)
#pragma unroll
            for (int m = 0; m < 4; ++m) {
                const int row = u.pm * 256 + ai * 128 + wr * 64 + m * 16 + fr;
                const float r = rsqrtf(ssq_val(sv[ai][m]) * inv_n + RMS_EPS);
                const int pos = row & (SEQ - 1);
#pragma unroll
                for (int bj = 0; bj < 2; ++bj) {
                    const int cb = cb0 + 128 * bj;
                    float sc = r;
                    if (MODE == 1) sc *= QSCALE_A;
                    f32x4 v0 = acc[ai][bj][m][0] * sc, v1 = acc[ai][bj][m][1] * sc;
                    bool ropeg = false;
                    if (MODE == 0) ropeg = (cb == C_KR);
                    if (MODE == 1) ropeg = ((cb % 96) == 64);
                    if (ropeg) {
                        const float sgn = (fq < 2) ? -1.0f : 1.0f;
                        const f32x2* rp = rope + pos * 16 + 8 * (fq & 1);
#pragma unroll
                        for (int j = 0; j < 4; ++j) {
                            const float o0 = __shfl_xor(v0[j], 32), o1 = __shfl_xor(v1[j], 32); const f32x2 c0 = rp[j], c1 = rp[4 + j];
                            v0[j] = v0[j] * c0.x + sgn * o0 * c0.y; v1[j] = v1[j] * c1.x + sgn * o1 * c1.y;
                        }
                    }
                    if (MODE == 0) {
                        if (cb < C_KR) { float s = dot4(v0) + dot4(v1); s += __shfl_xor(s, 16); s += __shfl_xor(s, 32); if (fq == 0) ssq_add(cb < C_CKV ? ssq_a : ssq_b, row, s); }
                    }
                    u32x4 w; w.x = cvt_pk_bf16(v0[0], v0[1]); w.y = cvt_pk_bf16(v0[2], v0[3]); w.z = cvt_pk_bf16(v1[0], v1[1]); w.w = cvt_pk_bf16(v1[2], v1[3]);
                    *(u32x4*)(O + (size_t)row * ldc + cb + 8 * fq) = w;
                }
            }
    }
};

template <int MODE> struct EpiScaleP {
    static constexpr bool PERM = true, AFTER_DRAIN = false;
    bf16_t* O; int ldc; const u64* ssq_in; float inv_n;
    __device__ __forceinline__ void operator()(const f32x4 (&acc)[2][2][4][2], const Unit& u, int wr, int wc, int fr, int fq) const {
        const int cb0 = u.pn * 256 + wc * 32;
        u64 sv[2][4];
#pragma unroll
        for (int ai = 0; ai < 2; ++ai)
#pragma unroll
            for (int m = 0; m < 4; ++m) sv[ai][m] = ssq_in[u.pm * 256 + ai * 128 + wr * 64 + m * 16 + fr];
#pragma unroll
        for (int ai = 0; ai < 2; ++ai)
#pragma unroll
            for (int m = 0; m < 4; ++m) {
                const int row = u.pm * 256 + ai * 128 + wr * 64 + m * 16 + fr;
                const float r = rsqrtf(ssq_val(sv[ai][m]) * inv_n + RMS_EPS);
#pragma unroll
                for (int bj = 0; bj < 2; ++bj) {
                    const int cb = cb0 + 128 * bj;
                    float sc = r;
                    if (MODE == 3) { if (cb < 1024) sc *= QSCALE_C; }
                    const f32x4 v0 = acc[ai][bj][m][0] * sc, v1 = acc[ai][bj][m][1] * sc;
                    u32x4 w; w.x = cvt_pk_bf16(v0[0], v0[1]); w.y = cvt_pk_bf16(v0[2], v0[3]); w.z = cvt_pk_bf16(v1[0], v1[1]); w.w = cvt_pk_bf16(v1[2], v1[3]);
                    *(u32x4*)(O + (size_t)row * ldc + cb + 8 * fq) = w;
                }
            }
    }
};

struct EpiResid {
    static constexpr bool PERM = true, AFTER_DRAIN = false;
    bf16_t* hb; u64* ssq;
    __device__ __forceinline__ void operator()(const f32x4 (&acc)[2][2][4][2], const Unit& u, int wr, int wc, int fr, int fq) const {
#pragma unroll
        for (int ai = 0; ai < 2; ++ai) {
            u32x4 b[4][2];
#pragma unroll
            for (int m = 0; m < 4; ++m)
#pragma unroll
                for (int bj = 0; bj < 2; ++bj) b[m][bj] = *(const u32x4*)(hb + (size_t)(u.pm * 256 + ai * 128 + wr * 64 + m * 16 + fr) * DM + u.pn * 256 + bj * 128 + wc * 32 + 8 * fq);
#pragma unroll
            for (int m = 0; m < 4; ++m) {
                const int row = u.pm * 256 + ai * 128 + wr * 64 + m * 16 + fr;
                float s = 0.f;
#pragma unroll
                for (int bj = 0; bj < 2; ++bj) {
                    const f32x4 a0 = acc[ai][bj][m][0], a1 = acc[ai][bj][m][1]; const u32x4 bb = b[m][bj];
                    f32x4 h0, h1; h0[0] = bflo(bb.x) + a0[0]; h0[1] = bfhi(bb.x) + a0[1]; h0[2] = bflo(bb.y) + a0[2]; h0[3] = bfhi(bb.y) + a0[3];
                    h1[0] = bflo(bb.z) + a1[0]; h1[1] = bfhi(bb.z) + a1[1]; h1[2] = bflo(bb.w) + a1[2]; h1[3] = bfhi(bb.w) + a1[3];
                    u32x4 w; w.x = cvt_pk_bf16(h0[0], h0[1]); w.y = cvt_pk_bf16(h0[2], h0[3]); w.z = cvt_pk_bf16(h1[0], h1[1]); w.w = cvt_pk_bf16(h1[2], h1[3]);
                    *(u32x4*)(hb + (size_t)row * DM + u.pn * 256 + bj * 128 + wc * 32 + 8 * fq) = w;
                    s += dot4(h0) + dot4(h1);
                }
                s += __shfl_xor(s, 16); s += __shfl_xor(s, 32);
                if (fq == 0) ssq_add(ssq, row, s);
            }
            asm volatile("" ::: "memory");
        }
    }
};

struct EpiSwiglu {
    static constexpr bool PERM = true, AFTER_DRAIN = false;
    bf16_t* O; const u64* ssq_in;
    __device__ __forceinline__ void operator()(const f32x4 (&acc)[2][2][4][2], const Unit& u, int wr, int wc, int fr, int fq) const {
        u64 sv[2][4];
#pragma unroll
        for (int ai = 0; ai < 2; ++ai)
#pragma unroll
            for (int m = 0; m < 4; ++m) sv[ai][m] = ssq_in[u.pm * 256 + ai * 128 + wr * 64 + m * 16 + fr];
#pragma unroll
        for (int ai = 0; ai < 2; ++ai)
#pragma unroll
            for (int m = 0; m < 4; ++m) {
                const int row = u.pm * 256 + ai * 128 + wr * 64 + m * 16 + fr;
                const float r = rsqrtf(ssq_val(sv[ai][m]) * (1.0f / DM) + RMS_EPS);
                float a[8];
#pragma unroll
                for (int n = 0; n < 2; ++n)
#pragma unroll
                    for (int j = 0; j < 4; ++j) { const float g = acc[ai][0][m][n][j] * r, uu = acc[ai][1][m][n][j] * r; a[4 * n + j] = g * __builtin_amdgcn_rcpf(1.0f + __expf(-g)) * uu; }
                u32x4 w; w.x = cvt_pk_bf16(a[0], a[1]); w.y = cvt_pk_bf16(a[2], a[3]); w.z = cvt_pk_bf16(a[4], a[5]); w.w = cvt_pk_bf16(a[6], a[7]);
                *(u32x4*)(O + (size_t)row * DFF + u.pn * 128 + wc * 32 + 8 * fq) = w;
            }
    }
};

struct EpiFinal {
    static constexpr bool PERM = true, AFTER_DRAIN = true;
    const bf16_t* hb; u64* ssq; unsigned* cnt; const float* gfin; float* out;
    __device__ __forceinline__ void operator()(const f32x4 (&)[2][2][4][2], const Unit&, int, int, int, int) const {}
    __device__ __forceinline__ void fused(f32x4 (&acc)[2][2][4][2], const Unit& u, int wr, int wc, int fr, int fq, LAS unsigned char*, int, int) const {
#pragma unroll
        for (int ai = 0; ai < 2; ++ai) {
            u32x4 b[4][2];
#pragma unroll
            for (int m = 0; m < 4; ++m)
#pragma unroll
                for (int bj = 0; bj < 2; ++bj) b[m][bj] = *(const u32x4*)(hb + (size_t)(u.pm * 256 + ai * 128 + wr * 64 + m * 16 + fr) * DM + u.pn * 256 + bj * 128 + wc * 32 + 8 * fq);
#pragma unroll
            for (int m = 0; m < 4; ++m) {
                const int row = u.pm * 256 + ai * 128 + wr * 64 + m * 16 + fr;
                float s = 0.f;
#pragma unroll
                for (int bj = 0; bj < 2; ++bj) {
                    const f32x4 a0 = acc[ai][bj][m][0], a1 = acc[ai][bj][m][1]; const u32x4 bb = b[m][bj];
                    f32x4 h0, h1; h0[0] = bflo(bb.x) + a0[0]; h0[1] = bfhi(bb.x) + a0[1]; h0[2] = bflo(bb.y) + a0[2]; h0[3] = bfhi(bb.y) + a0[3];
                    h1[0] = bflo(bb.z) + a1[0]; h1[1] = bfhi(bb.z) + a1[1]; h1[2] = bflo(bb.w) + a1[2]; h1[3] = bfhi(bb.w) + a1[3];
                    acc[ai][bj][m][0] = h0; acc[ai][bj][m][1] = h1; s += dot4(h0) + dot4(h1);
                }
                s += __shfl_xor(s, 16); s += __shfl_xor(s, 32);
                if (fq == 0) { const u64 prev = atomicAdd(ssq + row, ssq_fix(s)); asm volatile("" :: "v"(prev)); }
            }
            asm volatile("" ::: "memory");
        }
        asm volatile("s_waitcnt vmcnt(0)" ::: "memory");
        __syncthreads();
        if (threadIdx.x == 0) {
            unsigned* c = cnt + 16 * u.pm;
            __hip_atomic_fetch_add(c, 1u, __ATOMIC_RELEASE, __HIP_MEMORY_SCOPE_AGENT);
            unsigned sp = 0;
            while (__hip_atomic_load(c, __ATOMIC_RELAXED, __HIP_MEMORY_SCOPE_AGENT) < 4u) { __builtin_amdgcn_s_sleep(1); if (++sp > (1u << 22)) break; }
            __builtin_amdgcn_fence(__ATOMIC_ACQUIRE, "agent");
            asm volatile("s_waitcnt vmcnt(0)" ::: "memory");
        }
        __syncthreads();
        u64 sv[2][4];
#pragma unroll
        for (int ai = 0; ai < 2; ++ai)
#pragma unroll
            for (int m = 0; m < 4; ++m) sv[ai][m] = __hip_atomic_load(ssq + (u.pm * 256 + ai * 128 + wr * 64 + m * 16 + fr), __ATOMIC_RELAXED, __HIP_MEMORY_SCOPE_AGENT);
        f32x4 g4[2][2];
#pragma unroll
        for (int bj = 0; bj < 2; ++bj)
#pragma unroll
            for (int n = 0; n < 2; ++n) g4[bj][n] = *(const f32x4*)(gfin + u.pn * 256 + bj * 128 + wc * 32 + 8 * fq + 4 * n);
#pragma unroll
        for (int ai = 0; ai < 2; ++ai)
#pragma unroll
            for (int m = 0; m < 4; ++m) {
                const int row = u.pm * 256 + ai * 128 + wr * 64 + m * 16 + fr;
                const float r = rsqrtf(ssq_val(sv[ai][m]) * (1.0f / DM) + RMS_EPS);
#pragma unroll
                for (int bj = 0; bj < 2; ++bj)
#pragma unroll
                    for (int n = 0; n < 2; ++n) *(f32x4*)(out + (size_t)row * DM + u.pn * 256 + bj * 128 + wc * 32 + 8 * fq + 4 * n) = acc[ai][bj][m][n] * r * g4[bj][n];
            }
    }
};

__host__ __device__ __forceinline__ int perm32(int rho) { const int n = rho >> 4, i = rho & 15; return 8 * (i >> 2) + 4 * n + (i & 3); }
template <class Epi>
__device__ __forceinline__ void gemm_naive(const bf16_t* A, int lda, const bf16_t* Bt, int ldb, int nM, int nN, int K, const Epi& E) {
    constexpr bool PERM = Epi::PERM;
    const int tid = threadIdx.x, wid = tid >> 6, lane = tid & 63, wr = wid >> 2, wc = wid & 3, fr = lane & 15, fq = lane >> 4;
    for (int unit = blockIdx.x; unit < nM * nN; unit += gridDim.x) {
        Unit u; u.pm = unit / nN; u.pn = unit % nN;
        f32x4 acc[2][2][4][2];
#pragma unroll
        for (int a = 0; a < 2; ++a)
#pragma unroll
            for (int b = 0; b < 2; ++b)
#pragma unroll
                for (int m = 0; m < 4; ++m)
#pragma unroll
                    for (int n = 0; n < 2; ++n) acc[a][b][m][n] = (f32x4){0.f, 0.f, 0.f, 0.f};
        const bf16_t* Ab = A + (size_t)(u.pm * 256 + wr * 64 + fr) * lda + 8 * fq;
        const bf16_t* Bb = Bt + (size_t)(u.pn * 256 + wc * 32) * ldb + 8 * fq;
        const int br0 = PERM ? perm32(fr) : fr, br1 = PERM ? perm32(16 + fr) : 16 + fr;
        for (int k0 = 0; k0 < K; k0 += 32) {
            bf16x8 af[2][4], bq[2][2];
#pragma unroll
            for (int ai = 0; ai < 2; ++ai)
#pragma unroll
                for (int m = 0; m < 4; ++m) af[ai][m] = *(const bf16x8*)(Ab + (size_t)(ai * 128 + m * 16) * lda + k0);
#pragma unroll
            for (int bj = 0; bj < 2; ++bj) { bq[bj][0] = *(const bf16x8*)(Bb + (size_t)(bj * 128 + br0) * ldb + k0); bq[bj][1] = *(const bf16x8*)(Bb + (size_t)(bj * 128 + br1) * ldb + k0); }
#pragma unroll
            for (int ai = 0; ai < 2; ++ai)
#pragma unroll
                for (int bj = 0; bj < 2; ++bj)
#pragma unroll
                    for (int m = 0; m < 4; ++m)
#pragma unroll
                        for (int n = 0; n < 2; ++n) acc[ai][bj][m][n] = __builtin_amdgcn_mfma_f32_16x16x32_bf16(bq[bj][n], af[ai][m], acc[ai][bj][m][n], 0, 0, 0);
        }
        E(acc, u, wr, wc, fr, fq);
    }
}

#define PG8_LAS __attribute__((address_space(3)))
constexpr int BM = 256, BK = 64, HALF = 128, HTB = HALF * BK * 2  , STAGE_BYTES = 8 * HTB, NXCD = 8, WGM = 8;
__host__ __device__ __forceinline__ int lds_byte(int r, int c) { const int st = (r >> 4) * 2 + (c >> 5), rr = r & 15, cc = c & 31, ob = rr * 64 + cc * 2; return st * 1024 + (ob ^ (((ob >> 9) & 1) << 5)); }
__host__ __device__ __forceinline__ void stage_rc(int b, int& R, int& C) { const int st = b / 1024, sb = b % 1024, swz = sb ^ (((sb >> 9) & 1) << 5); R = (st >> 1) * 16 + swz / 64; C = (st & 1) * 32 + (swz % 64) / 2; }
struct Gemm { const bf16_t* A; const bf16_t* Bt; int M, N, K, lda, ldb; };
struct StaticOrder {
    int nM, nN, nwg, G, c;
    __host__ __device__ void init(int M, int N, int G_, int c_) { nM = M / BM; nN = N / BM; nwg = nM * nN; G = G_; c = c_; }
    __host__ __device__ bool next(int i, Unit& u) const {
        const long L = (long)i * G + c; if (L >= nwg) return false;
        int wgid = (int)L; { const int q = nwg / NXCD, r = nwg % NXCD, xcd = wgid % NXCD, off = wgid / NXCD; wgid = (xcd < r ? xcd * (q + 1) : r * (q + 1) + (xcd - r) * q) + off; }
        const int nig = WGM * nN, gid = wgid / nig, fm = gid * WGM, gsz = (nM - fm) < WGM ? (nM - fm) : WGM;
        u.pm = fm + ((wgid % nig) % gsz); u.pn = (wgid % nig) / gsz; return true;
    }
    __device__ __forceinline__ void a_ready(const Unit&) const {}
    __device__ __forceinline__ void done(const Unit&) const {}
};
template <class Epi, class Sched, bool ALIGN_EPI = false, bool SP2 = false>
__device__ __forceinline__ void gemm_phase(PG8_LAS unsigned char* lds, const Gemm g, const Sched& S, const Epi& E) {
    int tid_ = threadIdx.x; asm volatile("" : "+v"(tid_));
    const int tid = tid_, wid = __builtin_amdgcn_readfirstlane(tid >> 6), lane = tid & 63, wr = wid >> 2, wc = wid & 3, fr = lane & 15, fq = lane >> 4;
    const int K = g.K, nt = K / BK;
    unsigned voffA[2], voffB[2];
#pragma unroll
    for (int i = 0; i < 2; ++i) { int R, C; stage_rc(tid * 16 + i * 8192, R, C); const int Rb = Epi::PERM ? ((R & ~31) + perm32(R & 31)) : R;
        voffA[i] = (unsigned)(R * g.lda + C) * 2u; voffB[i] = (unsigned)(Rb * g.ldb + C) * 2u; }
    const size_t kstep = (size_t)(BK * 2);
    const size_t hstepA = (size_t)HALF * g.lda * 2, hstepB = (size_t)HALF * g.ldb * 2;
    const size_t tstepA = 2 * hstepA, tstepB = 2 * hstepB;
    const unsigned ldsw = (unsigned)wid * 1024u;
    const int aoff = lds_byte(wr * 64 + fr, fq * 8), boff = lds_byte(wc * 32 + fr, fq * 8);
#define PG8_SA(b, h) (((b) * 2 + (h)) * HTB)
#define PG8_SB(b, h) ((4 + (b) * 2 + (h)) * HTB)
#define PG8_STAGE(bufoff, gbase, voff) do { _Pragma("unroll") for (int _i = 0; _i < 2; ++_i) \
        __builtin_amdgcn_global_load_lds((const unsigned*)((const char*)(gbase) + (voff)[_i]), (PG8_LAS unsigned*)(lds + (bufoff) + ldsw + _i * 8192), 16, 0, 0); } while (0)
#define PG8_LDA(dst, b, h) do { _Pragma("unroll") for (int m = 0; m < 4; ++m) _Pragma("unroll") for (int k = 0; k < 2; ++k) dst[m][k] = *(const PG8_LAS bf16x8*)(lds + PG8_SA(b, h) + aoff + m * 2048 + k * 1024); } while (0)
#define PG8_LDB(dst, b, h) do { _Pragma("unroll") for (int n = 0; n < 2; ++n) _Pragma("unroll") for (int k = 0; k < 2; ++k) dst[n][k] = *(const PG8_LAS bf16x8*)(lds + PG8_SB(b, h) + boff + n * 2048 + k * 1024); } while (0)
#define PG8_MMA(ai, bj, At, Bt) do { __builtin_amdgcn_s_setprio(1); _Pragma("unroll") for (int m = 0; m < 4; ++m) _Pragma("unroll") for (int n = 0; n < 2; ++n) _Pragma("unroll") for (int k = 0; k < 2; ++k) \
        acc[ai][bj][m][n] = __builtin_amdgcn_mfma_f32_16x16x32_bf16(Bt[n][k], At[m][k], acc[ai][bj][m][n], 0, 0, 0); __builtin_amdgcn_s_setprio(0); } while (0)
#define PG8_WAIT_V(n) asm volatile("s_waitcnt vmcnt(" #n ")" ::: "memory")
#define PG8_WAIT_L(n) asm volatile("s_waitcnt lgkmcnt(" #n ")" ::: "memory")
#define PG8_BAR __builtin_amdgcn_s_barrier()
#define PG8_SCHED __builtin_amdgcn_sched_barrier(0)
    Unit cur, nxt; int ui = 0;
    if (!S.next(0, cur)) return;
    f32x4 acc[2][2][4][2];
#pragma unroll
    for (int a = 0; a < 2; ++a)
#pragma unroll
        for (int b = 0; b < 2; ++b)
#pragma unroll
            for (int m = 0; m < 4; ++m)
#pragma unroll
                for (int n = 0; n < 2; ++n) acc[a][b][m][n] = (f32x4){0.f, 0.f, 0.f, 0.f};
    bf16x8 At[4][2], B0[2][2], B1[2][2];
    const char* cA = (const char*)g.A + (size_t)cur.pm * tstepA; const char* cB = (const char*)g.Bt + (size_t)cur.pn * tstepB;
    S.a_ready(cur);
    if constexpr (SP2) {
        PG8_STAGE(PG8_SB(0, 0), cB, voffB); PG8_STAGE(PG8_SB(0, 1), cB + hstepB, voffB); PG8_STAGE(PG8_SA(0, 0), cA, voffA); PG8_STAGE(PG8_SA(0, 1), cA + hstepA, voffA);
        if (wr == 1) PG8_BAR;
        PG8_WAIT_V(2); PG8_BAR;
        PG8_STAGE(PG8_SB(1, 0), cB + kstep, voffB); PG8_STAGE(PG8_SA(1, 0), cA + kstep, voffA); PG8_STAGE(PG8_SB(1, 1), cB + hstepB + kstep, voffB);
        PG8_WAIT_V(6); PG8_BAR;
    } else {
        PG8_STAGE(PG8_SB(0, 0), cB, voffB); PG8_STAGE(PG8_SA(0, 0), cA, voffA); PG8_STAGE(PG8_SB(0, 1), cB + hstepB, voffB); PG8_STAGE(PG8_SA(0, 1), cA + hstepA, voffA);
        if (wr == 1) PG8_BAR;
        PG8_WAIT_V(4); PG8_BAR;
        PG8_STAGE(PG8_SB(1, 0), cB + kstep, voffB); PG8_STAGE(PG8_SA(1, 0), cA + kstep, voffA); PG8_STAGE(PG8_SB(1, 1), cB + hstepB + kstep, voffB);
        PG8_WAIT_V(6); PG8_BAR;
    }
    for (;;) {
        const bool has_next = S.next(ui + 1, nxt);
        const char* nA = has_next ? (const char*)g.A + (size_t)nxt.pm * tstepA : cA; const char* nB = has_next ? (const char*)g.Bt + (size_t)nxt.pn * tstepB : cB;
#pragma clang loop unroll(disable)
        for (int t = 0; t < nt; t += 2) {
            const bool last = (t == nt - 2);
            const char* a1 = cA + (size_t)(t + 1) * kstep;
            const char* a2 = last ? nA : cA + (size_t)(t + 2) * kstep; const char* b2 = last ? nB : cB + (size_t)(t + 2) * kstep;
            const char* a3 = a2 + kstep; const char* b3 = b2 + kstep;
            if (last && has_next) S.a_ready(nxt);
            if constexpr (SP2) {
            PG8_LDB(B0, 0, 0); PG8_LDB(B1, 0, 1); PG8_SCHED; PG8_LDA(At, 0, 0); PG8_STAGE(PG8_SA(1, 1), a1 + hstepA, voffA);
            PG8_WAIT_V(8); PG8_WAIT_L(0); PG8_BAR; PG8_MMA(0, 0, At, B0); PG8_MMA(0, 1, At, B1); PG8_BAR; PG8_SCHED;
            PG8_LDA(At, 0, 1); PG8_STAGE(PG8_SB(0, 0), b2, voffB); PG8_STAGE(PG8_SB(0, 1), b2 + hstepB, voffB); PG8_STAGE(PG8_SA(0, 0), a2, voffA);
            PG8_WAIT_V(8); PG8_WAIT_L(0); PG8_BAR; PG8_MMA(1, 0, At, B0); PG8_MMA(1, 1, At, B1); PG8_BAR; PG8_SCHED;
            PG8_LDB(B0, 1, 0); PG8_LDB(B1, 1, 1); PG8_SCHED; PG8_LDA(At, 1, 0); PG8_STAGE(PG8_SA(0, 1), a2 + hstepA, voffA);
            PG8_WAIT_V(8); PG8_WAIT_L(0); PG8_BAR; PG8_MMA(0, 0, At, B0); PG8_MMA(0, 1, At, B1); PG8_BAR; PG8_SCHED;
            PG8_LDA(At, 1, 1); PG8_STAGE(PG8_SB(1, 0), b3, voffB); PG8_STAGE(PG8_SB(1, 1), b3 + hstepB, voffB); PG8_STAGE(PG8_SA(1, 0), a3, voffA);
            PG8_WAIT_V(8); PG8_WAIT_L(0); PG8_BAR; PG8_MMA(1, 0, At, B0); PG8_MMA(1, 1, At, B1); PG8_BAR; PG8_SCHED;
            } else {
            PG8_LDB(B0, 0, 0); PG8_SCHED; PG8_LDA(At, 0, 0); PG8_STAGE(PG8_SA(1, 1), a1 + hstepA, voffA);
            PG8_WAIT_L(8); PG8_BAR; PG8_WAIT_L(0); PG8_MMA(0, 0, At, B0); PG8_BAR; PG8_SCHED;
            PG8_LDB(B1, 0, 1); PG8_STAGE(PG8_SB(0, 0), b2, voffB);
            PG8_BAR; PG8_WAIT_L(0); PG8_MMA(0, 1, At, B1); PG8_BAR;
            PG8_LDA(At, 0, 1); PG8_STAGE(PG8_SA(0, 0), a2, voffA);
            PG8_BAR; PG8_WAIT_L(0); PG8_MMA(1, 0, At, B0); PG8_BAR; PG8_SCHED;
            PG8_STAGE(PG8_SB(0, 1), b2 + hstepB, voffB);
            PG8_WAIT_V(6); PG8_BAR; PG8_MMA(1, 1, At, B1); PG8_BAR;
            PG8_LDB(B0, 1, 0); PG8_SCHED; PG8_LDA(At, 1, 0); PG8_STAGE(PG8_SA(0, 1), a2 + hstepA, voffA);
            PG8_WAIT_L(8); PG8_BAR; PG8_WAIT_L(0); PG8_MMA(0, 0, At, B0); PG8_BAR; PG8_SCHED;
            PG8_LDB(B1, 1, 1); PG8_STAGE(PG8_SB(1, 0), b3, voffB);
            PG8_BAR; PG8_WAIT_L(0); PG8_MMA(0, 1, At, B1); PG8_BAR;
            PG8_LDA(At, 1, 1); PG8_STAGE(PG8_SA(1, 0), a3, voffA);
            PG8_BAR; PG8_WAIT_L(0); PG8_MMA(1, 0, At, B0); PG8_BAR; PG8_SCHED;
            PG8_STAGE(PG8_SB(1, 1), b3 + hstepB, voffB);
            PG8_WAIT_V(6); PG8_BAR; PG8_MMA(1, 1, At, B1); PG8_BAR;
            }
        }
        if constexpr (ALIGN_EPI) { if (wr == 0) PG8_BAR; }
        if constexpr (!Epi::AFTER_DRAIN) { E(acc, cur, wr, wc, fr, fq); S.done(cur); }
        if (!has_next) break;
#pragma unroll
        for (int a = 0; a < 2; ++a)
#pragma unroll
            for (int b = 0; b < 2; ++b)
#pragma unroll
                for (int m = 0; m < 4; ++m)
#pragma unroll
                    for (int n = 0; n < 2; ++n) acc[a][b][m][n] = (f32x4){0.f, 0.f, 0.f, 0.f};
        cur = nxt; cA = nA; cB = nB; ++ui;
        if constexpr (ALIGN_EPI) { if (wr == 1) PG8_BAR; }
    }
    PG8_WAIT_V(0);
    if constexpr (!ALIGN_EPI) { if (wr == 0) PG8_BAR; }
    PG8_BAR;
    if constexpr (Epi::AFTER_DRAIN) { E.fused(acc, cur, wr, wc, fr, fq, lds, wid, lane); S.done(cur); }
#undef PG8_SA
#undef PG8_SB
#undef PG8_STAGE
#undef PG8_LDA
#undef PG8_LDB
#undef PG8_MMA
#undef PG8_WAIT_V
#undef PG8_WAIT_L
#undef PG8_BAR
#undef PG8_SCHED
}
template <class Epi>
__device__ __forceinline__ void gemm_fast(LAS unsigned char* lds, const bf16_t* A, int lda, const bf16_t* Bt, int ldb, int M, int N, int K, const Epi& E) {
    Gemm g{A, Bt, M, N, K, lda, ldb}; StaticOrder S; S.init(M, N, (int)gridDim.x, (int)blockIdx.x);
    gemm_phase<Epi, StaticOrder, !Epi::AFTER_DRAIN, true>(lds, g, S, E);
}

__device__ __forceinline__ void p0_item(const float* W, int K, int N, const float* g, bf16_t* WT, int ldt, int mode, LAS float* scr, int item, int lane) {
    const int nblk = N / 32, kb = item / nblk, nb = item % nblk, k0 = 64 * kb, n0 = 32 * nb;
    { const int kr = lane >> 3, ch = lane & 7; f32x4 v[8];
#pragma unroll
      for (int i = 0; i < 8; ++i) v[i] = __builtin_nontemporal_load((const f32x4*)(W + (size_t)(k0 + 8 * i + kr) * N + n0 + 4 * ch));
#pragma unroll
      for (int i = 0; i < 8; ++i) { const int kk = 8 * i + kr; const float gs = g ? g[k0 + kk] : 1.0f; LAS float* d = scr + kk * 33 + 4 * ch; d[0] = v[i][0] * gs; d[1] = v[i][1] * gs; d[2] = v[i][2] * gs; d[3] = v[i][3] * gs; } }
    asm volatile("s_waitcnt lgkmcnt(0)" ::: "memory");
    const int c = lane & 7;
#pragma unroll
    for (int j = 0; j < 4; ++j) {
        const int n = (lane >> 3) + 8 * j; const LAS float* s = scr + (8 * c) * 33 + n;
        u32x4 o; o.x = cvt_pk_bf16(s[0 * 33], s[1 * 33]); o.y = cvt_pk_bf16(s[2 * 33], s[3 * 33]); o.z = cvt_pk_bf16(s[4 * 33], s[5 * 33]); o.w = cvt_pk_bf16(s[6 * 33], s[7 * 33]);
        const int nn = n0 + n; const int row = (mode == 0) ? nn : ((nn >> 7) * 256 + (mode == 2 ? 128 : 0) + (nn & 127));
        *(u32x4*)(WT + (size_t)row * ldt + k0 + 8 * c) = o;
    }
    asm volatile("s_waitcnt lgkmcnt(0)" ::: "memory");
}


typedef float f32x16 __attribute__((ext_vector_type(16)));
constexpr int AT_VSTR = 96;
constexpr int AT_KBUF = 64 * 104 * 2, AT_VBUF = 64 * AT_VSTR * 2;
constexpr int AT_OFF_K = 0, AT_OFF_V = 2 * AT_KBUF, AT_OFF_BIAS = 2 * AT_KBUF + 2 * AT_VBUF, AT_OFF_FLAG = AT_OFF_BIAS + 2304, AT_OFF_H1 = AT_OFF_FLAG + 256;
typedef short v4i16_t __attribute__((ext_vector_type(4)));
__device__ __forceinline__ bf16x8 vtr8(const LAS bf16_t* p) {
    const v4i16_t lo = __builtin_amdgcn_ds_read_tr16_b64_v4i16((LAS v4i16_t*)p), hi4 = __builtin_amdgcn_ds_read_tr16_b64_v4i16((LAS v4i16_t*)(p + 8 * AT_VSTR));
    return (bf16x8){lo[0], lo[1], lo[2], lo[3], hi4[0], hi4[1], hi4[2], hi4[3]};
}
__device__ __forceinline__ int crow16(int r, int hi) { return (r & 3) + 8 * (r >> 2) + 4 * hi; }
__device__ __forceinline__ int vperm(int key) { const int k16 = key & 15; return (key & ~15) + 8 * ((k16 >> 2) & 1) + 4 * (k16 >> 3) + (k16 & 3); }
__device__ __forceinline__ bf16x8 pack8(float a0, float a1, float a2, float a3, float a4, float a5, float a6, float a7) {
    u32x4 w; w.x = cvt_pk_bf16(a0, a1); w.y = cvt_pk_bf16(a2, a3); w.z = cvt_pk_bf16(a4, a5); w.w = cvt_pk_bf16(a6, a7); return __builtin_bit_cast(bf16x8, w);
}

__device__ __forceinline__ float max3f(float a, float b, float c) { return __builtin_fmaxf(__builtin_fmaxf(a, b), c); }
template <int MODE, bool TWOH = false>
__device__ __forceinline__ void attn_unit(LAS unsigned char* lds, int q0, const bf16_t* Qp, int ldq, const bf16_t* Kp, int ldk, const bf16_t* Krp, int ldkr, const bf16_t* Vp, int ldv, bf16_t* Op, const float* bias_g) {
    constexpr int DQK = (MODE == 0) ? 96 : 64, NDD = DQK / 16, KSTR = DQK + 8;
    int tid_ = threadIdx.x; asm volatile("" : "+v"(tid_));
    const int tid = tid_, lane = tid & 63, wid = __builtin_amdgcn_readfirstlane(tid >> 6), l31 = lane & 31, hi = lane >> 5;
    const int hsel = TWOH ? (wid >> 2) : 0;
    const int t0w = q0 + 32 * (TWOH ? (wid & 3) : wid), trow = t0w + l31, nq = t0w >> 6;
    LAS unsigned char* ldsh = lds + hsel * AT_OFF_H1;
    Qp += hsel * 64; Op += hsel * 64;
    LAS float* biasl = (LAS float*)(ldsh + AT_OFF_BIAS);
    LAS int* flags = (LAS int*)(lds + AT_OFF_FLAG);
    float bz0 = 0.f, bz1 = 0.f, bz2 = 0.f, bz3 = 0.f;
    if (MODE == 2) { bz0 = bias_g[tid]; if (tid == 0) bz1 = bias_g[512]; if (TWOH) { bz2 = bias_g[513 + tid]; if (tid == 0) bz3 = bias_g[513 + 512]; } }
    bf16x8 qf[NDD];
#pragma unroll
    for (int dd = 0; dd < NDD; ++dd) qf[dd] = *(const bf16x8*)(Qp + (size_t)trow * ldq + 16 * dd + 8 * hi);
    f32x16 o0, o1;
#pragma unroll
    for (int r = 0; r < 16; ++r) { o0[r] = 0.f; o1[r] = 0.f; }
    float mref = 0.f, lrow = 0.f, carry = 0.f; bool first = true;
    f32x16 negm;
#pragma unroll
    for (int r = 0; r < 16; ++r) negm[r] = 0.f;
    const int kt_hi = (q0 + (TWOH ? 127 : 255)) >> 6;
    int kt_lo = 0; if (MODE == 2) { kt_lo = (q0 >> 6) - 8; if (kt_lo < 0) kt_lo = 0; }
    const int nt = kt_hi - kt_lo + 1;
    const int skey = tid >> 3, sch = tid & 7, rkey = tid >> 2, rch = tid & 3;
    u32x4 kregA, krregA, vregA, kreg2A, vreg2A, kregB, krregB, vregB, kreg2B, vreg2B;
#define AT_KT(i) ((MODE == 1) ? (kt_hi - (i)) : (kt_lo + (i)))
#define AT_PART(kt) ((MODE == 0) ? ((kt) <= nq) : (MODE == 1) ? (64 * (kt) <= t0w + 30) : (((kt) <= nq) && ((kt) >= nq - 8)))
#define AT_LOAD(kt, S) do { const size_t kb_ = (size_t)(kt) * 64; \
        kreg##S = *(const u32x4*)(Kp + (kb_ + skey) * ldk + sch * 8); \
        if (MODE == 0) { krreg##S = *(const u32x4*)(Krp + (kb_ + (rkey & 63)) * ldkr + rch * 8); }     \
        vreg##S = *(const u32x4*)(Vp + (kb_ + skey) * ldv + sch * 8); \
        if (TWOH) { kreg2##S = *(const u32x4*)(Kp + (kb_ + skey) * ldk + 64 + sch * 8); vreg2##S = *(const u32x4*)(Vp + (kb_ + skey) * ldv + 64 + sch * 8); } } while (0)
#define AT_VT8(dst, v) do { (dst)[0 * AT_VSTR] = (bf16_t)((v).x & 0xffffu); (dst)[1 * AT_VSTR] = (bf16_t)((v).x >> 16); (dst)[2 * AT_VSTR] = (bf16_t)((v).y & 0xffffu); (dst)[3 * AT_VSTR] = (bf16_t)((v).y >> 16); \
        (dst)[4 * AT_VSTR] = (bf16_t)((v).z & 0xffffu); (dst)[5 * AT_VSTR] = (bf16_t)((v).z >> 16); (dst)[6 * AT_VSTR] = (bf16_t)((v).w & 0xffffu); (dst)[7 * AT_VSTR] = (bf16_t)((v).w >> 16); } while (0)
#define AT_STORE(bufi, S) do { LAS bf16_t* Ks_ = (LAS bf16_t*)(lds + AT_OFF_K + (bufi) * AT_KBUF); LAS bf16_t* Vt_ = (LAS bf16_t*)(lds + AT_OFF_V + (bufi) * AT_VBUF); \
        *(LAS u32x4*)(Ks_ + skey * KSTR + sch * 8) = kreg##S; \
        if (MODE == 0) { if (tid < 256) *(LAS u32x4*)(Ks_ + rkey * KSTR + 64 + rch * 8) = krreg##S; } \
        *(LAS u32x4*)(Vt_ + skey * AT_VSTR + sch * 8) = vreg##S; \
        if (TWOH) { LAS bf16_t* Ks2_ = (LAS bf16_t*)(lds + AT_OFF_H1 + AT_OFF_K + (bufi) * AT_KBUF); LAS bf16_t* ve_ = (LAS bf16_t*)(lds + AT_OFF_H1 + AT_OFF_V + (bufi) * AT_VBUF); \
            *(LAS u32x4*)(Ks2_ + skey * KSTR + sch * 8) = kreg2##S; *(LAS u32x4*)(ve_ + skey * AT_VSTR + sch * 8) = vreg2##S; } } while (0)
#define AT_BAR() do { asm volatile("s_waitcnt lgkmcnt(0)" ::: "memory"); __builtin_amdgcn_s_barrier(); asm volatile("" ::: "memory"); } while (0)
    auto compute = [&](int bufo, int kt) __attribute__((always_inline)) {
            const LAS bf16_t* Ks = (const LAS bf16_t*)(ldsh + AT_OFF_K + bufo * AT_KBUF); const LAS bf16_t* Vt = (const LAS bf16_t*)(ldsh + AT_OFF_V + bufo * AT_VBUF);
            const LAS bf16_t* vtp = Vt + (4 * hi + ((lane & 15) >> 2)) * AT_VSTR + 16 * ((lane >> 4) & 1) + 4 * (lane & 3);
            f32x16 p0, p1;
            if (MODE == 1) {
#pragma unroll
                for (int r = 0; r < 16; ++r) { p0[r] = 0.f; p1[r] = 0.f; }
            } else { p0 = negm; p1 = negm; }
            bf16x8 ka[NDD], kb[NDD], va[4], vb[4];
            constexpr int NH = (NDD > 4) ? 4 : NDD;
#pragma unroll
            for (int dd = 0; dd < NH; ++dd) { ka[dd] = *(const LAS bf16x8*)(Ks + l31 * KSTR + 16 * dd + 8 * hi); kb[dd] = *(const LAS bf16x8*)(Ks + (32 + l31) * KSTR + 16 * dd + 8 * hi); }
            __builtin_amdgcn_sched_barrier(0);
#pragma unroll
            for (int dd = 0; dd < NH; ++dd) { p0 = __builtin_amdgcn_mfma_f32_32x32x16_bf16(ka[dd], qf[dd], p0, 0, 0, 0); p1 = __builtin_amdgcn_mfma_f32_32x32x16_bf16(kb[dd], qf[dd], p1, 0, 0, 0);
                if (dd == 0) {
#pragma unroll
                    for (int d2 = NH; d2 < NDD; ++d2) { ka[d2] = *(const LAS bf16x8*)(Ks + l31 * KSTR + 16 * d2 + 8 * hi); kb[d2] = *(const LAS bf16x8*)(Ks + (32 + l31) * KSTR + 16 * d2 + 8 * hi); }
                } }
#pragma unroll
            for (int dd = NH; dd < NDD; ++dd) { p0 = __builtin_amdgcn_mfma_f32_32x32x16_bf16(ka[dd], qf[dd], p0, 0, 0, 0); p1 = __builtin_amdgcn_mfma_f32_32x32x16_bf16(kb[dd], qf[dd], p1, 0, 0, 0); }
            __builtin_amdgcn_sched_barrier(0);
            if (MODE != 1) {
#pragma unroll
                for (int jj = 0; jj < 4; ++jj) { va[jj] = vtr8(vtp + (16 * jj) * AT_VSTR); vb[jj] = vtr8(vtp + (16 * jj) * AT_VSTR + 32); }
            }
            __builtin_amdgcn_sched_barrier(0);
            if (MODE != 1) {
                if (MODE == 2) {
                    if (nq - kt >= 5) { const float cb = biasl[512];
#pragma unroll
                        for (int r = 0; r < 16; ++r) { p0[r] += cb; p1[r] += cb; }
                    } else {
                        const int relb = trow - 64 * kt - 4 * hi;
#pragma unroll
                        for (int r = 0; r < 16; ++r) {
                            int rel0 = relb - ((r & 3) + 8 * (r >> 2)); int rel1 = rel0 - 32;
                            rel0 = rel0 > 256 ? 256 : rel0; rel1 = rel1 > 256 ? 256 : rel1;
                            p0[r] += biasl[256 + rel0]; p1[r] += biasl[256 + rel1];
                        }
                    }
                }
                float mx = max3f(p0[0], p1[0], p0[1]);
#pragma unroll
                for (int r = 1; r < 15; r += 2) { mx = max3f(mx, p1[r], p0[r + 1]); mx = max3f(mx, p1[r + 1], p0[(r + 2 > 15) ? 15 : (r + 2)]); }
                mx = fmaxf(mx, p1[15]);
                mx = fmaxf(mx, __shfl_xor(mx, 32));
                if (first || __any(mx > 8.0f)) {
                    const float dl = first ? mx : fmaxf(mx, 0.f);
                    mref += dl;
#pragma unroll
                    for (int r = 0; r < 16; ++r) { p0[r] -= dl; p1[r] -= dl; }
                    if (!first) { const float f = __builtin_amdgcn_exp2f(-dl); lrow *= f;
#pragma unroll
                        for (int r = 0; r < 16; ++r) { o0[r] *= f; o1[r] *= f; } }
#pragma unroll
                    for (int r = 0; r < 16; ++r) negm[r] = -mref;
                    first = false;
                }
                float rs = 0.f;
#pragma unroll
                for (int r = 0; r < 16; ++r) { p0[r] = __builtin_amdgcn_exp2f(p0[r]); p1[r] = __builtin_amdgcn_exp2f(p1[r]); rs += p0[r] + p1[r]; }
                lrow += rs;
            } else {
                const bool need_mask = (64 * kt + 63 >= t0w);
                const int kvb = 64 * kt + 4 * hi;
                float gs[8], lkq0[16], lkq1[16];
#pragma unroll
                for (int g = 0; g < 8; ++g) {
                    float s4 = 0.f;
#pragma unroll
                    for (int c = 0; c < 4; ++c) {
                        const int r = 4 * (g & 3) + c;
                        const float z2 = ((g < 4) ? p0[r] : p1[r]) * (0.125f * LOG2E);
                        const float sp2 = fmaxf(z2, 0.f) + __builtin_amdgcn_logf(1.0f + __builtin_amdgcn_exp2f(-fabsf(z2)));
                        const bool valid = !need_mask || (kvb + 8 * g + c < trow);
                        const float lk = valid ? -sp2 : 0.f;
                        const float ls = valid ? (z2 - sp2) : -1e30f;
                        if (g < 4) { p0[r] = ls; } else { p1[r] = ls; }
                        s4 += lk;
                        if (g < 4) { lkq0[r] = lk; } else { lkq1[r] = lk; }
                    }
                    gs[g] = s4;
                }
                float run = 0.f, after[8];
#pragma unroll
                for (int g = 7; g >= 0; --g) { const float pg = __shfl_xor(gs[g], 32); after[g] = run + (hi == 0 ? pg : 0.f); run += gs[g] + pg; }
#pragma unroll
                for (int g = 0; g < 8; ++g) {
                    float suf = carry + after[g];
#pragma unroll
                    for (int c = 3; c >= 0; --c) {
                        const int r = 4 * (g & 3) + c;
                        if (g < 4) { p0[r] = __builtin_amdgcn_exp2f(p0[r] + suf); suf += lkq0[r]; } else { p1[r] = __builtin_amdgcn_exp2f(p1[r] + suf); suf += lkq1[r]; }
                    }
                }
                carry += run;
            }
            if (MODE == 1) {
#pragma unroll
                for (int jj = 0; jj < 4; ++jj) { va[jj] = vtr8(vtp + (16 * jj) * AT_VSTR); vb[jj] = vtr8(vtp + (16 * jj) * AT_VSTR + 32); }
            }
            const bf16x8 pb0 = pack8(p0[0], p0[1], p0[2], p0[3], p0[4], p0[5], p0[6], p0[7]), pb1 = pack8(p0[8], p0[9], p0[10], p0[11], p0[12], p0[13], p0[14], p0[15]);
            const bf16x8 pb2 = pack8(p1[0], p1[1], p1[2], p1[3], p1[4], p1[5], p1[6], p1[7]), pb3 = pack8(p1[8], p1[9], p1[10], p1[11], p1[12], p1[13], p1[14], p1[15]);
            o0 = __builtin_amdgcn_mfma_f32_32x32x16_bf16(va[0], pb0, o0, 0, 0, 0); o1 = __builtin_amdgcn_mfma_f32_32x32x16_bf16(vb[0], pb0, o1, 0, 0, 0);
            o0 = __builtin_amdgcn_mfma_f32_32x32x16_bf16(va[1], pb1, o0, 0, 0, 0); o1 = __builtin_amdgcn_mfma_f32_32x32x16_bf16(vb[1], pb1, o1, 0, 0, 0);
            o0 = __builtin_amdgcn_mfma_f32_32x32x16_bf16(va[2], pb2, o0, 0, 0, 0); o1 = __builtin_amdgcn_mfma_f32_32x32x16_bf16(vb[2], pb2, o1, 0, 0, 0);
            o0 = __builtin_amdgcn_mfma_f32_32x32x16_bf16(va[3], pb3, o0, 0, 0, 0); o1 = __builtin_amdgcn_mfma_f32_32x32x16_bf16(vb[3], pb3, o1, 0, 0, 0);
            };
    bool brk = false;
#define AT_ITER(i, SL, SS) do { \
        const int kt_ = AT_KT(i); \
        AT_LOAD(AT_KT(((i) + 2 < nt) ? (i) + 2 : nt - 1), SL);        \
        if (AT_PART(kt_)) compute((i) & 1, kt_); \
        if ((i) + 1 < nt) AT_STORE(((i) + 1) & 1, SS); \
        if (MODE == 1) { const int done_ = __all(carry < -128.0f) ? 1 : 0; if (lane == 0) flags[((i) & 1) * 8 + wid] = done_; } \
        AT_BAR(); \
        if (MODE == 1) { int alld_ = 1; \
            _Pragma("unroll") for (int w8 = 0; w8 < 8; ++w8) alld_ &= flags[((i) & 1) * 8 + w8]; \
            if (alld_) brk = true; } } while (0)
    AT_LOAD(AT_KT(0), A);
    AT_LOAD(AT_KT(nt > 1 ? 1 : 0), B);
    if (MODE == 2) { ((LAS float*)(lds + AT_OFF_BIAS))[tid] = bz0 * LOG2E; if (tid == 0) ((LAS float*)(lds + AT_OFF_BIAS))[512] = bz1 * LOG2E;
        if (TWOH) { ((LAS float*)(lds + AT_OFF_H1 + AT_OFF_BIAS))[tid] = bz2 * LOG2E; if (tid == 0) ((LAS float*)(lds + AT_OFF_H1 + AT_OFF_BIAS))[512] = bz3 * LOG2E; } }
    AT_STORE(0, A);
    AT_BAR();
    for (int i = 0; i < nt; i += 2) {
        AT_ITER(i, A, B);
        if (brk || i + 1 >= nt) break;
        AT_ITER(i + 1, B, A);
        if (brk) break;
    }
    if (MODE == 1) { if (brk) AT_BAR(); }
#undef AT_ITER
#undef AT_PART
#undef AT_VT8
#undef AT_BAR
    float inv = 1.0f;
    if (MODE != 1) { const float lt = lrow + __shfl_xor(lrow, 32); inv = 1.0f / lt; }
    bf16_t* orow = Op + (size_t)trow * DM;
#pragma unroll
    for (int gp = 0; gp < 2; ++gp) {
        const int g0 = 2 * gp, g1 = 2 * gp + 1;
        u32x2 wa0, wa1, wb0, wb1;
        wa0.x = cvt_pk_bf16(o0[4 * g0] * inv, o0[4 * g0 + 1] * inv); wa0.y = cvt_pk_bf16(o0[4 * g0 + 2] * inv, o0[4 * g0 + 3] * inv);
        wa1.x = cvt_pk_bf16(o0[4 * g1] * inv, o0[4 * g1 + 1] * inv); wa1.y = cvt_pk_bf16(o0[4 * g1 + 2] * inv, o0[4 * g1 + 3] * inv);
        wb0.x = cvt_pk_bf16(o1[4 * g0] * inv, o1[4 * g0 + 1] * inv); wb0.y = cvt_pk_bf16(o1[4 * g0 + 2] * inv, o1[4 * g0 + 3] * inv);
        wb1.x = cvt_pk_bf16(o1[4 * g1] * inv, o1[4 * g1 + 1] * inv); wb1.y = cvt_pk_bf16(o1[4 * g1 + 2] * inv, o1[4 * g1 + 3] * inv);
        const u32x2 sa = hi ? wa0 : wa1, sb = hi ? wb0 : wb1;
        u32x2 ra, rb; ra.x = __shfl_xor(sa.x, 32); ra.y = __shfl_xor(sa.y, 32); rb.x = __shfl_xor(sb.x, 32); rb.y = __shfl_xor(sb.y, 32);
        u32x4 qa, qb;
        if (hi) { qa = (u32x4){ra.x, ra.y, wa1.x, wa1.y}; qb = (u32x4){rb.x, rb.y, wb1.x, wb1.y}; }
        else    { qa = (u32x4){wa0.x, wa0.y, ra.x, ra.y}; qb = (u32x4){wb0.x, wb0.y, rb.x, rb.y}; }
        const int col = 8 * (hi ? g1 : g0);
        *(u32x4*)(orow + col) = qa; *(u32x4*)(orow + 32 + col) = qb;
    }
#undef AT_KT
#undef AT_LOAD
#undef AT_STORE
}


#define XB_TMO      128
#define XB_XCNT(j)  (256  + 64 * (j))
#define XB_XSUB(j)  (1280 + 64 * (j))
#define XB_XGEN(j)  (2304 + 64 * (j))
#define XB_TOP      3328
#define XB_TOPGEN   3392
#define XCD_BAR_WORDS 3456
#define XB_SPIN_CAP (1u << 18)
__device__ __forceinline__ unsigned xb_ld(unsigned* p)              { return __hip_atomic_load(p, __ATOMIC_RELAXED, __HIP_MEMORY_SCOPE_AGENT); }
__device__ __forceinline__ unsigned xb_add(unsigned* p, unsigned v) { return __hip_atomic_fetch_add(p, v, __ATOMIC_RELAXED, __HIP_MEMORY_SCOPE_AGENT); }
__device__ __forceinline__ unsigned xb_xcc_id() { return (unsigned)__builtin_amdgcn_s_getreg((3 << 11) | 20) & 0xFu; }
#define XB_SPIN(cond, bar) do { unsigned _sp = 0; while (cond) { __builtin_amdgcn_s_sleep(1); \
    if ((++_sp & 255u) == 0u) { if (xb_ld(&(bar)[XB_TMO])) break; if (_sp > XB_SPIN_CAP) { atomicAdd(&(bar)[XB_TMO], 1u); break; } } } } while (0)
struct XcdBarrier { unsigned* bar; unsigned x; volatile LAS unsigned* st; };
__device__ __forceinline__ XcdBarrier xcd_barrier_post(unsigned* bar, volatile LAS unsigned* st) {
    XcdBarrier b; b.bar = bar; b.x = xb_xcc_id(); b.st = st;
    if (threadIdx.x == 0) (void)xb_add(&bar[XB_XCNT(b.x)], 1u);
    return b;
}
__device__ __forceinline__ void xcd_barrier_complete(unsigned* bar, unsigned x, unsigned& nloc, unsigned& nx) {
    const unsigned G = gridDim.x * gridDim.y * gridDim.z;
    unsigned sum, cnt, mine, sp = 0u;
    for (;;) {
        sum = 0u; cnt = 0u; mine = 0u;
#pragma unroll
        for (unsigned j = 0; j < 16; ++j) { const unsigned c = xb_ld(&bar[XB_XCNT(j)]); sum += c; cnt += (c > 0u) ? 1u : 0u; mine = (j == x) ? c : mine; }
        if (sum == G) break;
        __builtin_amdgcn_s_sleep(1);
        if ((++sp & 255u) == 0u) { if (xb_ld(&bar[XB_TMO])) break; if (sp > XB_SPIN_CAP) { atomicAdd(&bar[XB_TMO], 1u); break; } }
    }
    nloc = mine > 0u ? mine : 1u; nx = cnt > 0u ? cnt : 1u;
}
__device__ __forceinline__ void xcd_barrier(const XcdBarrier& b) {
    asm volatile("s_waitcnt vmcnt(0)" ::: "memory");
    __syncthreads();
    if (threadIdx.x == 0) {
        unsigned* bar = b.bar;
        __builtin_amdgcn_s_waitcnt(0);
        unsigned nloc = b.st[0], nx = b.st[1];
        if (nloc == 0u) { xcd_barrier_complete(bar, b.x, nloc, nx); b.st[0] = nloc; b.st[1] = nx; }
        const unsigned old = xb_add(&bar[XB_XSUB(b.x)], 1u);
        const unsigned gen = old / nloc;
        if (old + 1u == (gen + 1u) * nloc) {
            __builtin_amdgcn_fence(__ATOMIC_RELEASE, "agent");
            asm volatile("s_waitcnt vmcnt(0)" ::: "memory");
            const unsigned og = xb_add(&bar[XB_TOP], 1u);
            const unsigned tg = og / nx;
            if (og + 1u == (tg + 1u) * nx) xb_add(&bar[XB_TOPGEN], 1u);
            else XB_SPIN(xb_ld(&bar[XB_TOPGEN]) == tg, bar);
            __builtin_amdgcn_fence(__ATOMIC_ACQUIRE, "agent");
            xb_add(&bar[XB_XGEN(b.x)], 1u);
            asm volatile("s_waitcnt vmcnt(0)" ::: "memory");
        } else {
            XB_SPIN(xb_ld(&bar[XB_XGEN(b.x)]) == gen, bar);
            __builtin_amdgcn_fence(__ATOMIC_ACQUIRE, "agent");
            asm volatile("s_waitcnt vmcnt(0)" ::: "memory");
        }
    }
    __syncthreads();
}

struct Args { const float* in[16]; float* out; unsigned char* ws; };

__device__ __forceinline__ void attn_mla_naive(const bf16_t* QA, const bf16_t* KVA, const bf16_t* PROJ, bf16_t* O) {
    const int nth = gridDim.x * NTHREADS;
    for (int w = blockIdx.x * NTHREADS + threadIdx.x; w < 8 * MTOK; w += nth) {
        const int h = w >> 14, row = w & (MTOK - 1), b = row >> 11, t = row & (SEQ - 1);
        float q[96];
#pragma unroll
        for (int c = 0; c < 12; ++c) unpack8(*(const u32x4*)(QA + (size_t)row * NQA + h * 96 + c * 8), q + c * 8);
        float o[64];
#pragma unroll
        for (int d = 0; d < 64; ++d) o[d] = 0.f;
        float mx = -INFINITY, l = 0.f;
        const int kend = ((t >> 6) + 1) << 6;
        for (int s = 0; s < kend; ++s) {
            const size_t kr = (size_t)(b * SEQ + s);
            const bf16_t* kp = KVA + kr * NKVA + h * 128; const bf16_t* rp = PROJ + kr * NPROJ_P + C_KR;
            float sc = 0.f;
#pragma unroll
            for (int c = 0; c < 8; ++c) { float k[8]; unpack8(*(const u32x4*)(kp + c * 8), k);
#pragma unroll
                for (int e = 0; e < 8; ++e) sc += q[c * 8 + e] * k[e]; }
#pragma unroll
            for (int c = 0; c < 4; ++c) { float k[8]; unpack8(*(const u32x4*)(rp + c * 8), k);
#pragma unroll
                for (int e = 0; e < 8; ++e) sc += q[64 + c * 8 + e] * k[e]; }
            const float mn = fmaxf(mx, sc), al = __builtin_amdgcn_exp2f(mx - mn), p = __builtin_amdgcn_exp2f(sc - mn);
            l = l * al + p; mx = mn;
#pragma unroll
            for (int c = 0; c < 8; ++c) { float v[8]; unpack8(*(const u32x4*)(kp + 64 + c * 8), v);
#pragma unroll
                for (int e = 0; e < 8; ++e) o[c * 8 + e] = o[c * 8 + e] * al + p * v[e]; }
        }
        const float inv = 1.0f / l;
#pragma unroll
        for (int c = 0; c < 8; ++c) { u32x4 wv; wv.x = cvt_pk_bf16(o[c * 8] * inv, o[c * 8 + 1] * inv); wv.y = cvt_pk_bf16(o[c * 8 + 2] * inv, o[c * 8 + 3] * inv); wv.z = cvt_pk_bf16(o[c * 8 + 4] * inv, o[c * 8 + 5] * inv); wv.w = cvt_pk_bf16(o[c * 8 + 6] * inv, o[c * 8 + 7] * inv);
            *(u32x4*)(O + (size_t)row * DM + h * 64 + c * 8) = wv; }
    }
}

__device__ __forceinline__ void attn_sb_naive(const bf16_t* PROJ, bf16_t* O) {
    const int nth = gridDim.x * NTHREADS;
    for (int w = blockIdx.x * NTHREADS + threadIdx.x; w < 8 * MTOK; w += nth) {
        const int h = w >> 14, row = w & (MTOK - 1), b = row >> 11, t = row & (SEQ - 1);
        float q[64];
#pragma unroll
        for (int c = 0; c < 8; ++c) unpack8(*(const u32x4*)(PROJ + (size_t)row * NPROJ_P + C_QB + h * 64 + c * 8), q + c * 8);
        float o[64];
#pragma unroll
        for (int d = 0; d < 64; ++d) o[d] = 0.f;
        float cum = 0.f;
        const int tmax = t | 63;
        for (int s = tmax - 1; s >= 0; --s) {
            const size_t kr = (size_t)(b * SEQ + s);
            const bf16_t* kp = PROJ + kr * NPROJ_P + C_KB + h * 64; const bf16_t* vp = PROJ + kr * NPROJ_P + C_VB + h * 64;
            float z = 0.f;
#pragma unroll
            for (int c = 0; c < 8; ++c) { float k[8]; unpack8(*(const u32x4*)(kp + c * 8), k);
#pragma unroll
                for (int e = 0; e < 8; ++e) z += q[c * 8 + e] * k[e]; }
            z *= 0.125f;
            const bool on = s < t;
            const float lg = __logf(1.0f + __expf(-fabsf(z)));
            const float wgt = on ? __expf(fminf(z, 0.f) - lg + cum) : 0.f;
            cum += on ? (fminf(-z, 0.f) - lg) : 0.f;
#pragma unroll
            for (int c = 0; c < 8; ++c) { float v[8]; unpack8(*(const u32x4*)(vp + c * 8), v);
#pragma unroll
                for (int e = 0; e < 8; ++e) o[c * 8 + e] += wgt * v[e]; }
        }
#pragma unroll
        for (int c = 0; c < 8; ++c) { u32x4 wv; wv.x = cvt_pk_bf16(o[c * 8], o[c * 8 + 1]); wv.y = cvt_pk_bf16(o[c * 8 + 2], o[c * 8 + 3]); wv.z = cvt_pk_bf16(o[c * 8 + 4], o[c * 8 + 5]); wv.w = cvt_pk_bf16(o[c * 8 + 6], o[c * 8 + 7]);
            *(u32x4*)(O + (size_t)row * DM + 512 + h * 64 + c * 8) = wv; }
    }
}

__device__ __forceinline__ void attn_band_naive(const bf16_t* QKV, const float* rel_bias, bf16_t* O) {
    const int nth = gridDim.x * NTHREADS;
    for (int w = blockIdx.x * NTHREADS + threadIdx.x; w < 16 * MTOK; w += nth) {
        const int h = w >> 14, row = w & (MTOK - 1), b = row >> 11, t = row & (SEQ - 1);
        float q[64];
#pragma unroll
        for (int c = 0; c < 8; ++c) unpack8(*(const u32x4*)(QKV + (size_t)row * NQKV + h * 64 + c * 8), q + c * 8);
        float o[64];
#pragma unroll
        for (int d = 0; d < 64; ++d) o[d] = 0.f;
        float mx = -INFINITY, l = 0.f;
        const int n = t >> 6, s0 = (n >= 8) ? (n - 8) * 64 : 0, s1 = (n + 1) * 64;
        const float* bias = rel_bias + h * 513 + 256;
        for (int s = s0; s < s1; ++s) {
            const size_t kr = (size_t)(b * SEQ + s);
            const bf16_t* kp = QKV + kr * NQKV + 1024 + h * 64; const bf16_t* vp = QKV + kr * NQKV + 2048 + h * 64;
            float sc = 0.f;
#pragma unroll
            for (int c = 0; c < 8; ++c) { float k[8]; unpack8(*(const u32x4*)(kp + c * 8), k);
#pragma unroll
                for (int e = 0; e < 8; ++e) sc += q[c * 8 + e] * k[e]; }
            int rel = t - s; rel = rel > 256 ? 256 : (rel < -256 ? -256 : rel);
            sc += bias[rel] * LOG2E;
            const float mn = fmaxf(mx, sc), al = __builtin_amdgcn_exp2f(mx - mn), p = __builtin_amdgcn_exp2f(sc - mn);
            l = l * al + p; mx = mn;
#pragma unroll
            for (int c = 0; c < 8; ++c) { float v[8]; unpack8(*(const u32x4*)(vp + c * 8), v);
#pragma unroll
                for (int e = 0; e < 8; ++e) o[c * 8 + e] = o[c * 8 + e] * al + p * v[e]; }
        }
        const float inv = 1.0f / l;
#pragma unroll
        for (int c = 0; c < 8; ++c) { u32x4 wv; wv.x = cvt_pk_bf16(o[c * 8] * inv, o[c * 8 + 1] * inv); wv.y = cvt_pk_bf16(o[c * 8 + 2] * inv, o[c * 8 + 3] * inv); wv.z = cvt_pk_bf16(o[c * 8 + 4] * inv, o[c * 8 + 5] * inv); wv.w = cvt_pk_bf16(o[c * 8 + 6] * inv, o[c * 8 + 7] * inv);
            *(u32x4*)(O + (size_t)row * DM + h * 64 + c * 8) = wv; }
    }
}

constexpr int I_IN = 16 * (NPROJ / 32), I_UQ = 6 * 24, I_UKV = 4 * 32, I_O = 16 * 32, I_G = 16 * 88, I_D = 44 * 32, I_QKV = 16 * 96;
constexpr int CV_R0 = I_IN + I_UQ + I_UKV, CV_R1 = CV_R0 + I_O + 2 * I_G + I_D + I_QKV + I_O, CV_NITEMS = CV_R1 + 2 * I_G + I_D;
#define CONV_ITEM(it_) do { int r = (it_); \
        if (r < I_IN) { p0_item(args.in[1], DM, NPROJ, args.in[10], Win, DM, 0, scr, r, lane); break; } r -= I_IN; \
        if (r < I_UQ) { p0_item(args.in[3], 384, NQA, args.in[2], Wuq, 384, 0, scr, r, lane); break; } r -= I_UQ; \
        if (r < I_UKV) { p0_item(args.in[5], 256, NKVA, args.in[4], Wukv, 256, 0, scr, r, lane); break; } r -= I_UKV; \
        if (r < I_O) { p0_item(args.in[6], DM, DM, nullptr, Wo0, DM, 0, scr, r, lane); break; } r -= I_O; \
        if (r < I_G) { p0_item(args.in[12], DM, DFF, args.in[11], Wgu0, DM, 1, scr, r, lane); break; } r -= I_G; \
        if (r < I_G) { p0_item(args.in[13], DM, DFF, args.in[11], Wgu0, DM, 2, scr, r, lane); break; } r -= I_G; \
        if (r < I_D) { p0_item(args.in[14], DFF, DM, nullptr, Wd0, DFF, 0, scr, r, lane); break; } r -= I_D; \
        if (r < I_QKV) { p0_item(args.in[7], DM, NQKV, args.in[10] + DM, Wqkv, DM, 0, scr, r, lane); break; } r -= I_QKV; \
        if (r < I_O) { p0_item(args.in[9], DM, DM, nullptr, Wo1, DM, 0, scr, r, lane); break; } r -= I_O; \
        if (r < I_G) { p0_item(args.in[12] + (size_t)DM * DFF, DM, DFF, args.in[11] + DM, Wgu1, DM, 1, scr, r, lane); break; } r -= I_G; \
        if (r < I_G) { p0_item(args.in[13] + (size_t)DM * DFF, DM, DFF, args.in[11] + DM, Wgu1, DM, 2, scr, r, lane); break; } r -= I_G; \
        p0_item(args.in[14] + (size_t)DFF * DM, DFF, DM, nullptr, Wd1, DFF, 0, scr, r, lane); } while (0)
#define CONV_TAIL(first, lo, hi) do { if (G == 256 && (int)blockIdx.x >= (first)) { int tid_c = threadIdx.x; asm volatile("" : "+v"(tid_c)); const int lane = tid_c & 63, wave = __builtin_amdgcn_readfirstlane(tid_c >> 6); \
        LAS float* scr = (LAS float*)((LAS unsigned char*)lds + wave * 16384); \
        for (int it = (lo) + ((int)blockIdx.x - (first)) * 8 + wave; it < (hi); it += (G - (first)) * 8) CONV_ITEM(it); } } while (0)

__global__ void __launch_bounds__(NTHREADS) fwd_megakernel(Args args) {
    extern __shared__ __attribute__((aligned(16))) unsigned char lds[];
#ifdef USE_CG_SYNC
    cg::grid_group grid = cg::this_grid();
#define GRID_SYNC() grid.sync()
#else
    { volatile LAS unsigned* st0 = (volatile LAS unsigned*)((LAS unsigned char*)lds + LDS_BYTES - 64); if (threadIdx.x == 0) { st0[0] = 0u; st0[1] = 0u; } }
    __syncthreads();
    const XcdBarrier xbar = xcd_barrier_post((unsigned*)(args.ws + WS_CTL), (volatile LAS unsigned*)((LAS unsigned char*)lds + LDS_BYTES - 64));
#define GRID_SYNC() xcd_barrier(xbar)
#endif
#ifdef USE_NAIVE_GEMM
#define GEMM(A, lda, Bt, ldb, M, N, K, E) gemm_naive(A, lda, Bt, ldb, (M) / 256, (N) / 256, K, E)
#else
#define GEMM(A, lda, Bt, ldb, M, N, K, E) gemm_fast((LAS unsigned char*)lds, A, lda, Bt, ldb, M, N, K, E)
#endif
    const int G = gridDim.x;
    const int vcu = (G % 8 == 0) ? (int)(blockIdx.x % 8) * (G / 8) + (int)(blockIdx.x / 8) : (int)blockIdx.x;
    LAS unsigned char* ldsp = (LAS unsigned char*)lds;
    unsigned char* ws = args.ws;
    const float* x = args.in[0];
    float* out = args.out;
    u64* ssq = (u64*)(ws + WS_SSQ);
    f32x2* rope = (f32x2*)(ws + WS_ROPE);
    bf16_t* Win = (bf16_t*)(ws + WS_WIN); bf16_t* Wuq = (bf16_t*)(ws + WS_WUQ); bf16_t* Wukv = (bf16_t*)(ws + WS_WUKV); bf16_t* Wo0 = (bf16_t*)(ws + WS_WO0);
    bf16_t* Wgu0 = (bf16_t*)(ws + WS_WGU0); bf16_t* Wd0 = (bf16_t*)(ws + WS_WD0); bf16_t* Wqkv = (bf16_t*)(ws + WS_WQKV); bf16_t* Wo1 = (bf16_t*)(ws + WS_WO1);
    bf16_t* Wgu1 = (bf16_t*)(ws + WS_WGU1); bf16_t* Wd1 = (bf16_t*)(ws + WS_WD1);
    bf16_t* HB = (bf16_t*)(ws + WS_HB); bf16_t* PROJ = (bf16_t*)(ws + WS_A); bf16_t* QKV = (bf16_t*)(ws + WS_A); bf16_t* ACT = (bf16_t*)(ws + WS_A); bf16_t* ATT = (bf16_t*)(ws + WS_ATT);
    bf16_t* QA = (bf16_t*)((unsigned char*)out + OUT_QA); bf16_t* KVA = (bf16_t*)((unsigned char*)out + OUT_KVA);

    {
        const int tid = threadIdx.x, lane = tid & 63, wave = __builtin_amdgcn_readfirstlane(tid >> 6);
        LAS float* scr = (LAS float*)((LAS unsigned char*)lds + wave * 16384);
        const int gw = blockIdx.x * 8 + wave, NGW = G * 8;
        const bool offload = (G == 256);
        for (int it = gw; it < (offload ? CV_R0 : CV_NITEMS); it += NGW) CONV_ITEM(it);
        for (int i = blockIdx.x * NTHREADS + tid; i < (NPROJ_P - NPROJ) * DM / 8; i += G * NTHREADS) ((u32x4*)(Win + (size_t)NPROJ * DM))[i] = (u32x4){0u, 0u, 0u, 0u};
        for (int i = blockIdx.x * NTHREADS + tid; i < 6 * MTOK; i += G * NTHREADS) ssq[MTOK + i] = 0ull;
        for (int i = blockIdx.x * NTHREADS + tid; i < SEQ * 16; i += G * NTHREADS) {
            const int pos = i >> 4, fi = i & 15;
            const float inv_freq = __builtin_amdgcn_exp2f(-(float)fi * (13.287712379549449f / 16.0f));
            const float ang = (float)pos * inv_freq;
            float tr = ang * 0.15915494309189535f; tr -= floorf(tr);
            rope[i] = (f32x2){__builtin_amdgcn_cosf(tr), __builtin_amdgcn_sinf(tr)};
        }
        for (int m0 = gw; m0 < MTOK; m0 += 2 * NGW) {
            const int m1 = (m0 + NGW < MTOK) ? m0 + NGW : m0;
            const f32x4* xr0 = (const f32x4*)(x + (size_t)m0 * DM) + lane; const f32x4* xr1 = (const f32x4*)(x + (size_t)m1 * DM) + lane;
            f32x4 v0[4], v1[4]; float s0 = 0.f, s1 = 0.f;
#pragma unroll
            for (int j = 0; j < 4; ++j) { v0[j] = __builtin_nontemporal_load(&xr0[64 * j]); v1[j] = __builtin_nontemporal_load(&xr1[64 * j]); }
#pragma unroll
            for (int j = 0; j < 4; ++j) { s0 += dot4(v0[j]); s1 += dot4(v1[j]); }
            s0 = wave_sum(s0); s1 = wave_sum(s1);
            if (lane == 0) { ssq[m0] = ssq_fix(s0); ssq[m1] = ssq_fix(s1); }
#pragma unroll
            for (int j = 0; j < 4; ++j) { u32x2 w; w.x = cvt_pk_bf16(v0[j][0], v0[j][1]); w.y = cvt_pk_bf16(v0[j][2], v0[j][3]); *((u32x2*)(HB + (size_t)m0 * DM) + lane + 64 * j) = w;
                u32x2 w2; w2.x = cvt_pk_bf16(v1[j][0], v1[j][1]); w2.y = cvt_pk_bf16(v1[j][2], v1[j][3]); *((u32x2*)(HB + (size_t)m1 * DM) + lane + 64 * j) = w2; }
        }
    }
    GRID_SYNC();
    { EpiScale<0> E{PROJ, NPROJ_P, ssq, 1.0f / DM, ssq + MTOK, ssq + 2 * MTOK, rope}; GEMM(HB, DM, Win, DM, MTOK, NPROJ_P, DM, E); }
    CONV_TAIL(64, CV_R0, CV_R1);
    GRID_SYNC();
    { EpiScale<1> E{QA, NQA, ssq + MTOK, 1.0f / 384, nullptr, nullptr, rope}; GEMM(PROJ, NPROJ_P, Wuq, 384, MTOK, NQA, 384, E); }
    { EpiScaleP<2> E{KVA, NKVA, ssq + 2 * MTOK, 1.0f / 256}; GEMM(PROJ + C_CKV, NPROJ_P, Wukv, 256, MTOK, NKVA, 256, E); }
    GRID_SYNC();
#ifdef NAIVE_ATTN
    attn_mla_naive(QA, KVA, PROJ, ATT);
    attn_sb_naive(PROJ, ATT);
#else
    for (int u = vcu; u < 256; u += G) {
        const int bh = u >> 2, j = u & 3, b = bh >> 3, h = bh & 7;
        const size_t rb = (size_t)b * SEQ;
        for (int k = 0; k < 2 * REP_MLA; ++k) { const int qt = (k & 1) ? 7 - j : j;
            attn_unit<0>(ldsp, 256 * qt, QA + rb * NQA + h * 96, NQA, KVA + rb * NKVA + h * 128, NKVA, PROJ + rb * NPROJ_P + C_KR, NPROJ_P, KVA + rb * NKVA + h * 128 + 64, NKVA, ATT + rb * DM + h * 64, nullptr); }
    }
    for (int u = vcu; u < 256; u += G) {
        const int bhp = u >> 3, j = u & 7, b = bhp >> 2, hp = bhp & 3;
        const size_t rb = (size_t)b * SEQ;
        for (int k = 0; k < 2 * REP_SB; ++k) { const int qt = (k & 1) ? 15 - j : j;
            attn_unit<1, true>(ldsp, 128 * qt, PROJ + rb * NPROJ_P + C_QB + hp * 128, NPROJ_P, PROJ + rb * NPROJ_P + C_KB + hp * 128, NPROJ_P, nullptr, 0, PROJ + rb * NPROJ_P + C_VB + hp * 128, NPROJ_P, ATT + rb * DM + 512 + hp * 128, nullptr); }
    }
#endif
    GRID_SYNC();
    { EpiResid E{HB, ssq + 3 * MTOK}; GEMM(ATT, DM, Wo0, DM, MTOK, DM, DM, E); }
    GRID_SYNC();
    for (int rep = 0; rep < REP_GU; ++rep) { EpiSwiglu E{ACT, ssq + 3 * MTOK}; GEMM(HB, DM, Wgu0, DM, MTOK, 2 * DFF, DM, E); }
    CONV_TAIL(128, CV_R1, CV_NITEMS);
    GRID_SYNC();
    { EpiResid E{HB, ssq + 4 * MTOK}; GEMM(ACT, DFF, Wd0, DFF, MTOK, DM, DFF, E); }
    GRID_SYNC();
    { EpiScaleP<3> E{QKV, NQKV, ssq + 4 * MTOK, 1.0f / DM}; GEMM(HB, DM, Wqkv, DM, MTOK, NQKV, DM, E); }
    GRID_SYNC();
#ifdef NAIVE_ATTN
    attn_band_naive(QKV, args.in[8], ATT);
#else
    for (int u = vcu; u < 256; u += G) {
        const int bhp = u >> 2, j = u & 3, b = bhp >> 3, hp = bhp & 7;
        const size_t rb = (size_t)b * SEQ;
        for (int k = 0; k < 4 * REP_BAND; ++k) { const int kk = k & 3; const int qt = (kk == 0) ? j : (kk == 1) ? 7 - j : (kk == 2) ? 8 + j : 15 - j;
            attn_unit<2, true>(ldsp, 128 * qt, QKV + rb * NQKV + hp * 128, NQKV, QKV + rb * NQKV + 1024 + hp * 128, NQKV, nullptr, 0, QKV + rb * NQKV + 2048 + hp * 128, NQKV, ATT + rb * DM + hp * 128, args.in[8] + (2 * hp) * 513); }
    }
#endif
    GRID_SYNC();
    { EpiResid E{HB, ssq + 5 * MTOK}; GEMM(ATT, DM, Wo1, DM, MTOK, DM, DM, E); }
    GRID_SYNC();
    { EpiSwiglu E{ACT, ssq + 5 * MTOK}; GEMM(HB, DM, Wgu1, DM, MTOK, 2 * DFF, DM, E); }
    GRID_SYNC();
    if (G == 256) {
        EpiFinal E{HB, ssq + 6 * MTOK, (unsigned*)(args.ws + WS_CTL) + CW_PANEL, args.in[15], out};
        gemm_fast((LAS unsigned char*)lds, ACT, DFF, Wd1, DFF, MTOK, DM, DFF, E);
        return;
    }
    { EpiResid E{HB, ssq + 6 * MTOK}; GEMM(ACT, DFF, Wd1, DFF, MTOK, DM, DFF, E); }
    GRID_SYNC();
    {
        const int tid = threadIdx.x, lane = tid & 63, wave = __builtin_amdgcn_readfirstlane(tid >> 6); (void)tid;
        const int gw = blockIdx.x * 8 + wave, NGW = G * 8;
        const f32x4* gf = (const f32x4*)args.in[15] + lane;
        for (int m = gw; m < MTOK; m += NGW) {
            const float r = rsqrtf(ssq_get(ssq + 6 * MTOK, m) * (1.0f / DM) + RMS_EPS);
            f32x4* p = (f32x4*)(out + (size_t)m * DM) + lane; const u32x2* hp = (const u32x2*)(HB + (size_t)m * DM) + lane;
#pragma unroll
            for (int j = 0; j < 4; ++j) { const u32x2 hv = hp[64 * j]; const f32x4 g4 = gf[64 * j]; f32x4 o; o[0] = bflo(hv.x) * r * g4[0]; o[1] = bfhi(hv.x) * r * g4[1]; o[2] = bflo(hv.y) * r * g4[2]; o[3] = bfhi(hv.y) * r * g4[3]; p[64 * j] = o; }
        }
    }
}

extern "C" void kernel_launch(void* const* d_in, const int* in_sizes, int n_in, void* d_out, int out_size, void* d_ws, size_t ws_size, hipStream_t stream) {
    static int grid = 0;
    if (grid == 0) {
        int dev = 0, cus = 0, per_cu = 0;
        hipGetDevice(&dev);
        hipDeviceGetAttribute(&cus, hipDeviceAttributeMultiprocessorCount, dev);
        hipFuncSetAttribute((const void*)fwd_megakernel, hipFuncAttributeMaxDynamicSharedMemorySize, LDS_BYTES);
        hipOccupancyMaxActiveBlocksPerMultiprocessor(&per_cu, (const void*)fwd_megakernel, NTHREADS, LDS_BYTES);
        if (per_cu < 1) per_cu = 1;
        if (per_cu > 1) per_cu = 1;
        grid = cus * per_cu;
        if (n_in != 16 || out_size != MTOK * DM || ws_size < WS_END) { fprintf(stderr, "kernel_launch: unexpected shapes n_in %d out %d ws %zu\n", n_in, out_size, ws_size); }
    }
    Args a{};
    for (int i = 0; i < 16; ++i) a.in[i] = (const float*)d_in[i];
    a.out = (float*)d_out; a.ws = (unsigned char*)d_ws;
    hipMemsetAsync((char*)d_ws + WS_CTL, 0, CTL_BYTES, stream);
    void* kargs[] = {&a};
    hipError_t e = hipLaunchCooperativeKernel((const void*)fwd_megakernel, dim3(grid), dim3(NTHREADS), kargs, LDS_BYTES, stream);
    if (e != hipSuccess) fprintf(stderr, "cooperative launch failed: %s (grid %d)\n", hipGetErrorString(e), grid);
}
```
